# Optimizing an MI355X kernel written in HIP

```python
import math
import jax
import jax.numpy as jnp
from jax import lax
import numpy as np

D_MODEL = 2048
BATCH = 1
SEQ = 8192
DEPTH = 1

GLA_HEADS = 4
GLA_DK = 256
GLA_DV = 512
GLA_GATE_RANK = 16
GLA_GATE_TEMP = 16.0
GLA_CHUNK = 64
DSA_HEADS = 16
DSA_HEAD_DIM = 128
IDX_HEADS = 16
IDX_DIM = 64
DSA_TOPK = 256
DSA_QBLOCK = 128
MEM_LEN = 256
XATTN_HEADS = 4
XATTN_HEAD_DIM = D_MODEL // XATTN_HEADS
PEER_HEADS = 8
PEER_NKEYS = 128
PEER_NEXPERTS = PEER_NKEYS * PEER_NKEYS
PEER_KEY_DIM = 256
PEER_HALF = PEER_KEY_DIM // 2
PEER_TOPK = 16
PEER_BLOCK = 64
ROPE_THETA = 10000.0
RMS_EPS = 1e-6

IN_WIDTHS = (
    GLA_HEADS * GLA_DK,
    GLA_HEADS * GLA_DK,
    GLA_HEADS * GLA_DV,
    GLA_HEADS * GLA_DV,
    GLA_GATE_RANK,
    DSA_HEADS * DSA_HEAD_DIM,
    DSA_HEAD_DIM,
    DSA_HEAD_DIM,
    IDX_HEADS * IDX_DIM,
    IDX_DIM,
    IDX_HEADS,
    D_MODEL,
    D_MODEL,
)
IN_DIM = sum(IN_WIDTHS)

kernel_name = "hybrid_gla_dsa_peer_block"


def rms_norm(x, g):
    xf = x.astype(jnp.float32)
    y = xf * lax.rsqrt(jnp.mean(xf * xf, axis=-1, keepdims=True) + RMS_EPS)
    return (y * g.astype(jnp.float32)).astype(x.dtype)


def rope(x, pos):
    d = x.shape[-1]
    inv = ROPE_THETA ** (-jnp.arange(0, d, 2, dtype=jnp.float32) / d)
    ang = pos.astype(jnp.float32)[..., None] * inv
    cos = jnp.cos(ang)[:, :, None, :]
    sin = jnp.sin(ang)[:, :, None, :]
    xf = x.astype(jnp.float32)
    x1, x2 = xf[..., : d // 2], xf[..., d // 2:]
    out = jnp.concatenate([x1 * cos - x2 * sin, x2 * cos + x1 * sin], axis=-1)
    return out.astype(x.dtype)


def split_cols(p):
    points, acc = [], 0
    for w in IN_WIDTHS[:-1]:
        acc += w
        points.append(acc)
    return jnp.split(p, points, axis=-1)


def gla_chunked(q, k, v, log_a):
    B, S, H, dk = q.shape
    dv = v.shape[-1]
    C = GLA_CHUNK
    nc = S // C

    def to_chunks(t):
        return t.astype(jnp.float32).reshape(B, nc, C, H, -1).transpose(1, 0, 3, 2, 4)

    qc = to_chunks(q * (dk ** -0.5))
    kc, vc, gc = to_chunks(k), to_chunks(v), to_chunks(log_a)
    causal = jnp.tril(jnp.ones((C, C), dtype=bool))[None, None, :, :, None]

    def step(state, inp):
        qb, kb, vb, gb = inp
        b = jnp.cumsum(gb, axis=2)
        o_inter = jnp.einsum('bhcd,bhde->bhce', qb * jnp.exp(b), state)
        diff = jnp.where(causal, b[:, :, :, None, :] - b[:, :, None, :, :], -jnp.inf)
        attn = jnp.einsum('bhijd,bhjd->bhij', qb[:, :, :, None, :] * jnp.exp(diff), kb)
        o_intra = jnp.einsum('bhij,bhje->bhie', attn, vb)
        b_last = b[:, :, -1:, :]
        new_state = jnp.exp(b_last[:, :, 0, :])[..., None] * state + jnp.einsum(
            'bhjd,bhje->bhde', kb * jnp.exp(b_last - b), vb)
        return new_state, o_inter + o_intra

    s0 = jnp.zeros((B, H, dk, dv), jnp.float32)
    _, o = lax.scan(step, s0, (qc, kc, vc, gc))
    return o.transpose(1, 0, 3, 2, 4).reshape(B, S, H, dv).astype(q.dtype)


def dsa_attention(q, k, v, q_idx, k_idx, w_idx):
    B, S, H, dh = q.shape
    topk = min(DSA_TOPK, S // 4)
    QB = DSA_QBLOCK
    nblk = S // QB
    key_pos = jnp.arange(S)
    scale = dh ** -0.5

    def block(i):
        t0 = i * QB
        q_b = lax.dynamic_slice_in_dim(q, t0, QB, axis=1)
        qi_b = lax.dynamic_slice_in_dim(q_idx, t0, QB, axis=1)
        w_b = lax.dynamic_slice_in_dim(w_idx, t0, QB, axis=1)
        t_pos = t0 + jnp.arange(QB)
        s_idx = jnp.einsum('bqhd,bsd->bqhs', qi_b, k_idx).astype(jnp.float32) * (IDX_DIM ** -0.5)
        score = jnp.einsum('bqhs,bqh->bqs', jax.nn.relu(s_idx),
                           w_b.astype(jnp.float32)) * (IDX_HEADS ** -0.5)
        visible = key_pos[None, :] <= t_pos[:, None]
        score = jnp.where(visible[None], score, -jnp.inf)
        _, sel = lax.top_k(score, topk)
        k_sel = jax.vmap(lambda kk, ii: kk[ii])(k, sel)
        v_sel = jax.vmap(lambda vv, ii: vv[ii])(v, sel)
        valid = sel <= t_pos[None, :, None]
        logits = jnp.einsum('bqhd,bqkd->bhqk', q_b, k_sel).astype(jnp.float32) * scale
        logits = jnp.where(valid[:, None], logits, -jnp.inf)
        p = jax.nn.softmax(logits, axis=-1).astype(v.dtype)
        return jnp.einsum('bhqk,bqkd->bqhd', p, v_sel)

    out = lax.map(block, jnp.arange(nblk))
    return out.transpose(1, 0, 2, 3, 4).reshape(B, S, H, dh)


def memory_cross_attention(hn, memn, wq, wk, wv, wo):
    B, S, _ = hn.shape
    M = memn.shape[1]
    q = (hn @ wq).reshape(B, S, XATTN_HEADS, XATTN_HEAD_DIM)
    k = (memn @ wk).reshape(B, M, XATTN_HEADS, XATTN_HEAD_DIM)
    v = (memn @ wv).reshape(B, M, XATTN_HEADS, XATTN_HEAD_DIM)
    logits = jnp.einsum('bshd,bmhd->bhsm', q, k).astype(jnp.float32) * (XATTN_HEAD_DIM ** -0.5)
    p = jax.nn.softmax(logits, axis=-1).astype(v.dtype)
    o = jnp.einsum('bhsm,bmhd->bshd', p, v).reshape(B, S, XATTN_HEADS * XATTN_HEAD_DIM)
    return o @ wo


def peer_ffn(xn, wq, sub_keys, u_tab, v_tab):
    B, S, D = xn.shape
    q = (xn @ wq).reshape(B, S, PEER_HEADS, 2, PEER_HALF)
    s = jnp.einsum('bshpd,hpnd->bshpn', q, sub_keys).astype(jnp.float32)
    top_v, top_i = lax.top_k(s, PEER_TOPK)
    cand = (top_v[..., 0, :, None] + top_v[..., 1, None, :]).reshape(B, S, PEER_HEADS, PEER_TOPK * PEER_TOPK)
    cand_v, cand_i = lax.top_k(cand, PEER_TOPK)
    i1 = jnp.take_along_axis(top_i[..., 0, :], cand_i // PEER_TOPK, axis=-1)
    i2 = jnp.take_along_axis(top_i[..., 1, :], cand_i % PEER_TOPK, axis=-1)
    experts = i1 * PEER_NKEYS + i2
    gates = jax.nn.softmax(cand_v, axis=-1).astype(xn.dtype)
    T = B * S
    nb = T // PEER_BLOCK
    x_b = xn.reshape(nb, PEER_BLOCK, D)
    e_b = experts.reshape(nb, PEER_BLOCK, PEER_HEADS * PEER_TOPK)
    g_b = gates.reshape(nb, PEER_BLOCK, PEER_HEADS * PEER_TOPK)

    def block(args):
        xb, eb, gb = args
        act = jax.nn.gelu(jnp.einsum('td,tkd->tk', xb, u_tab[eb]))
        return jnp.einsum('tk,tkd->td', gb * act, v_tab[eb])

    out = lax.map(block, (x_b, e_b, g_b))
    return out.reshape(B, S, D)


def setup_inputs(seed: int = 0) -> dict:
    key = jax.random.key(seed)
    ks = jax.random.split(key, 24)
    f32 = jnp.float32
    D = D_MODEL
    L = DEPTH

    def nrm(k, shape, scale):
        return jax.random.normal(k, shape, f32) * scale

    def gain(k, shape):
        return 1.0 + 0.02 * jax.random.normal(k, shape, f32)

    return {
        "x": nrm(ks[0], (BATCH, SEQ, D), 1.0),
        "mem": nrm(ks[1], (BATCH, MEM_LEN, D), 1.0),
        "positions": jnp.broadcast_to(jnp.arange(SEQ, dtype=jnp.int32), (BATCH, SEQ)),
        "norm_mix_g": gain(ks[2], (L, D)),
        "w_in": nrm(ks[3], (L, D, IN_DIM), D ** -0.5),
        "gla_gate_w2": nrm(ks[4], (L, GLA_GATE_RANK, GLA_HEADS * GLA_DK), GLA_GATE_RANK ** -0.5),
        "gla_gate_b": nrm(ks[5], (L, GLA_HEADS * GLA_DK), 0.1),
        "gla_head_norm_g": gain(ks[6], (L, GLA_HEADS, GLA_DV)),
        "w_proj_gla": nrm(ks[7], (L, GLA_HEADS * GLA_DV, D), (GLA_HEADS * GLA_DV) ** -0.5),
        "w_proj_dsa": nrm(ks[8], (L, DSA_HEADS * DSA_HEAD_DIM, D), (DSA_HEADS * DSA_HEAD_DIM) ** -0.5),
        "w_out": nrm(ks[9], (L, D, D), D ** -0.5),
        "norm_x_g": gain(ks[10], (L, D)),
        "norm_mem_g": gain(ks[11], (L, D)),
        "w_xq": nrm(ks[12], (L, D, XATTN_HEADS * XATTN_HEAD_DIM), D ** -0.5),
        "w_xk": nrm(ks[13], (L, D, XATTN_HEADS * XATTN_HEAD_DIM), D ** -0.5),
        "w_xv": nrm(ks[14], (L, D, XATTN_HEADS * XATTN_HEAD_DIM), D ** -0.5),
        "w_xo": nrm(ks[15], (L, XATTN_HEADS * XATTN_HEAD_DIM, D), (XATTN_HEADS * XATTN_HEAD_DIM) ** -0.5),
        "norm_ffn_g": gain(ks[16], (L, D)),
        "peer_wq": nrm(ks[17], (L, D, PEER_HEADS * PEER_KEY_DIM), D ** -0.5),
        "peer_sub_keys": nrm(ks[18], (L, PEER_HEADS, 2, PEER_NKEYS, PEER_HALF), PEER_HALF ** -0.5),
        "peer_u": nrm(ks[19], (L, PEER_NEXPERTS, D), D ** -0.5),
        "peer_v": nrm(ks[20], (L, PEER_NEXPERTS, D), 0.5),
        "norm_final_g": gain(ks[21], (D,)),
    }


def reference(x, mem, positions, norm_mix_g, w_in, gla_gate_w2, gla_gate_b, gla_head_norm_g,
              w_proj_gla, w_proj_dsa, w_out, norm_x_g, norm_mem_g, w_xq, w_xk, w_xv, w_xo,
              norm_ffn_g, peer_wq, peer_sub_keys, peer_u, peer_v, norm_final_g):
    B, S, D = x.shape
    h = x
    for l in range(DEPTH):
        a = rms_norm(h, norm_mix_g[l])
        (g_q, g_k, g_v, g_r, g_low, d_q, d_k, d_v, i_q, i_k, i_w, gate_a, gate_b) = split_cols(a @ w_in[l])

        log_a = jax.nn.log_sigmoid((g_low @ gla_gate_w2[l] + gla_gate_b[l]).astype(jnp.float32)) / GLA_GATE_TEMP
        o_a = gla_chunked(g_q.reshape(B, S, GLA_HEADS, GLA_DK),
                          g_k.reshape(B, S, GLA_HEADS, GLA_DK),
                          g_v.reshape(B, S, GLA_HEADS, GLA_DV),
                          log_a.reshape(B, S, GLA_HEADS, GLA_DK))
        o_a = rms_norm(o_a, gla_head_norm_g[l]).reshape(B, S, GLA_HEADS * GLA_DV) * jax.nn.silu(g_r)
        y_a = o_a @ w_proj_gla[l]

        q_b = rope(d_q.reshape(B, S, DSA_HEADS, DSA_HEAD_DIM), positions)
        k_b = rope(d_k[:, :, None, :], positions)[:, :, 0, :]
        qi = rope(i_q.reshape(B, S, IDX_HEADS, IDX_DIM), positions)
        ki = rope(i_k[:, :, None, :], positions)[:, :, 0, :]
        o_b = dsa_attention(q_b, k_b, d_v, qi, ki, i_w).reshape(B, S, DSA_HEADS * DSA_HEAD_DIM)
        y_b = o_b @ w_proj_dsa[l]

        merged = jax.nn.sigmoid(gate_a) * y_a + jax.nn.sigmoid(gate_b) * y_b
        h = h + merged @ w_out[l]

        h = h + memory_cross_attention(rms_norm(h, norm_x_g[l]), rms_norm(mem, norm_mem_g[l]),
                                       w_xq[l], w_xk[l], w_xv[l], w_xo[l])

        h = h + peer_ffn(rms_norm(h, norm_ffn_g[l]), peer_wq[l], peer_sub_keys[l], peer_u[l], peer_v[l])
    return rms_norm(h, norm_final_g)
```

```cpp
#include <hip/hip_runtime.h>
#include <hip/hip_cooperative_groups.h>
#include <cstdio>
#include <cstdint>
namespace cg = cooperative_groups;

#define GAS __attribute__((address_space(1)))
#define LAS __attribute__((address_space(3)))
typedef unsigned short bf16_t;
typedef short bf16x8 __attribute__((ext_vector_type(8)));
typedef short s16x4 __attribute__((ext_vector_type(4)));
typedef float f32x4 __attribute__((ext_vector_type(4)));
typedef float f32x2 __attribute__((ext_vector_type(2)));
typedef unsigned u32x4 __attribute__((ext_vector_type(4)));
typedef unsigned u32x2 __attribute__((ext_vector_type(2)));
#define RLX_AGENT __ATOMIC_RELAXED, __HIP_MEMORY_SCOPE_AGENT
#define LDS_WAIT() asm volatile("s_waitcnt lgkmcnt(0)" ::: "memory")
#define VM_WAIT() asm volatile("s_waitcnt vmcnt(0)" ::: "memory")

__device__ __forceinline__ unsigned f2bf(float f) { unsigned u = __builtin_bit_cast(unsigned, f); return (u + 0x7fffu + ((u >> 16) & 1u)) >> 16; }
__device__ __forceinline__ unsigned pk2(float lo, float hi) { return f2bf(lo) | (f2bf(hi) << 16); }
__device__ __forceinline__ float bf2f(unsigned short b) { return __builtin_bit_cast(float, (unsigned)b << 16); }
__device__ __forceinline__ float bflo(unsigned w) { return __builtin_bit_cast(float, w << 16); }
__device__ __forceinline__ float bfhi(unsigned w) { return __builtin_bit_cast(float, w & 0xffff0000u); }
__device__ __forceinline__ float wave_sum(float v) {
#pragma unroll
    for (int o = 1; o < 64; o <<= 1) v += __shfl_xor(v, o);
    return v;
}
__device__ __forceinline__ float sigmoidf_(float x) { return 1.f / (1.f + __expf(-x)); }

namespace pg8 {
constexpr int BM = 256, BK = 64, HALF = 128, HTB = HALF * BK * 2, STAGE_BYTES = 8 * HTB, NXCD = 8, WGM = 8;
__host__ __device__ __forceinline__ int lds_byte(int r, int c) { const int st = (r >> 4) * 2 + (c >> 5), rr = r & 15, cc = c & 31, ob = rr * 64 + cc * 2; return st * 1024 + (ob ^ (((ob >> 9) & 1) << 5)); }
__host__ __device__ __forceinline__ void stage_rc(int b, int& R, int& C) { const int st = b / 1024, sb = b % 1024, swz = sb ^ (((sb >> 9) & 1) << 5); R = (st >> 1) * 16 + swz / 64; C = (st & 1) * 32 + (swz % 64) / 2; }
__host__ __device__ __forceinline__ int perm32(int rho) { const int n = rho >> 4, i = rho & 15; return 8 * (i >> 2) + 4 * n + (i & 3); }

struct Unit { int pm, pn; };
struct Gemm { const bf16_t* A; const bf16_t* Bt; int M, N, K, lda, ldb; };

struct StaticOrder {
    int nM, nN, nwg, G, c;
    __device__ void init(int M, int N, int G_, int c_) { nM = M / BM; nN = N / BM; nwg = nM * nN; G = G_; c = c_; }
    __device__ bool next(int i, Unit& u) const {
        const long L = (long)i * G + c; if (L >= nwg) return false;
        int wgid = (int)L; { const int q = nwg / NXCD, r = nwg % NXCD, xcd = wgid % NXCD, off = wgid / NXCD; wgid = (xcd < r ? xcd * (q + 1) : r * (q + 1) + (xcd - r) * q) + off; }
        const int nig = WGM * nN, gid = wgid / nig, fm = gid * WGM, gsz = (nM - fm) < WGM ? (nM - fm) : WGM;
        u.pm = fm + ((wgid % nig) % gsz); u.pn = (wgid % nig) / gsz; return true;
    }
};

__device__ __forceinline__ unsigned cvt_pk_bf16(float lo, float hi) { unsigned r; asm volatile("v_cvt_pk_bf16_f32 %0, %1, %2" : "=v"(r) : "v"(lo), "v"(hi)); return r; }

template <class Epi, bool ALIGN_EPI>
__device__ __forceinline__ void gemm_phase(LAS unsigned char* lds, const Gemm g, const StaticOrder& S, const Epi& E) {
    const int tid = threadIdx.x, wid = __builtin_amdgcn_readfirstlane(tid >> 6), lane = tid & 63, wr = wid >> 2, wc = wid & 3, fr = lane & 15, fq = lane >> 4;
    const int K = g.K, nt = K / BK;
    unsigned voffA[2], voffB[2];
#pragma unroll
    for (int i = 0; i < 2; ++i) { int R, C; stage_rc(tid * 16 + i * 8192, R, C); const int Rb = (R & ~31) + perm32(R & 31);
        voffA[i] = (unsigned)(R * g.lda + C) * 2u; voffB[i] = (unsigned)(Rb * g.ldb + C) * 2u; }
    const size_t kstep = (size_t)(BK * 2);
    const size_t hstepA = (size_t)HALF * g.lda * 2, hstepB = (size_t)HALF * g.ldb * 2;
    const size_t tstepA = 2 * hstepA, tstepB = 2 * hstepB;
    const unsigned ldsw = (unsigned)wid * 1024u;
    const int aoff = lds_byte(wr * 64 + fr, fq * 8), boff = lds_byte(wc * 32 + fr, fq * 8);
#define PG8_SA(b, h) (((b) * 2 + (h)) * HTB)
#define PG8_SB(b, h) ((4 + (b) * 2 + (h)) * HTB)
#define PG8_STAGE(bufoff, gbase, voff) do { _Pragma("unroll") for (int _i = 0; _i < 2; ++_i) \
        __builtin_amdgcn_global_load_lds((const unsigned*)((const char*)(gbase) + (voff)[_i]), (LAS unsigned*)(lds + (bufoff) + ldsw + _i * 8192), 16, 0, 0); } while (0)
#define PG8_LDA(dst, b, h) do { _Pragma("unroll") for (int m = 0; m < 4; ++m) _Pragma("unroll") for (int k = 0; k < 2; ++k) dst[m][k] = *(const LAS bf16x8*)(lds + PG8_SA(b, h) + aoff + m * 2048 + k * 1024); } while (0)
#define PG8_LDB(dst, b, h) do { _Pragma("unroll") for (int n = 0; n < 2; ++n) _Pragma("unroll") for (int k = 0; k < 2; ++k) dst[n][k] = *(const LAS bf16x8*)(lds + PG8_SB(b, h) + boff + n * 2048 + k * 1024); } while (0)
#define PG8_MMA(ai, bj, At, Bt) do { __builtin_amdgcn_s_setprio(1); _Pragma("unroll") for (int m = 0; m < 4; ++m) _Pragma("unroll") for (int n = 0; n < 2; ++n) _Pragma("unroll") for (int k = 0; k < 2; ++k) \
        acc[ai][bj][m][n] = __builtin_amdgcn_mfma_f32_16x16x32_bf16(Bt[n][k], At[m][k], acc[ai][bj][m][n], 0, 0, 0); __builtin_amdgcn_s_setprio(0); } while (0)
#define PG8_WAIT_V(n) asm volatile("s_waitcnt vmcnt(" #n ")" ::: "memory")
#define PG8_WAIT_L(n) asm volatile("s_waitcnt lgkmcnt(" #n ")" ::: "memory")
#define PG8_BAR __builtin_amdgcn_s_barrier()
#define PG8_SCHED __builtin_amdgcn_sched_barrier(0)
    Unit cur, nxt; int ui = 0;
    if (!S.next(0, cur)) return;
    f32x4 acc[2][2][4][2];
#pragma unroll
    for (int a = 0; a < 2; ++a)
#pragma unroll
        for (int b = 0; b < 2; ++b)
#pragma unroll
            for (int m = 0; m < 4; ++m)
#pragma unroll
                for (int n = 0; n < 2; ++n) acc[a][b][m][n] = (f32x4){0.f, 0.f, 0.f, 0.f};
    bf16x8 At[4][2], B0[2][2], B1[2][2];
    const char* cA = (const char*)g.A + (size_t)cur.pm * tstepA; const char* cB = (const char*)g.Bt + (size_t)cur.pn * tstepB;
    PG8_STAGE(PG8_SB(0, 0), cB, voffB); PG8_STAGE(PG8_SB(0, 1), cB + hstepB, voffB); PG8_STAGE(PG8_SA(0, 0), cA, voffA); PG8_STAGE(PG8_SA(0, 1), cA + hstepA, voffA);
    if (wr == 1) PG8_BAR;
    PG8_WAIT_V(2); PG8_BAR;
    PG8_STAGE(PG8_SB(1, 0), cB + kstep, voffB); PG8_STAGE(PG8_SA(1, 0), cA + kstep, voffA); PG8_STAGE(PG8_SB(1, 1), cB + hstepB + kstep, voffB);
    PG8_WAIT_V(6); PG8_BAR;
    for (;;) {
        const bool has_next = S.next(ui + 1, nxt);
        const char* nA = has_next ? (const char*)g.A + (size_t)nxt.pm * tstepA : cA; const char* nB = has_next ? (const char*)g.Bt + (size_t)nxt.pn * tstepB : cB;
        for (int t = 0; t < nt; t += 2) {
            const bool last = (t == nt - 2);
            const char* a1 = cA + (size_t)(t + 1) * kstep;
            const char* a2 = last ? nA : cA + (size_t)(t + 2) * kstep; const char* b2 = last ? nB : cB + (size_t)(t + 2) * kstep;
            const char* a3 = a2 + kstep; const char* b3 = b2 + kstep;
            PG8_LDB(B0, 0, 0); PG8_LDB(B1, 0, 1); PG8_SCHED; PG8_LDA(At, 0, 0); PG8_STAGE(PG8_SA(1, 1), a1 + hstepA, voffA);
            PG8_WAIT_V(8); PG8_WAIT_L(0); PG8_BAR; PG8_MMA(0, 0, At, B0); PG8_MMA(0, 1, At, B1); PG8_BAR; PG8_SCHED;
            PG8_LDA(At, 0, 1); PG8_STAGE(PG8_SB(0, 0), b2, voffB); PG8_STAGE(PG8_SB(0, 1), b2 + hstepB, voffB); PG8_STAGE(PG8_SA(0, 0), a2, voffA);
            PG8_WAIT_V(8); PG8_WAIT_L(0); PG8_BAR; PG8_MMA(1, 0, At, B0); PG8_MMA(1, 1, At, B1); PG8_BAR; PG8_SCHED;
            PG8_LDB(B0, 1, 0); PG8_LDB(B1, 1, 1); PG8_SCHED; PG8_LDA(At, 1, 0); PG8_STAGE(PG8_SA(0, 1), a2 + hstepA, voffA);
            PG8_WAIT_V(8); PG8_WAIT_L(0); PG8_BAR; PG8_MMA(0, 0, At, B0); PG8_MMA(0, 1, At, B1); PG8_BAR; PG8_SCHED;
            PG8_LDA(At, 1, 1); PG8_STAGE(PG8_SB(1, 0), b3, voffB); PG8_STAGE(PG8_SB(1, 1), b3 + hstepB, voffB); PG8_STAGE(PG8_SA(1, 0), a3, voffA);
            PG8_WAIT_V(8); PG8_WAIT_L(0); PG8_BAR; PG8_MMA(1, 0, At, B0); PG8_MMA(1, 1, At, B1); PG8_BAR; PG8_SCHED;
        }
        if constexpr (ALIGN_EPI) { if (wr == 0) PG8_BAR; }
        if constexpr (!Epi::AFTER_DRAIN) { E(acc, cur, wr, wc, fr, fq); }
        if (!has_next) break;
#pragma unroll
        for (int a = 0; a < 2; ++a)
#pragma unroll
            for (int b = 0; b < 2; ++b)
#pragma unroll
                for (int m = 0; m < 4; ++m)
#pragma unroll
                    for (int n = 0; n < 2; ++n) acc[a][b][m][n] = (f32x4){0.f, 0.f, 0.f, 0.f};
        cur = nxt; cA = nA; cB = nB; ++ui;
        if constexpr (ALIGN_EPI) { if (wr == 1) PG8_BAR; }
    }
    PG8_WAIT_V(0);
    if constexpr (!ALIGN_EPI) { if (wr == 0) PG8_BAR; }
    PG8_BAR;
    if constexpr (Epi::AFTER_DRAIN) { E.fused(acc, cur, wr, wc, fr, fq, lds, wid, lane); }
#undef PG8_SA
#undef PG8_SB
#undef PG8_STAGE
#undef PG8_LDA
#undef PG8_LDB
#undef PG8_MMA
#undef PG8_WAIT_V
#undef PG8_WAIT_L
#undef PG8_BAR
#undef PG8_SCHED
}
}
using pg8::Unit;

constexpr int SEQ = 8192, DM = 2048, MEM = 256;
constexpr int NIN = 13824;
constexpr float EPS = 1e-6f;
constexpr size_t MiB = 1u << 20;
constexpr size_t WS_CTL = 0, CTL_ZERO_BYTES = 1 * MiB;
constexpr size_t WS_MEMN = 1 * MiB, WS_XK = 2 * MiB, WS_XV = 3 * MiB, WS_DVEC = 4 * MiB, WS_KEYS = 5 * MiB, WS_IW = 6 * MiB;
constexpr size_t WS_WPA = 8 * MiB, WS_WPB = 16 * MiB, WS_WOUT = 24 * MiB, WS_WXQ = 32 * MiB, WS_WXK = 40 * MiB, WS_WXV = 48 * MiB, WS_WXO = 56 * MiB, WS_WPQ = 64 * MiB;
constexpr size_t WS_WIN = 72 * MiB, WS_A0 = 126 * MiB;
constexpr size_t WS_QT = 72 * MiB, WS_KHT = 88 * MiB, WS_VT = 104 * MiB, WS_ATT = 136 * MiB, WS_KBR = 140 * MiB, WS_VB = 142 * MiB, WS_KIR = 144 * MiB, WS_SEL = 145 * MiB, WS_WQK = 153 * MiB, WS_WVO = 157 * MiB;
constexpr size_t WS_GR = 162 * MiB, WS_DQ = 194 * MiB, WS_GATES = 226 * MiB, WS_MISC = 290 * MiB, WS_IQ = 298 * MiB, WS_GQK = 314 * MiB, WS_GV = 346 * MiB, WS_SCORES = 378 * MiB, WS_OA = 506 * MiB;
constexpr size_t WS_ST = 378 * MiB, WS_T1 = 314 * MiB, WS_MERGED = 346 * MiB, WS_A1 = 162 * MiB, WS_XP = 298 * MiB, WS_A2 = 194 * MiB, WS_PQ = 226 * MiB, WS_EXPI = 258 * MiB, WS_GATEW = 262 * MiB;
constexpr size_t WS_UB = 378 * MiB, WS_VBF = 442 * MiB, WS_END = 538 * MiB;
constexpr int CW_BAR = 4096;
constexpr int CW_RSQ1 = 65536, CW_RSQ2 = 65536 + 8192;
constexpr int MISC_LD = 512;

constexpr int RING_BYTES = 131072;
constexpr int LDSCTL_OFF = 147456 - 256;
constexpr int LDS_BYTES = 147456;
constexpr int NWAVES = 8, NTHREADS = 512;

__device__ __forceinline__ u32x4 pack8(const f32x4 v0, const f32x4 v1) { u32x4 w; w.x = pg8::cvt_pk_bf16(v0[0], v0[1]); w.y = pg8::cvt_pk_bf16(v0[2], v0[3]); w.z = pg8::cvt_pk_bf16(v1[0], v1[1]); w.w = pg8::cvt_pk_bf16(v1[2], v1[3]); return w; }

struct EpiRoute {
    static constexpr bool AFTER_DRAIN = false;
    unsigned char* ws;
    __device__ __forceinline__ void operator()(const f32x4 (&acc)[2][2][4][2], const Unit& u, int wr, int wc, int fr, int fq) const {
        const int pn = u.pn; bf16_t* base; int ldc, c0;
        if (pn < 8) { base = (bf16_t*)(ws + WS_GQK); ldc = 2048; c0 = pn * 256; }
        else if (pn < 16) { base = (bf16_t*)(ws + WS_GV); ldc = 2048; c0 = (pn - 8) * 256; }
        else if (pn < 24) { base = (bf16_t*)(ws + WS_GR); ldc = 2048; c0 = (pn - 16) * 256; }
        else if (pn < 32) { base = (bf16_t*)(ws + WS_DQ); ldc = 2048; c0 = (pn - 24) * 256; }
        else if (pn < 36) { base = (bf16_t*)(ws + WS_IQ); ldc = 1024; c0 = (pn - 32) * 256; }
        else if (pn < 52) { base = (bf16_t*)(ws + WS_GATES); ldc = 4096; c0 = (pn - 36) * 256; }
        else { base = (bf16_t*)(ws + WS_MISC); ldc = MISC_LD; c0 = (pn - 52) * 256; }
        const int row0 = u.pm * 256 + wr * 64 + fr, col0 = c0 + wc * 32 + 8 * fq;
#pragma unroll
        for (int ai = 0; ai < 2; ++ai)
#pragma unroll
            for (int m = 0; m < 4; ++m) { bf16_t* rowp = base + (size_t)(row0 + ai * 128 + m * 16) * ldc + col0;
#pragma unroll
                for (int bj = 0; bj < 2; ++bj) *(u32x4*)(rowp + bj * 128) = pack8(acc[ai][bj][m][0], acc[ai][bj][m][1]); }
    }
};
struct EpiBf16 {
    static constexpr bool AFTER_DRAIN = false;
    bf16_t* O; int ldc; const float* rowsq;
    __device__ __forceinline__ void operator()(const f32x4 (&acc)[2][2][4][2], const Unit& u, int wr, int wc, int fr, int fq) const {
        const int row0 = u.pm * 256 + wr * 64 + fr, col0 = u.pn * 256 + wc * 32 + 8 * fq;
#pragma unroll
        for (int ai = 0; ai < 2; ++ai)
#pragma unroll
            for (int m = 0; m < 4; ++m) { const int row = row0 + ai * 128 + m * 16; bf16_t* rowp = O + (size_t)row * ldc + col0;
                const float sc = rowsq ? rsqrtf(rowsq[row] * (1.f / DM) + EPS) : 1.f;
#pragma unroll
                for (int bj = 0; bj < 2; ++bj) *(u32x4*)(rowp + bj * 128) = pack8(acc[ai][bj][m][0] * sc, acc[ai][bj][m][1] * sc); }
    }
};
struct EpiGate {
    static constexpr bool AFTER_DRAIN = false;
    bf16_t* O; const bf16_t* gates; int goff; const bf16_t* prev;
    __device__ __forceinline__ void operator()(const f32x4 (&acc)[2][2][4][2], const Unit& u, int wr, int wc, int fr, int fq) const {
        const int row0 = u.pm * 256 + wr * 64 + fr, col0 = u.pn * 256 + wc * 32 + 8 * fq;
#pragma unroll
        for (int ai = 0; ai < 2; ++ai)
#pragma unroll
            for (int m = 0; m < 4; ++m) { const int row = row0 + ai * 128 + m * 16;
#pragma unroll
                for (int bj = 0; bj < 2; ++bj) { const int col = col0 + bj * 128;
                    const u32x4 gw = *(const u32x4*)(gates + (size_t)row * 4096 + goff + col);
                    f32x4 v0 = acc[ai][bj][m][0], v1 = acc[ai][bj][m][1];
                    v0[0] *= sigmoidf_(bflo(gw.x)); v0[1] *= sigmoidf_(bfhi(gw.x)); v0[2] *= sigmoidf_(bflo(gw.y)); v0[3] *= sigmoidf_(bfhi(gw.y));
                    v1[0] *= sigmoidf_(bflo(gw.z)); v1[1] *= sigmoidf_(bfhi(gw.z)); v1[2] *= sigmoidf_(bflo(gw.w)); v1[3] *= sigmoidf_(bfhi(gw.w));
                    if (prev) { const u32x4 pw = *(const u32x4*)(prev + (size_t)row * DM + col);
                        v0[0] += bflo(pw.x); v0[1] += bfhi(pw.x); v0[2] += bflo(pw.y); v0[3] += bfhi(pw.y); v1[0] += bflo(pw.z); v1[1] += bfhi(pw.z); v1[2] += bflo(pw.w); v1[3] += bfhi(pw.w); }
                    *(u32x4*)(O + (size_t)row * DM + col) = pack8(v0, v1); } }
    }
};
struct EpiResNorm {
    static constexpr bool AFTER_DRAIN = false;
    const float* base; float* out; bf16_t* An; const float* gain; float* rowsq;
    __device__ __forceinline__ void operator()(const f32x4 (&acc)[2][2][4][2], const Unit& u, int wr, int wc, int fr, int fq) const {
        const int row0 = u.pm * 256 + wr * 64 + fr, col0 = u.pn * 256 + wc * 32 + 8 * fq;
        f32x4 gv[2][2];
#pragma unroll
        for (int bj = 0; bj < 2; ++bj) { gv[bj][0] = *(const f32x4*)(gain + col0 + bj * 128); gv[bj][1] = *(const f32x4*)(gain + col0 + bj * 128 + 4); }
#pragma unroll
        for (int ai = 0; ai < 2; ++ai)
#pragma unroll
            for (int m = 0; m < 4; ++m) { const int row = row0 + ai * 128 + m * 16; float ss = 0.f;
#pragma unroll
                for (int bj = 0; bj < 2; ++bj) { const size_t off = (size_t)row * DM + col0 + bj * 128;
                    const f32x4 h0 = *(const f32x4*)(base + off) + acc[ai][bj][m][0], h1 = *(const f32x4*)(base + off + 4) + acc[ai][bj][m][1];
                    *(f32x4*)(out + off) = h0; *(f32x4*)(out + off + 4) = h1;
                    ss += (h0[0] * h0[0] + h0[1] * h0[1]) + (h0[2] * h0[2] + h0[3] * h0[3]) + (h1[0] * h1[0] + h1[1] * h1[1]) + (h1[2] * h1[2] + h1[3] * h1[3]);
                    *(u32x4*)(An + off) = pack8(h0 * gv[bj][0], h1 * gv[bj][1]); }
                ss += __shfl_xor(ss, 16); ss += __shfl_xor(ss, 32);
                if (fq == 0) atomicAdd(rowsq + row, ss); }
    }
};
struct EpiSoftmax {
    static constexpr bool AFTER_DRAIN = true;
    bf16_t* O; int ldc; const float* rowsq; float scale;
    __device__ __forceinline__ void fused(f32x4 (&acc)[2][2][4][2], const Unit& u, int wr, int wc, int fr, int fq, LAS unsigned char* lds, int wid, int lane) const {
        LAS f32x2* P = (LAS f32x2*)lds;
        float mxs[2][4];
#pragma unroll
        for (int ai = 0; ai < 2; ++ai)
#pragma unroll
            for (int m = 0; m < 4; ++m) { const int rl = ai * 128 + wr * 64 + m * 16 + fr; const int row = u.pm * 256 + rl;
                const float sc = rsqrtf(rowsq[row] * (1.f / DM) + EPS) * scale; float mx = -3.0e38f;
#pragma unroll
                for (int bj = 0; bj < 2; ++bj)
#pragma unroll
                    for (int n = 0; n < 2; ++n) { f32x4 x = acc[ai][bj][m][n] * sc; acc[ai][bj][m][n] = x; mx = fmaxf(mx, fmaxf(fmaxf(x[0], x[1]), fmaxf(x[2], x[3]))); }
                mx = fmaxf(mx, __shfl_xor(mx, 16)); mx = fmaxf(mx, __shfl_xor(mx, 32)); float s = 0.f;
#pragma unroll
                for (int bj = 0; bj < 2; ++bj)
#pragma unroll
                    for (int n = 0; n < 2; ++n) { f32x4 x = acc[ai][bj][m][n]; x[0] = __expf(x[0] - mx); x[1] = __expf(x[1] - mx); x[2] = __expf(x[2] - mx); x[3] = __expf(x[3] - mx); acc[ai][bj][m][n] = x; s += (x[0] + x[1]) + (x[2] + x[3]); }
                s += __shfl_xor(s, 16); s += __shfl_xor(s, 32); mxs[ai][m] = mx;
                if (fq == 0) P[rl * 4 + wc] = (f32x2){mx, s}; }
        __syncthreads();
        const int col0 = u.pn * 256 + wc * 32 + 8 * fq;
#pragma unroll
        for (int ai = 0; ai < 2; ++ai)
#pragma unroll
            for (int m = 0; m < 4; ++m) { const int rl = ai * 128 + wr * 64 + m * 16 + fr; const int row = u.pm * 256 + rl;
                const f32x2 a = P[rl * 4 + 0], b = P[rl * 4 + 1], c = P[rl * 4 + 2], d = P[rl * 4 + 3];
                const float M = fmaxf(fmaxf(a.x, b.x), fmaxf(c.x, d.x));
                const float Ssum = a.y * __expf(a.x - M) + b.y * __expf(b.x - M) + c.y * __expf(c.x - M) + d.y * __expf(d.x - M);
                const float f = __expf(mxs[ai][m] - M) / Ssum;
#pragma unroll
                for (int bj = 0; bj < 2; ++bj) *(u32x4*)(O + (size_t)row * ldc + col0 + bj * 128) = pack8(acc[ai][bj][m][0] * f, acc[ai][bj][m][1] * f); }
        __syncthreads();
    }
};

#define XB_TMO      128
#define XB_XCNT(j)  (256  + 64 * (j))
#define XB_XSUB(j)  (1280 + 64 * (j))
#define XB_XGEN(j)  (2304 + 64 * (j))
#define XB_TOP      3328
#define XB_TOPGEN   3392
#define XCD_BAR_WORDS 3456
#define XB_SPIN_CAP (1u << 20)
__device__ __forceinline__ unsigned xb_ld(unsigned* p)              { return __hip_atomic_load(p, __ATOMIC_RELAXED, __HIP_MEMORY_SCOPE_AGENT); }
__device__ __forceinline__ unsigned xb_add(unsigned* p, unsigned v) { return __hip_atomic_fetch_add(p, v, __ATOMIC_RELAXED, __HIP_MEMORY_SCOPE_AGENT); }
__device__ __forceinline__ unsigned xb_xcc_id() { return (unsigned)__builtin_amdgcn_s_getreg((3 << 11) | 20) & 0xFu; }
#define XB_SPIN(cond, bar) do { unsigned _sp = 0; while (cond) { __builtin_amdgcn_s_sleep(1); \
    if ((++_sp & 255u) == 0u) { if (xb_ld(&(bar)[XB_TMO])) break; if (_sp > XB_SPIN_CAP) { atomicAdd(&(bar)[XB_TMO], 1u); break; } } } } while (0)
struct XcdBarrier { unsigned* bar; unsigned x; volatile LAS unsigned* st; };
__device__ __forceinline__ XcdBarrier xcd_barrier_post(unsigned* bar, volatile LAS unsigned* st) {
    XcdBarrier b; b.bar = bar; b.x = xb_xcc_id(); b.st = st;
    if (threadIdx.x == 0) (void)xb_add(&bar[XB_XCNT(b.x)], 1u);
    return b;
}
__device__ __forceinline__ void xcd_barrier_complete(unsigned* bar, unsigned x, unsigned& nloc, unsigned& nx) {
    const unsigned G = gridDim.x * gridDim.y * gridDim.z;
    unsigned sum, cnt, mine, sp = 0u;
    for (;;) {
        sum = 0u; cnt = 0u; mine = 0u;
#pragma unroll
        for (unsigned j = 0; j < 16; ++j) { const unsigned c = xb_ld(&bar[XB_XCNT(j)]); sum += c; cnt += (c > 0u) ? 1u : 0u; mine = (j == x) ? c : mine; }
        if (sum == G) break;
        __builtin_amdgcn_s_sleep(1);
        if ((++sp & 255u) == 0u) { if (xb_ld(&bar[XB_TMO])) break; if (sp > XB_SPIN_CAP) { atomicAdd(&bar[XB_TMO], 1u); break; } }
    }
    nloc = mine > 0u ? mine : 1u; nx = cnt > 0u ? cnt : 1u;
}
__device__ __forceinline__ void xcd_barrier(const XcdBarrier& b) {
    asm volatile("s_waitcnt vmcnt(0)" ::: "memory");
    __syncthreads();
    if (threadIdx.x == 0) {
        unsigned* bar = b.bar;
        __builtin_amdgcn_s_waitcnt(0);
        unsigned nloc = b.st[0], nx = b.st[1];
        if (nloc == 0u) { xcd_barrier_complete(bar, b.x, nloc, nx); b.st[0] = nloc; b.st[1] = nx; }
        const unsigned old = xb_add(&bar[XB_XSUB(b.x)], 1u);
        const unsigned gen = old / nloc;
        if (old + 1u == (gen + 1u) * nloc) {
            __builtin_amdgcn_fence(__ATOMIC_RELEASE, "agent");
            asm volatile("s_waitcnt vmcnt(0)" ::: "memory");
            const unsigned og = xb_add(&bar[XB_TOP], 1u);
            const unsigned tg = og / nx;
            if (og + 1u == (tg + 1u) * nx) xb_add(&bar[XB_TOPGEN], 1u);
            else XB_SPIN(xb_ld(&bar[XB_TOPGEN]) == tg, bar);
            __builtin_amdgcn_fence(__ATOMIC_ACQUIRE, "agent");
            xb_add(&bar[XB_XGEN(b.x)], 1u);
            asm volatile("s_waitcnt vmcnt(0)" ::: "memory");
        } else {
            XB_SPIN(xb_ld(&bar[XB_XGEN(b.x)]) == gen, bar);
            __builtin_amdgcn_fence(__ATOMIC_ACQUIRE, "agent");
            asm volatile("s_waitcnt vmcnt(0)" ::: "memory");
        }
    }
    __syncthreads();
}

struct Args { const float* in[23]; float* out; unsigned char* ws; int ph_lo, ph_hi, use_bar, pad; };
struct Frame {
    LAS unsigned char* lds;
    int tid, lane, wave, G, bid;
    unsigned char* ws;
};

template <int MT, int NT>
__device__ __forceinline__ void wave_gemm_nt(const bf16_t* A, int lda, const bf16_t* B, int ldb, int K, f32x4 (&acc)[MT][NT], int fr, int fq) {
    for (int k0 = 0; k0 < K; k0 += 32) {
        bf16x8 a[MT], b[NT];
#pragma unroll
        for (int mt = 0; mt < MT; ++mt) a[mt] = *(const bf16x8*)(A + (size_t)(16 * mt + fr) * lda + k0 + 8 * fq);
#pragma unroll
        for (int nt = 0; nt < NT; ++nt) b[nt] = *(const bf16x8*)(B + (size_t)(16 * nt + fr) * ldb + k0 + 8 * fq);
#pragma unroll
        for (int mt = 0; mt < MT; ++mt)
#pragma unroll
            for (int nt = 0; nt < NT; ++nt) acc[mt][nt] = __builtin_amdgcn_mfma_f32_16x16x32_bf16(a[mt], b[nt], acc[mt][nt], 0, 0, 0);
    }
}

__device__ __forceinline__ int win_src_col(int n) {
    if (n < 6144) return n;
    if (n < 8192) return 6160 + (n - 6144);
    if (n < 9216) return 8464 + (n - 8192);
    if (n < 11264) return 9568 + (n - 9216);
    if (n < 13312) return 11616 + (n - 11264);
    const int m = n - 13312;
    if (m < 16) return 6144 + m;
    if (m < 32) return 9552 + (m - 16);
    if (m < 96) return 9488 + (m - 32);
    if (m < 128) return -1;
    if (m < 256) return 8208 + (m - 128);
    if (m < 384) return 8336 + (m - 256);
    return -1;
}
__device__ __forceinline__ void transpose_item(const float* W, int N, int K, bf16_t* WT, int drow0, int srccol, int k0, LAS float* scr, int lane) {
#pragma unroll 8
    for (int i = 0; i < 32; ++i) { const int kk = 2 * i + (lane >> 5); scr[kk * 33 + (lane & 31)] = srccol >= 0 ? W[(size_t)(k0 + kk) * N + srccol] : 0.f; }
    LDS_WAIT(); asm volatile("" ::: "memory");
    const int c = lane & 7;
#pragma unroll
    for (int j = 0; j < 4; ++j) { const int n = (lane >> 3) + 8 * j; const LAS float* s = scr + (8 * c) * 33 + n;
        u32x4 o; o.x = pk2(s[0 * 33], s[1 * 33]); o.y = pk2(s[2 * 33], s[3 * 33]); o.z = pk2(s[4 * 33], s[5 * 33]); o.w = pk2(s[6 * 33], s[7 * 33]);
        *(u32x4*)(WT + (size_t)(drow0 + n) * K + k0 + 8 * c) = o; }
    LDS_WAIT(); asm volatile("" ::: "memory");
}
__device__ __forceinline__ void rms_row_to_bf16(const float* xrow, const float* gain, bf16_t* orow, int lane) {
    const f32x4* xr = (const f32x4*)xrow + lane; const f32x4* gr = (const f32x4*)gain + lane;
    f32x4 v[8]; float s = 0.f;
#pragma unroll
    for (int j = 0; j < 8; ++j) { v[j] = xr[64 * j]; s += (v[j][0] * v[j][0] + v[j][1] * v[j][1]) + (v[j][2] * v[j][2] + v[j][3] * v[j][3]); }
    const float rstd = rsqrtf(wave_sum(s) * (1.f / DM) + EPS);
    u32x2* o8 = (u32x2*)orow + lane;
#pragma unroll
    for (int j = 0; j < 8; ++j) { const f32x4 g = gr[64 * j]; u32x2 w; w.x = pk2(v[j][0] * rstd * g[0], v[j][1] * rstd * g[1]); w.y = pk2(v[j][2] * rstd * g[2], v[j][3] * rstd * g[3]); o8[64 * j] = w; }
}
__device__ __forceinline__ void cvt_copy(const float* src, bf16_t* dst, size_t n, size_t gtid, size_t gthreads) {
    for (size_t i = gtid; i < n / 8; i += gthreads) { const f32x4 a = *((const f32x4*)src + 2 * i), b = *((const f32x4*)src + 2 * i + 1);
        u32x4 w; w.x = pk2(a[0], a[1]); w.y = pk2(a[2], a[3]); w.z = pk2(b[0], b[1]); w.w = pk2(b[2], b[3]); *((u32x4*)dst + i) = w; }
}
__device__ __forceinline__ void p0_prologue(const Frame& F, const Args& a) {
    LAS float* scr = (LAS float*)(F.lds + F.wave * 16384);
    const int gw = F.bid * NWAVES + F.wave, NGW = F.G * NWAVES;
    constexpr int I_IN = (NIN / 32) * (DM / 64), I_SQ = (DM / 32) * (DM / 64);
    for (int it = gw; it < I_IN + 7 * I_SQ; it += NGW) {
        if (it < I_IN) { const int nb = it / (DM / 64), kb = it % (DM / 64); const int n = nb * 32 + (F.lane & 31);
            transpose_item(a.in[4], 13664, DM, (bf16_t*)(F.ws + WS_WIN), nb * 32, win_src_col(n), kb * 64, scr, F.lane); }
        else { const int r = it - I_IN, mi = r / I_SQ, q = r % I_SQ, nb = q / (DM / 64), kb = q % (DM / 64);
            const float* W; size_t off;
            switch (mi) { case 0: W = a.in[8]; off = WS_WPA; break; case 1: W = a.in[9]; off = WS_WPB; break; case 2: W = a.in[10]; off = WS_WOUT; break;
                          case 3: W = a.in[14]; off = WS_WXK; break; case 4: W = a.in[15]; off = WS_WXV; break; case 5: W = a.in[16]; off = WS_WXO; break; default: W = a.in[18]; off = WS_WPQ; break; }
            transpose_item(W, DM, DM, (bf16_t*)(F.ws + off), nb * 32, nb * 32 + (F.lane & 31), kb * 64, scr, F.lane); }
    }
    const size_t gtid = (size_t)F.bid * NTHREADS + F.tid, gth = (size_t)F.G * NTHREADS;
    cvt_copy(a.in[13], (bf16_t*)(F.ws + WS_WXQ), (size_t)DM * DM, gtid, gth);
    cvt_copy(a.in[19], (bf16_t*)(F.ws + WS_KEYS), (size_t)16 * 128 * 128, gtid, gth);
    for (int m = gw; m < SEQ + MEM; m += NGW) {
        if (m < SEQ) rms_row_to_bf16(a.in[0] + (size_t)m * DM, a.in[3], (bf16_t*)(F.ws + WS_A0) + (size_t)m * DM, F.lane);
        else rms_row_to_bf16(a.in[1] + (size_t)(m - SEQ) * DM, a.in[12], (bf16_t*)(F.ws + WS_MEMN) + (size_t)(m - SEQ) * DM, F.lane);
    }
}

__device__ __forceinline__ void sincos_red(float ang, float& s, float& c) {
    const float n = rintf(ang * 0.15915494309189535f);
    float r = fmaf(-n, 6.28318548202514648f, ang); r = fmaf(-n, -1.7484556000744883e-07f, r);
    const float f = r * 0.15915494309189535f;
    s = __builtin_amdgcn_sinf(f); c = __builtin_amdgcn_cosf(f);
}
__device__ __forceinline__ void rope_token(const Frame& F, const Args& a, int t) {
    const int l = F.lane; const float pos = (float)((const int*)a.in[2])[t];
    bf16_t* DQ = (bf16_t*)(F.ws + WS_DQ) + (size_t)t * DM; bf16_t* IQ = (bf16_t*)(F.ws + WS_IQ) + (size_t)t * 1024; const bf16_t* MS = (const bf16_t*)(F.ws + WS_MISC) + (size_t)t * MISC_LD;
    float s1, c1, s2, c2;
    { const float inv = powf(10000.f, -(float)(2 * l) / 128.f); sincos_red(pos * inv, s1, c1); }
    { const float inv = powf(10000.f, -(float)(2 * (l & 31)) / 64.f); sincos_red(pos * inv, s2, c2); }
#pragma unroll 4
    for (int h = 0; h < 16; ++h) { const float x1 = bf2f(DQ[h * 128 + l]), x2 = bf2f(DQ[h * 128 + 64 + l]);
        DQ[h * 128 + l] = (bf16_t)f2bf(x1 * c1 - x2 * s1); DQ[h * 128 + 64 + l] = (bf16_t)f2bf(x2 * c1 + x1 * s1); }
    { const float x1 = bf2f(MS[128 + l]), x2 = bf2f(MS[128 + 64 + l]); bf16_t* kb = (bf16_t*)(F.ws + WS_KBR) + (size_t)t * 128;
      kb[l] = (bf16_t)f2bf(x1 * c1 - x2 * s1); kb[64 + l] = (bf16_t)f2bf(x2 * c1 + x1 * s1); }
#pragma unroll 4
    for (int p = 0; p < 8; ++p) { const int h = 2 * p + (l >> 5), i = l & 31; const float x1 = bf2f(IQ[h * 64 + i]), x2 = bf2f(IQ[h * 64 + 32 + i]);
        IQ[h * 64 + i] = (bf16_t)f2bf(x1 * c2 - x2 * s2); IQ[h * 64 + 32 + i] = (bf16_t)f2bf(x2 * c2 + x1 * s2); }
    if (l < 32) { const float x1 = bf2f(MS[32 + l]), x2 = bf2f(MS[64 + l]); bf16_t* ki = (bf16_t*)(F.ws + WS_KIR) + (size_t)t * 64;
        ki[l] = (bf16_t)f2bf(x1 * c2 - x2 * s2); ki[32 + l] = (bf16_t)f2bf(x2 * c2 + x1 * s2); }
    { bf16_t* vb = (bf16_t*)(F.ws + WS_VB) + (size_t)t * 128; vb[l] = MS[256 + l]; vb[64 + l] = MS[320 + l]; }
    if (l < 16) ((float*)(F.ws + WS_IW))[(size_t)t * 16 + l] = bf2f(MS[16 + l]) * 0.03125f;
}
constexpr int GLP = 264;
__device__ __forceinline__ void gla_prep_item(const Frame& F, const Args& a, int item) {
    const int c = item >> 2, h = item & 3, t0 = c * 64, tid = F.tid;
    LAS bf16_t* sQ = (LAS bf16_t*)F.lds; LAS bf16_t* sK = sQ + 64 * GLP; LAS float* sG = (LAS float*)(sK + 64 * GLP);
    const bf16_t* GQK = (const bf16_t*)(F.ws + WS_GQK); const bf16_t* MS = (const bf16_t*)(F.ws + WS_MISC);
    for (int i = tid; i < 64 * 16; i += NTHREADS) sG[i] = bf2f(MS[(size_t)(t0 + (i >> 4)) * MISC_LD + (i & 15)]);
    __syncthreads();
    if (tid < 256) {
        const int d = tid, col = h * 256 + d;
        float w2c[16];
#pragma unroll
        for (int r = 0; r < 16; ++r) w2c[r] = a.in[5][r * 1024 + col];
        const float bias = a.in[6][col];
        bf16_t* QT = (bf16_t*)(F.ws + WS_QT);
        float b = 0.f;
        for (int j = 0; j < 64; ++j) {
            float z = bias;
#pragma unroll
            for (int r = 0; r < 16; ++r) z = fmaf(sG[j * 16 + r], w2c[r], z);
            const float ls = fminf(z, 0.f) - log1pf(__expf(-fabsf(z)));
            b += ls * (1.f / 16.f);
            const float q = bf2f(GQK[(size_t)(t0 + j) * DM + col]), k = bf2f(GQK[(size_t)(t0 + j) * DM + 1024 + col]);
            const float eb = __expf(b);
            const unsigned qb = f2bf(q * 0.0625f * eb), kb = f2bf(k / eb);
            QT[(size_t)(t0 + j) * 1024 + col] = (bf16_t)qb; sQ[j * GLP + d] = (bf16_t)qb; sK[j * GLP + d] = (bf16_t)kb;
        }
        const float eL = __expf(b);
        ((float*)(F.ws + WS_DVEC))[c * 1024 + col] = eL;
        bf16_t* KH = (bf16_t*)(F.ws + WS_KHT) + ((size_t)item * 256 + d) * 64;
#pragma unroll
        for (int j8 = 0; j8 < 8; ++j8) { u32x4 w;
            w.x = pk2(bf2f(sK[(j8 * 8 + 0) * GLP + d]) * eL, bf2f(sK[(j8 * 8 + 1) * GLP + d]) * eL); w.y = pk2(bf2f(sK[(j8 * 8 + 2) * GLP + d]) * eL, bf2f(sK[(j8 * 8 + 3) * GLP + d]) * eL);
            w.z = pk2(bf2f(sK[(j8 * 8 + 4) * GLP + d]) * eL, bf2f(sK[(j8 * 8 + 5) * GLP + d]) * eL); w.w = pk2(bf2f(sK[(j8 * 8 + 6) * GLP + d]) * eL, bf2f(sK[(j8 * 8 + 7) * GLP + d]) * eL);
            *(u32x4*)(KH + j8 * 8) = w; }
    } else {
        const bf16_t* GV = (const bf16_t*)(F.ws + WS_GV);
#pragma unroll 1
        for (int i = 0; i < 2; ++i) { const int e = (tid - 256) + 256 * i; bf16_t* VT = (bf16_t*)(F.ws + WS_VT) + ((size_t)item * 512 + e) * 64;
#pragma unroll
            for (int j8 = 0; j8 < 8; ++j8) { unsigned short v[8];
#pragma unroll
                for (int j = 0; j < 8; ++j) v[j] = GV[(size_t)(t0 + j8 * 8 + j) * DM + h * 512 + e];
                u32x4 w; w.x = v[0] | ((unsigned)v[1] << 16); w.y = v[2] | ((unsigned)v[3] << 16); w.z = v[4] | ((unsigned)v[5] << 16); w.w = v[6] | ((unsigned)v[7] << 16);
                *(u32x4*)(VT + j8 * 8) = w; } }
    }
    __syncthreads();
    { const int fr = F.lane & 15, fq = F.lane >> 4; bf16_t* AT = (bf16_t*)(F.ws + WS_ATT) + (size_t)item * 4096;
#pragma unroll
      for (int tt = 0; tt < 2; ++tt) { const int tile = F.wave * 2 + tt, ti = tile >> 2, tj = tile & 3; f32x4 acc = (f32x4){0.f, 0.f, 0.f, 0.f};
          if (tj <= ti) {
#pragma unroll
              for (int k0 = 0; k0 < 256; k0 += 32) { const bf16x8 av = *(const LAS bf16x8*)(sQ + (16 * ti + fr) * GLP + k0 + 8 * fq), bv = *(const LAS bf16x8*)(sK + (16 * tj + fr) * GLP + k0 + 8 * fq);
                  acc = __builtin_amdgcn_mfma_f32_16x16x32_bf16(av, bv, acc, 0, 0, 0); } }
#pragma unroll
          for (int r = 0; r < 4; ++r) { const int i = 16 * ti + 4 * fq + r, j = 16 * tj + fr; AT[i * 64 + j] = (bf16_t)f2bf(j <= i ? acc[r] : 0.f); } } }
    __syncthreads();
}

constexpr int SC_ITEMS = 1088;
__device__ __forceinline__ void scores_item(const Frame& F, int item) {
    int gq = 0, rem = item;
    while (rem >= 8 * (gq + 1)) { rem -= 8 * (gq + 1); ++gq; }
    const int qb = gq * 8 + rem / (gq + 1), kc = rem % (gq + 1);
    const int fr = F.lane & 15, fq = F.lane >> 4, tq0 = qb * 64 + F.wave * 8;
    const bf16_t* IQ = (const bf16_t*)(F.ws + WS_IQ); const bf16_t* KI = (const bf16_t*)(F.ws + WS_KIR); const float* IW = (const float*)(F.ws + WS_IW);
    _Float16* SC = (_Float16*)(F.ws + WS_SCORES);
    bf16x8 aq[8][2]; f32x4 wq[8];
#pragma unroll
    for (int q = 0; q < 8; ++q) { const bf16_t* p = IQ + (size_t)(tq0 + q) * 1024 + fr * 64 + 8 * fq; aq[q][0] = *(const bf16x8*)p; aq[q][1] = *(const bf16x8*)(p + 32);
        wq[q] = *(const f32x4*)(IW + (size_t)(tq0 + q) * 16 + 4 * fq); }
    for (int g4 = 0; g4 < 8; ++g4) {
        float outv[8];
#pragma unroll
        for (int q = 0; q < 8; ++q) outv[q] = 0.f;
#pragma unroll
        for (int kt = 0; kt < 4; ++kt) { const int key = kc * 512 + g4 * 64 + kt * 16 + fr; const bf16_t* kp = KI + (size_t)key * 64 + 8 * fq;
            const bf16x8 b0 = *(const bf16x8*)kp, b1 = *(const bf16x8*)(kp + 32);
#pragma unroll
            for (int q = 0; q < 8; ++q) { f32x4 acc = (f32x4){0.f, 0.f, 0.f, 0.f};
                acc = __builtin_amdgcn_mfma_f32_16x16x32_bf16(aq[q][0], b0, acc, 0, 0, 0); acc = __builtin_amdgcn_mfma_f32_16x16x32_bf16(aq[q][1], b1, acc, 0, 0, 0);
                float s = fmaxf(acc[0], 0.f) * wq[q][0]; s = fmaf(fmaxf(acc[1], 0.f), wq[q][1], s); s = fmaf(fmaxf(acc[2], 0.f), wq[q][2], s); s = fmaf(fmaxf(acc[3], 0.f), wq[q][3], s);
                s += __shfl_xor(s, 16); s += __shfl_xor(s, 32);
                outv[q] = (fq == kt) ? s : outv[q]; } }
#pragma unroll
        for (int q = 0; q < 8; ++q) SC[(size_t)(tq0 + q) * SEQ + kc * 512 + g4 * 64 + F.lane] = (_Float16)outv[q];
    }
}

__device__ __forceinline__ unsigned h16key(unsigned h) { return (h & 0x8000u) ? (~h & 0xffffu) : (h | 0x8000u); }
__device__ __forceinline__ void select_row(const Frame& F, int t) {
    int* SEL = (int*)(F.ws + WS_SEL) + (size_t)t * 256; const int l = F.lane;
    if (t < 256) {
#pragma unroll
        for (int i = 0; i < 4; ++i) { const int j = i * 64 + l; SEL[j] = (j <= t) ? j : 0; }
        return;
    }
    const unsigned short* SC = (const unsigned short*)(F.ws + WS_SCORES) + (size_t)t * SEQ;
    unsigned kk[64];
#pragma unroll
    for (int i = 0; i < 16; ++i) { const int s0 = (i * 64 + l) * 8; u32x4 v = (u32x4){0u, 0u, 0u, 0u};
        if (s0 <= t) v = *(const u32x4*)(SC + s0);
#pragma unroll
        for (int w = 0; w < 4; ++w) { const unsigned x = v[w]; unsigned lo = h16key(x & 0xffffu), hi = h16key(x >> 16);
            if (s0 + 2 * w > t) lo = 0u; if (s0 + 2 * w + 1 > t) hi = 0u; kk[i * 4 + w] = lo | (hi << 16); } }
    unsigned T = 0u;
    for (int bit = 15; bit >= 0; --bit) { const unsigned cand = T | (1u << bit); int cnt = 0;
#pragma unroll
        for (int r = 0; r < 64; ++r) { cnt += ((kk[r] & 0xffffu) >= cand) ? 1 : 0; cnt += ((kk[r] >> 16) >= cand) ? 1 : 0; }
#pragma unroll
        for (int o = 1; o < 64; o <<= 1) cnt += __shfl_xor(cnt, o);
        if (cnt >= 256) T = cand; }
    int cgt = 0;
#pragma unroll
    for (int r = 0; r < 64; ++r) { cgt += ((kk[r] & 0xffffu) > T) ? 1 : 0; cgt += ((kk[r] >> 16) > T) ? 1 : 0; }
#pragma unroll
    for (int o = 1; o < 64; o <<= 1) cgt += __shfl_xor(cgt, o);
    const int need = 256 - cgt; int base = 0, ties = 0;
#pragma unroll
    for (int r = 0; r < 64; ++r)
#pragma unroll
        for (int hf = 0; hf < 2; ++hf) { const unsigned key = hf ? (kk[r] >> 16) : (kk[r] & 0xffffu); const int s = ((r >> 2) * 64 + l) * 8 + (r & 3) * 2 + hf;
            const bool eq = (key == T); const unsigned long long beq = __ballot(eq);
            const int trank = ties + __builtin_amdgcn_mbcnt_hi((unsigned)(beq >> 32), __builtin_amdgcn_mbcnt_lo((unsigned)beq, 0));
            const bool take = (key > T) || (eq && trank < need); const unsigned long long bt = __ballot(take);
            const int pos = base + __builtin_amdgcn_mbcnt_hi((unsigned)(bt >> 32), __builtin_amdgcn_mbcnt_lo((unsigned)bt, 0));
            if (take) SEL[pos] = s;
            ties += __builtin_popcountll(beq); base += __builtin_popcountll(bt); }
}

constexpr int SP_PP = 264;
constexpr int SP_VP = 136;
constexpr int SP_WAVE_BYTES = 16 * SP_PP * 2 + 32 * SP_VP * 2;
__device__ __forceinline__ s16x4 tr_read4(unsigned lds_addr) { s16x4 r; asm volatile("ds_read_b64_tr_b16 %0, %1\n\ts_waitcnt lgkmcnt(0)" : "=&v"(r) : "v"(lds_addr) : "memory"); return r; }
__device__ __forceinline__ void sparse_attn_query(const Frame& F, int t) {
    const int l = F.lane, fr = l & 15, fq = l >> 4;
    LAS unsigned char* wl = F.lds + F.wave * SP_WAVE_BYTES; LAS bf16_t* sP = (LAS bf16_t*)wl; LAS bf16_t* sV = (LAS bf16_t*)(wl + 16 * SP_PP * 2);
    bf16_t* Q = (bf16_t*)(F.ws + WS_DQ) + (size_t)t * DM; const bf16_t* KB = (const bf16_t*)(F.ws + WS_KBR); const bf16_t* VB = (const bf16_t*)(F.ws + WS_VB);
    const int* SEL = (const int*)(F.ws + WS_SEL) + (size_t)t * 256; const int nvalid = t < 255 ? t + 1 : 256;
    bf16x8 aq[4];
#pragma unroll
    for (int ks = 0; ks < 4; ++ks) aq[ks] = *(const bf16x8*)(Q + fr * 128 + ks * 32 + 8 * fq);
    f32x4 sc[16];
#pragma unroll
    for (int kt = 0; kt < 16; ++kt) { const int srow = SEL[kt * 16 + fr]; const bf16_t* kp = KB + (size_t)srow * 128 + 8 * fq; f32x4 acc = (f32x4){0.f, 0.f, 0.f, 0.f};
#pragma unroll
        for (int ks = 0; ks < 4; ++ks) acc = __builtin_amdgcn_mfma_f32_16x16x32_bf16(aq[ks], *(const bf16x8*)(kp + ks * 32), acc, 0, 0, 0);
        const bool ok = (kt * 16 + fr) < nvalid;
#pragma unroll
        for (int r = 0; r < 4; ++r) acc[r] = ok ? acc[r] * 0.08838834764831845f : -3.0e38f;
        sc[kt] = acc; }
    f32x4 mx = sc[0];
#pragma unroll
    for (int kt = 1; kt < 16; ++kt)
#pragma unroll
        for (int r = 0; r < 4; ++r) mx[r] = fmaxf(mx[r], sc[kt][r]);
#pragma unroll
    for (int o = 1; o < 16; o <<= 1)
#pragma unroll
        for (int r = 0; r < 4; ++r) mx[r] = fmaxf(mx[r], __shfl_xor(mx[r], o));
    f32x4 sm = (f32x4){0.f, 0.f, 0.f, 0.f};
#pragma unroll
    for (int kt = 0; kt < 16; ++kt)
#pragma unroll
        for (int r = 0; r < 4; ++r) { const float e = __expf(sc[kt][r] - mx[r]); sc[kt][r] = e; sm[r] += e; }
#pragma unroll
    for (int o = 1; o < 16; o <<= 1)
#pragma unroll
        for (int r = 0; r < 4; ++r) sm[r] += __shfl_xor(sm[r], o);
#pragma unroll
    for (int r = 0; r < 4; ++r) sm[r] = 1.f / sm[r];
#pragma unroll
    for (int kt = 0; kt < 16; ++kt)
#pragma unroll
        for (int r = 0; r < 4; ++r) sP[(4 * fq + r) * SP_PP + kt * 16 + fr] = (bf16_t)f2bf(sc[kt][r] * sm[r]);
    LDS_WAIT();
    f32x4 o[8];
#pragma unroll
    for (int nt = 0; nt < 8; ++nt) o[nt] = (f32x4){0.f, 0.f, 0.f, 0.f};
    const unsigned vbase = (unsigned)(size_t)sV;
    for (int kst = 0; kst < 8; ++kst) {
#pragma unroll
        for (int i = 0; i < 8; ++i) { const int p = i * 64 + l, row = p >> 4, ch = p & 15; const int srow = SEL[kst * 32 + row];
            *(LAS u32x4*)(sV + row * SP_VP + ch * 8) = *(const u32x4*)(VB + (size_t)srow * 128 + ch * 8); }
        const bf16x8 pa = *(const LAS bf16x8*)(sP + fr * SP_PP + kst * 32 + 8 * fq);
        LDS_WAIT(); __builtin_amdgcn_sched_barrier(0);
#pragma unroll
        for (int nt = 0; nt < 8; ++nt) { const unsigned a0 = vbase + (unsigned)(((8 * fq + (fr >> 2)) * SP_VP + 16 * nt + 4 * (fr & 3)) * 2);
            const s16x4 lo = tr_read4(a0), hi = tr_read4(a0 + 4 * SP_VP * 2);
            bf16x8 bv; bv[0] = lo[0]; bv[1] = lo[1]; bv[2] = lo[2]; bv[3] = lo[3]; bv[4] = hi[0]; bv[5] = hi[1]; bv[6] = hi[2]; bv[7] = hi[3];
            __builtin_amdgcn_sched_barrier(0);
            o[nt] = __builtin_amdgcn_mfma_f32_16x16x32_bf16(pa, bv, o[nt], 0, 0, 0); }
        __builtin_amdgcn_sched_barrier(0);
    }
#pragma unroll
    for (int nt = 0; nt < 8; ++nt)
#pragma unroll
        for (int r = 0; r < 4; ++r) Q[(4 * fq + r) * 128 + 16 * nt + fr] = (bf16_t)f2bf(o[nt][r]);
}

__device__ __forceinline__ void gla_level1_item(const Frame& F, int item) {
    const int fr = F.lane & 15, fq = F.lane >> 4;
    const bf16_t* KH = (const bf16_t*)(F.ws + WS_KHT) + (size_t)item * 256 * 64; const bf16_t* VT = (const bf16_t*)(F.ws + WS_VT) + ((size_t)item * 512 + F.wave * 64) * 64;
    bf16_t* ST = (bf16_t*)(F.ws + WS_ST) + ((size_t)item * 512 + F.wave * 64) * 256;
    for (int db = 0; db < 4; ++db) {
        f32x4 acc[4][4];
#pragma unroll
        for (int i = 0; i < 4; ++i)
#pragma unroll
            for (int j = 0; j < 4; ++j) acc[i][j] = (f32x4){0.f, 0.f, 0.f, 0.f};
        wave_gemm_nt<4, 4>(KH + (size_t)db * 64 * 64, 64, VT, 64, 64, acc, fr, fq);
#pragma unroll
        for (int mt = 0; mt < 4; ++mt)
#pragma unroll
            for (int nt = 0; nt < 4; ++nt) { u32x2 w; w.x = pk2(acc[mt][nt][0], acc[mt][nt][1]); w.y = pk2(acc[mt][nt][2], acc[mt][nt][3]);
                *(u32x2*)(ST + (size_t)(16 * nt + fr) * 256 + db * 64 + 16 * mt + 4 * fq) = w; }
    }
}
__device__ __forceinline__ void gla_scan(const Frame& F) {
    const float* DV = (const float*)(F.ws + WS_DVEC); bf16_t* ST = (bf16_t*)(F.ws + WS_ST);
    for (int idx = F.bid * NTHREADS + F.tid; idx < 4 * 512 * 64; idx += F.G * NTHREADS) {
        const int h = idx >> 15, rem = idx & 32767, e = rem >> 6, d4 = (rem & 63) * 4;
        f32x4 run = (f32x4){0.f, 0.f, 0.f, 0.f};
#pragma unroll 4
        for (int c = 0; c < 128; ++c) { u32x2* p = (u32x2*)(ST + ((size_t)(c * 4 + h) * 512 + e) * 256 + d4); const u32x2 L = *p; const f32x4 dv = *(const f32x4*)(DV + c * 1024 + h * 256 + d4);
            u32x2 w; w.x = pk2(run[0], run[1]); w.y = pk2(run[2], run[3]); *p = w;
            run[0] = fmaf(dv[0], run[0], bflo(L.x)); run[1] = fmaf(dv[1], run[1], bfhi(L.x)); run[2] = fmaf(dv[2], run[2], bflo(L.y)); run[3] = fmaf(dv[3], run[3], bfhi(L.y)); }
    }
}
__device__ __forceinline__ void gla_out_item(const Frame& F, const Args& a, int item) {
    const int c = item >> 2, h = item & 3, t0 = c * 64, fr = F.lane & 15, fq = F.lane >> 4, w = F.wave;
    LAS float* sred = (LAS float*)F.lds;
    f32x4 acc[4][4];
#pragma unroll
    for (int i = 0; i < 4; ++i)
#pragma unroll
        for (int j = 0; j < 4; ++j) acc[i][j] = (f32x4){0.f, 0.f, 0.f, 0.f};
    wave_gemm_nt<4, 4>((const bf16_t*)(F.ws + WS_ST) + ((size_t)item * 512 + w * 64) * 256, 256, (const bf16_t*)(F.ws + WS_QT) + (size_t)t0 * 1024 + h * 256, 1024, 256, acc, fr, fq);
    wave_gemm_nt<4, 4>((const bf16_t*)(F.ws + WS_VT) + ((size_t)item * 512 + w * 64) * 64, 64, (const bf16_t*)(F.ws + WS_ATT) + (size_t)item * 4096, 64, 64, acc, fr, fq);
    float ss[4];
#pragma unroll
    for (int nt = 0; nt < 4; ++nt) { float s = 0.f;
#pragma unroll
        for (int mt = 0; mt < 4; ++mt) s += (acc[mt][nt][0] * acc[mt][nt][0] + acc[mt][nt][1] * acc[mt][nt][1]) + (acc[mt][nt][2] * acc[mt][nt][2] + acc[mt][nt][3] * acc[mt][nt][3]);
        s += __shfl_xor(s, 16); s += __shfl_xor(s, 32); ss[nt] = s;
        if (fq == 0) sred[w * 64 + 16 * nt + fr] = s; }
    __syncthreads();
    const bf16_t* GR = (const bf16_t*)(F.ws + WS_GR); bf16_t* OA = (bf16_t*)(F.ws + WS_OA); const float* gain = a.in[7] + h * 512;
#pragma unroll
    for (int nt = 0; nt < 4; ++nt) { const int tok = 16 * nt + fr; float tot = 0.f;
#pragma unroll
        for (int ww = 0; ww < 8; ++ww) tot += sred[ww * 64 + tok];
        const float rstd = rsqrtf(tot * (1.f / 512.f) + EPS);
#pragma unroll
        for (int mt = 0; mt < 4; ++mt) { const int e = w * 64 + 16 * mt + 4 * fq; const size_t off = (size_t)(t0 + tok) * DM + h * 512 + e;
            const u32x2 g = *(const u32x2*)(GR + off); const f32x4 gn = *(const f32x4*)(gain + e);
            const float r0 = bflo(g.x), r1 = bfhi(g.x), r2 = bflo(g.y), r3 = bfhi(g.y);
            u32x2 o; o.x = pk2(acc[mt][nt][0] * rstd * gn[0] * r0 * sigmoidf_(r0), acc[mt][nt][1] * rstd * gn[1] * r1 * sigmoidf_(r1));
            o.y = pk2(acc[mt][nt][2] * rstd * gn[2] * r2 * sigmoidf_(r2), acc[mt][nt][3] * rstd * gn[3] * r3 * sigmoidf_(r3));
            *(u32x2*)(OA + off) = o; } }
    __syncthreads();
}

__device__ const unsigned char PEER_CAND[52] = {
    0x00,0x01,0x02,0x03,0x04,0x05,0x06,0x07,0x08,0x09,0x0a,0x0b,0x0c,0x0d,0x0e,0x0f, 0x10,0x11,0x12,0x13,0x14,0x15,0x16,0x17, 0x20,0x21,0x22,0x23,0x24, 0x30,0x31,0x32,0x33,
    0x40,0x41,0x42, 0x50,0x51, 0x60,0x61, 0x70,0x71, 0x80,0x90,0xa0,0xb0,0xc0,0xd0,0xe0,0xf0, 0xff,0xff };
__device__ __forceinline__ unsigned f32ord(float f) { const unsigned u = __builtin_bit_cast(unsigned, f); return (u & 0x80000000u) ? ~u : (u | 0x80000000u); }
__device__ __forceinline__ float ordf32(unsigned k) { const unsigned u = (k & 0x80000000u) ? (k & 0x7fffffffu) : ~k; return __builtin_bit_cast(float, u); }
__device__ __forceinline__ void peer_select_item(const Frame& F, int item) {
    const int l = F.lane, fr = l & 15, fq = l >> 4, t0 = item * 16;
    LAS unsigned* tv = (LAS unsigned*)(F.lds + F.wave * 2048);
    const bf16_t* PQ = (const bf16_t*)(F.ws + WS_PQ); const bf16_t* KEYS = (const bf16_t*)(F.ws + WS_KEYS);
    int* EXPI = (int*)(F.ws + WS_EXPI); float* GATEW = (float*)(F.ws + WS_GATEW);
    for (int h = 0; h < 8; ++h) {
#pragma unroll 1
        for (int p = 0; p < 2; ++p) { const int g = h * 2 + p;
            f32x4 acc[8];
#pragma unroll
            for (int mt = 0; mt < 8; ++mt) acc[mt] = (f32x4){0.f, 0.f, 0.f, 0.f};
#pragma unroll
            for (int ks = 0; ks < 4; ++ks) { const bf16x8 bq = *(const bf16x8*)(PQ + (size_t)(t0 + fr) * DM + g * 128 + ks * 32 + 8 * fq);
#pragma unroll
                for (int mt = 0; mt < 8; ++mt) acc[mt] = __builtin_amdgcn_mfma_f32_16x16x32_bf16(*(const bf16x8*)(KEYS + ((size_t)g * 128 + 16 * mt + fr) * 128 + ks * 32 + 8 * fq), bq, acc[mt], 0, 0, 0); }
            unsigned kk[32];
#pragma unroll
            for (int mt = 0; mt < 8; ++mt)
#pragma unroll
                for (int r = 0; r < 4; ++r) kk[mt * 4 + r] = (f32ord(acc[mt][r]) & ~127u) | (unsigned)(127 - (16 * mt + 4 * fq + r));
#pragma unroll
            for (int i = 0; i < 16; ++i) { unsigned m = kk[0];
#pragma unroll
                for (int j = 1; j < 32; ++j) m = m > kk[j] ? m : kk[j];
                { const unsigned o = __shfl_xor(m, 16); m = m > o ? m : o; } { const unsigned o = __shfl_xor(m, 32); m = m > o ? m : o; }
#pragma unroll
                for (int j = 0; j < 32; ++j) kk[j] = (kk[j] == m) ? 0u : kk[j];
                if (fq == (i & 3)) tv[(fr * 2 + p) * 16 + i] = m; }
        }
        LDS_WAIT();
        unsigned ck[13];
#pragma unroll
        for (int ci = 0; ci < 13; ++ci) { const int cidx = fq + 4 * ci; const unsigned ab = PEER_CAND[cidx];
            if (cidx < 50) { const float v = ordf32(tv[(fr * 2 + 0) * 16 + (ab >> 4)] & ~127u) + ordf32(tv[(fr * 2 + 1) * 16 + (ab & 15)] & ~127u); ck[ci] = (f32ord(v) & ~63u) | (unsigned)(63 - cidx); }
            else ck[ci] = 0u; }
        float scv[4]; int exv[4];
#pragma unroll
        for (int i = 0; i < 16; ++i) { unsigned m = ck[0];
#pragma unroll
            for (int j = 1; j < 13; ++j) m = m > ck[j] ? m : ck[j];
            { const unsigned o = __shfl_xor(m, 16); m = m > o ? m : o; } { const unsigned o = __shfl_xor(m, 32); m = m > o ? m : o; }
#pragma unroll
            for (int j = 0; j < 13; ++j) ck[j] = (ck[j] == m) ? 0u : ck[j];
            if (fq == (i & 3)) { const int cidx = 63 - (int)(m & 63u); const unsigned ab = PEER_CAND[cidx];
                const int n1 = 127 - (int)(tv[(fr * 2 + 0) * 16 + (ab >> 4)] & 127u), n2 = 127 - (int)(tv[(fr * 2 + 1) * 16 + (ab & 15)] & 127u);
                exv[i >> 2] = n1 * 128 + n2; scv[i >> 2] = ordf32(m & ~63u); } }
        float mx = fmaxf(fmaxf(scv[0], scv[1]), fmaxf(scv[2], scv[3])); mx = fmaxf(mx, __shfl_xor(mx, 16)); mx = fmaxf(mx, __shfl_xor(mx, 32));
        float ev[4], s = 0.f;
#pragma unroll
        for (int j = 0; j < 4; ++j) { ev[j] = __expf(scv[j] - mx); s += ev[j]; }
        s += __shfl_xor(s, 16); s += __shfl_xor(s, 32); const float inv = 1.f / s;
#pragma unroll
        for (int j = 0; j < 4; ++j) { const size_t o = (size_t)(t0 + fr) * 128 + h * 16 + j * 4 + fq; EXPI[o] = exv[j]; GATEW[o] = ev[j] * inv; }
        LDS_WAIT();
    }
}
__device__ __forceinline__ float gelu_tanh(float x) { const float u = 0.7978845608028654f * (x + 0.044715f * x * x * x); const float e = __expf(2.f * u); const float th = 1.f - 2.f / (e + 1.f); return 0.5f * x * (1.f + th); }
__device__ __forceinline__ float dot8(const u32x4 w, const float* x) {
    return bflo(w.x) * x[0] + bfhi(w.x) * x[1] + bflo(w.y) * x[2] + bfhi(w.y) * x[3] + bflo(w.z) * x[4] + bfhi(w.z) * x[5] + bflo(w.w) * x[6] + bfhi(w.w) * x[7];
}
__device__ __forceinline__ void axpy8(const u32x4 w, float c, float* o) {
    o[0] = fmaf(c, bflo(w.x), o[0]); o[1] = fmaf(c, bfhi(w.x), o[1]); o[2] = fmaf(c, bflo(w.y), o[2]); o[3] = fmaf(c, bfhi(w.y), o[3]);
    o[4] = fmaf(c, bflo(w.z), o[4]); o[5] = fmaf(c, bfhi(w.z), o[5]); o[6] = fmaf(c, bflo(w.w), o[6]); o[7] = fmaf(c, bfhi(w.w), o[7]);
}
__device__ __forceinline__ void peer_expert_token(const Frame& F, const Args& a, int t) {
    const int l = F.lane;
    const bf16_t* UB = (const bf16_t*)(F.ws + WS_UB); const bf16_t* VB = (const bf16_t*)(F.ws + WS_VBF);
    const int* EXPI = (const int*)(F.ws + WS_EXPI) + (size_t)t * 128; const float* GATEW = (const float*)(F.ws + WS_GATEW) + (size_t)t * 128;
    const float rstd2 = rsqrtf(((const float*)(F.ws + WS_CTL))[CW_RSQ2 + t] * (1.f / DM) + EPS);
    float x[32], o[32];
#pragma unroll
    for (int i = 0; i < 4; ++i) { const u32x4 w = *(const u32x4*)((const bf16_t*)(F.ws + WS_A2) + (size_t)t * DM + i * 512 + l * 8);
        x[i * 8 + 0] = bflo(w.x); x[i * 8 + 1] = bfhi(w.x); x[i * 8 + 2] = bflo(w.y); x[i * 8 + 3] = bfhi(w.y); x[i * 8 + 4] = bflo(w.z); x[i * 8 + 5] = bfhi(w.z); x[i * 8 + 6] = bflo(w.w); x[i * 8 + 7] = bfhi(w.w); }
#pragma unroll
    for (int i = 0; i < 32; ++i) o[i] = 0.f;
    for (int jb = 0; jb < 64; ++jb) {
        const int e0 = __builtin_amdgcn_readfirstlane(EXPI[jb * 2]), e1 = __builtin_amdgcn_readfirstlane(EXPI[jb * 2 + 1]);
        const float g0 = __builtin_bit_cast(float, __builtin_amdgcn_readfirstlane(__builtin_bit_cast(int, GATEW[jb * 2]))), g1 = __builtin_bit_cast(float, __builtin_amdgcn_readfirstlane(__builtin_bit_cast(int, GATEW[jb * 2 + 1])));
        const bf16_t* u0 = UB + (size_t)e0 * DM + l * 8; const bf16_t* u1 = UB + (size_t)e1 * DM + l * 8; const bf16_t* v0 = VB + (size_t)e0 * DM + l * 8; const bf16_t* v1 = VB + (size_t)e1 * DM + l * 8;
        u32x4 uw0[4], uw1[4], vw0[4], vw1[4];
#pragma unroll
        for (int i = 0; i < 4; ++i) { uw0[i] = *(const u32x4*)(u0 + i * 512); uw1[i] = *(const u32x4*)(u1 + i * 512); }
#pragma unroll
        for (int i = 0; i < 4; ++i) { vw0[i] = *(const u32x4*)(v0 + i * 512); vw1[i] = *(const u32x4*)(v1 + i * 512); }
        float d0 = 0.f, d1 = 0.f;
#pragma unroll
        for (int i = 0; i < 4; ++i) { d0 += dot8(uw0[i], x + i * 8); d1 += dot8(uw1[i], x + i * 8); }
        d0 = wave_sum(d0); d1 = wave_sum(d1);
        const float c0 = g0 * gelu_tanh(d0 * rstd2), c1 = g1 * gelu_tanh(d1 * rstd2);
#pragma unroll
        for (int i = 0; i < 4; ++i) { axpy8(vw0[i], c0, o + i * 8); axpy8(vw1[i], c1, o + i * 8); }
    }
    float* H = a.out + (size_t)t * DM; const float* gf = a.in[22]; float ss = 0.f;
#pragma unroll
    for (int i = 0; i < 4; ++i) { const f32x4 ha = *(const f32x4*)(H + i * 512 + l * 8), hb = *(const f32x4*)(H + i * 512 + l * 8 + 4);
#pragma unroll
        for (int j = 0; j < 4; ++j) { o[i * 8 + j] += ha[j]; o[i * 8 + 4 + j] += hb[j]; }
#pragma unroll
        for (int j = 0; j < 8; ++j) ss += o[i * 8 + j] * o[i * 8 + j]; }
    const float rstd = rsqrtf(wave_sum(ss) * (1.f / DM) + EPS);
#pragma unroll
    for (int i = 0; i < 4; ++i) { const f32x4 ga = *(const f32x4*)(gf + i * 512 + l * 8), gb = *(const f32x4*)(gf + i * 512 + l * 8 + 4); f32x4 ra, rb;
#pragma unroll
        for (int j = 0; j < 4; ++j) { ra[j] = o[i * 8 + j] * rstd * ga[j]; rb[j] = o[i * 8 + 4 + j] * rstd * gb[j]; }
        *(f32x4*)(H + i * 512 + l * 8) = ra; *(f32x4*)(H + i * 512 + l * 8 + 4) = rb; }
}

constexpr int N_PHASES = 17;
__global__ void __launch_bounds__(NTHREADS, 2) hybrid_fwd(Args args) {
    extern __shared__ __attribute__((aligned(16))) unsigned char lds_raw[];
    Frame F;
    F.lds = (LAS unsigned char*)lds_raw;
    F.tid = threadIdx.x; F.lane = F.tid & 63; F.wave = __builtin_amdgcn_readfirstlane(F.tid >> 6);
    F.G = gridDim.x; F.bid = blockIdx.x; F.ws = args.ws;
    unsigned* ctl = (unsigned*)(args.ws + WS_CTL);
    volatile LAS unsigned* MISCW = (volatile LAS unsigned*)(F.lds + LDSCTL_OFF);
    if (F.tid < 64) MISCW[F.tid] = 0u;
    __syncthreads();
    XcdBarrier bar; bar.bar = ctl + CW_BAR; bar.x = 0; bar.st = nullptr;
    if (args.use_bar) bar = xcd_barrier_post(ctl + CW_BAR, MISCW + 8);
    const int lo = args.ph_lo, hi = args.ph_hi;
    LAS unsigned char* ring = F.lds;
    const int gw = F.bid * NWAVES + F.wave, NGW = F.G * NWAVES;
    float* rsq1 = (float*)ctl + CW_RSQ1; float* rsq2 = (float*)ctl + CW_RSQ2;
#define IN(k) (lo <= (k) && (k) < hi)
#define SEAM(k) do { if (args.use_bar && IN(k) && IN((k) + 1)) { if ((k) == 0) { cg::this_grid().sync(); } else { xcd_barrier(bar); } } } while (0)
#define ROT(r) ((F.bid + F.G - ((r) % F.G)) % F.G)

    if (IN(0)) { p0_prologue(F, args); }
    SEAM(0);
    if (IN(1)) {
        { pg8::Gemm g{(const bf16_t*)(F.ws + WS_A0), (const bf16_t*)(F.ws + WS_WIN), SEQ, NIN, DM, DM, DM}; pg8::StaticOrder S; S.init(SEQ, NIN, F.G, F.bid);
          EpiRoute E{F.ws}; pg8::gemm_phase<EpiRoute, true>(ring, g, S, E); }
        { pg8::Gemm g{(const bf16_t*)(F.ws + WS_MEMN), (const bf16_t*)(F.ws + WS_WXK), MEM, DM, DM, DM, DM}; pg8::StaticOrder S; S.init(MEM, DM, F.G, ROT(192));
          EpiBf16 E{(bf16_t*)(F.ws + WS_XK), DM, nullptr}; pg8::gemm_phase<EpiBf16, true>(ring, g, S, E); }
        { pg8::Gemm g{(const bf16_t*)(F.ws + WS_MEMN), (const bf16_t*)(F.ws + WS_WXV), MEM, DM, DM, DM, DM}; pg8::StaticOrder S; S.init(MEM, DM, F.G, ROT(200));
          EpiBf16 E{(bf16_t*)(F.ws + WS_XV), DM, nullptr}; pg8::gemm_phase<EpiBf16, true>(ring, g, S, E); }
    }
    SEAM(1);
    if (IN(2)) {
#pragma unroll 1
        for (int h = 0; h < 4; ++h) {
            pg8::Gemm g{(const bf16_t*)(F.ws + WS_XK) + h * 512, (const bf16_t*)(F.ws + WS_WXQ) + h * 512, MEM, DM, 512, DM, DM}; pg8::StaticOrder S; S.init(MEM, DM, F.G, ROT(8 * h));
            EpiBf16 E{(bf16_t*)(F.ws + WS_WQK) + (size_t)h * 256 * DM, DM, nullptr}; pg8::gemm_phase<EpiBf16, true>(ring, g, S, E); }
#pragma unroll 1
        for (int h = 0; h < 4; ++h) {
            pg8::Gemm g{(const bf16_t*)(F.ws + WS_WXO) + h * 512, (const bf16_t*)(F.ws + WS_XV) + h * 512, DM, MEM, 512, DM, DM}; pg8::StaticOrder S; S.init(DM, MEM, F.G, ROT(32 + 8 * h));
            EpiBf16 E{(bf16_t*)(F.ws + WS_WVO) + h * 256, 1024, nullptr}; pg8::gemm_phase<EpiBf16, true>(ring, g, S, E); }
        __syncthreads();
        for (int t = gw; t < SEQ; t += NGW) rope_token(F, args, t);
        for (int it = F.bid; it < 512; it += F.G) gla_prep_item(F, args, it);
    }
    SEAM(2);
    if (IN(3)) { for (int it = F.bid; it < SC_ITEMS; it += F.G) scores_item(F, it); }
    SEAM(3);
    if (IN(4)) { for (int t = gw; t < SEQ; t += NGW) select_row(F, t); }
    SEAM(4);
    if (IN(5)) { for (int t = gw; t < SEQ; t += NGW) sparse_attn_query(F, t); }
    SEAM(5);
    if (IN(6)) { for (int it = F.bid; it < 512; it += F.G) gla_level1_item(F, it); }
    SEAM(6);
    if (IN(7)) { gla_scan(F); }
    SEAM(7);
    if (IN(8)) { for (int it = F.bid; it < 512; it += F.G) gla_out_item(F, args, it); }
    SEAM(8);
    if (IN(9)) { pg8::Gemm g{(const bf16_t*)(F.ws + WS_OA), (const bf16_t*)(F.ws + WS_WPA), SEQ, DM, DM, DM, DM}; pg8::StaticOrder S; S.init(SEQ, DM, F.G, F.bid);
        EpiGate E{(bf16_t*)(F.ws + WS_T1), (const bf16_t*)(F.ws + WS_GATES), 0, nullptr}; pg8::gemm_phase<EpiGate, true>(ring, g, S, E); }
    SEAM(9);
    if (IN(10)) { pg8::Gemm g{(const bf16_t*)(F.ws + WS_DQ), (const bf16_t*)(F.ws + WS_WPB), SEQ, DM, DM, DM, DM}; pg8::StaticOrder S; S.init(SEQ, DM, F.G, F.bid);
        EpiGate E{(bf16_t*)(F.ws + WS_MERGED), (const bf16_t*)(F.ws + WS_GATES), 2048, (const bf16_t*)(F.ws + WS_T1)}; pg8::gemm_phase<EpiGate, true>(ring, g, S, E); }
    SEAM(10);
    if (IN(11)) { { pg8::Gemm g{(const bf16_t*)(F.ws + WS_MERGED), (const bf16_t*)(F.ws + WS_WOUT), SEQ, DM, DM, DM, DM}; pg8::StaticOrder S; S.init(SEQ, DM, F.G, F.bid);
          EpiResNorm E{args.in[0], args.out, (bf16_t*)(F.ws + WS_A1), args.in[11], rsq1}; pg8::gemm_phase<EpiResNorm, true>(ring, g, S, E); }
        const size_t gtid = (size_t)F.bid * NTHREADS + F.tid, gth = (size_t)F.G * NTHREADS;
        cvt_copy(args.in[20], (bf16_t*)(F.ws + WS_UB), (size_t)16384 * DM, gtid, gth);
        cvt_copy(args.in[21], (bf16_t*)(F.ws + WS_VBF), (size_t)16384 * DM, gtid, gth);
    }
    SEAM(11);
    if (IN(12)) { pg8::Gemm g{(const bf16_t*)(F.ws + WS_A1), (const bf16_t*)(F.ws + WS_WQK), SEQ, 1024, DM, DM, DM}; pg8::StaticOrder S; S.init(SEQ, 1024, F.G, F.bid);
        EpiSoftmax E{(bf16_t*)(F.ws + WS_XP), 1024, rsq1, 0.044194173824159216f}; pg8::gemm_phase<EpiSoftmax, false>(ring, g, S, E); }
    SEAM(12);
    if (IN(13)) { pg8::Gemm g{(const bf16_t*)(F.ws + WS_XP), (const bf16_t*)(F.ws + WS_WVO), SEQ, DM, 1024, 1024, 1024}; pg8::StaticOrder S; S.init(SEQ, DM, F.G, F.bid);
        EpiResNorm E{args.out, args.out, (bf16_t*)(F.ws + WS_A2), args.in[17], rsq2}; pg8::gemm_phase<EpiResNorm, true>(ring, g, S, E); }
    SEAM(13);
    if (IN(14)) { pg8::Gemm g{(const bf16_t*)(F.ws + WS_A2), (const bf16_t*)(F.ws + WS_WPQ), SEQ, DM, DM, DM, DM}; pg8::StaticOrder S; S.init(SEQ, DM, F.G, F.bid);
        EpiBf16 E{(bf16_t*)(F.ws + WS_PQ), DM, rsq2}; pg8::gemm_phase<EpiBf16, true>(ring, g, S, E); }
    SEAM(14);
    if (IN(15)) { for (int it = gw; it < SEQ / 16; it += NGW) peer_select_item(F, it); }
    SEAM(15);
    if (IN(16)) { for (int t = gw; t < SEQ; t += NGW) peer_expert_token(F, args, t); }
#undef IN
#undef SEAM
#undef ROT
}

#ifndef MK_ONE_LAUNCH
#define MK_ONE_LAUNCH 0
#endif
extern "C" void kernel_launch(void* const* d_in, const int* in_sizes, int n_in, void* d_out, int out_size, void* d_ws, size_t ws_size, hipStream_t stream) {
    static int grid = 0;
    if (grid == 0) {
        if (n_in != 23 || out_size != SEQ * DM || ws_size < WS_END) { fprintf(stderr, "kernel_launch: unexpected problem (n_in %d, out %d, ws %zu < %zu)\n", n_in, out_size, ws_size, (size_t)WS_END); grid = -1; return; }
        int dev = 0, cus = 0, per_cu = 0;
        if (hipGetDevice(&dev) != hipSuccess || hipDeviceGetAttribute(&cus, hipDeviceAttributeMultiprocessorCount, dev) != hipSuccess) { grid = -1; return; }
        if (hipFuncSetAttribute((const void*)hybrid_fwd, hipFuncAttributeMaxDynamicSharedMemorySize, LDS_BYTES) != hipSuccess) { fprintf(stderr, "kernel_launch: hipFuncSetAttribute failed\n"); grid = -1; return; }
        if (hipOccupancyMaxActiveBlocksPerMultiprocessor(&per_cu, (const void*)hybrid_fwd, NTHREADS, LDS_BYTES) != hipSuccess || per_cu < 1) { fprintf(stderr, "kernel_launch: occupancy query says %d\n", per_cu); per_cu = 1; }
        (void)hipGetLastError();
        grid = cus;
    }
    if (grid < 0) return;
    (void)hipMemsetAsync((char*)d_ws + WS_CTL, 0, CTL_ZERO_BYTES, stream);
    Args a{};
    for (int i = 0; i < 23; ++i) a.in[i] = (const float*)d_in[i];
    a.out = (float*)d_out; a.ws = (unsigned char*)d_ws;
#if MK_ONE_LAUNCH
    a.ph_lo = 0; a.ph_hi = N_PHASES; a.use_bar = 1;
    void* kargs[] = {&a};
    hipError_t e = hipLaunchCooperativeKernel((const void*)hybrid_fwd, dim3(grid), dim3(NTHREADS), kargs, LDS_BYTES, stream);
    if (e != hipSuccess) fprintf(stderr, "cooperative launch failed: %s (grid %d)\n", hipGetErrorString(e), grid);
#else
    for (int p = 0; p < N_PHASES; ++p) { a.ph_lo = p; a.ph_hi = p + 1; a.use_bar = 0;
        hipLaunchKernelGGL(hybrid_fwd, dim3(grid), dim3(NTHREADS), LDS_BYTES, stream, a); }
#endif
}
```

```cpp
#include <hip/hip_runtime.h>
#include <hip/hip_cooperative_groups.h>
#include <cstdio>
#include <cstdint>
namespace cg = cooperative_groups;

#define GAS __attribute__((address_space(1)))
#define LAS __attribute__((address_space(3)))
typedef unsigned short bf16_t;
typedef short bf16x8 __attribute__((ext_vector_type(8)));
typedef short s16x4 __attribute__((ext_vector_type(4)));
typedef float f32x4 __attribute__((ext_vector_type(4)));
typedef float f32x2 __attribute__((ext_vector_type(2)));
typedef unsigned u32x4 __attribute__((ext_vector_type(4)));
typedef unsigned u32x2 __attribute__((ext_vector_type(2)));
#define RLX_AGENT __ATOMIC_RELAXED, __HIP_MEMORY_SCOPE_AGENT
#define LDS_WAIT() asm volatile("s_waitcnt lgkmcnt(0)" ::: "memory")
#define VM_WAIT() asm volatile("s_waitcnt vmcnt(0)" ::: "memory")

__device__ __forceinline__ unsigned f2bf(float f) { unsigned u = __builtin_bit_cast(unsigned, f); return (u + 0x7fffu + ((u >> 16) & 1u)) >> 16; }
__device__ __forceinline__ unsigned pk2(float lo, float hi) { return f2bf(lo) | (f2bf(hi) << 16); }
__device__ __forceinline__ float bf2f(unsigned short b) { return __builtin_bit_cast(float, (unsigned)b << 16); }
__device__ __forceinline__ float bflo(unsigned w) { return __builtin_bit_cast(float, w << 16); }
__device__ __forceinline__ float bfhi(unsigned w) { return __builtin_bit_cast(float, w & 0xffff0000u); }
__device__ __forceinline__ float wave_sum(float v) {
#pragma unroll
    for (int o = 1; o < 64; o <<= 1) v += __shfl_xor(v, o);
    return v;
}
__device__ __forceinline__ float sigmoidf_(float x) { return 1.f / (1.f + __expf(-x)); }

namespace pg8 {
constexpr int BM = 256, BK = 64, HALF = 128, HTB = HALF * BK * 2, STAGE_BYTES = 8 * HTB, NXCD = 8, WGM = 8;
__host__ __device__ __forceinline__ int lds_byte(int r, int c) { const int st = (r >> 4) * 2 + (c >> 5), rr = r & 15, cc = c & 31, ob = rr * 64 + cc * 2; return st * 1024 + (ob ^ (((ob >> 9) & 1) << 5)); }
__host__ __device__ __forceinline__ void stage_rc(int b, int& R, int& C) { const int st = b / 1024, sb = b % 1024, swz = sb ^ (((sb >> 9) & 1) << 5); R = (st >> 1) * 16 + swz / 64; C = (st & 1) * 32 + (swz % 64) / 2; }
__host__ __device__ __forceinline__ int perm32(int rho) { const int n = rho >> 4, i = rho & 15; return 8 * (i >> 2) + 4 * n + (i & 3); }

struct Unit { int pm, pn; };
struct Gemm { const bf16_t* A; const bf16_t* Bt; int M, N, K, lda, ldb; };

struct StaticOrder {
    int nM, nN, nwg, G, c;
    __device__ void init(int M, int N, int G_, int c_) { nM = M / BM; nN = N / BM; nwg = nM * nN; G = G_; c = c_; }
    __device__ bool next(int i, Unit& u) const {
        const long L = (long)i * G + c; if (L >= nwg) return false;
        int wgid = (int)L; { const int q = nwg / NXCD, r = nwg % NXCD, xcd = wgid % NXCD, off = wgid / NXCD; wgid = (xcd < r ? xcd * (q + 1) : r * (q + 1) + (xcd - r) * q) + off; }
        const int nig = WGM * nN, gid = wgid / nig, fm = gid * WGM, gsz = (nM - fm) < WGM ? (nM - fm) : WGM;
        u.pm = fm + ((wgid % nig) % gsz); u.pn = (wgid % nig) / gsz; return true;
    }
};

__device__ __forceinline__ unsigned cvt_pk_bf16(float lo, float hi) { unsigned r; asm volatile("v_cvt_pk_bf16_f32 %0, %1, %2" : "=v"(r) : "v"(lo), "v"(hi)); return r; }

template <class Epi, bool ALIGN_EPI>
__device__ __forceinline__ void gemm_phase(LAS unsigned char* lds, const Gemm g, const StaticOrder& S, const Epi& E) {
    const int tid = threadIdx.x, wid = __builtin_amdgcn_readfirstlane(tid >> 6), lane = tid & 63, wr = wid >> 2, wc = wid & 3, fr = lane & 15, fq = lane >> 4;
    const int K = g.K, nt = K / BK;
    unsigned voffA[2], voffB[2];
#pragma unroll
    for (int i = 0; i < 2; ++i) { int R, C; stage_rc(tid * 16 + i * 8192, R, C); const int Rb = (R & ~31) + perm32(R & 31);
        voffA[i] = (unsigned)(R * g.lda + C) * 2u; voffB[i] = (unsigned)(Rb * g.ldb + C) * 2u; }
    const size_t kstep = (size_t)(BK * 2);
    const size_t hstepA = (size_t)HALF * g.lda * 2, hstepB = (size_t)HALF * g.ldb * 2;
    const size_t tstepA = 2 * hstepA, tstepB = 2 * hstepB;
    const unsigned ldsw = (unsigned)wid * 1024u;
    const int aoff = lds_byte(wr * 64 + fr, fq * 8), boff = lds_byte(wc * 32 + fr, fq * 8);
#define PG8_SA(b, h) (((b) * 2 + (h)) * HTB)
#define PG8_SB(b, h) ((4 + (b) * 2 + (h)) * HTB)
#define PG8_STAGE(bufoff, gbase, voff) do { _Pragma("unroll") for (int _i = 0; _i < 2; ++_i) \
        __builtin_amdgcn_global_load_lds((const unsigned*)((const char*)(gbase) + (voff)[_i]), (LAS unsigned*)(lds + (bufoff) + ldsw + _i * 8192), 16, 0, 0); } while (0)
#define PG8_LDA(dst, b, h) do { _Pragma("unroll") for (int m = 0; m < 4; ++m) _Pragma("unroll") for (int k = 0; k < 2; ++k) dst[m][k] = *(const LAS bf16x8*)(lds + PG8_SA(b, h) + aoff + m * 2048 + k * 1024); } while (0)
#define PG8_LDB(dst, b, h) do { _Pragma("unroll") for (int n = 0; n < 2; ++n) _Pragma("unroll") for (int k = 0; k < 2; ++k) dst[n][k] = *(const LAS bf16x8*)(lds + PG8_SB(b, h) + boff + n * 2048 + k * 1024); } while (0)
#define PG8_MMA(ai, bj, At, Bt) do { __builtin_amdgcn_s_setprio(1); _Pragma("unroll") for (int m = 0; m < 4; ++m) _Pragma("unroll") for (int n = 0; n < 2; ++n) _Pragma("unroll") for (int k = 0; k < 2; ++k) \
        acc[ai][bj][m][n] = __builtin_amdgcn_mfma_f32_16x16x32_bf16(Bt[n][k], At[m][k], acc[ai][bj][m][n], 0, 0, 0); __builtin_amdgcn_s_setprio(0); } while (0)
#define PG8_WAIT_V(n) asm volatile("s_waitcnt vmcnt(" #n ")" ::: "memory")
#define PG8_WAIT_L(n) asm volatile("s_waitcnt lgkmcnt(" #n ")" ::: "memory")
#define PG8_BAR __builtin_amdgcn_s_barrier()
#define PG8_SCHED __builtin_amdgcn_sched_barrier(0)
    Unit cur, nxt; int ui = 0;
    if (!S.next(0, cur)) return;
    f32x4 acc[2][2][4][2];
#pragma unroll
    for (int a = 0; a < 2; ++a)
#pragma unroll
        for (int b = 0; b < 2; ++b)
#pragma unroll
            for (int m = 0; m < 4; ++m)
#pragma unroll
                for (int n = 0; n < 2; ++n) acc[a][b][m][n] = (f32x4){0.f, 0.f, 0.f, 0.f};
    bf16x8 At[4][2], B0[2][2], B1[2][2];
    const char* cA = (const char*)g.A + (size_t)cur.pm * tstepA; const char* cB = (const char*)g.Bt + (size_t)cur.pn * tstepB;
    PG8_STAGE(PG8_SB(0, 0), cB, voffB); PG8_STAGE(PG8_SB(0, 1), cB + hstepB, voffB); PG8_STAGE(PG8_SA(0, 0), cA, voffA); PG8_STAGE(PG8_SA(0, 1), cA + hstepA, voffA);
    if (wr == 1) PG8_BAR;
    PG8_WAIT_V(2); PG8_BAR;
    PG8_STAGE(PG8_SB(1, 0), cB + kstep, voffB); PG8_STAGE(PG8_SA(1, 0), cA + kstep, voffA); PG8_STAGE(PG8_SB(1, 1), cB + hstepB + kstep, voffB);
    PG8_WAIT_V(6); PG8_BAR;
    for (;;) {
        const bool has_next = S.next(ui + 1, nxt);
        const char* nA = has_next ? (const char*)g.A + (size_t)nxt.pm * tstepA : cA; const char* nB = has_next ? (const char*)g.Bt + (size_t)nxt.pn * tstepB : cB;
        for (int t = 0; t < nt; t += 2) {
            const bool last = (t == nt - 2);
            const char* a1 = cA + (size_t)(t + 1) * kstep;
            const char* a2 = last ? nA : cA + (size_t)(t + 2) * kstep; const char* b2 = last ? nB : cB + (size_t)(t + 2) * kstep;
            const char* a3 = a2 + kstep; const char* b3 = b2 + kstep;
            PG8_LDB(B0, 0, 0); PG8_LDB(B1, 0, 1); PG8_SCHED; PG8_LDA(At, 0, 0); PG8_STAGE(PG8_SA(1, 1), a1 + hstepA, voffA);
            PG8_WAIT_V(8); PG8_WAIT_L(0); PG8_BAR; PG8_MMA(0, 0, At, B0); PG8_MMA(0, 1, At, B1); PG8_BAR; PG8_SCHED;
            PG8_LDA(At, 0, 1); PG8_STAGE(PG8_SB(0, 0), b2, voffB); PG8_STAGE(PG8_SB(0, 1), b2 + hstepB, voffB); PG8_STAGE(PG8_SA(0, 0), a2, voffA);
            PG8_WAIT_V(8); PG8_WAIT_L(0); PG8_BAR; PG8_MMA(1, 0, At, B0); PG8_MMA(1, 1, At, B1); PG8_BAR; PG8_SCHED;
            PG8_LDB(B0, 1, 0); PG8_LDB(B1, 1, 1); PG8_SCHED; PG8_LDA(At, 1, 0); PG8_STAGE(PG8_SA(0, 1), a2 + hstepA, voffA);
            PG8_WAIT_V(8); PG8_WAIT_L(0); PG8_BAR; PG8_MMA(0, 0, At, B0); PG8_MMA(0, 1, At, B1); PG8_BAR; PG8_SCHED;
            PG8_LDA(At, 1, 1); PG8_STAGE(PG8_SB(1, 0), b3, voffB); PG8_STAGE(PG8_SB(1, 1), b3 + hstepB, voffB); PG8_STAGE(PG8_SA(1, 0), a3, voffA);
            PG8_WAIT_V(8); PG8_WAIT_L(0); PG8_BAR; PG8_MMA(1, 0, At, B0); PG8_MMA(1, 1, At, B1); PG8_BAR; PG8_SCHED;
        }
        if constexpr (ALIGN_EPI) { if (wr == 0) PG8_BAR; }
        if constexpr (!Epi::AFTER_DRAIN) { E(acc, cur, wr, wc, fr, fq); }
        if (!has_next) break;
#pragma unroll
        for (int a = 0; a < 2; ++a)
#pragma unroll
            for (int b = 0; b < 2; ++b)
#pragma unroll
                for (int m = 0; m < 4; ++m)
#pragma unroll
                    for (int n = 0; n < 2; ++n) acc[a][b][m][n] = (f32x4){0.f, 0.f, 0.f, 0.f};
        cur = nxt; cA = nA; cB = nB; ++ui;
        if constexpr (ALIGN_EPI) { if (wr == 1) PG8_BAR; }
    }
    PG8_WAIT_V(0);
    if constexpr (!ALIGN_EPI) { if (wr == 0) PG8_BAR; }
    PG8_BAR;
    if constexpr (Epi::AFTER_DRAIN) { E.fused(acc, cur, wr, wc, fr, fq, lds, wid, lane); }
#undef PG8_SA
#undef PG8_SB
#undef PG8_STAGE
#undef PG8_LDA
#undef PG8_LDB
#undef PG8_MMA
#undef PG8_WAIT_V
#undef PG8_WAIT_L
#undef PG8_BAR
#undef PG8_SCHED
}
}
using pg8::Unit;

constexpr int SEQ = 8192, DM = 2048, MEM = 256;
constexpr int NIN = 13824;
constexpr float EPS = 1e-6f;
constexpr size_t MiB = 1u << 20;
constexpr size_t WS_CTL = 0, CTL_ZERO_BYTES = 1 * MiB;
constexpr size_t WS_MEMN = 1 * MiB, WS_XK = 2 * MiB, WS_XV = 3 * MiB, WS_DVEC = 4 * MiB, WS_KEYS = 5 * MiB, WS_IW = 6 * MiB;
constexpr size_t WS_WPA = 8 * MiB, WS_WPB = 16 * MiB, WS_WOUT = 24 * MiB, WS_WXQ = 32 * MiB, WS_WXK = 40 * MiB, WS_WXV = 48 * MiB, WS_WXO = 56 * MiB, WS_WPQ = 64 * MiB;
constexpr size_t WS_WIN = 72 * MiB, WS_A0 = 126 * MiB;
constexpr size_t WS_QT = 72 * MiB, WS_KHT = 88 * MiB, WS_VT = 104 * MiB, WS_ATT = 136 * MiB, WS_KBR = 140 * MiB, WS_VB = 142 * MiB, WS_KIR = 144 * MiB, WS_SEL = 145 * MiB, WS_WQK = 153 * MiB, WS_WVO = 157 * MiB;
constexpr size_t WS_GR = 162 * MiB, WS_DQ = 194 * MiB, WS_GATES = 226 * MiB, WS_MISC = 290 * MiB, WS_IQ = 298 * MiB, WS_GQK = 314 * MiB, WS_GV = 346 * MiB, WS_SCORES = 378 * MiB, WS_OA = 506 * MiB;
constexpr size_t WS_ST = 378 * MiB, WS_T1 = 314 * MiB, WS_MERGED = 346 * MiB, WS_A1 = 162 * MiB, WS_XP = 298 * MiB, WS_A2 = 194 * MiB, WS_PQ = 226 * MiB, WS_EXPI = 258 * MiB, WS_GATEW = 262 * MiB;
constexpr size_t WS_UB = 378 * MiB, WS_VBF = 442 * MiB, WS_END = 538 * MiB;
constexpr int CW_BAR = 4096;
constexpr int CW_RSQ1 = 65536, CW_RSQ2 = 65536 + 8192;
constexpr int MISC_LD = 512;

constexpr int RING_BYTES = 131072;
constexpr int LDSCTL_OFF = 147456 - 256;
constexpr int LDS_BYTES = 147456;
constexpr int NWAVES = 8, NTHREADS = 512;

__device__ __forceinline__ u32x4 pack8(const f32x4 v0, const f32x4 v1) { u32x4 w; w.x = pg8::cvt_pk_bf16(v0[0], v0[1]); w.y = pg8::cvt_pk_bf16(v0[2], v0[3]); w.z = pg8::cvt_pk_bf16(v1[0], v1[1]); w.w = pg8::cvt_pk_bf16(v1[2], v1[3]); return w; }

struct EpiRoute {
    static constexpr bool AFTER_DRAIN = false;
    unsigned char* ws;
    __device__ __forceinline__ void operator()(const f32x4 (&acc)[2][2][4][2], const Unit& u, int wr, int wc, int fr, int fq) const {
        const int pn = u.pn; bf16_t* base; int ldc, c0;
        if (pn < 8) { base = (bf16_t*)(ws + WS_GQK); ldc = 2048; c0 = pn * 256; }
        else if (pn < 16) { base = (bf16_t*)(ws + WS_GV); ldc = 2048; c0 = (pn - 8) * 256; }
        else if (pn < 24) { base = (bf16_t*)(ws + WS_GR); ldc = 2048; c0 = (pn - 16) * 256; }
        else if (pn < 32) { base = (bf16_t*)(ws + WS_DQ); ldc = 2048; c0 = (pn - 24) * 256; }
        else if (pn < 36) { base = (bf16_t*)(ws + WS_IQ); ldc = 1024; c0 = (pn - 32) * 256; }
        else if (pn < 52) { base = (bf16_t*)(ws + WS_GATES); ldc = 4096; c0 = (pn - 36) * 256; }
        else { base = (bf16_t*)(ws + WS_MISC); ldc = MISC_LD; c0 = (pn - 52) * 256; }
        const int row0 = u.pm * 256 + wr * 64 + fr, col0 = c0 + wc * 32 + 8 * fq;
#pragma unroll
        for (int ai = 0; ai < 2; ++ai)
#pragma unroll
            for (int m = 0; m < 4; ++m) { bf16_t* rowp = base + (size_t)(row0 + ai * 128 + m * 16) * ldc + col0;
#pragma unroll
                for (int bj = 0; bj < 2; ++bj) *(u32x4*)(rowp + bj * 128) = pack8(acc[ai][bj][m][0], acc[ai][bj][m][1]); }
    }
};
struct EpiBf16 {
    static constexpr bool AFTER_DRAIN = false;
    bf16_t* O; int ldc; const float* rowsq;
    __device__ __forceinline__ void operator()(const f32x4 (&acc)[2][2][4][2], const Unit& u, int wr, int wc, int fr, int fq) const {
        const int row0 = u.pm * 256 + wr * 64 + fr, col0 = u.pn * 256 + wc * 32 + 8 * fq;
#pragma unroll
        for (int ai = 0; ai < 2; ++ai)
#pragma unroll
            for (int m = 0; m < 4; ++m) { const int row = row0 + ai * 128 + m * 16; bf16_t* rowp = O + (size_t)row * ldc + col0;
                const float sc = rowsq ? rsqrtf(rowsq[row] * (1.f / DM) + EPS) : 1.f;
#pragma unroll
                for (int bj = 0; bj < 2; ++bj) *(u32x4*)(rowp + bj * 128) = pack8(acc[ai][bj][m][0] * sc, acc[ai][bj][m][1] * sc); }
    }
};
struct EpiGate {
    static constexpr bool AFTER_DRAIN = false;
    bf16_t* O; const bf16_t* gates; int goff; const bf16_t* prev;
    __device__ __forceinline__ void operator()(const f32x4 (&acc)[2][2][4][2], const Unit& u, int wr, int wc, int fr, int fq) const {
        const int row0 = u.pm * 256 + wr * 64 + fr, col0 = u.pn * 256 + wc * 32 + 8 * fq;
#pragma unroll
        for (int ai = 0; ai < 2; ++ai)
#pragma unroll
            for (int m = 0; m < 4; ++m) { const int row = row0 + ai * 128 + m * 16;
#pragma unroll
                for (int bj = 0; bj < 2; ++bj) { const int col = col0 + bj * 128;
                    const u32x4 gw = *(const u32x4*)(gates + (size_t)row * 4096 + goff + col);
                    f32x4 v0 = acc[ai][bj][m][0], v1 = acc[ai][bj][m][1];
                    v0[0] *= sigmoidf_(bflo(gw.x)); v0[1] *= sigmoidf_(bfhi(gw.x)); v0[2] *= sigmoidf_(bflo(gw.y)); v0[3] *= sigmoidf_(bfhi(gw.y));
                    v1[0] *= sigmoidf_(bflo(gw.z)); v1[1] *= sigmoidf_(bfhi(gw.z)); v1[2] *= sigmoidf_(bflo(gw.w)); v1[3] *= sigmoidf_(bfhi(gw.w));
                    if (prev) { const u32x4 pw = *(const u32x4*)(prev + (size_t)row * DM + col);
                        v0[0] += bflo(pw.x); v0[1] += bfhi(pw.x); v0[2] += bflo(pw.y); v0[3] += bfhi(pw.y); v1[0] += bflo(pw.z); v1[1] += bfhi(pw.z); v1[2] += bflo(pw.w); v1[3] += bfhi(pw.w); }
                    *(u32x4*)(O + (size_t)row * DM + col) = pack8(v0, v1); } }
    }
};
struct EpiResNorm {
    static constexpr bool AFTER_DRAIN = false;
    const float* base; float* out; bf16_t* An; const float* gain; float* rowsq;
    __device__ __forceinline__ void operator()(const f32x4 (&acc)[2][2][4][2], const Unit& u, int wr, int wc, int fr, int fq) const {
        const int row0 = u.pm * 256 + wr * 64 + fr, col0 = u.pn * 256 + wc * 32 + 8 * fq;
        f32x4 gv[2][2];
#pragma unroll
        for (int bj = 0; bj < 2; ++bj) { gv[bj][0] = *(const f32x4*)(gain + col0 + bj * 128); gv[bj][1] = *(const f32x4*)(gain + col0 + bj * 128 + 4); }
#pragma unroll
        for (int ai = 0; ai < 2; ++ai)
#pragma unroll
            for (int m = 0; m < 4; ++m) { const int row = row0 + ai * 128 + m * 16; float ss = 0.f;
#pragma unroll
                for (int bj = 0; bj < 2; ++bj) { const size_t off = (size_t)row * DM + col0 + bj * 128;
                    const f32x4 h0 = *(const f32x4*)(base + off) + acc[ai][bj][m][0], h1 = *(const f32x4*)(base + off + 4) + acc[ai][bj][m][1];
                    *(f32x4*)(out + off) = h0; *(f32x4*)(out + off + 4) = h1;
                    ss += (h0[0] * h0[0] + h0[1] * h0[1]) + (h0[2] * h0[2] + h0[3] * h0[3]) + (h1[0] * h1[0] + h1[1] * h1[1]) + (h1[2] * h1[2] + h1[3] * h1[3]);
                    *(u32x4*)(An + off) = pack8(h0 * gv[bj][0], h1 * gv[bj][1]); }
                ss += __shfl_xor(ss, 16); ss += __shfl_xor(ss, 32);
                if (fq == 0) atomicAdd(rowsq + row, ss); }
    }
};
struct EpiSoftmax {
    static constexpr bool AFTER_DRAIN = true;
    bf16_t* O; int ldc; const float* rowsq; float scale;
    __device__ __forceinline__ void fused(f32x4 (&acc)[2][2][4][2], const Unit& u, int wr, int wc, int fr, int fq, LAS unsigned char* lds, int wid, int lane) const {
        LAS f32x2* P = (LAS f32x2*)lds;
        float mxs[2][4];
#pragma unroll
        for (int ai = 0; ai < 2; ++ai)
#pragma unroll
            for (int m = 0; m < 4; ++m) { const int rl = ai * 128 + wr * 64 + m * 16 + fr; const int row = u.pm * 256 + rl;
                const float sc = rsqrtf(rowsq[row] * (1.f / DM) + EPS) * scale; float mx = -3.0e38f;
#pragma unroll
                for (int bj = 0; bj < 2; ++bj)
#pragma unroll
                    for (int n = 0; n < 2; ++n) { f32x4 x = acc[ai][bj][m][n] * sc; acc[ai][bj][m][n] = x; mx = fmaxf(mx, fmaxf(fmaxf(x[0], x[1]), fmaxf(x[2], x[3]))); }
                mx = fmaxf(mx, __shfl_xor(mx, 16)); mx = fmaxf(mx, __shfl_xor(mx, 32)); float s = 0.f;
#pragma unroll
                for (int bj = 0; bj < 2; ++bj)
#pragma unroll
                    for (int n = 0; n < 2; ++n) { f32x4 x = acc[ai][bj][m][n]; x[0] = __expf(x[0] - mx); x[1] = __expf(x[1] - mx); x[2] = __expf(x[2] - mx); x[3] = __expf(x[3] - mx); acc[ai][bj][m][n] = x; s += (x[0] + x[1]) + (x[2] + x[3]); }
                s += __shfl_xor(s, 16); s += __shfl_xor(s, 32); mxs[ai][m] = mx;
                if (fq == 0) P[rl * 4 + wc] = (f32x2){mx, s}; }
        __syncthreads();
        const int col0 = u.pn * 256 + wc * 32 + 8 * fq;
#pragma unroll
        for (int ai = 0; ai < 2; ++ai)
#pragma unroll
            for (int m = 0; m < 4; ++m) { const int rl = ai * 128 + wr * 64 + m * 16 + fr; const int row = u.pm * 256 + rl;
                const f32x2 a = P[rl * 4 + 0], b = P[rl * 4 + 1], c = P[rl * 4 + 2], d = P[rl * 4 + 3];
                const float M = fmaxf(fmaxf(a.x, b.x), fmaxf(c.x, d.x));
                const float Ssum = a.y * __expf(a.x - M) + b.y * __expf(b.x - M) + c.y * __expf(c.x - M) + d.y * __expf(d.x - M);
                const float f = __expf(mxs[ai][m] - M) / Ssum;
#pragma unroll
                for (int bj = 0; bj < 2; ++bj) *(u32x4*)(O + (size_t)row * ldc + col0 + bj * 128) = pack8(acc[ai][bj][m][0] * f, acc[ai][bj][m][1] * f); }
        __syncthreads();
    }
};

#define XB_TMO      128
#define XB_XCNT(j)  (256  + 64 * (j))
#define XB_XSUB(j)  (1280 + 64 * (j))
#define XB_XGEN(j)  (2304 + 64 * (j))
#define XB_TOP      3328
#define XB_TOPGEN   3392
#define XCD_BAR_WORDS 3456
#define XB_SPIN_CAP (1u << 20)
__device__ __forceinline__ unsigned xb_ld(unsigned* p)              { return __hip_atomic_load(p, __ATOMIC_RELAXED, __HIP_MEMORY_SCOPE_AGENT); }
__device__ __forceinline__ unsigned xb_add(unsigned* p, unsigned v) { return __hip_atomic_fetch_add(p, v, __ATOMIC_RELAXED, __HIP_MEMORY_SCOPE_AGENT); }
__device__ __forceinline__ unsigned xb_xcc_id() { return (unsigned)__builtin_amdgcn_s_getreg((3 << 11) | 20) & 0xFu; }
#define XB_SPIN(cond, bar) do { unsigned _sp = 0; while (cond) { __builtin_amdgcn_s_sleep(1); \
    if ((++_sp & 255u) == 0u) { if (xb_ld(&(bar)[XB_TMO])) break; if (_sp > XB_SPIN_CAP) { atomicAdd(&(bar)[XB_TMO], 1u); break; } } } } while (0)
struct XcdBarrier { unsigned* bar; unsigned x; volatile LAS unsigned* st; };
__device__ __forceinline__ XcdBarrier xcd_barrier_post(unsigned* bar, volatile LAS unsigned* st) {
    XcdBarrier b; b.bar = bar; b.x = xb_xcc_id(); b.st = st;
    if (threadIdx.x == 0) (void)xb_add(&bar[XB_XCNT(b.x)], 1u);
    return b;
}
__device__ __forceinline__ void xcd_barrier_complete(unsigned* bar, unsigned x, unsigned& nloc, unsigned& nx) {
    const unsigned G = gridDim.x * gridDim.y * gridDim.z;
    unsigned sum, cnt, mine, sp = 0u;
    for (;;) {
        sum = 0u; cnt = 0u; mine = 0u;
#pragma unroll
        for (unsigned j = 0; j < 16; ++j) { const unsigned c = xb_ld(&bar[XB_XCNT(j)]); sum += c; cnt += (c > 0u) ? 1u : 0u; mine = (j == x) ? c : mine; }
        if (sum == G) break;
        __builtin_amdgcn_s_sleep(1);
        if ((++sp & 255u) == 0u) { if (xb_ld(&bar[XB_TMO])) break; if (sp > XB_SPIN_CAP) { atomicAdd(&bar[XB_TMO], 1u); break; } }
    }
    nloc = mine > 0u ? mine : 1u; nx = cnt > 0u ? cnt : 1u;
}
__device__ __forceinline__ void xcd_barrier(const XcdBarrier& b) {
    asm volatile("s_waitcnt vmcnt(0)" ::: "memory");
    __syncthreads();
    if (threadIdx.x == 0) {
        unsigned* bar = b.bar;
        __builtin_amdgcn_s_waitcnt(0);
        unsigned nloc = b.st[0], nx = b.st[1];
        if (nloc == 0u) { xcd_barrier_complete(bar, b.x, nloc, nx); b.st[0] = nloc; b.st[1] = nx; }
        const unsigned old = xb_add(&bar[XB_XSUB(b.x)], 1u);
        const unsigned gen = old / nloc;
        if (old + 1u == (gen + 1u) * nloc) {
            __builtin_amdgcn_fence(__ATOMIC_RELEASE, "agent");
            asm volatile("s_waitcnt vmcnt(0)" ::: "memory");
            const unsigned og = xb_add(&bar[XB_TOP], 1u);
            const unsigned tg = og / nx;
            if (og + 1u == (tg + 1u) * nx) xb_add(&bar[XB_TOPGEN], 1u);
            else XB_SPIN(xb_ld(&bar[XB_TOPGEN]) == tg, bar);
            __builtin_amdgcn_fence(__ATOMIC_ACQUIRE, "agent");
            xb_add(&bar[XB_XGEN(b.x)], 1u);
            asm volatile("s_waitcnt vmcnt(0)" ::: "memory");
        } else {
            XB_SPIN(xb_ld(&bar[XB_XGEN(b.x)]) == gen, bar);
            __builtin_amdgcn_fence(__ATOMIC_ACQUIRE, "agent");
            asm volatile("s_waitcnt vmcnt(0)" ::: "memory");
        }
    }
    __syncthreads();
}

struct Args { const float* in[23]; float* out; unsigned char* ws; int ph_lo, ph_hi, use_bar, pad; };
struct Frame {
    LAS unsigned char* lds;
    int tid, lane, wave, G, bid;
    unsigned char* ws;
};

template <int MT, int NT>
__device__ __forceinline__ void wave_gemm_nt(const bf16_t* A, int lda, const bf16_t* B, int ldb, int K, f32x4 (&acc)[MT][NT], int fr, int fq) {
    for (int k0 = 0; k0 < K; k0 += 32) {
        bf16x8 a[MT], b[NT];
#pragma unroll
        for (int mt = 0; mt < MT; ++mt) a[mt] = *(const bf16x8*)(A + (size_t)(16 * mt + fr) * lda + k0 + 8 * fq);
#pragma unroll
        for (int nt = 0; nt < NT; ++nt) b[nt] = *(const bf16x8*)(B + (size_t)(16 * nt + fr) * ldb + k0 + 8 * fq);
#pragma unroll
        for (int mt = 0; mt < MT; ++mt)
#pragma unroll
            for (int nt = 0; nt < NT; ++nt) acc[mt][nt] = __builtin_amdgcn_mfma_f32_16x16x32_bf16(a[mt], b[nt], acc[mt][nt], 0, 0, 0);
    }
}

__device__ __forceinline__ int win_src_col(int n) {
    if (n < 6144) return n;
    if (n < 8192) return 6160 + (n - 6144);
    if (n < 9216) return 8464 + (n - 8192);
    if (n < 11264) return 9568 + (n - 9216);
    if (n < 13312) return 11616 + (n - 11264);
    const int m = n - 13312;
    if (m < 16) return 6144 + m;
    if (m < 32) return 9552 + (m - 16);
    if (m < 96) return 9488 + (m - 32);
    if (m < 128) return -1;
    if (m < 256) return 8208 + (m - 128);
    if (m < 384) return 8336 + (m - 256);
    return -1;
}
__device__ __forceinline__ void transpose_item(const float* W, int N, int K, bf16_t* WT, int drow0, int srccol, int k0, LAS float* scr, int lane) {
#pragma unroll 8
    for (int i = 0; i < 32; ++i) { const int kk = 2 * i + (lane >> 5); scr[kk * 33 + (lane & 31)] = srccol >= 0 ? W[(size_t)(k0 + kk) * N + srccol] : 0.f; }
    LDS_WAIT(); asm volatile("" ::: "memory");
    const int c = lane & 7;
#pragma unroll
    for (int j = 0; j < 4; ++j) { const int n = (lane >> 3) + 8 * j; const LAS float* s = scr + (8 * c) * 33 + n;
        u32x4 o; o.x = pk2(s[0 * 33], s[1 * 33]); o.y = pk2(s[2 * 33], s[3 * 33]); o.z = pk2(s[4 * 33], s[5 * 33]); o.w = pk2(s[6 * 33], s[7 * 33]);
        *(u32x4*)(WT + (size_t)(drow0 + n) * K + k0 + 8 * c) = o; }
    LDS_WAIT(); asm volatile("" ::: "memory");
}
__device__ __forceinline__ void rms_row_to_bf16(const float* xrow, const float* gain, bf16_t* orow, int lane) {
    const f32x4* xr = (const f32x4*)xrow + lane; const f32x4* gr = (const f32x4*)gain + lane;
    f32x4 v[8]; float s = 0.f;
#pragma unroll
    for (int j = 0; j < 8; ++j) { v[j] = xr[64 * j]; s += (v[j][0] * v[j][0] + v[j][1] * v[j][1]) + (v[j][2] * v[j][2] + v[j][3] * v[j][3]); }
    const float rstd = rsqrtf(wave_sum(s) * (1.f / DM) + EPS);
    u32x2* o8 = (u32x2*)orow + lane;
#pragma unroll
    for (int j = 0; j < 8; ++j) { const f32x4 g = gr[64 * j]; u32x2 w; w.x = pk2(v[j][0] * rstd * g[0], v[j][1] * rstd * g[1]); w.y = pk2(v[j][2] * rstd * g[2], v[j][3] * rstd * g[3]); o8[64 * j] = w; }
}
__device__ __forceinline__ void cvt_copy(const float* src, bf16_t* dst, size_t n, size_t gtid, size_t gthreads) {
    for (size_t i = gtid; i < n / 8; i += gthreads) { const f32x4 a = *((const f32x4*)src + 2 * i), b = *((const f32x4*)src + 2 * i + 1);
        u32x4 w; w.x = pk2(a[0], a[1]); w.y = pk2(a[2], a[3]); w.z = pk2(b[0], b[1]); w.w = pk2(b[2], b[3]); *((u32x4*)dst + i) = w; }
}
__device__ __forceinline__ void p0_prologue(const Frame& F, const Args& a) {
    LAS float* scr = (LAS float*)(F.lds + F.wave * 16384);
    const int gw = F.bid * NWAVES + F.wave, NGW = F.G * NWAVES;
    constexpr int I_IN = (NIN / 32) * (DM / 64), I_SQ = (DM / 32) * (DM / 64);
    for (int it = gw; it < I_IN + 7 * I_SQ; it += NGW) {
        if (it < I_IN) { const int nb = it / (DM / 64), kb = it % (DM / 64); const int n = nb * 32 + (F.lane & 31);
            transpose_item(a.in[4], 13664, DM, (bf16_t*)(F.ws + WS_WIN), nb * 32, win_src_col(n), kb * 64, scr, F.lane); }
        else { const int r = it - I_IN, mi = r / I_SQ, q = r % I_SQ, nb = q / (DM / 64), kb = q % (DM / 64);
            const float* W; size_t off;
            switch (mi) { case 0: W = a.in[8]; off = WS_WPA; break; case 1: W = a.in[9]; off = WS_WPB; break; case 2: W = a.in[10]; off = WS_WOUT; break;
                          case 3: W = a.in[14]; off = WS_WXK; break; case 4: W = a.in[15]; off = WS_WXV; break; case 5: W = a.in[16]; off = WS_WXO; break; default: W = a.in[18]; off = WS_WPQ; break; }
            transpose_item(W, DM, DM, (bf16_t*)(F.ws + off), nb * 32, nb * 32 + (F.lane & 31), kb * 64, scr, F.lane); }
    }
    const size_t gtid = (size_t)F.bid * NTHREADS + F.tid, gth = (size_t)F.G * NTHREADS;
    cvt_copy(a.in[13], (bf16_t*)(F.ws + WS_WXQ), (size_t)DM * DM, gtid, gth);
    cvt_copy(a.in[19], (bf16_t*)(F.ws + WS_KEYS), (size_t)16 * 128 * 128, gtid, gth);
    for (int m = gw; m < SEQ + MEM; m += NGW) {
        if (m < SEQ) rms_row_to_bf16(a.in[0] + (size_t)m * DM, a.in[3], (bf16_t*)(F.ws + WS_A0) + (size_t)m * DM, F.lane);
        else rms_row_to_bf16(a.in[1] + (size_t)(m - SEQ) * DM, a.in[12], (bf16_t*)(F.ws + WS_MEMN) + (size_t)(m - SEQ) * DM, F.lane);
    }
}

__device__ __forceinline__ void sincos_red(float ang, float& s, float& c) {
    const float n = rintf(ang * 0.15915494309189535f);
    float r = fmaf(-n, 6.28318548202514648f, ang); r = fmaf(-n, -1.7484556000744883e-07f, r);
    const float f = r * 0.15915494309189535f;
    s = __builtin_amdgcn_sinf(f); c = __builtin_amdgcn_cosf(f);
}
__device__ __forceinline__ void rope_token(const Frame& F, const Args& a, int t) {
    const int l = F.lane; const float pos = (float)((const int*)a.in[2])[t];
    bf16_t* DQ = (bf16_t*)(F.ws + WS_DQ) + (size_t)t * DM; bf16_t* IQ = (bf16_t*)(F.ws + WS_IQ) + (size_t)t * 1024; const bf16_t* MS = (const bf16_t*)(F.ws + WS_MISC) + (size_t)t * MISC_LD;
    float s1, c1, s2, c2;
    { const float inv = powf(10000.f, -(float)(2 * l) / 128.f); sincos_red(pos * inv, s1, c1); }
    { const float inv = powf(10000.f, -(float)(2 * (l & 31)) / 64.f); sincos_red(pos * inv, s2, c2); }
#pragma unroll 4
    for (int h = 0; h < 16; ++h) { const float x1 = bf2f(DQ[h * 128 + l]), x2 = bf2f(DQ[h * 128 + 64 + l]);
        DQ[h * 128 + l] = (bf16_t)f2bf(x1 * c1 - x2 * s1); DQ[h * 128 + 64 + l] = (bf16_t)f2bf(x2 * c1 + x1 * s1); }
    { const float x1 = bf2f(MS[128 + l]), x2 = bf2f(MS[128 + 64 + l]); bf16_t* kb = (bf16_t*)(F.ws + WS_KBR) + (size_t)t * 128;
      kb[l] = (bf16_t)f2bf(x1 * c1 - x2 * s1); kb[64 + l] = (bf16_t)f2bf(x2 * c1 + x1 * s1); }
#pragma unroll 4
    for (int p = 0; p < 8; ++p) { const int h = 2 * p + (l >> 5), i = l & 31; const float x1 = bf2f(IQ[h * 64 + i]), x2 = bf2f(IQ[h * 64 + 32 + i]);
        IQ[h * 64 + i] = (bf16_t)f2bf(x1 * c2 - x2 * s2); IQ[h * 64 + 32 + i] = (bf16_t)f2bf(x2 * c2 + x1 * s2); }
    if (l < 32) { const float x1 = bf2f(MS[32 + l]), x2 = bf2f(MS[64 + l]); bf16_t* ki = (bf16_t*)(F.ws + WS_KIR) + (size_t)t * 64;
        ki[l] = (bf16_t)f2bf(x1 * c2 - x2 * s2); ki[32 + l] = (bf16_t)f2bf(x2 * c2 + x1 * s2); }
    { bf16_t* vb = (bf16_t*)(F.ws + WS_VB) + (size_t)t * 128; vb[l] = MS[256 + l]; vb[64 + l] = MS[320 + l]; }
    if (l < 16) ((float*)(F.ws + WS_IW))[(size_t)t * 16 + l] = bf2f(MS[16 + l]) * 0.03125f;
}
constexpr int GLP = 264;
__device__ __forceinline__ void gla_prep_item(const Frame& F, const Args& a, int item) {
    const int c = item >> 2, h = item & 3, t0 = c * 64, tid = F.tid;
    LAS bf16_t* sQ = (LAS bf16_t*)F.lds; LAS bf16_t* sK = sQ + 64 * GLP; LAS float* sG = (LAS float*)(sK + 64 * GLP);
    const bf16_t* GQK = (const bf16_t*)(F.ws + WS_GQK); const bf16_t* MS = (const bf16_t*)(F.ws + WS_MISC);
    for (int i = tid; i < 64 * 16; i += NTHREADS) sG[i] = bf2f(MS[(size_t)(t0 + (i >> 4)) * MISC_LD + (i & 15)]);
    __syncthreads();
    if (tid < 256) {
        const int d = tid, col = h * 256 + d;
        float w2c[16];
#pragma unroll
        for (int r = 0; r < 16; ++r) w2c[r] = a.in[5][r * 1024 + col];
        const float bias = a.in[6][col];
        bf16_t* QT = (bf16_t*)(F.ws + WS_QT);
        float b = 0.f;
        for (int j = 0; j < 64; ++j) {
            float z = bias;
#pragma unroll
            for (int r = 0; r < 16; ++r) z = fmaf(sG[j * 16 + r], w2c[r], z);
            const float ls = fminf(z, 0.f) - log1pf(__expf(-fabsf(z)));
            b += ls * (1.f / 16.f);
            const float q = bf2f(GQK[(size_t)(t0 + j) * DM + col]), k = bf2f(GQK[(size_t)(t0 + j) * DM + 1024 + col]);
            const float eb = __expf(b);
            const unsigned qb = f2bf(q * 0.0625f * eb), kb = f2bf(k / eb);
            QT[(size_t)(t0 + j) * 1024 + col] = (bf16_t)qb; sQ[j * GLP + d] = (bf16_t)qb; sK[j * GLP + d] = (bf16_t)kb;
        }
        const float eL = __expf(b);
        ((float*)(F.ws + WS_DVEC))[c * 1024 + col] = eL;
        bf16_t* KH = (bf16_t*)(F.ws + WS_KHT) + ((size_t)item * 256 + d) * 64;
#pragma unroll
        for (int j8 = 0; j8 < 8; ++j8) { u32x4 w;
            w.x = pk2(bf2f(sK[(j8 * 8 + 0) * GLP + d]) * eL, bf2f(sK[(j8 * 8 + 1) * GLP + d]) * eL); w.y = pk2(bf2f(sK[(j8 * 8 + 2) * GLP + d]) * eL, bf2f(sK[(j8 * 8 + 3) * GLP + d]) * eL);
            w.z = pk2(bf2f(sK[(j8 * 8 + 4) * GLP + d]) * eL, bf2f(sK[(j8 * 8 + 5) * GLP + d]) * eL); w.w = pk2(bf2f(sK[(j8 * 8 + 6) * GLP + d]) * eL, bf2f(sK[(j8 * 8 + 7) * GLP + d]) * eL);
            *(u32x4*)(KH + j8 * 8) = w; }
    } else {
        const bf16_t* GV = (const bf16_t*)(F.ws + WS_GV);
#pragma unroll 1
        for (int i = 0; i < 2; ++i) { const int e = (tid - 256) + 256 * i; bf16_t* VT = (bf16_t*)(F.ws + WS_VT) + ((size_t)item * 512 + e) * 64;
#pragma unroll
            for (int j8 = 0; j8 < 8; ++j8) { unsigned short v[8];
#pragma unroll
                for (int j = 0; j < 8; ++j) v[j] = GV[(size_t)(t0 + j8 * 8 + j) * DM + h * 512 + e];
                u32x4 w; w.x = v[0] | ((unsigned)v[1] << 16); w.y = v[2] | ((unsigned)v[3] << 16); w.z = v[4] | ((unsigned)v[5] << 16); w.w = v[6] | ((unsigned)v[7] << 16);
                *(u32x4*)(VT + j8 * 8) = w; } }
    }
    __syncthreads();
    { const int fr = F.lane & 15, fq = F.lane >> 4; bf16_t* AT = (bf16_t*)(F.ws + WS_ATT) + (size_t)item * 4096;
#pragma unroll
      for (int tt = 0; tt < 2; ++tt) { const int tile = F.wave * 2 + tt, ti = tile >> 2, tj = tile & 3; f32x4 acc = (f32x4){0.f, 0.f, 0.f, 0.f};
          if (tj <= ti) {
#pragma unroll
              for (int k0 = 0; k0 < 256; k0 += 32) { const bf16x8 av = *(const LAS bf16x8*)(sQ + (16 * ti + fr) * GLP + k0 + 8 * fq), bv = *(const LAS bf16x8*)(sK + (16 * tj + fr) * GLP + k0 + 8 * fq);
                  acc = __builtin_amdgcn_mfma_f32_16x16x32_bf16(av, bv, acc, 0, 0, 0); } }
#pragma unroll
          for (int r = 0; r < 4; ++r) { const int i = 16 * ti + 4 * fq + r, j = 16 * tj + fr; AT[i * 64 + j] = (bf16_t)f2bf(j <= i ? acc[r] : 0.f); } } }
    __syncthreads();
}

constexpr int SC_ITEMS = 1088;
__device__ __forceinline__ void scores_item(const Frame& F, int item) {
    int gq = 0, rem = item;
    while (rem >= 8 * (gq + 1)) { rem -= 8 * (gq + 1); ++gq; }
    const int qb = gq * 8 + rem / (gq + 1), kc = rem % (gq + 1);
    const int fr = F.lane & 15, fq = F.lane >> 4, tq0 = qb * 64 + F.wave * 8;
    const bf16_t* IQ = (const bf16_t*)(F.ws + WS_IQ); const bf16_t* KI = (const bf16_t*)(F.ws + WS_KIR); const float* IW = (const float*)(F.ws + WS_IW);
    _Float16* SC = (_Float16*)(F.ws + WS_SCORES);
    bf16x8 aq[8][2]; f32x4 wq[8];
#pragma unroll
    for (int q = 0; q < 8; ++q) { const bf16_t* p = IQ + (size_t)(tq0 + q) * 1024 + fr * 64 + 8 * fq; aq[q][0] = *(const bf16x8*)p; aq[q][1] = *(const bf16x8*)(p + 32);
        wq[q] = *(const f32x4*)(IW + (size_t)(tq0 + q) * 16 + 4 * fq); }
    for (int g4 = 0; g4 < 8; ++g4) {
        float outv[8];
#pragma unroll
        for (int q = 0; q < 8; ++q) outv[q] = 0.f;
#pragma unroll
        for (int kt = 0; kt < 4; ++kt) { const int key = kc * 512 + g4 * 64 + kt * 16 + fr; const bf16_t* kp = KI + (size_t)key * 64 + 8 * fq;
            const bf16x8 b0 = *(const bf16x8*)kp, b1 = *(const bf16x8*)(kp + 32);
#pragma unroll
            for (int q = 0; q < 8; ++q) { f32x4 acc = (f32x4){0.f, 0.f, 0.f, 0.f};
                acc = __builtin_amdgcn_mfma_f32_16x16x32_bf16(aq[q][0], b0, acc, 0, 0, 0); acc = __builtin_amdgcn_mfma_f32_16x16x32_bf16(aq[q][1], b1, acc, 0, 0, 0);
                float s = fmaxf(acc[0], 0.f) * wq[q][0]; s = fmaf(fmaxf(acc[1], 0.f), wq[q][1], s); s = fmaf(fmaxf(acc[2], 0.f), wq[q][2], s); s = fmaf(fmaxf(acc[3], 0.f), wq[q][3], s);
                s += __shfl_xor(s, 16); s += __shfl_xor(s, 32);
                outv[q] = (fq == kt) ? s : outv[q]; } }
#pragma unroll
        for (int q = 0; q < 8; ++q) SC[(size_t)(tq0 + q) * SEQ + kc * 512 + g4 * 64 + F.lane] = (_Float16)outv[q];
    }
}

__device__ __forceinline__ unsigned h16key(unsigned h) { return (h & 0x8000u) ? (~h & 0xffffu) : (h | 0x8000u); }
__device__ __forceinline__ void select_row(const Frame& F, int t) {
    int* SEL = (int*)(F.ws + WS_SEL) + (size_t)t * 256; const int l = F.lane;
    if (t < 256) {
#pragma unroll
        for (int i = 0; i < 4; ++i) { const int j = i * 64 + l; SEL[j] = (j <= t) ? j : 0; }
        return;
    }
    const unsigned short* SC = (const unsigned short*)(F.ws + WS_SCORES) + (size_t)t * SEQ;
    unsigned kk[64];
#pragma unroll
    for (int i = 0; i < 16; ++i) { const int s0 = (i * 64 + l) * 8; u32x4 v = (u32x4){0u, 0u, 0u, 0u};
        if (s0 <= t) v = *(const u32x4*)(SC + s0);
#pragma unroll
        for (int w = 0; w < 4; ++w) { const unsigned x = v[w]; unsigned lo = h16key(x & 0xffffu), hi = h16key(x >> 16);
            if (s0 + 2 * w > t) lo = 0u; if (s0 + 2 * w + 1 > t) hi = 0u; kk[i * 4 + w] = lo | (hi << 16); } }
    unsigned T = 0u;
    for (int bit = 15; bit >= 0; --bit) { const unsigned cand = T | (1u << bit); int cnt = 0;
#pragma unroll
        for (int r = 0; r < 64; ++r) { cnt += ((kk[r] & 0xffffu) >= cand) ? 1 : 0; cnt += ((kk[r] >> 16) >= cand) ? 1 : 0; }
#pragma unroll
        for (int o = 1; o < 64; o <<= 1) cnt += __shfl_xor(cnt, o);
        if (cnt >= 256) T = cand; }
    int cgt = 0;
#pragma unroll
    for (int r = 0; r < 64; ++r) { cgt += ((kk[r] & 0xffffu) > T) ? 1 : 0; cgt += ((kk[r] >> 16) > T) ? 1 : 0; }
#pragma unroll
    for (int o = 1; o < 64; o <<= 1) cgt += __shfl_xor(cgt, o);
    const int need = 256 - cgt; int base = 0, ties = 0;
#pragma unroll
    for (int r = 0; r < 64; ++r)
#pragma unroll
        for (int hf = 0; hf < 2; ++hf) { const unsigned key = hf ? (kk[r] >> 16) : (kk[r] & 0xffffu); const int s = ((r >> 2) * 64 + l) * 8 + (r & 3) * 2 + hf;
            const bool eq = (key == T); const unsigned long long beq = __ballot(eq);
            const int trank = ties + __builtin_amdgcn_mbcnt_hi((unsigned)(beq >> 32), __builtin_amdgcn_mbcnt_lo((unsigned)beq, 0));
            const bool take = (key > T) || (eq && trank < need); const unsigned long long bt = __ballot(take);
            const int pos = base + __builtin_amdgcn_mbcnt_hi((unsigned)(bt >> 32), __builtin_amdgcn_mbcnt_lo((unsigned)bt, 0));
            if (take) SEL[pos] = s;
            ties += __builtin_popcountll(beq); base += __builtin_popcountll(bt); }
}

constexpr int SP_PP = 264;
constexpr int SP_VP = 136;
constexpr int SP_WAVE_BYTES = 16 * SP_PP * 2 + 32 * SP_VP * 2;
__device__ __forceinline__ s16x4 tr_read4(unsigned lds_addr) { s16x4 r; asm volatile("ds_read_b64_tr_b16 %0, %1\n\ts_waitcnt lgkmcnt(0)" : "=&v"(r) : "v"(lds_addr) : "memory"); return r; }
__device__ __forceinline__ void sparse_attn_query(const Frame& F, int t) {
    const int l = F.lane, fr = l & 15, fq = l >> 4;
    LAS unsigned char* wl = F.lds + F.wave * SP_WAVE_BYTES; LAS bf16_t* sP = (LAS bf16_t*)wl; LAS bf16_t* sV = (LAS bf16_t*)(wl + 16 * SP_PP * 2);
    bf16_t* Q = (bf16_t*)(F.ws + WS_DQ) + (size_t)t * DM; const bf16_t* KB = (const bf16_t*)(F.ws + WS_KBR); const bf16_t* VB = (const bf16_t*)(F.ws + WS_VB);
    const int* SEL = (const int*)(F.ws + WS_SEL) + (size_t)t * 256; const int nvalid = t < 255 ? t + 1 : 256;
    bf16x8 aq[4];
#pragma unroll
    for (int ks = 0; ks < 4; ++ks) aq[ks] = *(const bf16x8*)(Q + fr * 128 + ks * 32 + 8 * fq);
    f32x4 sc[16];
#pragma unroll
    for (int kt = 0; kt < 16; ++kt) { const int srow = SEL[kt * 16 + fr]; const bf16_t* kp = KB + (size_t)srow * 128 + 8 * fq; f32x4 acc = (f32x4){0.f, 0.f, 0.f, 0.f};
#pragma unroll
        for (int ks = 0; ks < 4; ++ks) acc = __builtin_amdgcn_mfma_f32_16x16x32_bf16(aq[ks], *(const bf16x8*)(kp + ks * 32), acc, 0, 0, 0);
        const bool ok = (kt * 16 + fr) < nvalid;
#pragma unroll
        for (int r = 0; r < 4; ++r) acc[r] = ok ? acc[r] * 0.08838834764831845f : -3.0e38f;
        sc[kt] = acc; }
    f32x4 mx = sc[0];
#pragma unroll
    for (int kt = 1; kt < 16; ++kt)
#pragma unroll
        for (int r = 0; r < 4; ++r) mx[r] = fmaxf(mx[r], sc[kt][r]);
#pragma unroll
    for (int o = 1; o < 16; o <<= 1)
#pragma unroll
        for (int r = 0; r < 4; ++r) mx[r] = fmaxf(mx[r], __shfl_xor(mx[r], o));
    f32x4 sm = (f32x4){0.f, 0.f, 0.f, 0.f};
#pragma unroll
    for (int kt = 0; kt < 16; ++kt)
#pragma unroll
        for (int r = 0; r < 4; ++r) { const float e = __expf(sc[kt][r] - mx[r]); sc[kt][r] = e; sm[r] += e; }
#pragma unroll
    for (int o = 1; o < 16; o <<= 1)
#pragma unroll
        for (int r = 0; r < 4; ++r) sm[r] += __shfl_xor(sm[r], o);
#pragma unroll
    for (int r = 0; r < 4; ++r) sm[r] = 1.f / sm[r];
#pragma unroll
    for (int kt = 0; kt < 16; ++kt)
#pragma unroll
        for (int r = 0; r < 4; ++r) sP[(4 * fq + r) * SP_PP + kt * 16 + fr] = (bf16_t)f2bf(sc[kt][r] * sm[r]);
    LDS_WAIT();
    f32x4 o[8];
#pragma unroll
    for (int nt = 0; nt < 8; ++nt) o[nt] = (f32x4){0.f, 0.f, 0.f, 0.f};
    const unsigned vbase = (unsigned)(size_t)sV;
    for (int kst = 0; kst < 8; ++kst) {
#pragma unroll
        for (int i = 0; i < 8; ++i) { const int p = i * 64 + l, row = p >> 4, ch = p & 15; const int srow = SEL[kst * 32 + row];
            *(LAS u32x4*)(sV + row * SP_VP + ch * 8) = *(const u32x4*)(VB + (size_t)srow * 128 + ch * 8); }
        const bf16x8 pa = *(const LAS bf16x8*)(sP + fr * SP_PP + kst * 32 + 8 * fq);
        LDS_WAIT(); __builtin_amdgcn_sched_barrier(0);
#pragma unroll
        for (int nt = 0; nt < 8; ++nt) { const unsigned a0 = vbase + (unsigned)(((8 * fq + (fr >> 2)) * SP_VP + 16 * nt + 4 * (fr & 3)) * 2);
            const s16x4 lo = tr_read4(a0), hi = tr_read4(a0 + 4 * SP_VP * 2);
            bf16x8 bv; bv[0] = lo[0]; bv[1] = lo[1]; bv[2] = lo[2]; bv[3] = lo[3]; bv[4] = hi[0]; bv[5] = hi[1]; bv[6] = hi[2]; bv[7] = hi[3];
            __builtin_amdgcn_sched_barrier(0);
            o[nt] = __builtin_amdgcn_mfma_f32_16x16x32_bf16(pa, bv, o[nt], 0, 0, 0); }
        __builtin_amdgcn_sched_barrier(0);
    }
#pragma unroll
    for (int nt = 0; nt < 8; ++nt)
#pragma unroll
        for (int r = 0; r < 4; ++r) Q[(4 * fq + r) * 128 + 16 * nt + fr] = (bf16_t)f2bf(o[nt][r]);
}

__device__ __forceinline__ void gla_level1_item(const Frame& F, int item) {
    const int fr = F.lane & 15, fq = F.lane >> 4;
    const bf16_t* KH = (const bf16_t*)(F.ws + WS_KHT) + (size_t)item * 256 * 64; const bf16_t* VT = (const bf16_t*)(F.ws + WS_VT) + ((size_t)item * 512 + F.wave * 64) * 64;
    bf16_t* ST = (bf16_t*)(F.ws + WS_ST) + ((size_t)item * 512 + F.wave * 64) * 256;
    for (int db = 0; db < 4; ++db) {
        f32x4 acc[4][4];
#pragma unroll
        for (int i = 0; i < 4; ++i)
#pragma unroll
            for (int j = 0; j < 4; ++j) acc[i][j] = (f32x4){0.f, 0.f, 0.f, 0.f};
        wave_gemm_nt<4, 4>(KH + (size_t)db * 64 * 64, 64, VT, 64, 64, acc, fr, fq);
#pragma unroll
        for (int mt = 0; mt < 4; ++mt)
#pragma unroll
            for (int nt = 0; nt < 4; ++nt) { u32x2 w; w.x = pk2(acc[mt][nt][0], acc[mt][nt][1]); w.y = pk2(acc[mt][nt][2], acc[mt][nt][3]);
                *(u32x2*)(ST + (size_t)(16 * nt + fr) * 256 + db * 64 + 16 * mt + 4 * fq) = w; }
    }
}
__device__ __forceinline__ void gla_scan(const Frame& F) {
    const float* DV = (const float*)(F.ws + WS_DVEC); bf16_t* ST = (bf16_t*)(F.ws + WS_ST);
    for (int idx = F.bid * NTHREADS + F.tid; idx < 4 * 512 * 64; idx += F.G * NTHREADS) {
        const int h = idx >> 15, rem = idx & 32767, e = rem >> 6, d4 = (rem & 63) * 4;
        f32x4 run = (f32x4){0.f, 0.f, 0.f, 0.f};
#pragma unroll 4
        for (int c = 0; c < 128; ++c) { u32x2* p = (u32x2*)(ST + ((size_t)(c * 4 + h) * 512 + e) * 256 + d4); const u32x2 L = *p; const f32x4 dv = *(const f32x4*)(DV + c * 1024 + h * 256 + d4);
            u32x2 w; w.x = pk2(run[0], run[1]); w.y = pk2(run[2], run[3]); *p = w;
            run[0] = fmaf(dv[0], run[0], bflo(L.x)); run[1] = fmaf(dv[1], run[1], bfhi(L.x)); run[2] = fmaf(dv[2], run[2], bflo(L.y)); run[3] = fmaf(dv[3], run[3], bfhi(L.y)); }
    }
}
__device__ __forceinline__ void gla_out_item(const Frame& F, const Args& a, int item) {
    const int c = item >> 2, h = item & 3, t0 = c * 64, fr = F.lane & 15, fq = F.lane >> 4, w = F.wave;
    LAS float* sred = (LAS float*)F.lds;
    f32x4 acc[4][4];
#pragma unroll
    for (int i = 0; i < 4; ++i)
#pragma unroll
        for (int j = 0; j < 4; ++j) acc[i][j] = (f32x4){0.f, 0.f, 0.f, 0.f};
    wave_gemm_nt<4, 4>((const bf16_t*)(F.ws + WS_ST) + ((size_t)item * 512 + w * 64) * 256, 256, (const bf16_t*)(F.ws + WS_QT) + (size_t)t0 * 1024 + h * 256, 1024, 256, acc, fr, fq);
    wave_gemm_nt<4, 4>((const bf16_t*)(F.ws + WS_VT) + ((size_t)item * 512 + w * 64) * 64, 64, (const bf16_t*)(F.ws + WS_ATT) + (size_t)item * 4096, 64, 64, acc, fr, fq);
    float ss[4];
#pragma unroll
    for (int nt = 0; nt < 4; ++nt) { float s = 0.f;
#pragma unroll
        for (int mt = 0; mt < 4; ++mt) s += (acc[mt][nt][0] * acc[mt][nt][0] + acc[mt][nt][1] * acc[mt][nt][1]) + (acc[mt][nt][2] * acc[mt][nt][2] + acc[mt][nt][3] * acc[mt][nt][3]);
        s += __shfl_xor(s, 16); s += __shfl_xor(s, 32); ss[nt] = s;
        if (fq == 0) sred[w * 64 + 16 * nt + fr] = s; }
    __syncthreads();
    const bf16_t* GR = (const bf16_t*)(F.ws + WS_GR); bf16_t* OA = (bf16_t*)(F.ws + WS_OA); const float* gain = a.in[7] + h * 512;
#pragma unroll
    for (int nt = 0; nt < 4; ++nt) { const int tok = 16 * nt + fr; float tot = 0.f;
#pragma unroll
        for (int ww = 0; ww < 8; ++ww) tot += sred[ww * 64 + tok];
        const float rstd = rsqrtf(tot * (1.f / 512.f) + EPS);
#pragma unroll
        for (int mt = 0; mt < 4; ++mt) { const int e = w * 64 + 16 * mt + 4 * fq; const size_t off = (size_t)(t0 + tok) * DM + h * 512 + e;
            const u32x2 g = *(const u32x2*)(GR + off); const f32x4 gn = *(const f32x4*)(gain + e);
            const float r0 = bflo(g.x), r1 = bfhi(g.x), r2 = bflo(g.y), r3 = bfhi(g.y);
            u32x2 o; o.x = pk2(acc[mt][nt][0] * rstd * gn[0] * r0 * sigmoidf_(r0), acc[mt][nt][1] * rstd * gn[1] * r1 * sigmoidf_(r1));
            o.y = pk2(acc[mt][nt][2] * rstd * gn[2] * r2 * sigmoidf_(r2), acc[mt][nt][3] * rstd * gn[3] * r3 * sigmoidf_(r3));
            *(u32x2*)(OA + off) = o; } }
    __syncthreads();
}

__device__ const unsigned char PEER_CAND[52] = {
    0x00,0x01,0x02,0x03,0x04,0x05,0x06,0x07,0x08,0x09,0x0a,0x0b,0x0c,0x0d,0x0e,0x0f, 0x10,0x11,0x12,0x13,0x14,0x15,0x16,0x17, 0x20,0x21,0x22,0x23,0x24, 0x30,0x31,0x32,0x33,
    0x40,0x41,0x42, 0x50,0x51, 0x60,0x61, 0x70,0x71, 0x80,0x90,0xa0,0xb0,0xc0,0xd0,0xe0,0xf0, 0xff,0xff };
__device__ __forceinline__ unsigned f32ord(float f) { const unsigned u = __builtin_bit_cast(unsigned, f); return (u & 0x80000000u) ? ~u : (u | 0x80000000u); }
__device__ __forceinline__ float ordf32(unsigned k) { const unsigned u = (k & 0x80000000u) ? (k & 0x7fffffffu) : ~k; return __builtin_bit_cast(float, u); }
__device__ __forceinline__ void peer_select_item(const Frame& F, int item) {
    const int l = F.lane, fr = l & 15, fq = l >> 4, t0 = item * 16;
    LAS unsigned* tv = (LAS unsigned*)(F.lds + F.wave * 2048);
    const bf16_t* PQ = (const bf16_t*)(F.ws + WS_PQ); const bf16_t* KEYS = (const bf16_t*)(F.ws + WS_KEYS);
    int* EXPI = (int*)(F.ws + WS_EXPI); float* GATEW = (float*)(F.ws + WS_GATEW);
    for (int h = 0; h < 8; ++h) {
#pragma unroll 1
        for (int p = 0; p < 2; ++p) { const int g = h * 2 + p;
            f32x4 acc[8];
#pragma unroll
            for (int mt = 0; mt < 8; ++mt) acc[mt] = (f32x4){0.f, 0.f, 0.f, 0.f};
#pragma unroll
            for (int ks = 0; ks < 4; ++ks) { const bf16x8 bq = *(const bf16x8*)(PQ + (size_t)(t0 + fr) * DM + g * 128 + ks * 32 + 8 * fq);
#pragma unroll
                for (int mt = 0; mt < 8; ++mt) acc[mt] = __builtin_amdgcn_mfma_f32_16x16x32_bf16(*(const bf16x8*)(KEYS + ((size_t)g * 128 + 16 * mt + fr) * 128 + ks * 32 + 8 * fq), bq, acc[mt], 0, 0, 0); }
            unsigned kk[32];
#pragma unroll
            for (int mt = 0; mt < 8; ++mt)
#pragma unroll
                for (int r = 0; r < 4; ++r) kk[mt * 4 + r] = (f32ord(acc[mt][r]) & ~127u) | (unsigned)(127 - (16 * mt + 4 * fq + r));
#pragma unroll
            for (int i = 0; i < 16; ++i) { unsigned m = kk[0];
#pragma unroll
                for (int j = 1; j < 32; ++j) m = m > kk[j] ? m : kk[j];
                { const unsigned o = __shfl_xor(m, 16); m = m > o ? m : o; } { const unsigned o = __shfl_xor(m, 32); m = m > o ? m : o; }
#pragma unroll
                for (int j = 0; j < 32; ++j) kk[j] = (kk[j] == m) ? 0u : kk[j];
                if (fq == (i & 3)) tv[(fr * 2 + p) * 16 + i] = m; }
        }
        LDS_WAIT();
        unsigned ck[13];
#pragma unroll
        for (int ci = 0; ci < 13; ++ci) { const int cidx = fq + 4 * ci; const unsigned ab = PEER_CAND[cidx];
            if (cidx < 50) { const float v = ordf32(tv[(fr * 2 + 0) * 16 + (ab >> 4)] & ~127u) + ordf32(tv[(fr * 2 + 1) * 16 + (ab & 15)] & ~127u); ck[ci] = (f32ord(v) & ~63u) | (unsigned)(63 - cidx); }
            else ck[ci] = 0u; }
        float scv[4]; int exv[4];
#pragma unroll
        for (int i = 0; i < 16; ++i) { unsigned m = ck[0];
#pragma unroll
            for (int j = 1; j < 13; ++j) m = m > ck[j] ? m : ck[j];
            { const unsigned o = __shfl_xor(m, 16); m = m > o ? m : o; } { const unsigned o = __shfl_xor(m, 32); m = m > o ? m : o; }
#pragma unroll
            for (int j = 0; j < 13; ++j) ck[j] = (ck[j] == m) ? 0u : ck[j];
            if (fq == (i & 3)) { const int cidx = 63 - (int)(m & 63u); const unsigned ab = PEER_CAND[cidx];
                const int n1 = 127 - (int)(tv[(fr * 2 + 0) * 16 + (ab >> 4)] & 127u), n2 = 127 - (int)(tv[(fr * 2 + 1) * 16 + (ab & 15)] & 127u);
                exv[i >> 2] = n1 * 128 + n2; scv[i >> 2] = ordf32(m & ~63u); } }
        float mx = fmaxf(fmaxf(scv[0], scv[1]), fmaxf(scv[2], scv[3])); mx = fmaxf(mx, __shfl_xor(mx, 16)); mx = fmaxf(mx, __shfl_xor(mx, 32));
        float ev[4], s = 0.f;
#pragma unroll
        for (int j = 0; j < 4; ++j) { ev[j] = __expf(scv[j] - mx); s += ev[j]; }
        s += __shfl_xor(s, 16); s += __shfl_xor(s, 32); const float inv = 1.f / s;
#pragma unroll
        for (int j = 0; j < 4; ++j) { const size_t o = (size_t)(t0 + fr) * 128 + h * 16 + j * 4 + fq; EXPI[o] = exv[j]; GATEW[o] = ev[j] * inv; }
        LDS_WAIT();
    }
}
__device__ __forceinline__ float gelu_tanh(float x) { const float u = 0.7978845608028654f * (x + 0.044715f * x * x * x); const float e = __expf(2.f * u); const float th = 1.f - 2.f / (e + 1.f); return 0.5f * x * (1.f + th); }
__device__ __forceinline__ float dot8(const u32x4 w, const float* x) {
    return bflo(w.x) * x[0] + bfhi(w.x) * x[1] + bflo(w.y) * x[2] + bfhi(w.y) * x[3] + bflo(w.z) * x[4] + bfhi(w.z) * x[5] + bflo(w.w) * x[6] + bfhi(w.w) * x[7];
}
__device__ __forceinline__ void axpy8(const u32x4 w, float c, float* o) {
    o[0] = fmaf(c, bflo(w.x), o[0]); o[1] = fmaf(c, bfhi(w.x), o[1]); o[2] = fmaf(c, bflo(w.y), o[2]); o[3] = fmaf(c, bfhi(w.y), o[3]);
    o[4] = fmaf(c, bflo(w.z), o[4]); o[5] = fmaf(c, bfhi(w.z), o[5]); o[6] = fmaf(c, bflo(w.w), o[6]); o[7] = fmaf(c, bfhi(w.w), o[7]);
}
__device__ __forceinline__ void peer_expert_token(const Frame& F, const Args& a, int t) {
    const int l = F.lane;
    const bf16_t* UB = (const bf16_t*)(F.ws + WS_UB); const bf16_t* VB = (const bf16_t*)(F.ws + WS_VBF);
    const int* EXPI = (const int*)(F.ws + WS_EXPI) + (size_t)t * 128; const float* GATEW = (const float*)(F.ws + WS_GATEW) + (size_t)t * 128;
    const float rstd2 = rsqrtf(((const float*)(F.ws + WS_CTL))[CW_RSQ2 + t] * (1.f / DM) + EPS);
    float x[32], o[32];
#pragma unroll
    for (int i = 0; i < 4; ++i) { const u32x4 w = *(const u32x4*)((const bf16_t*)(F.ws + WS_A2) + (size_t)t * DM + i * 512 + l * 8);
        x[i * 8 + 0] = bflo(w.x); x[i * 8 + 1] = bfhi(w.x); x[i * 8 + 2] = bflo(w.y); x[i * 8 + 3] = bfhi(w.y); x[i * 8 + 4] = bflo(w.z); x[i * 8 + 5] = bfhi(w.z); x[i * 8 + 6] = bflo(w.w); x[i * 8 + 7] = bfhi(w.w); }
#pragma unroll
    for (int i = 0; i < 32; ++i) o[i] = 0.f;
    for (int jb = 0; jb < 64; ++jb) {
        const int e0 = __builtin_amdgcn_readfirstlane(EXPI[jb * 2]), e1 = __builtin_amdgcn_readfirstlane(EXPI[jb * 2 + 1]);
        const float g0 = __builtin_bit_cast(float, __builtin_amdgcn_readfirstlane(__builtin_bit_cast(int, GATEW[jb * 2]))), g1 = __builtin_bit_cast(float, __builtin_amdgcn_readfirstlane(__builtin_bit_cast(int, GATEW[jb * 2 + 1])));
        const bf16_t* u0 = UB + (size_t)e0 * DM + l * 8; const bf16_t* u1 = UB + (size_t)e1 * DM + l * 8; const bf16_t* v0 = VB + (size_t)e0 * DM + l * 8; const bf16_t* v1 = VB + (size_t)e1 * DM + l * 8;
        u32x4 uw0[4], uw1[4], vw0[4], vw1[4];
#pragma unroll
        for (int i = 0; i < 4; ++i) { uw0[i] = *(const u32x4*)(u0 + i * 512); uw1[i] = *(const u32x4*)(u1 + i * 512); }
#pragma unroll
        for (int i = 0; i < 4; ++i) { vw0[i] = *(const u32x4*)(v0 + i * 512); vw1[i] = *(const u32x4*)(v1 + i * 512); }
        float d0 = 0.f, d1 = 0.f;
#pragma unroll
        for (int i = 0; i < 4; ++i) { d0 += dot8(uw0[i], x + i * 8); d1 += dot8(uw1[i], x + i * 8); }
        d0 = wave_sum(d0); d1 = wave_sum(d1);
        const float c0 = g0 * gelu_tanh(d0 * rstd2), c1 = g1 * gelu_tanh(d1 * rstd2);
#pragma unroll
        for (int i = 0; i < 4; ++i) { axpy8(vw0[i], c0, o + i * 8); axpy8(vw1[i], c1, o + i * 8); }
    }
    float* H = a.out + (size_t)t * DM; const float* gf = a.in[22]; float ss = 0.f;
#pragma unroll
    for (int i = 0; i < 4; ++i) { const f32x4 ha = *(const f32x4*)(H + i * 512 + l * 8), hb = *(const f32x4*)(H + i * 512 + l * 8 + 4);
#pragma unroll
        for (int j = 0; j < 4; ++j) { o[i * 8 + j] += ha[j]; o[i * 8 + 4 + j] += hb[j]; }
#pragma unroll
        for (int j = 0; j < 8; ++j) ss += o[i * 8 + j] * o[i * 8 + j]; }
    const float rstd = rsqrtf(wave_sum(ss) * (1.f / DM) + EPS);
#pragma unroll
    for (int i = 0; i < 4; ++i) { const f32x4 ga = *(const f32x4*)(gf + i * 512 + l * 8), gb = *(const f32x4*)(gf + i * 512 + l * 8 + 4); f32x4 ra, rb;
#pragma unroll
        for (int j = 0; j < 4; ++j) { ra[j] = o[i * 8 + j] * rstd * ga[j]; rb[j] = o[i * 8 + 4 + j] * rstd * gb[j]; }
        *(f32x4*)(H + i * 512 + l * 8) = ra; *(f32x4*)(H + i * 512 + l * 8 + 4) = rb; }
}

constexpr int N_PHASES = 17;
__global__ void __launch_bounds__(NTHREADS, 2) hybrid_fwd(Args args) {
    extern __shared__ __attribute__((aligned(16))) unsigned char lds_raw[];
    Frame F;
    F.lds = (LAS unsigned char*)lds_raw;
    F.tid = threadIdx.x; F.lane = F.tid & 63; F.wave = __builtin_amdgcn_readfirstlane(F.tid >> 6);
    F.G = gridDim.x; F.bid = blockIdx.x; F.ws = args.ws;
    unsigned* ctl = (unsigned*)(args.ws + WS_CTL);
    volatile LAS unsigned* MISCW = (volatile LAS unsigned*)(F.lds + LDSCTL_OFF);
    if (F.tid < 64) MISCW[F.tid] = 0u;
    __syncthreads();
    XcdBarrier bar; bar.bar = ctl + CW_BAR; bar.x = 0; bar.st = nullptr;
    if (args.use_bar) bar = xcd_barrier_post(ctl + CW_BAR, MISCW + 8);
    const int lo = args.ph_lo, hi = args.ph_hi;
    LAS unsigned char* ring = F.lds;
    const int gw = F.bid * NWAVES + F.wave, NGW = F.G * NWAVES;
    float* rsq1 = (float*)ctl + CW_RSQ1; float* rsq2 = (float*)ctl + CW_RSQ2;
#define IN(k) (lo <= (k) && (k) < hi)
#define SEAM(k) do { if (args.use_bar && IN(k) && IN((k) + 1)) { if ((k) == 0) { cg::this_grid().sync(); } else { xcd_barrier(bar); } } } while (0)
#define ROT(r) ((F.bid + F.G - ((r) % F.G)) % F.G)

    if (IN(0)) { p0_prologue(F, args); }
    SEAM(0);
    if (IN(1)) {
        { pg8::Gemm g{(const bf16_t*)(F.ws + WS_A0), (const bf16_t*)(F.ws + WS_WIN), SEQ, NIN, DM, DM, DM}; pg8::StaticOrder S; S.init(SEQ, NIN, F.G, F.bid);
          EpiRoute E{F.ws}; pg8::gemm_phase<EpiRoute, true>(ring, g, S, E); }
        { pg8::Gemm g{(const bf16_t*)(F.ws + WS_MEMN), (const bf16_t*)(F.ws + WS_WXK), MEM, DM, DM, DM, DM}; pg8::StaticOrder S; S.init(MEM, DM, F.G, ROT(192));
          EpiBf16 E{(bf16_t*)(F.ws + WS_XK), DM, nullptr}; pg8::gemm_phase<EpiBf16, true>(ring, g, S, E); }
        { pg8::Gemm g{(const bf16_t*)(F.ws + WS_MEMN), (const bf16_t*)(F.ws + WS_WXV), MEM, DM, DM, DM, DM}; pg8::StaticOrder S; S.init(MEM, DM, F.G, ROT(200));
          EpiBf16 E{(bf16_t*)(F.ws + WS_XV), DM, nullptr}; pg8::gemm_phase<EpiBf16, true>(ring, g, S, E); }
    }
    SEAM(1);
    if (IN(2)) {
#pragma unroll 1
        for (int h = 0; h < 4; ++h) {
            pg8::Gemm g{(const bf16_t*)(F.ws + WS_XK) + h * 512, (const bf16_t*)(F.ws + WS_WXQ) + h * 512, MEM, DM, 512, DM, DM}; pg8::StaticOrder S; S.init(MEM, DM, F.G, ROT(8 * h));
            EpiBf16 E{(bf16_t*)(F.ws + WS_WQK) + (size_t)h * 256 * DM, DM, nullptr}; pg8::gemm_phase<EpiBf16, true>(ring, g, S, E); }
#pragma unroll 1
        for (int h = 0; h < 4; ++h) {
            pg8::Gemm g{(const bf16_t*)(F.ws + WS_WXO) + h * 512, (const bf16_t*)(F.ws + WS_XV) + h * 512, DM, MEM, 512, DM, DM}; pg8::StaticOrder S; S.init(DM, MEM, F.G, ROT(32 + 8 * h));
            EpiBf16 E{(bf16_t*)(F.ws + WS_WVO) + h * 256, 1024, nullptr}; pg8::gemm_phase<EpiBf16, true>(ring, g, S, E); }
        __syncthreads();
        for (int t = gw; t < SEQ; t += NGW) rope_token(F, args, t);
        for (int it = F.bid; it < 512; it += F.G) gla_prep_item(F, args, it);
    }
    SEAM(2);
    if (IN(3)) { for (int it = F.bid; it < SC_ITEMS; it += F.G) scores_item(F, it); }
    SEAM(3);
    if (IN(4)) { for (int t = gw; t < SEQ; t += NGW) select_row(F, t); }
    SEAM(4);
    if (IN(5)) { for (int t = gw; t < SEQ; t += NGW) sparse_attn_query(F, t); }
    SEAM(5);
    if (IN(6)) { for (int it = F.bid; it < 512; it += F.G) gla_level1_item(F, it); }
    SEAM(6);
    if (IN(7)) { gla_scan(F); }
    SEAM(7);
    if (IN(8)) { for (int it = F.bid; it < 512; it += F.G) gla_out_item(F, args, it); }
    SEAM(8);
    if (IN(9)) { pg8::Gemm g{(const bf16_t*)(F.ws + WS_OA), (const bf16_t*)(F.ws + WS_WPA), SEQ, DM, DM, DM, DM}; pg8::StaticOrder S; S.init(SEQ, DM, F.G, F.bid);
        EpiGate E{(bf16_t*)(F.ws + WS_T1), (const bf16_t*)(F.ws + WS_GATES), 0, nullptr}; pg8::gemm_phase<EpiGate, true>(ring, g, S, E); }
    SEAM(9);
    if (IN(10)) { pg8::Gemm g{(const bf16_t*)(F.ws + WS_DQ), (const bf16_t*)(F.ws + WS_WPB), SEQ, DM, DM, DM, DM}; pg8::StaticOrder S; S.init(SEQ, DM, F.G, F.bid);
        EpiGate E{(bf16_t*)(F.ws + WS_MERGED), (const bf16_t*)(F.ws + WS_GATES), 2048, (const bf16_t*)(F.ws + WS_T1)}; pg8::gemm_phase<EpiGate, true>(ring, g, S, E); }
    SEAM(10);
    if (IN(11)) { { pg8::Gemm g{(const bf16_t*)(F.ws + WS_MERGED), (const bf16_t*)(F.ws + WS_WOUT), SEQ, DM, DM, DM, DM}; pg8::StaticOrder S; S.init(SEQ, DM, F.G, F.bid);
          EpiResNorm E{args.in[0], args.out, (bf16_t*)(F.ws + WS_A1), args.in[11], rsq1}; pg8::gemm_phase<EpiResNorm, true>(ring, g, S, E); }
        const size_t gtid = (size_t)F.bid * NTHREADS + F.tid, gth = (size_t)F.G * NTHREADS;
        cvt_copy(args.in[20], (bf16_t*)(F.ws + WS_UB), (size_t)16384 * DM, gtid, gth);
        cvt_copy(args.in[21], (bf16_t*)(F.ws + WS_VBF), (size_t)16384 * DM, gtid, gth);
    }
    SEAM(11);
    if (IN(12)) { pg8::Gemm g{(const bf16_t*)(F.ws + WS_A1), (const bf16_t*)(F.ws + WS_WQK), SEQ, 1024, DM, DM, DM}; pg8::StaticOrder S; S.init(SEQ, 1024, F.G, F.bid);
        EpiSoftmax E{(bf16_t*)(F.ws + WS_XP), 1024, rsq1, 0.044194173824159216f}; pg8::gemm_phase<EpiSoftmax, false>(ring, g, S, E); }
    SEAM(12);
    if (IN(13)) { pg8::Gemm g{(const bf16_t*)(F.ws + WS_XP), (const bf16_t*)(F.ws + WS_WVO), SEQ, DM, 1024, 1024, 1024}; pg8::StaticOrder S; S.init(SEQ, DM, F.G, F.bid);
        EpiResNorm E{args.out, args.out, (bf16_t*)(F.ws + WS_A2), args.in[17], rsq2}; pg8::gemm_phase<EpiResNorm, true>(ring, g, S, E); }
    SEAM(13);
    if (IN(14)) { pg8::Gemm g{(const bf16_t*)(F.ws + WS_A2), (const bf16_t*)(F.ws + WS_WPQ), SEQ, DM, DM, DM, DM}; pg8::StaticOrder S; S.init(SEQ, DM, F.G, F.bid);
        EpiBf16 E{(bf16_t*)(F.ws + WS_PQ), DM, rsq2}; pg8::gemm_phase<EpiBf16, true>(ring, g, S, E); }
    SEAM(14);
    if (IN(15)) { for (int it = gw; it < SEQ / 16; it += NGW) peer_select_item(F, it); }
    SEAM(15);
    if (IN(16)) { for (int t = gw; t < SEQ; t += NGW) peer_expert_token(F, args, t); }
#undef IN
#undef SEAM
#undef ROT
}

#ifndef MK_ONE_LAUNCH
#define MK_ONE_LAUNCH 1
#endif
extern "C" void kernel_launch(void* const* d_in, const int* in_sizes, int n_in, void* d_out, int out_size, void* d_ws, size_t ws_size, hipStream_t stream) {
    static int grid = 0;
    if (grid == 0) {
        if (n_in != 23 || out_size != SEQ * DM || ws_size < WS_END) { fprintf(stderr, "kernel_launch: unexpected problem (n_in %d, out %d, ws %zu < %zu)\n", n_in, out_size, ws_size, (size_t)WS_END); grid = -1; return; }
        int dev = 0, cus = 0, per_cu = 0;
        if (hipGetDevice(&dev) != hipSuccess || hipDeviceGetAttribute(&cus, hipDeviceAttributeMultiprocessorCount, dev) != hipSuccess) { grid = -1; return; }
        if (hipFuncSetAttribute((const void*)hybrid_fwd, hipFuncAttributeMaxDynamicSharedMemorySize, LDS_BYTES) != hipSuccess) { fprintf(stderr, "kernel_launch: hipFuncSetAttribute failed\n"); grid = -1; return; }
        if (hipOccupancyMaxActiveBlocksPerMultiprocessor(&per_cu, (const void*)hybrid_fwd, NTHREADS, LDS_BYTES) != hipSuccess || per_cu < 1) { fprintf(stderr, "kernel_launch: occupancy query says %d\n", per_cu); per_cu = 1; }
        (void)hipGetLastError();
        grid = cus;
    }
    if (grid < 0) return;
    (void)hipMemsetAsync((char*)d_ws + WS_CTL, 0, CTL_ZERO_BYTES, stream);
    Args a{};
    for (int i = 0; i < 23; ++i) a.in[i] = (const float*)d_in[i];
    a.out = (float*)d_out; a.ws = (unsigned char*)d_ws;
#if MK_ONE_LAUNCH
    a.ph_lo = 0; a.ph_hi = N_PHASES; a.use_bar = 1;
    void* kargs[] = {&a};
    hipError_t e = hipLaunchCooperativeKernel((const void*)hybrid_fwd, dim3(grid), dim3(NTHREADS), kargs, LDS_BYTES, stream);
    if (e != hipSuccess) fprintf(stderr, "cooperative launch failed: %s (grid %d)\n", hipGetErrorString(e), grid);
#else
    for (int p = 0; p < N_PHASES; ++p) { a.ph_lo = p; a.ph_hi = p + 1; a.use_bar = 0;
        hipLaunchKernelGGL(hybrid_fwd, dim3(grid), dim3(NTHREADS), LDS_BYTES, stream, a); }
#endif
}
```

```cpp
#include <hip/hip_runtime.h>
#include <hip/hip_cooperative_groups.h>
#include <cstdio>
#include <cstdint>
namespace cg = cooperative_groups;

#define GAS __attribute__((address_space(1)))
#define LAS __attribute__((address_space(3)))
typedef unsigned short bf16_t;
typedef short bf16x8 __attribute__((ext_vector_type(8)));
typedef short s16x4 __attribute__((ext_vector_type(4)));
typedef float f32x4 __attribute__((ext_vector_type(4)));
typedef float f32x2 __attribute__((ext_vector_type(2)));
typedef unsigned u32x4 __attribute__((ext_vector_type(4)));
typedef unsigned u32x2 __attribute__((ext_vector_type(2)));
#define RLX_AGENT __ATOMIC_RELAXED, __HIP_MEMORY_SCOPE_AGENT
#define LDS_WAIT() asm volatile("s_waitcnt lgkmcnt(0)" ::: "memory")
#define VM_WAIT() asm volatile("s_waitcnt vmcnt(0)" ::: "memory")

__device__ __forceinline__ unsigned f2bf(float f) { unsigned u = __builtin_bit_cast(unsigned, f); return (u + 0x7fffu + ((u >> 16) & 1u)) >> 16; }
__device__ __forceinline__ unsigned pk2(float lo, float hi) { return f2bf(lo) | (f2bf(hi) << 16); }
__device__ __forceinline__ float bf2f(unsigned short b) { return __builtin_bit_cast(float, (unsigned)b << 16); }
__device__ __forceinline__ float bflo(unsigned w) { return __builtin_bit_cast(float, w << 16); }
__device__ __forceinline__ float bfhi(unsigned w) { return __builtin_bit_cast(float, w & 0xffff0000u); }
__device__ __forceinline__ float wave_sum(float v) {
#pragma unroll
    for (int o = 1; o < 64; o <<= 1) v += __shfl_xor(v, o);
    return v;
}
__device__ __forceinline__ float sigmoidf_(float x) { return 1.f / (1.f + __expf(-x)); }

namespace pg8 {
constexpr int BM = 256, BK = 64, HALF = 128, HTB = HALF * BK * 2, STAGE_BYTES = 8 * HTB, NXCD = 8, WGM = 8;
__host__ __device__ __forceinline__ int lds_byte(int r, int c) { const int st = (r >> 4) * 2 + (c >> 5), rr = r & 15, cc = c & 31, ob = rr * 64 + cc * 2; return st * 1024 + (ob ^ (((ob >> 9) & 1) << 5)); }
__host__ __device__ __forceinline__ void stage_rc(int b, int& R, int& C) { const int st = b / 1024, sb = b % 1024, swz = sb ^ (((sb >> 9) & 1) << 5); R = (st >> 1) * 16 + swz / 64; C = (st & 1) * 32 + (swz % 64) / 2; }
__host__ __device__ __forceinline__ int perm32(int rho) { const int n = rho >> 4, i = rho & 15; return 8 * (i >> 2) + 4 * n + (i & 3); }

struct Unit { int pm, pn; };
struct Gemm { const bf16_t* A; const bf16_t* Bt; int M, N, K, lda, ldb; };

struct StaticOrder {
    int nM, nN, nwg, G, c;
    __device__ void init(int M, int N, int G_, int c_) { nM = M / BM; nN = N / BM; nwg = nM * nN; G = G_; c = c_; }
    __device__ bool next(int i, Unit& u) const {
        const long L = (long)i * G + c; if (L >= nwg) return false;
        int wgid = (int)L; { const int q = nwg / NXCD, r = nwg % NXCD, xcd = wgid % NXCD, off = wgid / NXCD; wgid = (xcd < r ? xcd * (q + 1) : r * (q + 1) + (xcd - r) * q) + off; }
        const int nig = WGM * nN, gid = wgid / nig, fm = gid * WGM, gsz = (nM - fm) < WGM ? (nM - fm) : WGM;
        u.pm = fm + ((wgid % nig) % gsz); u.pn = (wgid % nig) / gsz; return true;
    }
};

__device__ __forceinline__ unsigned cvt_pk_bf16(float lo, float hi) { unsigned r; asm volatile("v_cvt_pk_bf16_f32 %0, %1, %2" : "=v"(r) : "v"(lo), "v"(hi)); return r; }

template <class Epi, bool ALIGN_EPI>
__device__ __forceinline__ void gemm_phase(LAS unsigned char* lds, const Gemm g, const StaticOrder& S, const Epi& E) {
    const int tid = threadIdx.x, wid = __builtin_amdgcn_readfirstlane(tid >> 6), lane = tid & 63, wr = wid >> 2, wc = wid & 3, fr = lane & 15, fq = lane >> 4;
    const int K = g.K, nt = K / BK;
    unsigned voffA[2], voffB[2];
#pragma unroll
    for (int i = 0; i < 2; ++i) { int R, C; stage_rc(tid * 16 + i * 8192, R, C); const int Rb = (R & ~31) + perm32(R & 31);
        voffA[i] = (unsigned)(R * g.lda + C) * 2u; voffB[i] = (unsigned)(Rb * g.ldb + C) * 2u; }
    const size_t kstep = (size_t)(BK * 2);
    const size_t hstepA = (size_t)HALF * g.lda * 2, hstepB = (size_t)HALF * g.ldb * 2;
    const size_t tstepA = 2 * hstepA, tstepB = 2 * hstepB;
    const unsigned ldsw = (unsigned)wid * 1024u;
    const int aoff = lds_byte(wr * 64 + fr, fq * 8), boff = lds_byte(wc * 32 + fr, fq * 8);
#define PG8_SA(b, h) (((b) * 2 + (h)) * HTB)
#define PG8_SB(b, h) ((4 + (b) * 2 + (h)) * HTB)
#define PG8_STAGE(bufoff, gbase, voff) do { _Pragma("unroll") for (int _i = 0; _i < 2; ++_i) \
        __builtin_amdgcn_global_load_lds((const unsigned*)((const char*)(gbase) + (voff)[_i]), (LAS unsigned*)(lds + (bufoff) + ldsw + _i * 8192), 16, 0, 0); } while (0)
#define PG8_LDA(dst, b, h) do { _Pragma("unroll") for (int m = 0; m < 4; ++m) _Pragma("unroll") for (int k = 0; k < 2; ++k) dst[m][k] = *(const LAS bf16x8*)(lds + PG8_SA(b, h) + aoff + m * 2048 + k * 1024); } while (0)
#define PG8_LDB(dst, b, h) do { _Pragma("unroll") for (int n = 0; n < 2; ++n) _Pragma("unroll") for (int k = 0; k < 2; ++k) dst[n][k] = *(const LAS bf16x8*)(lds + PG8_SB(b, h) + boff + n * 2048 + k * 1024); } while (0)
#define PG8_MMA(ai, bj, At, Bt) do { __builtin_amdgcn_s_setprio(1); _Pragma("unroll") for (int m = 0; m < 4; ++m) _Pragma("unroll") for (int n = 0; n < 2; ++n) _Pragma("unroll") for (int k = 0; k < 2; ++k) \
        acc[ai][bj][m][n] = __builtin_amdgcn_mfma_f32_16x16x32_bf16(Bt[n][k], At[m][k], acc[ai][bj][m][n], 0, 0, 0); __builtin_amdgcn_s_setprio(0); } while (0)
#define PG8_WAIT_V(n) asm volatile("s_waitcnt vmcnt(" #n ")" ::: "memory")
#define PG8_WAIT_L(n) asm volatile("s_waitcnt lgkmcnt(" #n ")" ::: "memory")
#define PG8_BAR __builtin_amdgcn_s_barrier()
#define PG8_SCHED __builtin_amdgcn_sched_barrier(0)
    Unit cur, nxt; int ui = 0;
    if (!S.next(0, cur)) return;
    f32x4 acc[2][2][4][2];
#pragma unroll
    for (int a = 0; a < 2; ++a)
#pragma unroll
        for (int b = 0; b < 2; ++b)
#pragma unroll
            for (int m = 0; m < 4; ++m)
#pragma unroll
                for (int n = 0; n < 2; ++n) acc[a][b][m][n] = (f32x4){0.f, 0.f, 0.f, 0.f};
    bf16x8 At[4][2], B0[2][2], B1[2][2];
    const char* cA = (const char*)g.A + (size_t)cur.pm * tstepA; const char* cB = (const char*)g.Bt + (size_t)cur.pn * tstepB;
    PG8_STAGE(PG8_SB(0, 0), cB, voffB); PG8_STAGE(PG8_SB(0, 1), cB + hstepB, voffB); PG8_STAGE(PG8_SA(0, 0), cA, voffA); PG8_STAGE(PG8_SA(0, 1), cA + hstepA, voffA);
    if (wr == 1) PG8_BAR;
    PG8_WAIT_V(2); PG8_BAR;
    PG8_STAGE(PG8_SB(1, 0), cB + kstep, voffB); PG8_STAGE(PG8_SA(1, 0), cA + kstep, voffA); PG8_STAGE(PG8_SB(1, 1), cB + hstepB + kstep, voffB);
    PG8_WAIT_V(6); PG8_BAR;
    for (;;) {
        const bool has_next = S.next(ui + 1, nxt);
        const char* nA = has_next ? (const char*)g.A + (size_t)nxt.pm * tstepA : cA; const char* nB = has_next ? (const char*)g.Bt + (size_t)nxt.pn * tstepB : cB;
        for (int t = 0; t < nt; t += 2) {
            const bool last = (t == nt - 2);
            const char* a1 = cA + (size_t)(t + 1) * kstep;
            const char* a2 = last ? nA : cA + (size_t)(t + 2) * kstep; const char* b2 = last ? nB : cB + (size_t)(t + 2) * kstep;
            const char* a3 = a2 + kstep; const char* b3 = b2 + kstep;
            PG8_LDB(B0, 0, 0); PG8_LDB(B1, 0, 1); PG8_SCHED; PG8_LDA(At, 0, 0); PG8_STAGE(PG8_SA(1, 1), a1 + hstepA, voffA);
            PG8_WAIT_V(8); PG8_WAIT_L(0); PG8_BAR; PG8_MMA(0, 0, At, B0); PG8_MMA(0, 1, At, B1); PG8_BAR; PG8_SCHED;
            PG8_LDA(At, 0, 1); PG8_STAGE(PG8_SB(0, 0), b2, voffB); PG8_STAGE(PG8_SB(0, 1), b2 + hstepB, voffB); PG8_STAGE(PG8_SA(0, 0), a2, voffA);
            PG8_WAIT_V(8); PG8_WAIT_L(0); PG8_BAR; PG8_MMA(1, 0, At, B0); PG8_MMA(1, 1, At, B1); PG8_BAR; PG8_SCHED;
            PG8_LDB(B0, 1, 0); PG8_LDB(B1, 1, 1); PG8_SCHED; PG8_LDA(At, 1, 0); PG8_STAGE(PG8_SA(0, 1), a2 + hstepA, voffA);
            PG8_WAIT_V(8); PG8_WAIT_L(0); PG8_BAR; PG8_MMA(0, 0, At, B0); PG8_MMA(0, 1, At, B1); PG8_BAR; PG8_SCHED;
            PG8_LDA(At, 1, 1); PG8_STAGE(PG8_SB(1, 0), b3, voffB); PG8_STAGE(PG8_SB(1, 1), b3 + hstepB, voffB); PG8_STAGE(PG8_SA(1, 0), a3, voffA);
            PG8_WAIT_V(8); PG8_WAIT_L(0); PG8_BAR; PG8_MMA(1, 0, At, B0); PG8_MMA(1, 1, At, B1); PG8_BAR; PG8_SCHED;
        }
        if constexpr (ALIGN_EPI) { if (wr == 0) PG8_BAR; }
        if constexpr (!Epi::AFTER_DRAIN) { E(acc, cur, wr, wc, fr, fq); }
        if (!has_next) break;
#pragma unroll
        for (int a = 0; a < 2; ++a)
#pragma unroll
            for (int b = 0; b < 2; ++b)
#pragma unroll
                for (int m = 0; m < 4; ++m)
#pragma unroll
                    for (int n = 0; n < 2; ++n) acc[a][b][m][n] = (f32x4){0.f, 0.f, 0.f, 0.f};
        cur = nxt; cA = nA; cB = nB; ++ui;
        if constexpr (ALIGN_EPI) { if (wr == 1) PG8_BAR; }
    }
    PG8_WAIT_V(0);
    if constexpr (!ALIGN_EPI) { if (wr == 0) PG8_BAR; }
    PG8_BAR;
    if constexpr (Epi::AFTER_DRAIN) { E.fused(acc, cur, wr, wc, fr, fq, lds, wid, lane); }
#undef PG8_SA
#undef PG8_SB
#undef PG8_STAGE
#undef PG8_LDA
#undef PG8_LDB
#undef PG8_MMA
#undef PG8_WAIT_V
#undef PG8_WAIT_L
#undef PG8_BAR
#undef PG8_SCHED
}
}
using pg8::Unit;

constexpr int SEQ = 8192, DM = 2048, MEM = 256;
constexpr int NIN = 13824;
constexpr float EPS = 1e-6f;
constexpr size_t MiB = 1u << 20;
constexpr size_t WS_CTL = 0, CTL_ZERO_BYTES = 1 * MiB;
constexpr size_t WS_MEMN = 1 * MiB, WS_XK = 2 * MiB, WS_XV = 3 * MiB, WS_DVEC = 4 * MiB, WS_KEYS = 5 * MiB, WS_IW = 6 * MiB;
constexpr size_t WS_WPA = 8 * MiB, WS_WPB = 16 * MiB, WS_WOUT = 24 * MiB, WS_WXQ = 32 * MiB, WS_WXK = 40 * MiB, WS_WXV = 48 * MiB, WS_WXO = 56 * MiB, WS_WPQ = 64 * MiB;
constexpr size_t WS_WIN = 72 * MiB, WS_A0 = 126 * MiB;
constexpr size_t WS_QT = 72 * MiB, WS_KHT = 88 * MiB, WS_VT = 104 * MiB, WS_ATT = 136 * MiB, WS_KBR = 140 * MiB, WS_VB = 142 * MiB, WS_KIR = 144 * MiB, WS_SEL = 145 * MiB, WS_WQK = 153 * MiB, WS_WVO = 157 * MiB;
constexpr size_t WS_GR = 162 * MiB, WS_DQ = 194 * MiB, WS_GATES = 226 * MiB, WS_MISC = 290 * MiB, WS_IQ = 298 * MiB, WS_GQK = 314 * MiB, WS_GV = 346 * MiB, WS_SCORES = 378 * MiB, WS_OA = 506 * MiB;
constexpr size_t WS_ST = 378 * MiB, WS_T1 = 314 * MiB, WS_MERGED = 346 * MiB, WS_A1 = 162 * MiB, WS_XP = 298 * MiB, WS_A2 = 194 * MiB, WS_PQ = 226 * MiB, WS_EXPI = 258 * MiB, WS_GATEW = 262 * MiB;
constexpr size_t WS_UB = 378 * MiB, WS_VBF = 410 * MiB, WS_USC = 7 * MiB, WS_VSC = 7 * MiB + 65536, WS_END = 538 * MiB;
constexpr int CW_BAR = 4096;
constexpr int CW_RSQ1 = 65536, CW_RSQ2 = 65536 + 8192;
constexpr int MISC_LD = 512;

constexpr int RING_BYTES = 131072;
constexpr int LDSCTL_OFF = 147456 - 256;
constexpr int LDS_BYTES = 147456;
constexpr int NWAVES = 8, NTHREADS = 512;

__device__ __forceinline__ u32x4 pack8(const f32x4 v0, const f32x4 v1) { u32x4 w; w.x = pg8::cvt_pk_bf16(v0[0], v0[1]); w.y = pg8::cvt_pk_bf16(v0[2], v0[3]); w.z = pg8::cvt_pk_bf16(v1[0], v1[1]); w.w = pg8::cvt_pk_bf16(v1[2], v1[3]); return w; }

struct EpiRoute {
    static constexpr bool AFTER_DRAIN = false;
    unsigned char* ws;
    __device__ __forceinline__ void operator()(const f32x4 (&acc)[2][2][4][2], const Unit& u, int wr, int wc, int fr, int fq) const {
        const int pn = u.pn; bf16_t* base; int ldc, c0;
        if (pn < 8) { base = (bf16_t*)(ws + WS_GQK); ldc = 2048; c0 = pn * 256; }
        else if (pn < 16) { base = (bf16_t*)(ws + WS_GV); ldc = 2048; c0 = (pn - 8) * 256; }
        else if (pn < 24) { base = (bf16_t*)(ws + WS_GR); ldc = 2048; c0 = (pn - 16) * 256; }
        else if (pn < 32) { base = (bf16_t*)(ws + WS_DQ); ldc = 2048; c0 = (pn - 24) * 256; }
        else if (pn < 36) { base = (bf16_t*)(ws + WS_IQ); ldc = 1024; c0 = (pn - 32) * 256; }
        else if (pn < 52) { base = (bf16_t*)(ws + WS_GATES); ldc = 4096; c0 = (pn - 36) * 256; }
        else { base = (bf16_t*)(ws + WS_MISC); ldc = MISC_LD; c0 = (pn - 52) * 256; }
        const int row0 = u.pm * 256 + wr * 64 + fr, col0 = c0 + wc * 32 + 8 * fq;
#pragma unroll
        for (int ai = 0; ai < 2; ++ai)
#pragma unroll
            for (int m = 0; m < 4; ++m) { bf16_t* rowp = base + (size_t)(row0 + ai * 128 + m * 16) * ldc + col0;
#pragma unroll
                for (int bj = 0; bj < 2; ++bj) *(u32x4*)(rowp + bj * 128) = pack8(acc[ai][bj][m][0], acc[ai][bj][m][1]); }
    }
};
struct EpiBf16 {
    static constexpr bool AFTER_DRAIN = false;
    bf16_t* O; int ldc; const float* rowsq;
    __device__ __forceinline__ void operator()(const f32x4 (&acc)[2][2][4][2], const Unit& u, int wr, int wc, int fr, int fq) const {
        const int row0 = u.pm * 256 + wr * 64 + fr, col0 = u.pn * 256 + wc * 32 + 8 * fq;
#pragma unroll
        for (int ai = 0; ai < 2; ++ai)
#pragma unroll
            for (int m = 0; m < 4; ++m) { const int row = row0 + ai * 128 + m * 16; bf16_t* rowp = O + (size_t)row * ldc + col0;
                const float sc = rowsq ? rsqrtf(rowsq[row] * (1.f / DM) + EPS) : 1.f;
#pragma unroll
                for (int bj = 0; bj < 2; ++bj) *(u32x4*)(rowp + bj * 128) = pack8(acc[ai][bj][m][0] * sc, acc[ai][bj][m][1] * sc); }
    }
};
struct EpiGate {
    static constexpr bool AFTER_DRAIN = false;
    bf16_t* O; const bf16_t* gates; int goff; const bf16_t* prev;
    __device__ __forceinline__ void operator()(const f32x4 (&acc)[2][2][4][2], const Unit& u, int wr, int wc, int fr, int fq) const {
        const int row0 = u.pm * 256 + wr * 64 + fr, col0 = u.pn * 256 + wc * 32 + 8 * fq;
#pragma unroll
        for (int ai = 0; ai < 2; ++ai)
#pragma unroll
            for (int m = 0; m < 4; ++m) { const int row = row0 + ai * 128 + m * 16;
#pragma unroll
                for (int bj = 0; bj < 2; ++bj) { const int col = col0 + bj * 128;
                    const u32x4 gw = *(const u32x4*)(gates + (size_t)row * 4096 + goff + col);
                    f32x4 v0 = acc[ai][bj][m][0], v1 = acc[ai][bj][m][1];
                    v0[0] *= sigmoidf_(bflo(gw.x)); v0[1] *= sigmoidf_(bfhi(gw.x)); v0[2] *= sigmoidf_(bflo(gw.y)); v0[3] *= sigmoidf_(bfhi(gw.y));
                    v1[0] *= sigmoidf_(bflo(gw.z)); v1[1] *= sigmoidf_(bfhi(gw.z)); v1[2] *= sigmoidf_(bflo(gw.w)); v1[3] *= sigmoidf_(bfhi(gw.w));
                    if (prev) { const u32x4 pw = *(const u32x4*)(prev + (size_t)row * DM + col);
                        v0[0] += bflo(pw.x); v0[1] += bfhi(pw.x); v0[2] += bflo(pw.y); v0[3] += bfhi(pw.y); v1[0] += bflo(pw.z); v1[1] += bfhi(pw.z); v1[2] += bflo(pw.w); v1[3] += bfhi(pw.w); }
                    *(u32x4*)(O + (size_t)row * DM + col) = pack8(v0, v1); } }
    }
};
struct EpiResNorm {
    static constexpr bool AFTER_DRAIN = false;
    const float* base; float* out; bf16_t* An; const float* gain; float* rowsq;
    __device__ __forceinline__ void operator()(const f32x4 (&acc)[2][2][4][2], const Unit& u, int wr, int wc, int fr, int fq) const {
        const int row0 = u.pm * 256 + wr * 64 + fr, col0 = u.pn * 256 + wc * 32 + 8 * fq;
        f32x4 gv[2][2];
#pragma unroll
        for (int bj = 0; bj < 2; ++bj) { gv[bj][0] = *(const f32x4*)(gain + col0 + bj * 128); gv[bj][1] = *(const f32x4*)(gain + col0 + bj * 128 + 4); }
#pragma unroll
        for (int ai = 0; ai < 2; ++ai)
#pragma unroll
            for (int m = 0; m < 4; ++m) { const int row = row0 + ai * 128 + m * 16; float ss = 0.f;
#pragma unroll
                for (int bj = 0; bj < 2; ++bj) { const size_t off = (size_t)row * DM + col0 + bj * 128;
                    const f32x4 h0 = *(const f32x4*)(base + off) + acc[ai][bj][m][0], h1 = *(const f32x4*)(base + off + 4) + acc[ai][bj][m][1];
                    *(f32x4*)(out + off) = h0; *(f32x4*)(out + off + 4) = h1;
                    ss += (h0[0] * h0[0] + h0[1] * h0[1]) + (h0[2] * h0[2] + h0[3] * h0[3]) + (h1[0] * h1[0] + h1[1] * h1[1]) + (h1[2] * h1[2] + h1[3] * h1[3]);
                    *(u32x4*)(An + off) = pack8(h0 * gv[bj][0], h1 * gv[bj][1]); }
                ss += __shfl_xor(ss, 16); ss += __shfl_xor(ss, 32);
                if (fq == 0) atomicAdd(rowsq + row, ss); }
    }
};
struct EpiSoftmax {
    static constexpr bool AFTER_DRAIN = true;
    bf16_t* O; int ldc; const float* rowsq; float scale;
    __device__ __forceinline__ void fused(f32x4 (&acc)[2][2][4][2], const Unit& u, int wr, int wc, int fr, int fq, LAS unsigned char* lds, int wid, int lane) const {
        LAS f32x2* P = (LAS f32x2*)lds;
        float mxs[2][4];
#pragma unroll
        for (int ai = 0; ai < 2; ++ai)
#pragma unroll
            for (int m = 0; m < 4; ++m) { const int rl = ai * 128 + wr * 64 + m * 16 + fr; const int row = u.pm * 256 + rl;
                const float sc = rsqrtf(rowsq[row] * (1.f / DM) + EPS) * scale; float mx = -3.0e38f;
#pragma unroll
                for (int bj = 0; bj < 2; ++bj)
#pragma unroll
                    for (int n = 0; n < 2; ++n) { f32x4 x = acc[ai][bj][m][n] * sc; acc[ai][bj][m][n] = x; mx = fmaxf(mx, fmaxf(fmaxf(x[0], x[1]), fmaxf(x[2], x[3]))); }
                mx = fmaxf(mx, __shfl_xor(mx, 16)); mx = fmaxf(mx, __shfl_xor(mx, 32)); float s = 0.f;
#pragma unroll
                for (int bj = 0; bj < 2; ++bj)
#pragma unroll
                    for (int n = 0; n < 2; ++n) { f32x4 x = acc[ai][bj][m][n]; x[0] = __expf(x[0] - mx); x[1] = __expf(x[1] - mx); x[2] = __expf(x[2] - mx); x[3] = __expf(x[3] - mx); acc[ai][bj][m][n] = x; s += (x[0] + x[1]) + (x[2] + x[3]); }
                s += __shfl_xor(s, 16); s += __shfl_xor(s, 32); mxs[ai][m] = mx;
                if (fq == 0) P[rl * 4 + wc] = (f32x2){mx, s}; }
        __syncthreads();
        const int col0 = u.pn * 256 + wc * 32 + 8 * fq;
#pragma unroll
        for (int ai = 0; ai < 2; ++ai)
#pragma unroll
            for (int m = 0; m < 4; ++m) { const int rl = ai * 128 + wr * 64 + m * 16 + fr; const int row = u.pm * 256 + rl;
                const f32x2 a = P[rl * 4 + 0], b = P[rl * 4 + 1], c = P[rl * 4 + 2], d = P[rl * 4 + 3];
                const float M = fmaxf(fmaxf(a.x, b.x), fmaxf(c.x, d.x));
                const float Ssum = a.y * __expf(a.x - M) + b.y * __expf(b.x - M) + c.y * __expf(c.x - M) + d.y * __expf(d.x - M);
                const float f = __expf(mxs[ai][m] - M) / Ssum;
#pragma unroll
                for (int bj = 0; bj < 2; ++bj) *(u32x4*)(O + (size_t)row * ldc + col0 + bj * 128) = pack8(acc[ai][bj][m][0] * f, acc[ai][bj][m][1] * f); }
        __syncthreads();
    }
};

#define XB_TMO      128
#define XB_XCNT(j)  (256  + 64 * (j))
#define XB_XSUB(j)  (1280 + 64 * (j))
#define XB_XGEN(j)  (2304 + 64 * (j))
#define XB_TOP      3328
#define XB_TOPGEN   3392
#define XCD_BAR_WORDS 3456
#define XB_SPIN_CAP (1u << 20)
__device__ __forceinline__ unsigned xb_ld(unsigned* p)              { return __hip_atomic_load(p, __ATOMIC_RELAXED, __HIP_MEMORY_SCOPE_AGENT); }
__device__ __forceinline__ unsigned xb_add(unsigned* p, unsigned v) { return __hip_atomic_fetch_add(p, v, __ATOMIC_RELAXED, __HIP_MEMORY_SCOPE_AGENT); }
__device__ __forceinline__ unsigned xb_xcc_id() { return (unsigned)__builtin_amdgcn_s_getreg((3 << 11) | 20) & 0xFu; }
#define XB_SPIN(cond, bar) do { unsigned _sp = 0; while (cond) { __builtin_amdgcn_s_sleep(1); \
    if ((++_sp & 255u) == 0u) { if (xb_ld(&(bar)[XB_TMO])) break; if (_sp > XB_SPIN_CAP) { atomicAdd(&(bar)[XB_TMO], 1u); break; } } } } while (0)
struct XcdBarrier { unsigned* bar; unsigned x; volatile LAS unsigned* st; };
__device__ __forceinline__ XcdBarrier xcd_barrier_post(unsigned* bar, volatile LAS unsigned* st) {
    XcdBarrier b; b.bar = bar; b.x = xb_xcc_id(); b.st = st;
    if (threadIdx.x == 0) (void)xb_add(&bar[XB_XCNT(b.x)], 1u);
    return b;
}
__device__ __forceinline__ void xcd_barrier_complete(unsigned* bar, unsigned x, unsigned& nloc, unsigned& nx) {
    const unsigned G = gridDim.x * gridDim.y * gridDim.z;
    unsigned sum, cnt, mine, sp = 0u;
    for (;;) {
        sum = 0u; cnt = 0u; mine = 0u;
#pragma unroll
        for (unsigned j = 0; j < 16; ++j) { const unsigned c = xb_ld(&bar[XB_XCNT(j)]); sum += c; cnt += (c > 0u) ? 1u : 0u; mine = (j == x) ? c : mine; }
        if (sum == G) break;
        __builtin_amdgcn_s_sleep(1);
        if ((++sp & 255u) == 0u) { if (xb_ld(&bar[XB_TMO])) break; if (sp > XB_SPIN_CAP) { atomicAdd(&bar[XB_TMO], 1u); break; } }
    }
    nloc = mine > 0u ? mine : 1u; nx = cnt > 0u ? cnt : 1u;
}
__device__ __forceinline__ void xcd_barrier(const XcdBarrier& b) {
    asm volatile("s_waitcnt vmcnt(0)" ::: "memory");
    __syncthreads();
    if (threadIdx.x == 0) {
        unsigned* bar = b.bar;
        __builtin_amdgcn_s_waitcnt(0);
        unsigned nloc = b.st[0], nx = b.st[1];
        if (nloc == 0u) { xcd_barrier_complete(bar, b.x, nloc, nx); b.st[0] = nloc; b.st[1] = nx; }
        const unsigned old = xb_add(&bar[XB_XSUB(b.x)], 1u);
        const unsigned gen = old / nloc;
        if (old + 1u == (gen + 1u) * nloc) {
            __builtin_amdgcn_fence(__ATOMIC_RELEASE, "agent");
            asm volatile("s_waitcnt vmcnt(0)" ::: "memory");
            const unsigned og = xb_add(&bar[XB_TOP], 1u);
            const unsigned tg = og / nx;
            if (og + 1u == (tg + 1u) * nx) xb_add(&bar[XB_TOPGEN], 1u);
            else XB_SPIN(xb_ld(&bar[XB_TOPGEN]) == tg, bar);
            __builtin_amdgcn_fence(__ATOMIC_ACQUIRE, "agent");
            xb_add(&bar[XB_XGEN(b.x)], 1u);
            asm volatile("s_waitcnt vmcnt(0)" ::: "memory");
        } else {
            XB_SPIN(xb_ld(&bar[XB_XGEN(b.x)]) == gen, bar);
            __builtin_amdgcn_fence(__ATOMIC_ACQUIRE, "agent");
            asm volatile("s_waitcnt vmcnt(0)" ::: "memory");
        }
    }
    __syncthreads();
}

struct Args { const float* in[23]; float* out; unsigned char* ws; int ph_lo, ph_hi, use_bar, pad; };
struct Frame {
    LAS unsigned char* lds;
    int tid, lane, wave, G, bid;
    unsigned char* ws;
};

template <int MT, int NT>
__device__ __forceinline__ void wave_gemm_nt(const bf16_t* A, int lda, const bf16_t* B, int ldb, int K, f32x4 (&acc)[MT][NT], int fr, int fq) {
    for (int k0 = 0; k0 < K; k0 += 32) {
        bf16x8 a[MT], b[NT];
#pragma unroll
        for (int mt = 0; mt < MT; ++mt) a[mt] = *(const bf16x8*)(A + (size_t)(16 * mt + fr) * lda + k0 + 8 * fq);
#pragma unroll
        for (int nt = 0; nt < NT; ++nt) b[nt] = *(const bf16x8*)(B + (size_t)(16 * nt + fr) * ldb + k0 + 8 * fq);
#pragma unroll
        for (int mt = 0; mt < MT; ++mt)
#pragma unroll
            for (int nt = 0; nt < NT; ++nt) acc[mt][nt] = __builtin_amdgcn_mfma_f32_16x16x32_bf16(a[mt], b[nt], acc[mt][nt], 0, 0, 0);
    }
}

__device__ __forceinline__ int win_src_col(int n) {
    if (n < 6144) return n;
    if (n < 8192) return 6160 + (n - 6144);
    if (n < 9216) return 8464 + (n - 8192);
    if (n < 11264) return 9568 + (n - 9216);
    if (n < 13312) return 11616 + (n - 11264);
    const int m = n - 13312;
    if (m < 16) return 6144 + m;
    if (m < 32) return 9552 + (m - 16);
    if (m < 96) return 9488 + (m - 32);
    if (m < 128) return -1;
    if (m < 256) return 8208 + (m - 128);
    if (m < 384) return 8336 + (m - 256);
    return -1;
}
__device__ __forceinline__ void transpose_item(const float* W, int N, int K, bf16_t* WT, int drow0, int srccol, int k0, LAS float* scr, int lane) {
#pragma unroll 8
    for (int i = 0; i < 32; ++i) { const int kk = 2 * i + (lane >> 5); scr[kk * 33 + (lane & 31)] = srccol >= 0 ? W[(size_t)(k0 + kk) * N + srccol] : 0.f; }
    LDS_WAIT(); asm volatile("" ::: "memory");
    const int c = lane & 7;
#pragma unroll
    for (int j = 0; j < 4; ++j) { const int n = (lane >> 3) + 8 * j; const LAS float* s = scr + (8 * c) * 33 + n;
        u32x4 o; o.x = pk2(s[0 * 33], s[1 * 33]); o.y = pk2(s[2 * 33], s[3 * 33]); o.z = pk2(s[4 * 33], s[5 * 33]); o.w = pk2(s[6 * 33], s[7 * 33]);
        *(u32x4*)(WT + (size_t)(drow0 + n) * K + k0 + 8 * c) = o; }
    LDS_WAIT(); asm volatile("" ::: "memory");
}
__device__ __forceinline__ void rms_row_to_bf16(const float* xrow, const float* gain, bf16_t* orow, int lane) {
    const f32x4* xr = (const f32x4*)xrow + lane; const f32x4* gr = (const f32x4*)gain + lane;
    f32x4 v[8]; float s = 0.f;
#pragma unroll
    for (int j = 0; j < 8; ++j) { v[j] = xr[64 * j]; s += (v[j][0] * v[j][0] + v[j][1] * v[j][1]) + (v[j][2] * v[j][2] + v[j][3] * v[j][3]); }
    const float rstd = rsqrtf(wave_sum(s) * (1.f / DM) + EPS);
    u32x2* o8 = (u32x2*)orow + lane;
#pragma unroll
    for (int j = 0; j < 8; ++j) { const f32x4 g = gr[64 * j]; u32x2 w; w.x = pk2(v[j][0] * rstd * g[0], v[j][1] * rstd * g[1]); w.y = pk2(v[j][2] * rstd * g[2], v[j][3] * rstd * g[3]); o8[64 * j] = w; }
}
__device__ __forceinline__ void cvt_copy(const float* src, bf16_t* dst, size_t n, size_t gtid, size_t gthreads) {
    for (size_t i = gtid; i < n / 8; i += gthreads) { const f32x4 a = *((const f32x4*)src + 2 * i), b = *((const f32x4*)src + 2 * i + 1);
        u32x4 w; w.x = pk2(a[0], a[1]); w.y = pk2(a[2], a[3]); w.z = pk2(b[0], b[1]); w.w = pk2(b[2], b[3]); *((u32x4*)dst + i) = w; }
}
__device__ __forceinline__ void p0_prologue(const Frame& F, const Args& a) {
    LAS float* scr = (LAS float*)(F.lds + F.wave * 16384);
    const int gw = F.bid * NWAVES + F.wave, NGW = F.G * NWAVES;
    constexpr int I_IN = (NIN / 32) * (DM / 64), I_SQ = (DM / 32) * (DM / 64);
    for (int it = gw; it < I_IN + 7 * I_SQ; it += NGW) {
        if (it < I_IN) { const int nb = it / (DM / 64), kb = it % (DM / 64); const int n = nb * 32 + (F.lane & 31);
            transpose_item(a.in[4], 13664, DM, (bf16_t*)(F.ws + WS_WIN), nb * 32, win_src_col(n), kb * 64, scr, F.lane); }
        else { const int r = it - I_IN, mi = r / I_SQ, q = r % I_SQ, nb = q / (DM / 64), kb = q % (DM / 64);
            const float* W; size_t off;
            switch (mi) { case 0: W = a.in[8]; off = WS_WPA; break; case 1: W = a.in[9]; off = WS_WPB; break; case 2: W = a.in[10]; off = WS_WOUT; break;
                          case 3: W = a.in[14]; off = WS_WXK; break; case 4: W = a.in[15]; off = WS_WXV; break; case 5: W = a.in[16]; off = WS_WXO; break; default: W = a.in[18]; off = WS_WPQ; break; }
            transpose_item(W, DM, DM, (bf16_t*)(F.ws + off), nb * 32, nb * 32 + (F.lane & 31), kb * 64, scr, F.lane); }
    }
    const size_t gtid = (size_t)F.bid * NTHREADS + F.tid, gth = (size_t)F.G * NTHREADS;
    cvt_copy(a.in[13], (bf16_t*)(F.ws + WS_WXQ), (size_t)DM * DM, gtid, gth);
    cvt_copy(a.in[19], (bf16_t*)(F.ws + WS_KEYS), (size_t)16 * 128 * 128, gtid, gth);
    for (int m = gw; m < SEQ + MEM; m += NGW) {
        if (m < SEQ) rms_row_to_bf16(a.in[0] + (size_t)m * DM, a.in[3], (bf16_t*)(F.ws + WS_A0) + (size_t)m * DM, F.lane);
        else rms_row_to_bf16(a.in[1] + (size_t)(m - SEQ) * DM, a.in[12], (bf16_t*)(F.ws + WS_MEMN) + (size_t)(m - SEQ) * DM, F.lane);
    }
}

__device__ __forceinline__ void sincos_red(float ang, float& s, float& c) {
    const float n = rintf(ang * 0.15915494309189535f);
    float r = fmaf(-n, 6.28318548202514648f, ang); r = fmaf(-n, -1.7484556000744883e-07f, r);
    const float f = r * 0.15915494309189535f;
    s = __builtin_amdgcn_sinf(f); c = __builtin_amdgcn_cosf(f);
}
__device__ __forceinline__ void rope_token(const Frame& F, const Args& a, int t) {
    const int l = F.lane; const float pos = (float)((const int*)a.in[2])[t];
    bf16_t* DQ = (bf16_t*)(F.ws + WS_DQ) + (size_t)t * DM; bf16_t* IQ = (bf16_t*)(F.ws + WS_IQ) + (size_t)t * 1024; const bf16_t* MS = (const bf16_t*)(F.ws + WS_MISC) + (size_t)t * MISC_LD;
    float s1, c1, s2, c2;
    { const float inv = powf(10000.f, -(float)(2 * l) / 128.f); sincos_red(pos * inv, s1, c1); }
    { const float inv = powf(10000.f, -(float)(2 * (l & 31)) / 64.f); sincos_red(pos * inv, s2, c2); }
#pragma unroll 4
    for (int h = 0; h < 16; ++h) { const float x1 = bf2f(DQ[h * 128 + l]), x2 = bf2f(DQ[h * 128 + 64 + l]);
        DQ[h * 128 + l] = (bf16_t)f2bf(x1 * c1 - x2 * s1); DQ[h * 128 + 64 + l] = (bf16_t)f2bf(x2 * c1 + x1 * s1); }
    { const float x1 = bf2f(MS[128 + l]), x2 = bf2f(MS[128 + 64 + l]); bf16_t* kb = (bf16_t*)(F.ws + WS_KBR) + (size_t)t * 128;
      kb[l] = (bf16_t)f2bf(x1 * c1 - x2 * s1); kb[64 + l] = (bf16_t)f2bf(x2 * c1 + x1 * s1); }
#pragma unroll 4
    for (int p = 0; p < 8; ++p) { const int h = 2 * p + (l >> 5), i = l & 31; const float x1 = bf2f(IQ[h * 64 + i]), x2 = bf2f(IQ[h * 64 + 32 + i]);
        IQ[h * 64 + i] = (bf16_t)f2bf(x1 * c2 - x2 * s2); IQ[h * 64 + 32 + i] = (bf16_t)f2bf(x2 * c2 + x1 * s2); }
    if (l < 32) { const float x1 = bf2f(MS[32 + l]), x2 = bf2f(MS[64 + l]); bf16_t* ki = (bf16_t*)(F.ws + WS_KIR) + (size_t)t * 64;
        ki[l] = (bf16_t)f2bf(x1 * c2 - x2 * s2); ki[32 + l] = (bf16_t)f2bf(x2 * c2 + x1 * s2); }
    { bf16_t* vb = (bf16_t*)(F.ws + WS_VB) + (size_t)t * 128; vb[l] = MS[256 + l]; vb[64 + l] = MS[320 + l]; }
    if (l < 16) ((float*)(F.ws + WS_IW))[(size_t)t * 16 + l] = bf2f(MS[16 + l]) * 0.03125f;
}
constexpr int GLP = 264;
__device__ __forceinline__ void gla_prep_item(const Frame& F, const Args& a, int item) {
    const int c = item >> 2, h = item & 3, t0 = c * 64, tid = F.tid;
    LAS bf16_t* sQ = (LAS bf16_t*)F.lds; LAS bf16_t* sK = sQ + 64 * GLP; LAS float* sG = (LAS float*)(sK + 64 * GLP);
    const bf16_t* GQK = (const bf16_t*)(F.ws + WS_GQK); const bf16_t* MS = (const bf16_t*)(F.ws + WS_MISC);
    for (int i = tid; i < 64 * 16; i += NTHREADS) sG[i] = bf2f(MS[(size_t)(t0 + (i >> 4)) * MISC_LD + (i & 15)]);
    __syncthreads();
    if (tid < 256) {
        const int d = tid, col = h * 256 + d;
        float w2c[16];
#pragma unroll
        for (int r = 0; r < 16; ++r) w2c[r] = a.in[5][r * 1024 + col];
        const float bias = a.in[6][col];
        bf16_t* QT = (bf16_t*)(F.ws + WS_QT);
        float b = 0.f;
        for (int j = 0; j < 64; ++j) {
            float z = bias;
#pragma unroll
            for (int r = 0; r < 16; ++r) z = fmaf(sG[j * 16 + r], w2c[r], z);
            const float ls = fminf(z, 0.f) - log1pf(__expf(-fabsf(z)));
            b += ls * (1.f / 16.f);
            const float q = bf2f(GQK[(size_t)(t0 + j) * DM + col]), k = bf2f(GQK[(size_t)(t0 + j) * DM + 1024 + col]);
            const float eb = __expf(b);
            const unsigned qb = f2bf(q * 0.0625f * eb), kb = f2bf(k / eb);
            QT[(size_t)(t0 + j) * 1024 + col] = (bf16_t)qb; sQ[j * GLP + d] = (bf16_t)qb; sK[j * GLP + d] = (bf16_t)kb;
        }
        const float eL = __expf(b);
        ((float*)(F.ws + WS_DVEC))[c * 1024 + col] = eL;
        bf16_t* KH = (bf16_t*)(F.ws + WS_KHT) + ((size_t)item * 256 + d) * 64;
#pragma unroll
        for (int j8 = 0; j8 < 8; ++j8) { u32x4 w;
            w.x = pk2(bf2f(sK[(j8 * 8 + 0) * GLP + d]) * eL, bf2f(sK[(j8 * 8 + 1) * GLP + d]) * eL); w.y = pk2(bf2f(sK[(j8 * 8 + 2) * GLP + d]) * eL, bf2f(sK[(j8 * 8 + 3) * GLP + d]) * eL);
            w.z = pk2(bf2f(sK[(j8 * 8 + 4) * GLP + d]) * eL, bf2f(sK[(j8 * 8 + 5) * GLP + d]) * eL); w.w = pk2(bf2f(sK[(j8 * 8 + 6) * GLP + d]) * eL, bf2f(sK[(j8 * 8 + 7) * GLP + d]) * eL);
            *(u32x4*)(KH + j8 * 8) = w; }
    } else {
        const bf16_t* GV = (const bf16_t*)(F.ws + WS_GV);
#pragma unroll 1
        for (int i = 0; i < 2; ++i) { const int e = (tid - 256) + 256 * i; bf16_t* VT = (bf16_t*)(F.ws + WS_VT) + ((size_t)item * 512 + e) * 64;
#pragma unroll
            for (int j8 = 0; j8 < 8; ++j8) { unsigned short v[8];
#pragma unroll
                for (int j = 0; j < 8; ++j) v[j] = GV[(size_t)(t0 + j8 * 8 + j) * DM + h * 512 + e];
                u32x4 w; w.x = v[0] | ((unsigned)v[1] << 16); w.y = v[2] | ((unsigned)v[3] << 16); w.z = v[4] | ((unsigned)v[5] << 16); w.w = v[6] | ((unsigned)v[7] << 16);
                *(u32x4*)(VT + j8 * 8) = w; } }
    }
    __syncthreads();
    { const int fr = F.lane & 15, fq = F.lane >> 4; bf16_t* AT = (bf16_t*)(F.ws + WS_ATT) + (size_t)item * 4096;
#pragma unroll
      for (int tt = 0; tt < 2; ++tt) { const int tile = F.wave * 2 + tt, ti = tile >> 2, tj = tile & 3; f32x4 acc = (f32x4){0.f, 0.f, 0.f, 0.f};
          if (tj <= ti) {
#pragma unroll
              for (int k0 = 0; k0 < 256; k0 += 32) { const bf16x8 av = *(const LAS bf16x8*)(sQ + (16 * ti + fr) * GLP + k0 + 8 * fq), bv = *(const LAS bf16x8*)(sK + (16 * tj + fr) * GLP + k0 + 8 * fq);
                  acc = __builtin_amdgcn_mfma_f32_16x16x32_bf16(av, bv, acc, 0, 0, 0); } }
#pragma unroll
          for (int r = 0; r < 4; ++r) { const int i = 16 * ti + 4 * fq + r, j = 16 * tj + fr; AT[i * 64 + j] = (bf16_t)f2bf(j <= i ? acc[r] : 0.f); } } }
    __syncthreads();
}

constexpr int SC_ITEMS = 1088;
__device__ __forceinline__ void scores_item(const Frame& F, int item) {
    int gq = 0, rem = item;
    while (rem >= 8 * (gq + 1)) { rem -= 8 * (gq + 1); ++gq; }
    const int qb = gq * 8 + rem / (gq + 1), kc = rem % (gq + 1);
    const int fr = F.lane & 15, fq = F.lane >> 4, tq0 = qb * 64 + F.wave * 8;
    const bf16_t* IQ = (const bf16_t*)(F.ws + WS_IQ); const bf16_t* KI = (const bf16_t*)(F.ws + WS_KIR); const float* IW = (const float*)(F.ws + WS_IW);
    _Float16* SC = (_Float16*)(F.ws + WS_SCORES);
    bf16x8 aq[8][2]; f32x4 wq[8];
#pragma unroll
    for (int q = 0; q < 8; ++q) { const bf16_t* p = IQ + (size_t)(tq0 + q) * 1024 + fr * 64 + 8 * fq; aq[q][0] = *(const bf16x8*)p; aq[q][1] = *(const bf16x8*)(p + 32);
        wq[q] = *(const f32x4*)(IW + (size_t)(tq0 + q) * 16 + 4 * fq); }
    for (int g4 = 0; g4 < 8; ++g4) {
        float outv[8];
#pragma unroll
        for (int q = 0; q < 8; ++q) outv[q] = 0.f;
#pragma unroll
        for (int kt = 0; kt < 4; ++kt) { const int key = kc * 512 + g4 * 64 + kt * 16 + fr; const bf16_t* kp = KI + (size_t)key * 64 + 8 * fq;
            const bf16x8 b0 = *(const bf16x8*)kp, b1 = *(const bf16x8*)(kp + 32);
#pragma unroll
            for (int q = 0; q < 8; ++q) { f32x4 acc = (f32x4){0.f, 0.f, 0.f, 0.f};
                acc = __builtin_amdgcn_mfma_f32_16x16x32_bf16(aq[q][0], b0, acc, 0, 0, 0); acc = __builtin_amdgcn_mfma_f32_16x16x32_bf16(aq[q][1], b1, acc, 0, 0, 0);
                float s = fmaxf(acc[0], 0.f) * wq[q][0]; s = fmaf(fmaxf(acc[1], 0.f), wq[q][1], s); s = fmaf(fmaxf(acc[2], 0.f), wq[q][2], s); s = fmaf(fmaxf(acc[3], 0.f), wq[q][3], s);
                s += __shfl_xor(s, 16); s += __shfl_xor(s, 32);
                outv[q] = (fq == kt) ? s : outv[q]; } }
#pragma unroll
        for (int q = 0; q < 8; ++q) SC[(size_t)(tq0 + q) * SEQ + kc * 512 + g4 * 64 + F.lane] = (_Float16)outv[q];
    }
}

__device__ __forceinline__ unsigned h16key(unsigned h) { return (h & 0x8000u) ? (~h & 0xffffu) : (h | 0x8000u); }
__device__ __forceinline__ void select_row(const Frame& F, int t) {
    int* SEL = (int*)(F.ws + WS_SEL) + (size_t)t * 256; const int l = F.lane;
    if (t < 256) {
#pragma unroll
        for (int i = 0; i < 4; ++i) { const int j = i * 64 + l; SEL[j] = (j <= t) ? j : 0; }
        return;
    }
    const unsigned short* SC = (const unsigned short*)(F.ws + WS_SCORES) + (size_t)t * SEQ;
    unsigned kk[64];
#pragma unroll
    for (int i = 0; i < 16; ++i) { const int s0 = (i * 64 + l) * 8; u32x4 v = (u32x4){0u, 0u, 0u, 0u};
        if (s0 <= t) v = *(const u32x4*)(SC + s0);
#pragma unroll
        for (int w = 0; w < 4; ++w) { const unsigned x = v[w]; unsigned lo = h16key(x & 0xffffu), hi = h16key(x >> 16);
            if (s0 + 2 * w > t) lo = 0u; if (s0 + 2 * w + 1 > t) hi = 0u; kk[i * 4 + w] = lo | (hi << 16); } }
    unsigned T = 0u;
    for (int bit = 15; bit >= 0; --bit) { const unsigned cand = T | (1u << bit); int cnt = 0;
#pragma unroll
        for (int r = 0; r < 64; ++r) { cnt += ((kk[r] & 0xffffu) >= cand) ? 1 : 0; cnt += ((kk[r] >> 16) >= cand) ? 1 : 0; }
#pragma unroll
        for (int o = 1; o < 64; o <<= 1) cnt += __shfl_xor(cnt, o);
        if (cnt >= 256) T = cand; }
    int cgt = 0;
#pragma unroll
    for (int r = 0; r < 64; ++r) { cgt += ((kk[r] & 0xffffu) > T) ? 1 : 0; cgt += ((kk[r] >> 16) > T) ? 1 : 0; }
#pragma unroll
    for (int o = 1; o < 64; o <<= 1) cgt += __shfl_xor(cgt, o);
    const int need = 256 - cgt; int base = 0, ties = 0;
#pragma unroll
    for (int r = 0; r < 64; ++r)
#pragma unroll
        for (int hf = 0; hf < 2; ++hf) { const unsigned key = hf ? (kk[r] >> 16) : (kk[r] & 0xffffu); const int s = ((r >> 2) * 64 + l) * 8 + (r & 3) * 2 + hf;
            const bool eq = (key == T); const unsigned long long beq = __ballot(eq);
            const int trank = ties + __builtin_amdgcn_mbcnt_hi((unsigned)(beq >> 32), __builtin_amdgcn_mbcnt_lo((unsigned)beq, 0));
            const bool take = (key > T) || (eq && trank < need); const unsigned long long bt = __ballot(take);
            const int pos = base + __builtin_amdgcn_mbcnt_hi((unsigned)(bt >> 32), __builtin_amdgcn_mbcnt_lo((unsigned)bt, 0));
            if (take) SEL[pos] = s;
            ties += __builtin_popcountll(beq); base += __builtin_popcountll(bt); }
}

constexpr int SP_PP = 264;
constexpr int SP_VP = 136;
constexpr int SP_WAVE_BYTES = 16 * SP_PP * 2 + 32 * SP_VP * 2;
__device__ __forceinline__ s16x4 tr_read4(unsigned lds_addr) { s16x4 r; asm volatile("ds_read_b64_tr_b16 %0, %1\n\ts_waitcnt lgkmcnt(0)" : "=&v"(r) : "v"(lds_addr) : "memory"); return r; }
__device__ __forceinline__ void sparse_attn_query(const Frame& F, int t) {
    const int l = F.lane, fr = l & 15, fq = l >> 4;
    LAS unsigned char* wl = F.lds + F.wave * SP_WAVE_BYTES; LAS bf16_t* sP = (LAS bf16_t*)wl; LAS bf16_t* sV = (LAS bf16_t*)(wl + 16 * SP_PP * 2);
    bf16_t* Q = (bf16_t*)(F.ws + WS_DQ) + (size_t)t * DM; const bf16_t* KB = (const bf16_t*)(F.ws + WS_KBR); const bf16_t* VB = (const bf16_t*)(F.ws + WS_VB);
    const int* SEL = (const int*)(F.ws + WS_SEL) + (size_t)t * 256; const int nvalid = t < 255 ? t + 1 : 256;
    bf16x8 aq[4];
#pragma unroll
    for (int ks = 0; ks < 4; ++ks) aq[ks] = *(const bf16x8*)(Q + fr * 128 + ks * 32 + 8 * fq);
    f32x4 sc[16];
#pragma unroll
    for (int kt = 0; kt < 16; ++kt) { const int srow = SEL[kt * 16 + fr]; const bf16_t* kp = KB + (size_t)srow * 128 + 8 * fq; f32x4 acc = (f32x4){0.f, 0.f, 0.f, 0.f};
#pragma unroll
        for (int ks = 0; ks < 4; ++ks) acc = __builtin_amdgcn_mfma_f32_16x16x32_bf16(aq[ks], *(const bf16x8*)(kp + ks * 32), acc, 0, 0, 0);
        const bool ok = (kt * 16 + fr) < nvalid;
#pragma unroll
        for (int r = 0; r < 4; ++r) acc[r] = ok ? acc[r] * 0.08838834764831845f : -3.0e38f;
        sc[kt] = acc; }
    f32x4 mx = sc[0];
#pragma unroll
    for (int kt = 1; kt < 16; ++kt)
#pragma unroll
        for (int r = 0; r < 4; ++r) mx[r] = fmaxf(mx[r], sc[kt][r]);
#pragma unroll
    for (int o = 1; o < 16; o <<= 1)
#pragma unroll
        for (int r = 0; r < 4; ++r) mx[r] = fmaxf(mx[r], __shfl_xor(mx[r], o));
    f32x4 sm = (f32x4){0.f, 0.f, 0.f, 0.f};
#pragma unroll
    for (int kt = 0; kt < 16; ++kt)
#pragma unroll
        for (int r = 0; r < 4; ++r) { const float e = __expf(sc[kt][r] - mx[r]); sc[kt][r] = e; sm[r] += e; }
#pragma unroll
    for (int o = 1; o < 16; o <<= 1)
#pragma unroll
        for (int r = 0; r < 4; ++r) sm[r] += __shfl_xor(sm[r], o);
#pragma unroll
    for (int r = 0; r < 4; ++r) sm[r] = 1.f / sm[r];
#pragma unroll
    for (int kt = 0; kt < 16; ++kt)
#pragma unroll
        for (int r = 0; r < 4; ++r) sP[(4 * fq + r) * SP_PP + kt * 16 + fr] = (bf16_t)f2bf(sc[kt][r] * sm[r]);
    LDS_WAIT();
    f32x4 o[8];
#pragma unroll
    for (int nt = 0; nt < 8; ++nt) o[nt] = (f32x4){0.f, 0.f, 0.f, 0.f};
    const unsigned vbase = (unsigned)(size_t)sV;
    for (int kst = 0; kst < 8; ++kst) {
#pragma unroll
        for (int i = 0; i < 8; ++i) { const int p = i * 64 + l, row = p >> 4, ch = p & 15; const int srow = SEL[kst * 32 + row];
            *(LAS u32x4*)(sV + row * SP_VP + ch * 8) = *(const u32x4*)(VB + (size_t)srow * 128 + ch * 8); }
        const bf16x8 pa = *(const LAS bf16x8*)(sP + fr * SP_PP + kst * 32 + 8 * fq);
        LDS_WAIT(); __builtin_amdgcn_sched_barrier(0);
#pragma unroll
        for (int nt = 0; nt < 8; ++nt) { const unsigned a0 = vbase + (unsigned)(((8 * fq + (fr >> 2)) * SP_VP + 16 * nt + 4 * (fr & 3)) * 2);
            const s16x4 lo = tr_read4(a0), hi = tr_read4(a0 + 4 * SP_VP * 2);
            bf16x8 bv; bv[0] = lo[0]; bv[1] = lo[1]; bv[2] = lo[2]; bv[3] = lo[3]; bv[4] = hi[0]; bv[5] = hi[1]; bv[6] = hi[2]; bv[7] = hi[3];
            __builtin_amdgcn_sched_barrier(0);
            o[nt] = __builtin_amdgcn_mfma_f32_16x16x32_bf16(pa, bv, o[nt], 0, 0, 0); }
        __builtin_amdgcn_sched_barrier(0);
    }
#pragma unroll
    for (int nt = 0; nt < 8; ++nt)
#pragma unroll
        for (int r = 0; r < 4; ++r) Q[(4 * fq + r) * 128 + 16 * nt + fr] = (bf16_t)f2bf(o[nt][r]);
}

__device__ __forceinline__ void gla_level1_item(const Frame& F, int item) {
    const int fr = F.lane & 15, fq = F.lane >> 4;
    const bf16_t* KH = (const bf16_t*)(F.ws + WS_KHT) + (size_t)item * 256 * 64; const bf16_t* VT = (const bf16_t*)(F.ws + WS_VT) + ((size_t)item * 512 + F.wave * 64) * 64;
    bf16_t* ST = (bf16_t*)(F.ws + WS_ST) + ((size_t)item * 512 + F.wave * 64) * 256;
    for (int db = 0; db < 4; ++db) {
        f32x4 acc[4][4];
#pragma unroll
        for (int i = 0; i < 4; ++i)
#pragma unroll
            for (int j = 0; j < 4; ++j) acc[i][j] = (f32x4){0.f, 0.f, 0.f, 0.f};
        wave_gemm_nt<4, 4>(KH + (size_t)db * 64 * 64, 64, VT, 64, 64, acc, fr, fq);
#pragma unroll
        for (int mt = 0; mt < 4; ++mt)
#pragma unroll
            for (int nt = 0; nt < 4; ++nt) { u32x2 w; w.x = pk2(acc[mt][nt][0], acc[mt][nt][1]); w.y = pk2(acc[mt][nt][2], acc[mt][nt][3]);
                *(u32x2*)(ST + (size_t)(16 * nt + fr) * 256 + db * 64 + 16 * mt + 4 * fq) = w; }
    }
}
__device__ __forceinline__ void gla_scan(const Frame& F) {
    const float* DV = (const float*)(F.ws + WS_DVEC); bf16_t* ST = (bf16_t*)(F.ws + WS_ST);
    for (int idx = F.bid * NTHREADS + F.tid; idx < 4 * 512 * 64; idx += F.G * NTHREADS) {
        const int h = idx >> 15, rem = idx & 32767, e = rem >> 6, d4 = (rem & 63) * 4;
        f32x4 run = (f32x4){0.f, 0.f, 0.f, 0.f};
#pragma unroll 4
        for (int c = 0; c < 128; ++c) { u32x2* p = (u32x2*)(ST + ((size_t)(c * 4 + h) * 512 + e) * 256 + d4); const u32x2 L = *p; const f32x4 dv = *(const f32x4*)(DV + c * 1024 + h * 256 + d4);
            u32x2 w; w.x = pk2(run[0], run[1]); w.y = pk2(run[2], run[3]); *p = w;
            run[0] = fmaf(dv[0], run[0], bflo(L.x)); run[1] = fmaf(dv[1], run[1], bfhi(L.x)); run[2] = fmaf(dv[2], run[2], bflo(L.y)); run[3] = fmaf(dv[3], run[3], bfhi(L.y)); }
    }
}
__device__ __forceinline__ void gla_out_item(const Frame& F, const Args& a, int item) {
    const int c = item >> 2, h = item & 3, t0 = c * 64, fr = F.lane & 15, fq = F.lane >> 4, w = F.wave;
    LAS float* sred = (LAS float*)F.lds;
    f32x4 acc[4][4];
#pragma unroll
    for (int i = 0; i < 4; ++i)
#pragma unroll
        for (int j = 0; j < 4; ++j) acc[i][j] = (f32x4){0.f, 0.f, 0.f, 0.f};
    wave_gemm_nt<4, 4>((const bf16_t*)(F.ws + WS_ST) + ((size_t)item * 512 + w * 64) * 256, 256, (const bf16_t*)(F.ws + WS_QT) + (size_t)t0 * 1024 + h * 256, 1024, 256, acc, fr, fq);
    wave_gemm_nt<4, 4>((const bf16_t*)(F.ws + WS_VT) + ((size_t)item * 512 + w * 64) * 64, 64, (const bf16_t*)(F.ws + WS_ATT) + (size_t)item * 4096, 64, 64, acc, fr, fq);
    float ss[4];
#pragma unroll
    for (int nt = 0; nt < 4; ++nt) { float s = 0.f;
#pragma unroll
        for (int mt = 0; mt < 4; ++mt) s += (acc[mt][nt][0] * acc[mt][nt][0] + acc[mt][nt][1] * acc[mt][nt][1]) + (acc[mt][nt][2] * acc[mt][nt][2] + acc[mt][nt][3] * acc[mt][nt][3]);
        s += __shfl_xor(s, 16); s += __shfl_xor(s, 32); ss[nt] = s;
        if (fq == 0) sred[w * 64 + 16 * nt + fr] = s; }
    __syncthreads();
    const bf16_t* GR = (const bf16_t*)(F.ws + WS_GR); bf16_t* OA = (bf16_t*)(F.ws + WS_OA); const float* gain = a.in[7] + h * 512;
#pragma unroll
    for (int nt = 0; nt < 4; ++nt) { const int tok = 16 * nt + fr; float tot = 0.f;
#pragma unroll
        for (int ww = 0; ww < 8; ++ww) tot += sred[ww * 64 + tok];
        const float rstd = rsqrtf(tot * (1.f / 512.f) + EPS);
#pragma unroll
        for (int mt = 0; mt < 4; ++mt) { const int e = w * 64 + 16 * mt + 4 * fq; const size_t off = (size_t)(t0 + tok) * DM + h * 512 + e;
            const u32x2 g = *(const u32x2*)(GR + off); const f32x4 gn = *(const f32x4*)(gain + e);
            const float r0 = bflo(g.x), r1 = bfhi(g.x), r2 = bflo(g.y), r3 = bfhi(g.y);
            u32x2 o; o.x = pk2(acc[mt][nt][0] * rstd * gn[0] * r0 * sigmoidf_(r0), acc[mt][nt][1] * rstd * gn[1] * r1 * sigmoidf_(r1));
            o.y = pk2(acc[mt][nt][2] * rstd * gn[2] * r2 * sigmoidf_(r2), acc[mt][nt][3] * rstd * gn[3] * r3 * sigmoidf_(r3));
            *(u32x2*)(OA + off) = o; } }
    __syncthreads();
}

__device__ const unsigned char PEER_CAND[52] = {
    0x00,0x01,0x02,0x03,0x04,0x05,0x06,0x07,0x08,0x09,0x0a,0x0b,0x0c,0x0d,0x0e,0x0f, 0x10,0x11,0x12,0x13,0x14,0x15,0x16,0x17, 0x20,0x21,0x22,0x23,0x24, 0x30,0x31,0x32,0x33,
    0x40,0x41,0x42, 0x50,0x51, 0x60,0x61, 0x70,0x71, 0x80,0x90,0xa0,0xb0,0xc0,0xd0,0xe0,0xf0, 0xff,0xff };
__device__ __forceinline__ unsigned f32ord(float f) { const unsigned u = __builtin_bit_cast(unsigned, f); return (u & 0x80000000u) ? ~u : (u | 0x80000000u); }
__device__ __forceinline__ float ordf32(unsigned k) { const unsigned u = (k & 0x80000000u) ? (k & 0x7fffffffu) : ~k; return __builtin_bit_cast(float, u); }
__device__ __forceinline__ unsigned umax_x32(unsigned v) { const unsigned o = __shfl_xor(v, 32); return v > o ? v : o; }
__device__ __forceinline__ float fmax_x32(float v) { return fmaxf(v, __shfl_xor(v, 32)); }
__device__ __forceinline__ float fadd_x32(float v) { return v + __shfl_xor(v, 32); }
__device__ __forceinline__ void peer_select_item(const Frame& F, int item) {
    const int l = F.lane, fr = l & 15, fq = l >> 4, t0 = (item >> 3) * 16, h = item & 7;
    LAS unsigned* tv = (LAS unsigned*)(F.lds + F.wave * 2048);
    const bf16_t* PQ = (const bf16_t*)(F.ws + WS_PQ); const bf16_t* KEYS = (const bf16_t*)(F.ws + WS_KEYS);
    int* EXPI = (int*)(F.ws + WS_EXPI); float* GATEW = (float*)(F.ws + WS_GATEW);
    {
#pragma unroll 1
        for (int p = 0; p < 2; ++p) { const int g = h * 2 + p;
            f32x4 acc[8];
#pragma unroll
            for (int mt = 0; mt < 8; ++mt) acc[mt] = (f32x4){0.f, 0.f, 0.f, 0.f};
#pragma unroll
            for (int ks = 0; ks < 4; ++ks) { const bf16x8 bq = *(const bf16x8*)(PQ + (size_t)(t0 + fr) * DM + g * 128 + ks * 32 + 8 * fq);
#pragma unroll
                for (int mt = 0; mt < 8; ++mt) acc[mt] = __builtin_amdgcn_mfma_f32_16x16x32_bf16(*(const bf16x8*)(KEYS + ((size_t)g * 128 + 16 * mt + fr) * 128 + ks * 32 + 8 * fq), bq, acc[mt], 0, 0, 0); }
            unsigned kk[32];
#pragma unroll
            for (int mt = 0; mt < 8; ++mt)
#pragma unroll
                for (int r = 0; r < 4; ++r) kk[mt * 4 + r] = (f32ord(acc[mt][r]) & ~127u) | (unsigned)(127 - (16 * mt + 4 * fq + r));
#pragma unroll
            for (int i = 0; i < 16; ++i) { unsigned m = kk[0];
#pragma unroll
                for (int j = 1; j < 32; ++j) m = m > kk[j] ? m : kk[j];
                { const unsigned o = __shfl_xor(m, 16); m = m > o ? m : o; } m = umax_x32(m);
#pragma unroll
                for (int j = 0; j < 32; ++j) kk[j] = (kk[j] == m) ? 0u : kk[j];
                if (fq == (i & 3)) tv[(fr * 2 + p) * 16 + i] = m; }
        }
        LDS_WAIT();
        unsigned ck[13];
#pragma unroll
        for (int ci = 0; ci < 13; ++ci) { const int cidx = fq + 4 * ci; const unsigned ab = PEER_CAND[cidx];
            if (cidx < 50) { const float v = ordf32(tv[(fr * 2 + 0) * 16 + (ab >> 4)] & ~127u) + ordf32(tv[(fr * 2 + 1) * 16 + (ab & 15)] & ~127u); ck[ci] = (f32ord(v) & ~63u) | (unsigned)(63 - cidx); }
            else ck[ci] = 0u; }
        float scv[4]; int exv[4];
#pragma unroll
        for (int i = 0; i < 16; ++i) { unsigned m = ck[0];
#pragma unroll
            for (int j = 1; j < 13; ++j) m = m > ck[j] ? m : ck[j];
            { const unsigned o = __shfl_xor(m, 16); m = m > o ? m : o; } m = umax_x32(m);
#pragma unroll
            for (int j = 0; j < 13; ++j) ck[j] = (ck[j] == m) ? 0u : ck[j];
            if (fq == (i & 3)) { const int cidx = 63 - (int)(m & 63u); const unsigned ab = PEER_CAND[cidx];
                const int n1 = 127 - (int)(tv[(fr * 2 + 0) * 16 + (ab >> 4)] & 127u), n2 = 127 - (int)(tv[(fr * 2 + 1) * 16 + (ab & 15)] & 127u);
                exv[i >> 2] = n1 * 128 + n2; scv[i >> 2] = ordf32(m & ~63u); } }
        float mx = fmaxf(fmaxf(scv[0], scv[1]), fmaxf(scv[2], scv[3])); mx = fmaxf(mx, __shfl_xor(mx, 16)); mx = fmax_x32(mx);
        float ev[4], s = 0.f;
#pragma unroll
        for (int j = 0; j < 4; ++j) { ev[j] = __expf(scv[j] - mx); s += ev[j]; }
        s += __shfl_xor(s, 16); s = fadd_x32(s); const float inv = 1.f / s;
#pragma unroll
        for (int j = 0; j < 4; ++j) { const size_t o = (size_t)(t0 + fr) * 128 + h * 16 + j * 4 + fq; EXPI[o] = exv[j]; GATEW[o] = ev[j] * inv; }
        LDS_WAIT();
    }
}
__device__ __forceinline__ float gelu_tanh(float x) { const float u = 0.7978845608028654f * (x + 0.044715f * x * x * x); const float e = __expf(2.f * u); const float th = 1.f - 2.f / (e + 1.f); return 0.5f * x * (1.f + th); }
__device__ __forceinline__ void quant_row(const float* src, unsigned char* dst, float* scale_out, int lane) {
    f32x4 v[8]; float mx = 0.f;
#pragma unroll
    for (int i = 0; i < 2; ++i)
#pragma unroll
        for (int j = 0; j < 4; ++j) { const f32x4 x = *(const f32x4*)(src + i * 1024 + lane * 16 + j * 4); v[i * 4 + j] = x; mx = fmaxf(mx, fmaxf(fmaxf(fabsf(x[0]), fabsf(x[1])), fmaxf(fabsf(x[2]), fabsf(x[3])))); }
#pragma unroll
    for (int o = 1; o < 64; o <<= 1) mx = fmaxf(mx, __shfl_xor(mx, o));
    const float inv = mx > 0.f ? 127.f / mx : 0.f;
#pragma unroll
    for (int i = 0; i < 2; ++i) { u32x4 w;
#pragma unroll
        for (int j = 0; j < 4; ++j) { const f32x4 x = v[i * 4 + j];
            const unsigned b0 = (unsigned)(rintf(x[0] * inv) + 128.f), b1 = (unsigned)(rintf(x[1] * inv) + 128.f), b2 = (unsigned)(rintf(x[2] * inv) + 128.f), b3 = (unsigned)(rintf(x[3] * inv) + 128.f);
            w[j] = b0 | (b1 << 8) | (b2 << 16) | (b3 << 24); }
        *(u32x4*)(dst + i * 1024 + lane * 16) = w; }
    if (lane == 0) *scale_out = mx * (1.f / 127.f);
}
__device__ __forceinline__ float ub(unsigned w, int b) { return (float)((w >> (8 * b)) & 0xffu); }
__device__ __forceinline__ float dot16q(const u32x4 w, const float* x) {
    float s = 0.f;
#pragma unroll
    for (int k = 0; k < 4; ++k) { s = fmaf(ub(w[k], 0), x[4 * k + 0], s); s = fmaf(ub(w[k], 1), x[4 * k + 1], s); s = fmaf(ub(w[k], 2), x[4 * k + 2], s); s = fmaf(ub(w[k], 3), x[4 * k + 3], s); }
    return s;
}
__device__ __forceinline__ void axpy16q(const u32x4 w, float c, float* o) {
#pragma unroll
    for (int k = 0; k < 4; ++k) { o[4 * k + 0] = fmaf(c, ub(w[k], 0), o[4 * k + 0]); o[4 * k + 1] = fmaf(c, ub(w[k], 1), o[4 * k + 1]); o[4 * k + 2] = fmaf(c, ub(w[k], 2), o[4 * k + 2]); o[4 * k + 3] = fmaf(c, ub(w[k], 3), o[4 * k + 3]); }
}
__device__ __forceinline__ void peer_expert_token(const Frame& F, const Args& a, int t) {
    const int l = F.lane;
    const unsigned char* UQ = (const unsigned char*)(F.ws + WS_UB); const unsigned char* VQ = (const unsigned char*)(F.ws + WS_VBF);
    const float* US = (const float*)(F.ws + WS_USC); const float* VS = (const float*)(F.ws + WS_VSC);
    const int* EXPI = (const int*)(F.ws + WS_EXPI) + (size_t)t * 128; const float* GATEW = (const float*)(F.ws + WS_GATEW) + (size_t)t * 128;
    const float rstd2 = rsqrtf(((const float*)(F.ws + WS_CTL))[CW_RSQ2 + t] * (1.f / DM) + EPS);
    float x[32], o[32]; float sumx = 0.f, csum = 0.f;
#pragma unroll
    for (int i = 0; i < 2; ++i)
#pragma unroll
        for (int hf = 0; hf < 2; ++hf) { const u32x4 w = *(const u32x4*)((const bf16_t*)(F.ws + WS_A2) + (size_t)t * DM + i * 1024 + l * 16 + hf * 8); float* xp = x + i * 16 + hf * 8;
            xp[0] = bflo(w.x); xp[1] = bfhi(w.x); xp[2] = bflo(w.y); xp[3] = bfhi(w.y); xp[4] = bflo(w.z); xp[5] = bfhi(w.z); xp[6] = bflo(w.w); xp[7] = bfhi(w.w); }
#pragma unroll
    for (int i = 0; i < 32; ++i) { o[i] = 0.f; sumx += x[i]; }
    sumx *= 128.f;
    for (int jb = 0; jb < 32; ++jb) {
        int e[4]; float g[4];
#pragma unroll
        for (int q = 0; q < 4; ++q) { e[q] = __builtin_amdgcn_readfirstlane(EXPI[jb * 4 + q]); g[q] = __builtin_bit_cast(float, __builtin_amdgcn_readfirstlane(__builtin_bit_cast(int, GATEW[jb * 4 + q]))); }
        u32x4 uw[4][2], vw[4][2];
#pragma unroll
        for (int q = 0; q < 4; ++q) { uw[q][0] = *(const u32x4*)(UQ + (size_t)e[q] * DM + l * 16); uw[q][1] = *(const u32x4*)(UQ + (size_t)e[q] * DM + 1024 + l * 16); }
#pragma unroll
        for (int q = 0; q < 4; ++q) { vw[q][0] = *(const u32x4*)(VQ + (size_t)e[q] * DM + l * 16); vw[q][1] = *(const u32x4*)(VQ + (size_t)e[q] * DM + 1024 + l * 16); }
        float d[4];
#pragma unroll
        for (int q = 0; q < 4; ++q) d[q] = dot16q(uw[q][0], x) + dot16q(uw[q][1], x + 16) - sumx;
#pragma unroll
        for (int o_ = 1; o_ < 64; o_ <<= 1) {
#pragma unroll
            for (int q = 0; q < 4; ++q) d[q] += __shfl_xor(d[q], o_); }
#pragma unroll
        for (int q = 0; q < 4; ++q) { const float c = g[q] * gelu_tanh(d[q] * US[e[q]] * rstd2) * VS[e[q]]; csum += c; axpy16q(vw[q][0], c, o); axpy16q(vw[q][1], c, o + 16); }
    }
    float* H = a.out + (size_t)t * DM; const float* gf = a.in[22]; float ss = 0.f; csum *= 128.f;
#pragma unroll
    for (int i = 0; i < 2; ++i)
#pragma unroll
        for (int j = 0; j < 4; ++j) { const f32x4 hv = *(const f32x4*)(H + i * 1024 + l * 16 + j * 4);
#pragma unroll
            for (int k = 0; k < 4; ++k) { const float v = o[i * 16 + j * 4 + k] - csum + hv[k]; o[i * 16 + j * 4 + k] = v; ss += v * v; } }
    const float rstd = rsqrtf(wave_sum(ss) * (1.f / DM) + EPS);
#pragma unroll
    for (int i = 0; i < 2; ++i)
#pragma unroll
        for (int j = 0; j < 4; ++j) { const f32x4 gv = *(const f32x4*)(gf + i * 1024 + l * 16 + j * 4); f32x4 r;
#pragma unroll
            for (int k = 0; k < 4; ++k) r[k] = o[i * 16 + j * 4 + k] * rstd * gv[k];
            *(f32x4*)(H + i * 1024 + l * 16 + j * 4) = r; }
}

constexpr int N_PHASES = 17;
__global__ void __launch_bounds__(NTHREADS, 2) hybrid_fwd(Args args) {
    extern __shared__ __attribute__((aligned(16))) unsigned char lds_raw[];
    Frame F;
    F.lds = (LAS unsigned char*)lds_raw;
    F.tid = threadIdx.x; F.lane = F.tid & 63; F.wave = __builtin_amdgcn_readfirstlane(F.tid >> 6);
    F.G = gridDim.x; F.bid = blockIdx.x; F.ws = args.ws;
    unsigned* ctl = (unsigned*)(args.ws + WS_CTL);
    volatile LAS unsigned* MISCW = (volatile LAS unsigned*)(F.lds + LDSCTL_OFF);
    if (F.tid < 64) MISCW[F.tid] = 0u;
    __syncthreads();
    XcdBarrier bar; bar.bar = ctl + CW_BAR; bar.x = 0; bar.st = nullptr;
    if (args.use_bar) bar = xcd_barrier_post(ctl + CW_BAR, MISCW + 8);
    const int lo = args.ph_lo, hi = args.ph_hi;
    LAS unsigned char* ring = F.lds;
    const int gw = F.bid * NWAVES + F.wave, NGW = F.G * NWAVES;
    float* rsq1 = (float*)ctl + CW_RSQ1; float* rsq2 = (float*)ctl + CW_RSQ2;
#define IN(k) (lo <= (k) && (k) < hi)
#define SEAM(k) do { if (args.use_bar && IN(k) && IN((k) + 1)) { if ((k) == 0) { cg::this_grid().sync(); } else { xcd_barrier(bar); } } } while (0)
#define ROT(r) ((F.bid + F.G - ((r) % F.G)) % F.G)

    if (IN(0)) { p0_prologue(F, args); }
    SEAM(0);
    if (IN(1)) {
        { pg8::Gemm g{(const bf16_t*)(F.ws + WS_A0), (const bf16_t*)(F.ws + WS_WIN), SEQ, NIN, DM, DM, DM}; pg8::StaticOrder S; S.init(SEQ, NIN, F.G, F.bid);
          EpiRoute E{F.ws}; pg8::gemm_phase<EpiRoute, true>(ring, g, S, E); }
        { pg8::Gemm g{(const bf16_t*)(F.ws + WS_MEMN), (const bf16_t*)(F.ws + WS_WXK), MEM, DM, DM, DM, DM}; pg8::StaticOrder S; S.init(MEM, DM, F.G, ROT(192));
          EpiBf16 E{(bf16_t*)(F.ws + WS_XK), DM, nullptr}; pg8::gemm_phase<EpiBf16, true>(ring, g, S, E); }
        { pg8::Gemm g{(const bf16_t*)(F.ws + WS_MEMN), (const bf16_t*)(F.ws + WS_WXV), MEM, DM, DM, DM, DM}; pg8::StaticOrder S; S.init(MEM, DM, F.G, ROT(200));
          EpiBf16 E{(bf16_t*)(F.ws + WS_XV), DM, nullptr}; pg8::gemm_phase<EpiBf16, true>(ring, g, S, E); }
    }
    SEAM(1);
    if (IN(2)) {
#pragma unroll 1
        for (int h = 0; h < 4; ++h) {
            pg8::Gemm g{(const bf16_t*)(F.ws + WS_XK) + h * 512, (const bf16_t*)(F.ws + WS_WXQ) + h * 512, MEM, DM, 512, DM, DM}; pg8::StaticOrder S; S.init(MEM, DM, F.G, ROT(8 * h));
            EpiBf16 E{(bf16_t*)(F.ws + WS_WQK) + (size_t)h * 256 * DM, DM, nullptr}; pg8::gemm_phase<EpiBf16, true>(ring, g, S, E); }
#pragma unroll 1
        for (int h = 0; h < 4; ++h) {
            pg8::Gemm g{(const bf16_t*)(F.ws + WS_WXO) + h * 512, (const bf16_t*)(F.ws + WS_XV) + h * 512, DM, MEM, 512, DM, DM}; pg8::StaticOrder S; S.init(DM, MEM, F.G, ROT(32 + 8 * h));
            EpiBf16 E{(bf16_t*)(F.ws + WS_WVO) + h * 256, 1024, nullptr}; pg8::gemm_phase<EpiBf16, true>(ring, g, S, E); }
        __syncthreads();
        for (int t = gw; t < SEQ; t += NGW) rope_token(F, args, t);
        for (int it = F.bid; it < 512; it += F.G) gla_prep_item(F, args, it);
    }
    SEAM(2);
    if (IN(3)) { for (int it = F.bid; it < SC_ITEMS; it += F.G) scores_item(F, it); }
    SEAM(3);
    if (IN(4)) { for (int t = gw; t < SEQ; t += NGW) select_row(F, t); }
    SEAM(4);
    if (IN(5)) { for (int t = gw; t < SEQ; t += NGW) sparse_attn_query(F, t); }
    SEAM(5);
    if (IN(6)) { for (int it = F.bid; it < 512; it += F.G) gla_level1_item(F, it); }
    SEAM(6);
    if (IN(7)) { gla_scan(F); }
    SEAM(7);
    if (IN(8)) { for (int it = F.bid; it < 512; it += F.G) gla_out_item(F, args, it); }
    SEAM(8);
    if (IN(9)) { pg8::Gemm g{(const bf16_t*)(F.ws + WS_OA), (const bf16_t*)(F.ws + WS_WPA), SEQ, DM, DM, DM, DM}; pg8::StaticOrder S; S.init(SEQ, DM, F.G, F.bid);
        EpiGate E{(bf16_t*)(F.ws + WS_T1), (const bf16_t*)(F.ws + WS_GATES), 0, nullptr}; pg8::gemm_phase<EpiGate, true>(ring, g, S, E); }
    SEAM(9);
    if (IN(10)) { pg8::Gemm g{(const bf16_t*)(F.ws + WS_DQ), (const bf16_t*)(F.ws + WS_WPB), SEQ, DM, DM, DM, DM}; pg8::StaticOrder S; S.init(SEQ, DM, F.G, F.bid);
        EpiGate E{(bf16_t*)(F.ws + WS_MERGED), (const bf16_t*)(F.ws + WS_GATES), 2048, (const bf16_t*)(F.ws + WS_T1)}; pg8::gemm_phase<EpiGate, true>(ring, g, S, E); }
    SEAM(10);
    if (IN(11)) { { pg8::Gemm g{(const bf16_t*)(F.ws + WS_MERGED), (const bf16_t*)(F.ws + WS_WOUT), SEQ, DM, DM, DM, DM}; pg8::StaticOrder S; S.init(SEQ, DM, F.G, F.bid);
          EpiResNorm E{args.in[0], args.out, (bf16_t*)(F.ws + WS_A1), args.in[11], rsq1}; pg8::gemm_phase<EpiResNorm, true>(ring, g, S, E); }
        for (int r = gw; r < 32768; r += NGW) { const int e = r & 16383;
            if (r < 16384) quant_row(args.in[20] + (size_t)e * DM, (unsigned char*)(F.ws + WS_UB) + (size_t)e * DM, (float*)(F.ws + WS_USC) + e, F.lane);
            else quant_row(args.in[21] + (size_t)e * DM, (unsigned char*)(F.ws + WS_VBF) + (size_t)e * DM, (float*)(F.ws + WS_VSC) + e, F.lane); }
    }
    SEAM(11);
    if (IN(12)) { pg8::Gemm g{(const bf16_t*)(F.ws + WS_A1), (const bf16_t*)(F.ws + WS_WQK), SEQ, 1024, DM, DM, DM}; pg8::StaticOrder S; S.init(SEQ, 1024, F.G, F.bid);
        EpiSoftmax E{(bf16_t*)(F.ws + WS_XP), 1024, rsq1, 0.044194173824159216f}; pg8::gemm_phase<EpiSoftmax, false>(ring, g, S, E); }
    SEAM(12);
    if (IN(13)) { pg8::Gemm g{(const bf16_t*)(F.ws + WS_XP), (const bf16_t*)(F.ws + WS_WVO), SEQ, DM, 1024, 1024, 1024}; pg8::StaticOrder S; S.init(SEQ, DM, F.G, F.bid);
        EpiResNorm E{args.out, args.out, (bf16_t*)(F.ws + WS_A2), args.in[17], rsq2}; pg8::gemm_phase<EpiResNorm, true>(ring, g, S, E); }
    SEAM(13);
    if (IN(14)) { pg8::Gemm g{(const bf16_t*)(F.ws + WS_A2), (const bf16_t*)(F.ws + WS_WPQ), SEQ, DM, DM, DM, DM}; pg8::StaticOrder S; S.init(SEQ, DM, F.G, F.bid);
        EpiBf16 E{(bf16_t*)(F.ws + WS_PQ), DM, rsq2}; pg8::gemm_phase<EpiBf16, true>(ring, g, S, E); }
    SEAM(14);
    if (IN(15)) { for (int it = gw; it < SEQ / 2; it += NGW) peer_select_item(F, it); }
    SEAM(15);
    if (IN(16)) { for (int t = gw; t < SEQ; t += NGW) peer_expert_token(F, args, t); }
#undef IN
#undef SEAM
#undef ROT
}

#ifndef MK_ONE_LAUNCH
#define MK_ONE_LAUNCH 1
#endif
extern "C" void kernel_launch(void* const* d_in, const int* in_sizes, int n_in, void* d_out, int out_size, void* d_ws, size_t ws_size, hipStream_t stream) {
    static int grid = 0;
    if (grid == 0) {
        if (n_in != 23 || out_size != SEQ * DM || ws_size < WS_END) { fprintf(stderr, "kernel_launch: unexpected problem (n_in %d, out %d, ws %zu < %zu)\n", n_in, out_size, ws_size, (size_t)WS_END); grid = -1; return; }
        int dev = 0, cus = 0, per_cu = 0;
        if (hipGetDevice(&dev) != hipSuccess || hipDeviceGetAttribute(&cus, hipDeviceAttributeMultiprocessorCount, dev) != hipSuccess) { grid = -1; return; }
        if (hipFuncSetAttribute((const void*)hybrid_fwd, hipFuncAttributeMaxDynamicSharedMemorySize, LDS_BYTES) != hipSuccess) { fprintf(stderr, "kernel_launch: hipFuncSetAttribute failed\n"); grid = -1; return; }
        if (hipOccupancyMaxActiveBlocksPerMultiprocessor(&per_cu, (const void*)hybrid_fwd, NTHREADS, LDS_BYTES) != hipSuccess || per_cu < 1) { fprintf(stderr, "kernel_launch: occupancy query says %d\n", per_cu); per_cu = 1; }
        (void)hipGetLastError();
        grid = cus;
    }
    if (grid < 0) return;
    (void)hipMemsetAsync((char*)d_ws + WS_CTL, 0, CTL_ZERO_BYTES, stream);
    Args a{};
    for (int i = 0; i < 23; ++i) a.in[i] = (const float*)d_in[i];
    a.out = (float*)d_out; a.ws = (unsigned char*)d_ws;
#if MK_ONE_LAUNCH
    a.ph_lo = 0; a.ph_hi = N_PHASES; a.use_bar = 1;
    void* kargs[] = {&a};
    hipError_t e = hipLaunchCooperativeKernel((const void*)hybrid_fwd, dim3(grid), dim3(NTHREADS), kargs, LDS_BYTES, stream);
    if (e != hipSuccess) fprintf(stderr, "cooperative launch failed: %s (grid %d)\n", hipGetErrorString(e), grid);
#else
    for (int p = 0; p < N_PHASES; ++p) { a.ph_lo = p; a.ph_hi = p + 1; a.use_bar = 0;
        hipLaunchKernelGGL(hybrid_fwd, dim3(grid), dim3(NTHREADS), LDS_BYTES, stream, a); }
#endif
}
```

```cpp
#include <hip/hip_runtime.h>
#include <hip/hip_cooperative_groups.h>
#include <cstdio>
#include <cstdint>
namespace cg = cooperative_groups;

#define GAS __attribute__((address_space(1)))
#define LAS __attribute__((address_space(3)))
typedef unsigned short bf16_t;
typedef short bf16x8 __attribute__((ext_vector_type(8)));
typedef short s16x4 __attribute__((ext_vector_type(4)));
typedef float f32x4 __attribute__((ext_vector_type(4)));
typedef float f32x2 __attribute__((ext_vector_type(2)));
typedef unsigned u32x4 __attribute__((ext_vector_type(4)));
typedef unsigned u32x2 __attribute__((ext_vector_type(2)));
#define RLX_AGENT __ATOMIC_RELAXED, __HIP_MEMORY_SCOPE_AGENT
#define LDS_WAIT() asm volatile("s_waitcnt lgkmcnt(0)" ::: "memory")
#define VM_WAIT() asm volatile("s_waitcnt vmcnt(0)" ::: "memory")

__device__ __forceinline__ int lane_id() { int l; asm volatile("v_mbcnt_lo_u32_b32 %0, -1, 0\n\tv_mbcnt_hi_u32_b32 %0, -1, %0" : "=v"(l)); return l; }
__device__ __forceinline__ unsigned f2bf(float f) { unsigned u = __builtin_bit_cast(unsigned, f); return (u + 0x7fffu + ((u >> 16) & 1u)) >> 16; }
__device__ __forceinline__ unsigned pk2(float lo, float hi) { return f2bf(lo) | (f2bf(hi) << 16); }
__device__ __forceinline__ float bf2f(unsigned short b) { return __builtin_bit_cast(float, (unsigned)b << 16); }
__device__ __forceinline__ float bflo(unsigned w) { return __builtin_bit_cast(float, w << 16); }
__device__ __forceinline__ float bfhi(unsigned w) { return __builtin_bit_cast(float, w & 0xffff0000u); }
__device__ __forceinline__ float wave_sum(float v) {
#pragma unroll
    for (int o = 1; o < 64; o <<= 1) v += __shfl_xor(v, o);
    return v;
}
__device__ __forceinline__ float sigmoidf_(float x) { return 1.f / (1.f + __expf(-x)); }

namespace pg8 {
constexpr int BM = 256, BK = 64, HALF = 128, HTB = HALF * BK * 2, STAGE_BYTES = 8 * HTB, NXCD = 8, WGM = 8;
__host__ __device__ __forceinline__ int lds_byte(int r, int c) { const int st = (r >> 4) * 2 + (c >> 5), rr = r & 15, cc = c & 31, ob = rr * 64 + cc * 2; return st * 1024 + (ob ^ (((ob >> 9) & 1) << 5)); }
__host__ __device__ __forceinline__ void stage_rc(int b, int& R, int& C) { const int st = b / 1024, sb = b % 1024, swz = sb ^ (((sb >> 9) & 1) << 5); R = (st >> 1) * 16 + swz / 64; C = (st & 1) * 32 + (swz % 64) / 2; }
__host__ __device__ __forceinline__ int perm32(int rho) { const int n = rho >> 4, i = rho & 15; return 8 * (i >> 2) + 4 * n + (i & 3); }

struct Unit { int pm, pn; };
struct Gemm { const bf16_t* A; const bf16_t* Bt; int M, N, K, lda, ldb; };

struct StaticOrder {
    int nM, nN, nwg, G, c;
    __device__ void init(int M, int N, int G_, int c_) { nM = M / BM; nN = N / BM; nwg = nM * nN; G = G_; c = c_; }
    __device__ bool next(int i, Unit& u) const {
        const long L = (long)i * G + c; if (L >= nwg) return false;
        int wgid = (int)L; { const int q = nwg / NXCD, r = nwg % NXCD, xcd = wgid % NXCD, off = wgid / NXCD; wgid = (xcd < r ? xcd * (q + 1) : r * (q + 1) + (xcd - r) * q) + off; }
        const int nig = WGM * nN, gid = wgid / nig, fm = gid * WGM, gsz = (nM - fm) < WGM ? (nM - fm) : WGM;
        u.pm = fm + ((wgid % nig) % gsz); u.pn = (wgid % nig) / gsz; return true;
    }
};

__device__ __forceinline__ unsigned cvt_pk_bf16(float lo, float hi) { unsigned r; asm volatile("v_cvt_pk_bf16_f32 %0, %1, %2" : "=v"(r) : "v"(lo), "v"(hi)); return r; }

template <class Epi, bool ALIGN_EPI>
__device__ __forceinline__ void gemm_phase(LAS unsigned char* lds, const Gemm g, const StaticOrder& S, const Epi& E, int wave_in) {
    const int lane = lane_id(), wid = wave_in, tid = wid * 64 + lane, wr = wid >> 2, wc = wid & 3, fr = lane & 15, fq = lane >> 4;
    const int K = g.K, nt = K / BK;
    unsigned voffA[2], voffB[2];
#pragma unroll
    for (int i = 0; i < 2; ++i) { int R, C; stage_rc(tid * 16 + i * 8192, R, C); const int Rb = (R & ~31) + perm32(R & 31);
        voffA[i] = (unsigned)(R * g.lda + C) * 2u; voffB[i] = (unsigned)(Rb * g.ldb + C) * 2u; }
    const size_t kstep = (size_t)(BK * 2);
    const size_t hstepA = (size_t)HALF * g.lda * 2, hstepB = (size_t)HALF * g.ldb * 2;
    const size_t tstepA = 2 * hstepA, tstepB = 2 * hstepB;
    const unsigned ldsw = (unsigned)wid * 1024u;
    const int aoff = lds_byte(wr * 64 + fr, fq * 8), boff = lds_byte(wc * 32 + fr, fq * 8);
#define PG8_SA(b, h) (((b) * 2 + (h)) * HTB)
#define PG8_SB(b, h) ((4 + (b) * 2 + (h)) * HTB)
#define PG8_STAGE(bufoff, gbase, voff) do { _Pragma("unroll") for (int _i = 0; _i < 2; ++_i) \
        __builtin_amdgcn_global_load_lds((const unsigned*)((const char*)(gbase) + (voff)[_i]), (LAS unsigned*)(lds + (bufoff) + ldsw + _i * 8192), 16, 0, 0); } while (0)
#define PG8_LDA(dst, b, h) do { _Pragma("unroll") for (int m = 0; m < 4; ++m) _Pragma("unroll") for (int k = 0; k < 2; ++k) dst[m][k] = *(const LAS bf16x8*)(lds + PG8_SA(b, h) + aoff + m * 2048 + k * 1024); } while (0)
#define PG8_LDB(dst, b, h) do { _Pragma("unroll") for (int n = 0; n < 2; ++n) _Pragma("unroll") for (int k = 0; k < 2; ++k) dst[n][k] = *(const LAS bf16x8*)(lds + PG8_SB(b, h) + boff + n * 2048 + k * 1024); } while (0)
#define PG8_MMA(ai, bj, At, Bt) do { __builtin_amdgcn_s_setprio(1); _Pragma("unroll") for (int m = 0; m < 4; ++m) _Pragma("unroll") for (int n = 0; n < 2; ++n) _Pragma("unroll") for (int k = 0; k < 2; ++k) \
        acc[ai][bj][m][n] = __builtin_amdgcn_mfma_f32_16x16x32_bf16(Bt[n][k], At[m][k], acc[ai][bj][m][n], 0, 0, 0); __builtin_amdgcn_s_setprio(0); } while (0)
#define PG8_WAIT_V(n) asm volatile("s_waitcnt vmcnt(" #n ")" ::: "memory")
#define PG8_WAIT_L(n) asm volatile("s_waitcnt lgkmcnt(" #n ")" ::: "memory")
#define PG8_BAR __builtin_amdgcn_s_barrier()
#define PG8_SCHED __builtin_amdgcn_sched_barrier(0)
    Unit cur, nxt; int ui = 0;
    if (!S.next(0, cur)) return;
    f32x4 acc[2][2][4][2];
#pragma unroll
    for (int a = 0; a < 2; ++a)
#pragma unroll
        for (int b = 0; b < 2; ++b)
#pragma unroll
            for (int m = 0; m < 4; ++m)
#pragma unroll
                for (int n = 0; n < 2; ++n) acc[a][b][m][n] = (f32x4){0.f, 0.f, 0.f, 0.f};
    bf16x8 At[4][2], B0[2][2], B1[2][2];
    const char* cA = (const char*)g.A + (size_t)cur.pm * tstepA; const char* cB = (const char*)g.Bt + (size_t)cur.pn * tstepB;
    PG8_STAGE(PG8_SB(0, 0), cB, voffB); PG8_STAGE(PG8_SB(0, 1), cB + hstepB, voffB); PG8_STAGE(PG8_SA(0, 0), cA, voffA); PG8_STAGE(PG8_SA(0, 1), cA + hstepA, voffA);
    if (wr == 1) PG8_BAR;
    PG8_WAIT_V(2); PG8_BAR;
    PG8_STAGE(PG8_SB(1, 0), cB + kstep, voffB); PG8_STAGE(PG8_SA(1, 0), cA + kstep, voffA); PG8_STAGE(PG8_SB(1, 1), cB + hstepB + kstep, voffB);
    PG8_WAIT_V(6); PG8_BAR;
    for (;;) {
        const bool has_next = S.next(ui + 1, nxt);
        const char* nA = has_next ? (const char*)g.A + (size_t)nxt.pm * tstepA : cA; const char* nB = has_next ? (const char*)g.Bt + (size_t)nxt.pn * tstepB : cB;
        for (int t = 0; t < nt; t += 2) {
            const bool last = (t == nt - 2);
            const char* a1 = cA + (size_t)(t + 1) * kstep;
            const char* a2 = last ? nA : cA + (size_t)(t + 2) * kstep; const char* b2 = last ? nB : cB + (size_t)(t + 2) * kstep;
            const char* a3 = a2 + kstep; const char* b3 = b2 + kstep;
            PG8_LDB(B0, 0, 0); PG8_LDB(B1, 0, 1); PG8_SCHED; PG8_LDA(At, 0, 0); PG8_STAGE(PG8_SA(1, 1), a1 + hstepA, voffA);
            PG8_WAIT_V(8); PG8_WAIT_L(0); PG8_BAR; PG8_MMA(0, 0, At, B0); PG8_MMA(0, 1, At, B1); PG8_BAR; PG8_SCHED;
            PG8_LDA(At, 0, 1); PG8_STAGE(PG8_SB(0, 0), b2, voffB); PG8_STAGE(PG8_SB(0, 1), b2 + hstepB, voffB); PG8_STAGE(PG8_SA(0, 0), a2, voffA);
            PG8_WAIT_V(8); PG8_WAIT_L(0); PG8_BAR; PG8_MMA(1, 0, At, B0); PG8_MMA(1, 1, At, B1); PG8_BAR; PG8_SCHED;
            PG8_LDB(B0, 1, 0); PG8_LDB(B1, 1, 1); PG8_SCHED; PG8_LDA(At, 1, 0); PG8_STAGE(PG8_SA(0, 1), a2 + hstepA, voffA);
            PG8_WAIT_V(8); PG8_WAIT_L(0); PG8_BAR; PG8_MMA(0, 0, At, B0); PG8_MMA(0, 1, At, B1); PG8_BAR; PG8_SCHED;
            PG8_LDA(At, 1, 1); PG8_STAGE(PG8_SB(1, 0), b3, voffB); PG8_STAGE(PG8_SB(1, 1), b3 + hstepB, voffB); PG8_STAGE(PG8_SA(1, 0), a3, voffA);
            PG8_WAIT_V(8); PG8_WAIT_L(0); PG8_BAR; PG8_MMA(1, 0, At, B0); PG8_MMA(1, 1, At, B1); PG8_BAR; PG8_SCHED;
        }
        if constexpr (ALIGN_EPI) { if (wr == 0) PG8_BAR; }
        if constexpr (!Epi::AFTER_DRAIN) { E(acc, cur, wr, wc, fr, fq); }
        if (!has_next) break;
#pragma unroll
        for (int a = 0; a < 2; ++a)
#pragma unroll
            for (int b = 0; b < 2; ++b)
#pragma unroll
                for (int m = 0; m < 4; ++m)
#pragma unroll
                    for (int n = 0; n < 2; ++n) acc[a][b][m][n] = (f32x4){0.f, 0.f, 0.f, 0.f};
        cur = nxt; cA = nA; cB = nB; ++ui;
        if constexpr (ALIGN_EPI) { if (wr == 1) PG8_BAR; }
    }
    PG8_WAIT_V(0);
    if constexpr (!ALIGN_EPI) { if (wr == 0) PG8_BAR; }
    PG8_BAR;
    if constexpr (Epi::AFTER_DRAIN) { E.fused(acc, cur, wr, wc, fr, fq, lds, wid, lane); }
#undef PG8_SA
#undef PG8_SB
#undef PG8_STAGE
#undef PG8_LDA
#undef PG8_LDB
#undef PG8_MMA
#undef PG8_WAIT_V
#undef PG8_WAIT_L
#undef PG8_BAR
#undef PG8_SCHED
}
}
using pg8::Unit;

constexpr int SEQ = 8192, DM = 2048, MEM = 256;
constexpr int NIN = 13824;
constexpr float EPS = 1e-6f;
constexpr size_t MiB = 1u << 20;
constexpr size_t WS_CTL = 0, CTL_ZERO_BYTES = 1 * MiB;
constexpr size_t WS_MEMN = 1 * MiB, WS_XK = 2 * MiB, WS_XV = 3 * MiB, WS_DVEC = 4 * MiB, WS_KEYS = 5 * MiB, WS_IW = 6 * MiB;
constexpr size_t WS_WPA = 8 * MiB, WS_WPB = 16 * MiB, WS_WOUT = 24 * MiB, WS_WXQ = 32 * MiB, WS_WXK = 40 * MiB, WS_WXV = 48 * MiB, WS_WXO = 56 * MiB, WS_WPQ = 64 * MiB;
constexpr size_t WS_WIN = 72 * MiB, WS_A0 = 126 * MiB;
constexpr size_t WS_QT = 72 * MiB, WS_KHT = 88 * MiB, WS_VT = 104 * MiB, WS_ATT = 136 * MiB, WS_KBR = 140 * MiB, WS_VB = 142 * MiB, WS_KIR = 144 * MiB, WS_SEL = 145 * MiB, WS_WQK = 153 * MiB, WS_WVO = 157 * MiB;
constexpr size_t WS_GR = 162 * MiB, WS_DQ = 194 * MiB, WS_GATES = 226 * MiB, WS_MISC = 290 * MiB, WS_IQ = 298 * MiB, WS_GQK = 314 * MiB, WS_GV = 346 * MiB, WS_SCORES = 378 * MiB, WS_OA = 506 * MiB;
constexpr size_t WS_ST = 378 * MiB, WS_OB = 314 * MiB, WS_T1 = 346 * MiB, WS_MERGED = 194 * MiB, WS_A1 = 162 * MiB, WS_XP = 298 * MiB, WS_A2 = 194 * MiB, WS_PQ = 226 * MiB, WS_EXPI = 258 * MiB, WS_GATEW = 262 * MiB;
constexpr size_t WS_UB = 378 * MiB, WS_VBF = 410 * MiB, WS_USC = 7 * MiB, WS_VSC = 7 * MiB + 65536, WS_END = 538 * MiB;
constexpr int CW_BAR = 4096;
constexpr int CW_RSQ1 = 65536, CW_RSQ2 = 65536 + 8192;
constexpr int MISC_LD = 512;

constexpr int RING_BYTES = 131072;
constexpr int LDSCTL_OFF = 147456 - 256;
constexpr int LDS_BYTES = 147456;
constexpr int NWAVES = 8, NTHREADS = 512;

__device__ __forceinline__ u32x4 pack8(const f32x4 v0, const f32x4 v1) { u32x4 w; w.x = pg8::cvt_pk_bf16(v0[0], v0[1]); w.y = pg8::cvt_pk_bf16(v0[2], v0[3]); w.z = pg8::cvt_pk_bf16(v1[0], v1[1]); w.w = pg8::cvt_pk_bf16(v1[2], v1[3]); return w; }

struct EpiRoute {
    static constexpr bool AFTER_DRAIN = false;
    unsigned char* ws;
    __device__ __forceinline__ void operator()(const f32x4 (&acc)[2][2][4][2], const Unit& u, int wr, int wc, int fr, int fq) const {
        const int pn = u.pn; bf16_t* base; int ldc, c0;
        if (pn < 8) { base = (bf16_t*)(ws + WS_GQK); ldc = 2048; c0 = pn * 256; }
        else if (pn < 16) { base = (bf16_t*)(ws + WS_GV); ldc = 2048; c0 = (pn - 8) * 256; }
        else if (pn < 24) { base = (bf16_t*)(ws + WS_GR); ldc = 2048; c0 = (pn - 16) * 256; }
        else if (pn < 32) { base = (bf16_t*)(ws + WS_DQ); ldc = 2048; c0 = (pn - 24) * 256; }
        else if (pn < 36) { base = (bf16_t*)(ws + WS_IQ); ldc = 1024; c0 = (pn - 32) * 256; }
        else if (pn < 52) { base = (bf16_t*)(ws + WS_GATES); ldc = 4096; c0 = (pn - 36) * 256; }
        else { base = (bf16_t*)(ws + WS_MISC); ldc = MISC_LD; c0 = (pn - 52) * 256; }
        const int row0 = u.pm * 256 + wr * 64 + fr, col0 = c0 + wc * 32 + 8 * fq;
#pragma unroll
        for (int ai = 0; ai < 2; ++ai)
#pragma unroll
            for (int m = 0; m < 4; ++m) { bf16_t* rowp = base + (size_t)(row0 + ai * 128 + m * 16) * ldc + col0;
#pragma unroll
                for (int bj = 0; bj < 2; ++bj) *(u32x4*)(rowp + bj * 128) = pack8(acc[ai][bj][m][0], acc[ai][bj][m][1]); }
    }
};
struct EpiBf16 {
    static constexpr bool AFTER_DRAIN = false;
    bf16_t* O; int ldc; const float* rowsq;
    __device__ __forceinline__ void operator()(const f32x4 (&acc)[2][2][4][2], const Unit& u, int wr, int wc, int fr, int fq) const {
        const int row0 = u.pm * 256 + wr * 64 + fr, col0 = u.pn * 256 + wc * 32 + 8 * fq;
#pragma unroll
        for (int ai = 0; ai < 2; ++ai)
#pragma unroll
            for (int m = 0; m < 4; ++m) { const int row = row0 + ai * 128 + m * 16; bf16_t* rowp = O + (size_t)row * ldc + col0;
                const float sc = rowsq ? rsqrtf(rowsq[row] * (1.f / DM) + EPS) : 1.f;
#pragma unroll
                for (int bj = 0; bj < 2; ++bj) *(u32x4*)(rowp + bj * 128) = pack8(acc[ai][bj][m][0] * sc, acc[ai][bj][m][1] * sc); }
    }
};
struct EpiGate {
    static constexpr bool AFTER_DRAIN = false;
    bf16_t* O; const bf16_t* gates; int goff; const bf16_t* prev;
    __device__ __forceinline__ void operator()(const f32x4 (&acc)[2][2][4][2], const Unit& u, int wr, int wc, int fr, int fq) const {
        const int row0 = u.pm * 256 + wr * 64 + fr, col0 = u.pn * 256 + wc * 32 + 8 * fq;
#pragma unroll
        for (int ai = 0; ai < 2; ++ai)
#pragma unroll
            for (int m = 0; m < 4; ++m) { const int row = row0 + ai * 128 + m * 16;
#pragma unroll
                for (int bj = 0; bj < 2; ++bj) { const int col = col0 + bj * 128;
                    const u32x4 gw = *(const u32x4*)(gates + (size_t)row * 4096 + goff + col);
                    f32x4 v0 = acc[ai][bj][m][0], v1 = acc[ai][bj][m][1];
                    v0[0] *= sigmoidf_(bflo(gw.x)); v0[1] *= sigmoidf_(bfhi(gw.x)); v0[2] *= sigmoidf_(bflo(gw.y)); v0[3] *= sigmoidf_(bfhi(gw.y));
                    v1[0] *= sigmoidf_(bflo(gw.z)); v1[1] *= sigmoidf_(bfhi(gw.z)); v1[2] *= sigmoidf_(bflo(gw.w)); v1[3] *= sigmoidf_(bfhi(gw.w));
                    if (prev) { const u32x4 pw = *(const u32x4*)(prev + (size_t)row * DM + col);
                        v0[0] += bflo(pw.x); v0[1] += bfhi(pw.x); v0[2] += bflo(pw.y); v0[3] += bfhi(pw.y); v1[0] += bflo(pw.z); v1[1] += bfhi(pw.z); v1[2] += bflo(pw.w); v1[3] += bfhi(pw.w); }
                    *(u32x4*)(O + (size_t)row * DM + col) = pack8(v0, v1); } }
    }
};
struct EpiResNorm {
    static constexpr bool AFTER_DRAIN = false;
    const float* base; float* out; bf16_t* An; const float* gain; float* rowsq;
    __device__ __forceinline__ void operator()(const f32x4 (&acc)[2][2][4][2], const Unit& u, int wr, int wc, int fr, int fq) const {
        const int row0 = u.pm * 256 + wr * 64 + fr, col0 = u.pn * 256 + wc * 32 + 8 * fq;
        f32x4 gv[2][2];
#pragma unroll
        for (int bj = 0; bj < 2; ++bj) { gv[bj][0] = *(const f32x4*)(gain + col0 + bj * 128); gv[bj][1] = *(const f32x4*)(gain + col0 + bj * 128 + 4); }
#pragma unroll
        for (int ai = 0; ai < 2; ++ai)
#pragma unroll
            for (int m = 0; m < 4; ++m) { const int row = row0 + ai * 128 + m * 16; float ss = 0.f;
#pragma unroll
                for (int bj = 0; bj < 2; ++bj) { const size_t off = (size_t)row * DM + col0 + bj * 128;
                    const f32x4 h0 = *(const f32x4*)(base + off) + acc[ai][bj][m][0], h1 = *(const f32x4*)(base + off + 4) + acc[ai][bj][m][1];
                    *(f32x4*)(out + off) = h0; *(f32x4*)(out + off + 4) = h1;
                    ss += (h0[0] * h0[0] + h0[1] * h0[1]) + (h0[2] * h0[2] + h0[3] * h0[3]) + (h1[0] * h1[0] + h1[1] * h1[1]) + (h1[2] * h1[2] + h1[3] * h1[3]);
                    *(u32x4*)(An + off) = pack8(h0 * gv[bj][0], h1 * gv[bj][1]); }
                ss += __shfl_xor(ss, 16); ss += __shfl_xor(ss, 32);
                if (fq == 0) atomicAdd(rowsq + row, ss); }
    }
};
struct EpiSoftmax {
    static constexpr bool AFTER_DRAIN = true;
    bf16_t* O; int ldc; const float* rowsq; float scale;
    __device__ __forceinline__ void fused(f32x4 (&acc)[2][2][4][2], const Unit& u, int wr, int wc, int fr, int fq, LAS unsigned char* lds, int wid, int lane) const {
        LAS f32x2* P = (LAS f32x2*)lds;
        float mxs[2][4];
#pragma unroll
        for (int ai = 0; ai < 2; ++ai)
#pragma unroll
            for (int m = 0; m < 4; ++m) { const int rl = ai * 128 + wr * 64 + m * 16 + fr; const int row = u.pm * 256 + rl;
                const float sc = rsqrtf(rowsq[row] * (1.f / DM) + EPS) * scale; float mx = -3.0e38f;
#pragma unroll
                for (int bj = 0; bj < 2; ++bj)
#pragma unroll
                    for (int n = 0; n < 2; ++n) { f32x4 x = acc[ai][bj][m][n] * sc; acc[ai][bj][m][n] = x; mx = fmaxf(mx, fmaxf(fmaxf(x[0], x[1]), fmaxf(x[2], x[3]))); }
                mx = fmaxf(mx, __shfl_xor(mx, 16)); mx = fmaxf(mx, __shfl_xor(mx, 32)); float s = 0.f;
#pragma unroll
                for (int bj = 0; bj < 2; ++bj)
#pragma unroll
                    for (int n = 0; n < 2; ++n) { f32x4 x = acc[ai][bj][m][n]; x[0] = __expf(x[0] - mx); x[1] = __expf(x[1] - mx); x[2] = __expf(x[2] - mx); x[3] = __expf(x[3] - mx); acc[ai][bj][m][n] = x; s += (x[0] + x[1]) + (x[2] + x[3]); }
                s += __shfl_xor(s, 16); s += __shfl_xor(s, 32); mxs[ai][m] = mx;
                if (fq == 0) P[rl * 4 + wc] = (f32x2){mx, s}; }
        __syncthreads();
        const int col0 = u.pn * 256 + wc * 32 + 8 * fq;
#pragma unroll
        for (int ai = 0; ai < 2; ++ai)
#pragma unroll
            for (int m = 0; m < 4; ++m) { const int rl = ai * 128 + wr * 64 + m * 16 + fr; const int row = u.pm * 256 + rl;
                const f32x2 a = P[rl * 4 + 0], b = P[rl * 4 + 1], c = P[rl * 4 + 2], d = P[rl * 4 + 3];
                const float M = fmaxf(fmaxf(a.x, b.x), fmaxf(c.x, d.x));
                const float Ssum = a.y * __expf(a.x - M) + b.y * __expf(b.x - M) + c.y * __expf(c.x - M) + d.y * __expf(d.x - M);
                const float f = __expf(mxs[ai][m] - M) / Ssum;
#pragma unroll
                for (int bj = 0; bj < 2; ++bj) *(u32x4*)(O + (size_t)row * ldc + col0 + bj * 128) = pack8(acc[ai][bj][m][0] * f, acc[ai][bj][m][1] * f); }
        __syncthreads();
    }
};

#define XB_TMO      128
#define XB_XCNT(j)  (256  + 64 * (j))
#define XB_XSUB(j)  (1280 + 64 * (j))
#define XB_XGEN(j)  (2304 + 64 * (j))
#define XB_TOP      3328
#define XB_TOPGEN   3392
#define XCD_BAR_WORDS 3456
#define XB_SPIN_CAP (1u << 20)
__device__ __forceinline__ unsigned xb_ld(unsigned* p)              { return __hip_atomic_load(p, __ATOMIC_RELAXED, __HIP_MEMORY_SCOPE_AGENT); }
__device__ __forceinline__ unsigned xb_add(unsigned* p, unsigned v) { return __hip_atomic_fetch_add(p, v, __ATOMIC_RELAXED, __HIP_MEMORY_SCOPE_AGENT); }
__device__ __forceinline__ unsigned xb_xcc_id() { return (unsigned)__builtin_amdgcn_s_getreg((3 << 11) | 20) & 0xFu; }
#define XB_SPIN(cond, bar) do { unsigned _sp = 0; while (cond) { __builtin_amdgcn_s_sleep(1); \
    if ((++_sp & 255u) == 0u) { if (xb_ld(&(bar)[XB_TMO])) break; if (_sp > XB_SPIN_CAP) { atomicAdd(&(bar)[XB_TMO], 1u); break; } } } } while (0)
struct XcdBarrier { unsigned* bar; unsigned x; volatile LAS unsigned* st; };
__device__ __forceinline__ XcdBarrier xcd_barrier_post(unsigned* bar, volatile LAS unsigned* st, bool t0) {
    XcdBarrier b; b.bar = bar; b.x = xb_xcc_id(); b.st = st;
    if (t0) (void)xb_add(&bar[XB_XCNT(b.x)], 1u);
    return b;
}
__device__ __forceinline__ void xcd_barrier_complete(unsigned* bar, unsigned x, unsigned& nloc, unsigned& nx) {
    const unsigned G = gridDim.x * gridDim.y * gridDim.z;
    unsigned sum, cnt, mine, sp = 0u;
    for (;;) {
        sum = 0u; cnt = 0u; mine = 0u;
#pragma unroll
        for (unsigned j = 0; j < 16; ++j) { const unsigned c = xb_ld(&bar[XB_XCNT(j)]); sum += c; cnt += (c > 0u) ? 1u : 0u; mine = (j == x) ? c : mine; }
        if (sum == G) break;
        __builtin_amdgcn_s_sleep(1);
        if ((++sp & 255u) == 0u) { if (xb_ld(&bar[XB_TMO])) break; if (sp > XB_SPIN_CAP) { atomicAdd(&bar[XB_TMO], 1u); break; } }
    }
    nloc = mine > 0u ? mine : 1u; nx = cnt > 0u ? cnt : 1u;
}
__device__ __forceinline__ void xcd_barrier(const XcdBarrier& b, int wave) {
    asm volatile("s_waitcnt vmcnt(0)" ::: "memory");
    __syncthreads();
    if (wave == 0 && lane_id() == 0) {
        unsigned* bar = b.bar;
        __builtin_amdgcn_s_waitcnt(0);
        unsigned nloc = b.st[0], nx = b.st[1];
        if (nloc == 0u) { xcd_barrier_complete(bar, b.x, nloc, nx); b.st[0] = nloc; b.st[1] = nx; }
        const unsigned old = xb_add(&bar[XB_XSUB(b.x)], 1u);
        const unsigned gen = old / nloc;
        if (old + 1u == (gen + 1u) * nloc) {
            __builtin_amdgcn_fence(__ATOMIC_RELEASE, "agent");
            asm volatile("s_waitcnt vmcnt(0)" ::: "memory");
            const unsigned og = xb_add(&bar[XB_TOP], 1u);
            const unsigned tg = og / nx;
            if (og + 1u == (tg + 1u) * nx) xb_add(&bar[XB_TOPGEN], 1u);
            else XB_SPIN(xb_ld(&bar[XB_TOPGEN]) == tg, bar);
            __builtin_amdgcn_fence(__ATOMIC_ACQUIRE, "agent");
            xb_add(&bar[XB_XGEN(b.x)], 1u);
            asm volatile("s_waitcnt vmcnt(0)" ::: "memory");
        } else {
            XB_SPIN(xb_ld(&bar[XB_XGEN(b.x)]) == gen, bar);
            __builtin_amdgcn_fence(__ATOMIC_ACQUIRE, "agent");
            asm volatile("s_waitcnt vmcnt(0)" ::: "memory");
        }
    }
    __syncthreads();
}

struct Args { const float* in[23]; float* out; unsigned char* ws; int ph_lo, ph_hi, use_bar, pad; };
struct Frame {
    LAS unsigned char* lds;
    int wave, G, bid;
    unsigned char* ws;
};

template <int MT, int NT>
__device__ __forceinline__ void wave_gemm_nt(const bf16_t* A, int lda, const bf16_t* B, int ldb, int K, f32x4 (&acc)[MT][NT], int fr, int fq) {
    for (int k0 = 0; k0 < K; k0 += 32) {
        bf16x8 a[MT], b[NT];
#pragma unroll
        for (int mt = 0; mt < MT; ++mt) a[mt] = *(const bf16x8*)(A + (size_t)(16 * mt + fr) * lda + k0 + 8 * fq);
#pragma unroll
        for (int nt = 0; nt < NT; ++nt) b[nt] = *(const bf16x8*)(B + (size_t)(16 * nt + fr) * ldb + k0 + 8 * fq);
#pragma unroll
        for (int mt = 0; mt < MT; ++mt)
#pragma unroll
            for (int nt = 0; nt < NT; ++nt) acc[mt][nt] = __builtin_amdgcn_mfma_f32_16x16x32_bf16(a[mt], b[nt], acc[mt][nt], 0, 0, 0);
    }
}

__device__ __forceinline__ int win_src_col(int n) {
    if (n < 6144) return n;
    if (n < 8192) return 6160 + (n - 6144);
    if (n < 9216) return 8464 + (n - 8192);
    if (n < 11264) return 9568 + (n - 9216);
    if (n < 13312) return 11616 + (n - 11264);
    const int m = n - 13312;
    if (m < 16) return 6144 + m;
    if (m < 32) return 9552 + (m - 16);
    if (m < 96) return 9488 + (m - 32);
    if (m < 128) return -1;
    if (m < 256) return 8208 + (m - 128);
    if (m < 384) return 8336 + (m - 256);
    return -1;
}
__device__ __forceinline__ void transpose_item(const float* W, int N, int K, bf16_t* WT, int drow0, int srccol, int k0, LAS float* scr, int lane) {
    float v[64];
#pragma unroll
    for (int i = 0; i < 64; ++i) v[i] = srccol >= 0 ? W[(size_t)(k0 + i) * N + srccol] : 0.f;
#pragma unroll
    for (int i = 0; i < 64; ++i) scr[i * 65 + lane] = v[i];
    LDS_WAIT(); asm volatile("" ::: "memory");
    const int c = lane & 7;
#pragma unroll
    for (int j = 0; j < 8; ++j) { const int n = (lane >> 3) + 8 * j; const LAS float* s = scr + (8 * c) * 65 + n;
        u32x4 o; o.x = pk2(s[0 * 65], s[1 * 65]); o.y = pk2(s[2 * 65], s[3 * 65]); o.z = pk2(s[4 * 65], s[5 * 65]); o.w = pk2(s[6 * 65], s[7 * 65]);
        *(u32x4*)(WT + (size_t)(drow0 + n) * K + k0 + 8 * c) = o; }
    LDS_WAIT(); asm volatile("" ::: "memory");
}
__device__ __forceinline__ void rms_row_to_bf16(const float* xrow, const float* gain, bf16_t* orow, int lane) {
    const f32x4* xr = (const f32x4*)xrow + lane; const f32x4* gr = (const f32x4*)gain + lane;
    f32x4 v[8]; float s = 0.f;
#pragma unroll
    for (int j = 0; j < 8; ++j) { v[j] = xr[64 * j]; s += (v[j][0] * v[j][0] + v[j][1] * v[j][1]) + (v[j][2] * v[j][2] + v[j][3] * v[j][3]); }
    const float rstd = rsqrtf(wave_sum(s) * (1.f / DM) + EPS);
    u32x2* o8 = (u32x2*)orow + lane;
#pragma unroll
    for (int j = 0; j < 8; ++j) { const f32x4 g = gr[64 * j]; u32x2 w; w.x = pk2(v[j][0] * rstd * g[0], v[j][1] * rstd * g[1]); w.y = pk2(v[j][2] * rstd * g[2], v[j][3] * rstd * g[3]); o8[64 * j] = w; }
}
__device__ __forceinline__ void cvt_copy(const float* src, bf16_t* dst, size_t n, size_t gtid, size_t gthreads) {
    for (size_t i = gtid; i < n / 8; i += gthreads) { const f32x4 a = *((const f32x4*)src + 2 * i), b = *((const f32x4*)src + 2 * i + 1);
        u32x4 w; w.x = pk2(a[0], a[1]); w.y = pk2(a[2], a[3]); w.z = pk2(b[0], b[1]); w.w = pk2(b[2], b[3]); *((u32x4*)dst + i) = w; }
}
__device__ __forceinline__ void p0_prologue(const Frame& F, const Args& a) {
    const int lane_ = lane_id(), tid_ = F.wave * 64 + lane_; (void)tid_;
    LAS float* scr = (LAS float*)(F.lds + F.wave * 16896);
    const int gw = F.bid * NWAVES + F.wave, NGW = F.G * NWAVES;
    constexpr int I_IN = (NIN / 64) * (DM / 64), I_SQ = (DM / 64) * (DM / 64);
    for (int it = gw; it < I_IN + 7 * I_SQ; it += NGW) {
        if (it < I_IN) { const int nb = it / (DM / 64), kb = it % (DM / 64); const int n = nb * 64 + lane_;
            transpose_item(a.in[4], 13664, DM, (bf16_t*)(F.ws + WS_WIN), nb * 64, win_src_col(n), kb * 64, scr, lane_); }
        else { const int r = it - I_IN, mi = r / I_SQ, q = r % I_SQ, nb = q / (DM / 64), kb = q % (DM / 64);
            const float* W; size_t off;
            switch (mi) { case 0: W = a.in[8]; off = WS_WPA; break; case 1: W = a.in[9]; off = WS_WPB; break; case 2: W = a.in[10]; off = WS_WOUT; break;
                          case 3: W = a.in[14]; off = WS_WXK; break; case 4: W = a.in[15]; off = WS_WXV; break; case 5: W = a.in[16]; off = WS_WXO; break; default: W = a.in[18]; off = WS_WPQ; break; }
            transpose_item(W, DM, DM, (bf16_t*)(F.ws + off), nb * 64, nb * 64 + lane_, kb * 64, scr, lane_); }
    }
    const size_t gtid = (size_t)F.bid * NTHREADS + tid_, gth = (size_t)F.G * NTHREADS;
    cvt_copy(a.in[13], (bf16_t*)(F.ws + WS_WXQ), (size_t)DM * DM, gtid, gth);
    cvt_copy(a.in[19], (bf16_t*)(F.ws + WS_KEYS), (size_t)16 * 128 * 128, gtid, gth);
    for (int m = gw; m < SEQ + MEM; m += NGW) {
        if (m < SEQ) rms_row_to_bf16(a.in[0] + (size_t)m * DM, a.in[3], (bf16_t*)(F.ws + WS_A0) + (size_t)m * DM, lane_);
        else rms_row_to_bf16(a.in[1] + (size_t)(m - SEQ) * DM, a.in[12], (bf16_t*)(F.ws + WS_MEMN) + (size_t)(m - SEQ) * DM, lane_);
    }
}

__device__ __forceinline__ void sincos_red(float ang, float& s, float& c) {
    const float n = rintf(ang * 0.15915494309189535f);
    float r = fmaf(-n, 6.28318548202514648f, ang); r = fmaf(-n, -1.7484556000744883e-07f, r);
    const float f = r * 0.15915494309189535f;
    s = __builtin_amdgcn_sinf(f); c = __builtin_amdgcn_cosf(f);
}
__device__ __forceinline__ void rope_token(const Frame& F, const Args& a, int t) {
    const int lane_ = lane_id(), tid_ = F.wave * 64 + lane_; (void)tid_;
    const int l = lane_; const float pos = (float)((const int*)a.in[2])[t];
    bf16_t* DQ = (bf16_t*)(F.ws + WS_DQ) + (size_t)t * DM; bf16_t* IQ = (bf16_t*)(F.ws + WS_IQ) + (size_t)t * 1024; const bf16_t* MS = (const bf16_t*)(F.ws + WS_MISC) + (size_t)t * MISC_LD;
    float s1, c1, s2, c2;
    { const float inv = powf(10000.f, -(float)(2 * l) / 128.f); sincos_red(pos * inv, s1, c1); }
    { const float inv = powf(10000.f, -(float)(2 * (l & 31)) / 64.f); sincos_red(pos * inv, s2, c2); }
#pragma unroll 4
    for (int h = 0; h < 16; ++h) { const float x1 = bf2f(DQ[h * 128 + l]), x2 = bf2f(DQ[h * 128 + 64 + l]);
        DQ[h * 128 + l] = (bf16_t)f2bf(x1 * c1 - x2 * s1); DQ[h * 128 + 64 + l] = (bf16_t)f2bf(x2 * c1 + x1 * s1); }
    { const float x1 = bf2f(MS[128 + l]), x2 = bf2f(MS[128 + 64 + l]); bf16_t* kb = (bf16_t*)(F.ws + WS_KBR) + (size_t)t * 128;
      kb[l] = (bf16_t)f2bf(x1 * c1 - x2 * s1); kb[64 + l] = (bf16_t)f2bf(x2 * c1 + x1 * s1); }
#pragma unroll 4
    for (int p = 0; p < 8; ++p) { const int h = 2 * p + (l >> 5), i = l & 31; const float x1 = bf2f(IQ[h * 64 + i]), x2 = bf2f(IQ[h * 64 + 32 + i]);
        IQ[h * 64 + i] = (bf16_t)f2bf(x1 * c2 - x2 * s2); IQ[h * 64 + 32 + i] = (bf16_t)f2bf(x2 * c2 + x1 * s2); }
    if (l < 32) { const float x1 = bf2f(MS[32 + l]), x2 = bf2f(MS[64 + l]); bf16_t* ki = (bf16_t*)(F.ws + WS_KIR) + (size_t)t * 64;
        ki[l] = (bf16_t)f2bf(x1 * c2 - x2 * s2); ki[32 + l] = (bf16_t)f2bf(x2 * c2 + x1 * s2); }
    { bf16_t* vb = (bf16_t*)(F.ws + WS_VB) + (size_t)t * 128; vb[l] = MS[256 + l]; vb[64 + l] = MS[320 + l]; }
    if (l < 16) ((float*)(F.ws + WS_IW))[(size_t)t * 16 + l] = bf2f(MS[16 + l]) * 0.03125f;
}
constexpr int GLP = 264;
__device__ __forceinline__ void gla_prep_item(const Frame& F, const Args& a, int item) {
    const int lane_ = lane_id(), tid_ = F.wave * 64 + lane_; (void)tid_;
    const int c = item >> 2, h = item & 3, t0 = c * 64, tid = tid_;
    LAS bf16_t* sQ = (LAS bf16_t*)F.lds; LAS bf16_t* sK = sQ + 64 * GLP; LAS float* sG = (LAS float*)(sK + 64 * GLP);
    const bf16_t* GQK = (const bf16_t*)(F.ws + WS_GQK); const bf16_t* MS = (const bf16_t*)(F.ws + WS_MISC);
    for (int i = tid; i < 64 * 16; i += NTHREADS) sG[i] = bf2f(MS[(size_t)(t0 + (i >> 4)) * MISC_LD + (i & 15)]);
    __syncthreads();
    if (tid < 256) {
        const int d = tid, col = h * 256 + d;
        float w2c[16];
#pragma unroll
        for (int r = 0; r < 16; ++r) w2c[r] = a.in[5][r * 1024 + col];
        const float bias = a.in[6][col];
        bf16_t* QT = (bf16_t*)(F.ws + WS_QT);
        float b = 0.f;
        for (int j = 0; j < 64; ++j) {
            float z = bias;
#pragma unroll
            for (int r = 0; r < 16; ++r) z = fmaf(sG[j * 16 + r], w2c[r], z);
            const float ls = fminf(z, 0.f) - log1pf(__expf(-fabsf(z)));
            b += ls * (1.f / 16.f);
            const float q = bf2f(GQK[(size_t)(t0 + j) * DM + col]), k = bf2f(GQK[(size_t)(t0 + j) * DM + 1024 + col]);
            const float eb = __expf(b);
            const unsigned qb = f2bf(q * 0.0625f * eb), kb = f2bf(k / eb);
            QT[(size_t)(t0 + j) * 1024 + col] = (bf16_t)qb; sQ[j * GLP + d] = (bf16_t)qb; sK[j * GLP + d] = (bf16_t)kb;
        }
        const float eL = __expf(b);
        ((float*)(F.ws + WS_DVEC))[c * 1024 + col] = eL;
        bf16_t* KH = (bf16_t*)(F.ws + WS_KHT) + ((size_t)item * 256 + d) * 64;
#pragma unroll
        for (int j8 = 0; j8 < 8; ++j8) { u32x4 w;
            w.x = pk2(bf2f(sK[(j8 * 8 + 0) * GLP + d]) * eL, bf2f(sK[(j8 * 8 + 1) * GLP + d]) * eL); w.y = pk2(bf2f(sK[(j8 * 8 + 2) * GLP + d]) * eL, bf2f(sK[(j8 * 8 + 3) * GLP + d]) * eL);
            w.z = pk2(bf2f(sK[(j8 * 8 + 4) * GLP + d]) * eL, bf2f(sK[(j8 * 8 + 5) * GLP + d]) * eL); w.w = pk2(bf2f(sK[(j8 * 8 + 6) * GLP + d]) * eL, bf2f(sK[(j8 * 8 + 7) * GLP + d]) * eL);
            *(u32x4*)(KH + j8 * 8) = w; }
    } else {
        const bf16_t* GV = (const bf16_t*)(F.ws + WS_GV);
#pragma unroll 1
        for (int i = 0; i < 2; ++i) { const int e = (tid - 256) + 256 * i; bf16_t* VT = (bf16_t*)(F.ws + WS_VT) + ((size_t)item * 512 + e) * 64;
#pragma unroll
            for (int j8 = 0; j8 < 8; ++j8) { unsigned short v[8];
#pragma unroll
                for (int j = 0; j < 8; ++j) v[j] = GV[(size_t)(t0 + j8 * 8 + j) * DM + h * 512 + e];
                u32x4 w; w.x = v[0] | ((unsigned)v[1] << 16); w.y = v[2] | ((unsigned)v[3] << 16); w.z = v[4] | ((unsigned)v[5] << 16); w.w = v[6] | ((unsigned)v[7] << 16);
                *(u32x4*)(VT + j8 * 8) = w; } }
    }
    __syncthreads();
    { const int fr = lane_ & 15, fq = lane_ >> 4; bf16_t* AT = (bf16_t*)(F.ws + WS_ATT) + (size_t)item * 4096;
#pragma unroll
      for (int tt = 0; tt < 2; ++tt) { const int tile = F.wave * 2 + tt, ti = tile >> 2, tj = tile & 3; f32x4 acc = (f32x4){0.f, 0.f, 0.f, 0.f};
          if (tj <= ti) {
#pragma unroll
              for (int k0 = 0; k0 < 256; k0 += 32) { const bf16x8 av = *(const LAS bf16x8*)(sQ + (16 * ti + fr) * GLP + k0 + 8 * fq), bv = *(const LAS bf16x8*)(sK + (16 * tj + fr) * GLP + k0 + 8 * fq);
                  acc = __builtin_amdgcn_mfma_f32_16x16x32_bf16(av, bv, acc, 0, 0, 0); } }
#pragma unroll
          for (int r = 0; r < 4; ++r) { const int i = 16 * ti + 4 * fq + r, j = 16 * tj + fr; AT[i * 64 + j] = (bf16_t)f2bf(j <= i ? acc[r] : 0.f); } } }
    __syncthreads();
}

__device__ __forceinline__ float relu_(float x) { const int i = __builtin_bit_cast(int, x); return __builtin_bit_cast(float, i > 0 ? i : 0); }
constexpr int SC_ITEMS = 1088;
__device__ __forceinline__ void scores_item(const Frame& F, int item) {
    const int lane_ = lane_id(), tid_ = F.wave * 64 + lane_; (void)tid_;
    int gq = 0, rem = item;
    while (rem >= 8 * (gq + 1)) { rem -= 8 * (gq + 1); ++gq; }
    const int qb = gq * 8 + rem / (gq + 1), kc = rem % (gq + 1);
    const int fr = lane_ & 15, fq = lane_ >> 4, tq0 = qb * 64 + F.wave * 8;
    const bf16_t* IQ = (const bf16_t*)(F.ws + WS_IQ); const bf16_t* KI = (const bf16_t*)(F.ws + WS_KIR); const float* IW = (const float*)(F.ws + WS_IW);
    unsigned short* SC = (unsigned short*)(F.ws + WS_SCORES);
    bf16x8 aq[2][4][2]; f32x4 wq[2][4];
#pragma unroll
    for (int G = 0; G < 2; ++G)
#pragma unroll
        for (int j = 0; j < 4; ++j) { const bf16_t* p = IQ + (size_t)(tq0 + 4 * G + (fr >> 2)) * 1024 + (4 * j + (fr & 3)) * 64 + 8 * fq; aq[G][j][0] = *(const bf16x8*)p; aq[G][j][1] = *(const bf16x8*)(p + 32);
            wq[G][j] = *(const f32x4*)(IW + (size_t)(tq0 + 4 * G + fq) * 16 + 4 * j); }
    for (int g4 = 0; g4 < 8; ++g4) {
        const int key0 = kc * 512 + g4 * 64;
        bf16x8 bk[4][2];
#pragma unroll
        for (int kt = 0; kt < 4; ++kt) { const bf16_t* kp = KI + (size_t)(key0 + 4 * fr + kt) * 64 + 8 * fq; bk[kt][0] = *(const bf16x8*)kp; bk[kt][1] = *(const bf16x8*)(kp + 32); }
#pragma unroll
        for (int G = 0; G < 2; ++G) { float sv[4];
#pragma unroll
            for (int kt = 0; kt < 4; ++kt) { float s0 = 0.f, s1 = 0.f;
#pragma unroll
                for (int j = 0; j < 4; ++j) { f32x4 acc = __builtin_amdgcn_mfma_f32_16x16x32_bf16(aq[G][j][0], bk[kt][0], (f32x4){0.f, 0.f, 0.f, 0.f}, 0, 0, 0); acc = __builtin_amdgcn_mfma_f32_16x16x32_bf16(aq[G][j][1], bk[kt][1], acc, 0, 0, 0);
                    s0 = fmaf(relu_(acc[0]), wq[G][j][0], s0); s1 = fmaf(relu_(acc[1]), wq[G][j][1], s1); s0 = fmaf(relu_(acc[2]), wq[G][j][2], s0); s1 = fmaf(relu_(acc[3]), wq[G][j][3], s1); }
                sv[kt] = s0 + s1; }
            const _Float16 h0 = (_Float16)sv[0], h1 = (_Float16)sv[1], h2 = (_Float16)sv[2], h3 = (_Float16)sv[3];
            u32x2 w; w.x = (unsigned)__builtin_bit_cast(unsigned short, h0) | ((unsigned)__builtin_bit_cast(unsigned short, h1) << 16); w.y = (unsigned)__builtin_bit_cast(unsigned short, h2) | ((unsigned)__builtin_bit_cast(unsigned short, h3) << 16);
            *(u32x2*)(SC + (size_t)(tq0 + 4 * G + fq) * SEQ + key0 + 4 * fr) = w; }
    }
}

__device__ __forceinline__ unsigned h16key(unsigned h) { return (h & 0x8000u) ? (~h & 0xffffu) : (h | 0x8000u); }
typedef unsigned short u16x2 __attribute__((ext_vector_type(2)));
constexpr int SEL_LDS_OFF = 137216;
__device__ __forceinline__ int cnt_ge(const unsigned (&kk)[64], unsigned c) {
    const unsigned cm1 = (c - 1u) * 0x00010001u, one = 0x00010001u; unsigned acc = 0u;
#pragma unroll
    for (int r = 0; r < 64; ++r) { unsigned tmp;
        asm("v_pk_sub_u16 %0, %2, %3 clamp\n\tv_pk_min_u16 %0, %0, %4\n\tv_pk_add_u16 %1, %1, %0" : "=&v"(tmp), "+v"(acc) : "v"(kk[r]), "v"(cm1), "v"(one)); }
    return (int)(acc & 0xffffu) + (int)(acc >> 16);
}
__device__ __forceinline__ void select_row(const Frame& F, int t) {
    const int lane_ = lane_id();
    LAS int* SEL = (LAS int*)(F.lds + SEL_LDS_OFF) + F.wave * 256; const int l = lane_;
    if (t < 256) {
#pragma unroll
        for (int i = 0; i < 4; ++i) { const int j = i * 64 + l; SEL[j] = (j <= t) ? j : 0; }
        return;
    }
    const unsigned short* SC = (const unsigned short*)(F.ws + WS_SCORES) + (size_t)t * SEQ;
    unsigned kk[64];
#pragma unroll
    for (int i = 0; i < 16; ++i) { const int s0 = (i * 64 + l) * 8; u32x4 v = (u32x4){0u, 0u, 0u, 0u};
        if (s0 <= t) v = *(const u32x4*)(SC + s0);
#pragma unroll
        for (int w = 0; w < 4; ++w) { const unsigned x = v[w]; unsigned lo = h16key(x & 0xffffu), hi = h16key(x >> 16);
            if (s0 + 2 * w > t) lo = 0u; if (s0 + 2 * w + 1 > t) hi = 0u; kk[i * 4 + w] = lo | (hi << 16); } }
    unsigned T = 0u;
    for (int bit = 15; bit >= 0; --bit) { const unsigned cand = T | (1u << bit); int cnt = cnt_ge(kk, cand);
#pragma unroll
        for (int o = 1; o < 64; o <<= 1) cnt += __shfl_xor(cnt, o);
        if (cnt >= 256) T = cand; }
    const int nge = cnt_ge(kk, T); const int ngt = (T < 0xffffu) ? cnt_ge(kk, T + 1u) : 0; const int neq = nge - ngt;
    int pg = ngt, pe = neq;
#pragma unroll
    for (int o = 1; o < 64; o <<= 1) { const int a = __shfl_up(pg, o), b = __shfl_up(pe, o); if (l >= o) { pg += a; pe += b; } }
    const int totgt = __shfl(pg, 63); pg -= ngt; pe -= neq;
    const int need = 256 - totgt; int mytake = need - pe; mytake = mytake < 0 ? 0 : (mytake > neq ? neq : mytake);
    int off = pg + (pe < need ? pe : need), tk = 0;
#pragma unroll
    for (int r = 0; r < 64; ++r)
#pragma unroll
        for (int hf = 0; hf < 2; ++hf) { const unsigned key = hf ? (kk[r] >> 16) : (kk[r] & 0xffffu); const int s = ((r >> 2) * 64 + l) * 8 + (r & 3) * 2 + hf;
            const bool eq = (key == T); const bool take = (key > T) || (eq && tk < mytake);
            if (take) SEL[off] = s;
            off += take ? 1 : 0; tk += eq ? 1 : 0; }
}

constexpr int SP_PP = 264;
constexpr int SP_VP = 136;
constexpr int SP_WAVE_BYTES = 16 * SP_PP * 2 + 32 * SP_VP * 2;
__device__ __forceinline__ s16x4 tr_read4(unsigned lds_addr) { s16x4 r; asm volatile("ds_read_b64_tr_b16 %0, %1\n\ts_waitcnt lgkmcnt(0)" : "=&v"(r) : "v"(lds_addr) : "memory"); return r; }
__device__ __forceinline__ void sparse_attn_query(const Frame& F, int t) {
    const int lane_ = lane_id(), tid_ = F.wave * 64 + lane_; (void)tid_;
    const int l = lane_, fr = l & 15, fq = l >> 4;
    LAS unsigned char* wl = F.lds + F.wave * SP_WAVE_BYTES; LAS bf16_t* sP = (LAS bf16_t*)wl; LAS bf16_t* sV = (LAS bf16_t*)(wl + 16 * SP_PP * 2);
    const bf16_t* Q = (const bf16_t*)(F.ws + WS_DQ) + (size_t)t * DM; bf16_t* OB = (bf16_t*)(F.ws + WS_OB) + (size_t)t * DM; const bf16_t* KB = (const bf16_t*)(F.ws + WS_KBR); const bf16_t* VB = (const bf16_t*)(F.ws + WS_VB);
    const LAS int* SEL = (const LAS int*)(F.lds + SEL_LDS_OFF) + F.wave * 256; const int nvalid = t < 255 ? t + 1 : 256;
    LDS_WAIT();
    bf16x8 aq[4];
#pragma unroll
    for (int ks = 0; ks < 4; ++ks) aq[ks] = *(const bf16x8*)(Q + fr * 128 + ks * 32 + 8 * fq);
    f32x4 sc[16];
#pragma unroll
    for (int kt = 0; kt < 16; ++kt) { const int srow = SEL[kt * 16 + fr]; const bf16_t* kp = KB + (size_t)srow * 128 + 8 * fq; f32x4 acc = (f32x4){0.f, 0.f, 0.f, 0.f};
#pragma unroll
        for (int ks = 0; ks < 4; ++ks) acc = __builtin_amdgcn_mfma_f32_16x16x32_bf16(aq[ks], *(const bf16x8*)(kp + ks * 32), acc, 0, 0, 0);
        const bool ok = (kt * 16 + fr) < nvalid;
#pragma unroll
        for (int r = 0; r < 4; ++r) acc[r] = ok ? acc[r] * 0.08838834764831845f : -3.0e38f;
        sc[kt] = acc; }
    f32x4 mx = sc[0];
#pragma unroll
    for (int kt = 1; kt < 16; ++kt)
#pragma unroll
        for (int r = 0; r < 4; ++r) mx[r] = fmaxf(mx[r], sc[kt][r]);
#pragma unroll
    for (int o = 1; o < 16; o <<= 1)
#pragma unroll
        for (int r = 0; r < 4; ++r) mx[r] = fmaxf(mx[r], __shfl_xor(mx[r], o));
    f32x4 sm = (f32x4){0.f, 0.f, 0.f, 0.f};
#pragma unroll
    for (int kt = 0; kt < 16; ++kt)
#pragma unroll
        for (int r = 0; r < 4; ++r) { const float e = __expf(sc[kt][r] - mx[r]); sc[kt][r] = e; sm[r] += e; }
#pragma unroll
    for (int o = 1; o < 16; o <<= 1)
#pragma unroll
        for (int r = 0; r < 4; ++r) sm[r] += __shfl_xor(sm[r], o);
#pragma unroll
    for (int r = 0; r < 4; ++r) sm[r] = 1.f / sm[r];
#pragma unroll
    for (int kt = 0; kt < 16; ++kt)
#pragma unroll
        for (int r = 0; r < 4; ++r) sP[(4 * fq + r) * SP_PP + kt * 16 + fr] = (bf16_t)f2bf(sc[kt][r] * sm[r]);
    LDS_WAIT();
    f32x4 o[8];
#pragma unroll
    for (int nt = 0; nt < 8; ++nt) o[nt] = (f32x4){0.f, 0.f, 0.f, 0.f};
    const unsigned vbase = (unsigned)(size_t)sV;
    for (int kst = 0; kst < 8; ++kst) {
#pragma unroll
        for (int i = 0; i < 8; ++i) { const int p = i * 64 + l, row = p >> 4, ch = p & 15; const int srow = SEL[kst * 32 + row];
            *(LAS u32x4*)(sV + row * SP_VP + ch * 8) = *(const u32x4*)(VB + (size_t)srow * 128 + ch * 8); }
        const bf16x8 pa = *(const LAS bf16x8*)(sP + fr * SP_PP + kst * 32 + 8 * fq);
        LDS_WAIT(); __builtin_amdgcn_sched_barrier(0);
#pragma unroll
        for (int nt = 0; nt < 8; ++nt) { const unsigned a0 = vbase + (unsigned)(((8 * fq + (fr >> 2)) * SP_VP + 16 * nt + 4 * (fr & 3)) * 2);
            const s16x4 lo = tr_read4(a0), hi = tr_read4(a0 + 4 * SP_VP * 2);
            bf16x8 bv; bv[0] = lo[0]; bv[1] = lo[1]; bv[2] = lo[2]; bv[3] = lo[3]; bv[4] = hi[0]; bv[5] = hi[1]; bv[6] = hi[2]; bv[7] = hi[3];
            __builtin_amdgcn_sched_barrier(0);
            o[nt] = __builtin_amdgcn_mfma_f32_16x16x32_bf16(pa, bv, o[nt], 0, 0, 0); }
        __builtin_amdgcn_sched_barrier(0);
    }
#pragma unroll
    for (int nt = 0; nt < 8; ++nt)
#pragma unroll
        for (int r = 0; r < 4; ++r) OB[(4 * fq + r) * 128 + 16 * nt + fr] = (bf16_t)f2bf(o[nt][r]);
}

__device__ __forceinline__ void gla_level1_item(const Frame& F, int item) {
    const int lane_ = lane_id(), tid_ = F.wave * 64 + lane_; (void)tid_;
    const int fr = lane_ & 15, fq = lane_ >> 4;
    const bf16_t* KH = (const bf16_t*)(F.ws + WS_KHT) + (size_t)item * 256 * 64; const bf16_t* VT = (const bf16_t*)(F.ws + WS_VT) + ((size_t)item * 512 + F.wave * 64) * 64;
    bf16_t* ST = (bf16_t*)(F.ws + WS_ST) + ((size_t)item * 512 + F.wave * 64) * 256;
    for (int db = 0; db < 4; ++db) {
        f32x4 acc[4][4];
#pragma unroll
        for (int i = 0; i < 4; ++i)
#pragma unroll
            for (int j = 0; j < 4; ++j) acc[i][j] = (f32x4){0.f, 0.f, 0.f, 0.f};
        wave_gemm_nt<4, 4>(KH + (size_t)db * 64 * 64, 64, VT, 64, 64, acc, fr, fq);
#pragma unroll
        for (int mt = 0; mt < 4; ++mt)
#pragma unroll
            for (int nt = 0; nt < 4; ++nt) { u32x2 w; w.x = pk2(acc[mt][nt][0], acc[mt][nt][1]); w.y = pk2(acc[mt][nt][2], acc[mt][nt][3]);
                *(u32x2*)(ST + (size_t)(16 * nt + fr) * 256 + db * 64 + 16 * mt + 4 * fq) = w; }
    }
}
__device__ __forceinline__ void gla_scan(const Frame& F) {
    const int lane_ = lane_id(), tid_ = F.wave * 64 + lane_; (void)tid_;
    const float* DV = (const float*)(F.ws + WS_DVEC); bf16_t* ST = (bf16_t*)(F.ws + WS_ST);
    for (int idx = F.bid * NTHREADS + tid_; idx < 4 * 512 * 64; idx += F.G * NTHREADS) {
        const int h = idx >> 15, rem = idx & 32767, e = rem >> 6, d4 = (rem & 63) * 4;
        f32x4 run = (f32x4){0.f, 0.f, 0.f, 0.f};
#pragma unroll 16
        for (int c = 0; c < 128; ++c) { u32x2* p = (u32x2*)(ST + ((size_t)(c * 4 + h) * 512 + e) * 256 + d4); const u32x2 L = *p; const f32x4 dv = *(const f32x4*)(DV + c * 1024 + h * 256 + d4);
            u32x2 w; w.x = pk2(run[0], run[1]); w.y = pk2(run[2], run[3]); *p = w;
            run[0] = fmaf(dv[0], run[0], bflo(L.x)); run[1] = fmaf(dv[1], run[1], bfhi(L.x)); run[2] = fmaf(dv[2], run[2], bflo(L.y)); run[3] = fmaf(dv[3], run[3], bfhi(L.y)); }
    }
}
__device__ __forceinline__ void gla_out_item(const Frame& F, const Args& a, int item) {
    const int lane_ = lane_id(), tid_ = F.wave * 64 + lane_; (void)tid_;
    const int c = item >> 2, h = item & 3, t0 = c * 64, fr = lane_ & 15, fq = lane_ >> 4, w = F.wave;
    LAS float* sred = (LAS float*)F.lds;
    f32x4 acc[4][4];
#pragma unroll
    for (int i = 0; i < 4; ++i)
#pragma unroll
        for (int j = 0; j < 4; ++j) acc[i][j] = (f32x4){0.f, 0.f, 0.f, 0.f};
    wave_gemm_nt<4, 4>((const bf16_t*)(F.ws + WS_ST) + ((size_t)item * 512 + w * 64) * 256, 256, (const bf16_t*)(F.ws + WS_QT) + (size_t)t0 * 1024 + h * 256, 1024, 256, acc, fr, fq);
    wave_gemm_nt<4, 4>((const bf16_t*)(F.ws + WS_VT) + ((size_t)item * 512 + w * 64) * 64, 64, (const bf16_t*)(F.ws + WS_ATT) + (size_t)item * 4096, 64, 64, acc, fr, fq);
    float ss[4];
#pragma unroll
    for (int nt = 0; nt < 4; ++nt) { float s = 0.f;
#pragma unroll
        for (int mt = 0; mt < 4; ++mt) s += (acc[mt][nt][0] * acc[mt][nt][0] + acc[mt][nt][1] * acc[mt][nt][1]) + (acc[mt][nt][2] * acc[mt][nt][2] + acc[mt][nt][3] * acc[mt][nt][3]);
        s += __shfl_xor(s, 16); s += __shfl_xor(s, 32); ss[nt] = s;
        if (fq == 0) sred[w * 64 + 16 * nt + fr] = s; }
    __syncthreads();
    const bf16_t* GR = (const bf16_t*)(F.ws + WS_GR); bf16_t* OA = (bf16_t*)(F.ws + WS_OA); const float* gain = a.in[7] + h * 512;
#pragma unroll
    for (int nt = 0; nt < 4; ++nt) { const int tok = 16 * nt + fr; float tot = 0.f;
#pragma unroll
        for (int ww = 0; ww < 8; ++ww) tot += sred[ww * 64 + tok];
        const float rstd = rsqrtf(tot * (1.f / 512.f) + EPS);
#pragma unroll
        for (int mt = 0; mt < 4; ++mt) { const int e = w * 64 + 16 * mt + 4 * fq; const size_t off = (size_t)(t0 + tok) * DM + h * 512 + e;
            const u32x2 g = *(const u32x2*)(GR + off); const f32x4 gn = *(const f32x4*)(gain + e);
            const float r0 = bflo(g.x), r1 = bfhi(g.x), r2 = bflo(g.y), r3 = bfhi(g.y);
            u32x2 o; o.x = pk2(acc[mt][nt][0] * rstd * gn[0] * r0 * sigmoidf_(r0), acc[mt][nt][1] * rstd * gn[1] * r1 * sigmoidf_(r1));
            o.y = pk2(acc[mt][nt][2] * rstd * gn[2] * r2 * sigmoidf_(r2), acc[mt][nt][3] * rstd * gn[3] * r3 * sigmoidf_(r3));
            *(u32x2*)(OA + off) = o; } }
    __syncthreads();
}

__device__ const unsigned char PEER_CAND[52] = {
    0x00,0x01,0x02,0x03,0x04,0x05,0x06,0x07,0x08,0x09,0x0a,0x0b,0x0c,0x0d,0x0e,0x0f, 0x10,0x11,0x12,0x13,0x14,0x15,0x16,0x17, 0x20,0x21,0x22,0x23,0x24, 0x30,0x31,0x32,0x33,
    0x40,0x41,0x42, 0x50,0x51, 0x60,0x61, 0x70,0x71, 0x80,0x90,0xa0,0xb0,0xc0,0xd0,0xe0,0xf0, 0xff,0xff };
__device__ __forceinline__ unsigned f32ord(float f) { const unsigned u = __builtin_bit_cast(unsigned, f); return (u & 0x80000000u) ? ~u : (u | 0x80000000u); }
__device__ __forceinline__ float ordf32(unsigned k) { const unsigned u = (k & 0x80000000u) ? (k & 0x7fffffffu) : ~k; return __builtin_bit_cast(float, u); }
__device__ __forceinline__ unsigned umax_x32(unsigned v) { const unsigned o = __shfl_xor(v, 32); return v > o ? v : o; }
__device__ __forceinline__ float fmax_x32(float v) { return fmaxf(v, __shfl_xor(v, 32)); }
__device__ __forceinline__ float fadd_x32(float v) { return v + __shfl_xor(v, 32); }
__device__ __forceinline__ void peer_select_item(const Frame& F, int item) {
    const int lane_ = lane_id(), tid_ = F.wave * 64 + lane_; (void)tid_;
    const int l = lane_, fr = l & 15, fq = l >> 4, t0 = (item >> 3) * 16, h = item & 7;
    LAS unsigned* tv = (LAS unsigned*)(F.lds + F.wave * 2048);
    const bf16_t* PQ = (const bf16_t*)(F.ws + WS_PQ); const bf16_t* KEYS = (const bf16_t*)(F.ws + WS_KEYS);
    int* EXPI = (int*)(F.ws + WS_EXPI); float* GATEW = (float*)(F.ws + WS_GATEW);
    {
#pragma unroll 1
        for (int p = 0; p < 2; ++p) { const int g = h * 2 + p;
            f32x4 acc[8];
#pragma unroll
            for (int mt = 0; mt < 8; ++mt) acc[mt] = (f32x4){0.f, 0.f, 0.f, 0.f};
#pragma unroll
            for (int ks = 0; ks < 4; ++ks) { const bf16x8 bq = *(const bf16x8*)(PQ + (size_t)(t0 + fr) * DM + g * 128 + ks * 32 + 8 * fq);
#pragma unroll
                for (int mt = 0; mt < 8; ++mt) acc[mt] = __builtin_amdgcn_mfma_f32_16x16x32_bf16(*(const bf16x8*)(KEYS + ((size_t)g * 128 + 16 * mt + fr) * 128 + ks * 32 + 8 * fq), bq, acc[mt], 0, 0, 0); }
            unsigned kk[32];
#pragma unroll
            for (int mt = 0; mt < 8; ++mt)
#pragma unroll
                for (int r = 0; r < 4; ++r) kk[mt * 4 + r] = (f32ord(acc[mt][r]) & ~127u) | (unsigned)(127 - (16 * mt + 4 * fq + r));
#pragma unroll
            for (int i = 0; i < 16; ++i) { unsigned m = kk[0];
#pragma unroll
                for (int j = 1; j < 32; ++j) m = m > kk[j] ? m : kk[j];
                { const unsigned o = __shfl_xor(m, 16); m = m > o ? m : o; } m = umax_x32(m);
#pragma unroll
                for (int j = 0; j < 32; ++j) kk[j] = (kk[j] == m) ? 0u : kk[j];
                if (fq == (i & 3)) tv[(fr * 2 + p) * 16 + i] = m; }
        }
        LDS_WAIT();
        unsigned ck[13];
#pragma unroll
        for (int ci = 0; ci < 13; ++ci) { const int cidx = fq + 4 * ci; const unsigned ab = PEER_CAND[cidx];
            if (cidx < 50) { const float v = ordf32(tv[(fr * 2 + 0) * 16 + (ab >> 4)] & ~127u) + ordf32(tv[(fr * 2 + 1) * 16 + (ab & 15)] & ~127u); ck[ci] = (f32ord(v) & ~63u) | (unsigned)(63 - cidx); }
            else ck[ci] = 0u; }
        float scv[4]; int exv[4];
#pragma unroll
        for (int i = 0; i < 16; ++i) { unsigned m = ck[0];
#pragma unroll
            for (int j = 1; j < 13; ++j) m = m > ck[j] ? m : ck[j];
            { const unsigned o = __shfl_xor(m, 16); m = m > o ? m : o; } m = umax_x32(m);
#pragma unroll
            for (int j = 0; j < 13; ++j) ck[j] = (ck[j] == m) ? 0u : ck[j];
            if (fq == (i & 3)) { const int cidx = 63 - (int)(m & 63u); const unsigned ab = PEER_CAND[cidx];
                const int n1 = 127 - (int)(tv[(fr * 2 + 0) * 16 + (ab >> 4)] & 127u), n2 = 127 - (int)(tv[(fr * 2 + 1) * 16 + (ab & 15)] & 127u);
                exv[i >> 2] = n1 * 128 + n2; scv[i >> 2] = ordf32(m & ~63u); } }
        float mx = fmaxf(fmaxf(scv[0], scv[1]), fmaxf(scv[2], scv[3])); mx = fmaxf(mx, __shfl_xor(mx, 16)); mx = fmax_x32(mx);
        float ev[4], s = 0.f;
#pragma unroll
        for (int j = 0; j < 4; ++j) { ev[j] = __expf(scv[j] - mx); s += ev[j]; }
        s += __shfl_xor(s, 16); s = fadd_x32(s); const float inv = 1.f / s;
#pragma unroll
        for (int j = 0; j < 4; ++j) { const size_t o = (size_t)(t0 + fr) * 128 + h * 16 + j * 4 + fq; EXPI[o] = exv[j]; GATEW[o] = ev[j] * inv; }
        LDS_WAIT();
    }
}
__device__ __forceinline__ float gelu_tanh(float x) { const float u = 0.7978845608028654f * (x + 0.044715f * x * x * x); const float e = __expf(2.f * u); const float th = 1.f - 2.f / (e + 1.f); return 0.5f * x * (1.f + th); }
__device__ __forceinline__ void quant_row(const float* src, unsigned char* dst, float* scale_out, int lane) {
    f32x4 v[8]; float mx = 0.f;
#pragma unroll
    for (int i = 0; i < 2; ++i)
#pragma unroll
        for (int j = 0; j < 4; ++j) { const f32x4 x = *(const f32x4*)(src + i * 1024 + lane * 16 + j * 4); v[i * 4 + j] = x; mx = fmaxf(mx, fmaxf(fmaxf(fabsf(x[0]), fabsf(x[1])), fmaxf(fabsf(x[2]), fabsf(x[3])))); }
#pragma unroll
    for (int o = 1; o < 64; o <<= 1) mx = fmaxf(mx, __shfl_xor(mx, o));
    const float inv = mx > 0.f ? 127.f / mx : 0.f;
#pragma unroll
    for (int i = 0; i < 2; ++i) { u32x4 w;
#pragma unroll
        for (int j = 0; j < 4; ++j) { const f32x4 x = v[i * 4 + j];
            const unsigned b0 = (unsigned)(rintf(x[0] * inv) + 128.f), b1 = (unsigned)(rintf(x[1] * inv) + 128.f), b2 = (unsigned)(rintf(x[2] * inv) + 128.f), b3 = (unsigned)(rintf(x[3] * inv) + 128.f);
            w[j] = b0 | (b1 << 8) | (b2 << 16) | (b3 << 24); }
        *(u32x4*)(dst + i * 1024 + lane * 16) = w; }
    if (lane == 0) *scale_out = mx * (1.f / 127.f);
}
__device__ __forceinline__ float ub(unsigned w, int b) { return (float)((w >> (8 * b)) & 0xffu); }
__device__ __forceinline__ float dot16q(const u32x4 w, const float* x) {
    float s = 0.f;
#pragma unroll
    for (int k = 0; k < 4; ++k) { s = fmaf(ub(w[k], 0), x[4 * k + 0], s); s = fmaf(ub(w[k], 1), x[4 * k + 1], s); s = fmaf(ub(w[k], 2), x[4 * k + 2], s); s = fmaf(ub(w[k], 3), x[4 * k + 3], s); }
    return s;
}
__device__ __forceinline__ void axpy16q(const u32x4 w, float c, float* o) {
#pragma unroll
    for (int k = 0; k < 4; ++k) { o[4 * k + 0] = fmaf(c, ub(w[k], 0), o[4 * k + 0]); o[4 * k + 1] = fmaf(c, ub(w[k], 1), o[4 * k + 1]); o[4 * k + 2] = fmaf(c, ub(w[k], 2), o[4 * k + 2]); o[4 * k + 3] = fmaf(c, ub(w[k], 3), o[4 * k + 3]); }
}
__device__ __forceinline__ void peer_expert_token(const Frame& F, const Args& a, int t) {
    const int lane_ = lane_id(), tid_ = F.wave * 64 + lane_; (void)tid_;
    const int l = lane_;
    const unsigned char* UQ = (const unsigned char*)(F.ws + WS_UB); const unsigned char* VQ = (const unsigned char*)(F.ws + WS_VBF);
    const float* US = (const float*)(F.ws + WS_USC); const float* VS = (const float*)(F.ws + WS_VSC);
    const int* EXPI = (const int*)(F.ws + WS_EXPI) + (size_t)t * 128; const float* GATEW = (const float*)(F.ws + WS_GATEW) + (size_t)t * 128;
    const float rstd2 = rsqrtf(((const float*)(F.ws + WS_CTL))[CW_RSQ2 + t] * (1.f / DM) + EPS);
    float x[32], o[32]; float sumx = 0.f, csum = 0.f;
#pragma unroll
    for (int i = 0; i < 2; ++i)
#pragma unroll
        for (int hf = 0; hf < 2; ++hf) { const u32x4 w = *(const u32x4*)((const bf16_t*)(F.ws + WS_A2) + (size_t)t * DM + i * 1024 + l * 16 + hf * 8); float* xp = x + i * 16 + hf * 8;
            xp[0] = bflo(w.x); xp[1] = bfhi(w.x); xp[2] = bflo(w.y); xp[3] = bfhi(w.y); xp[4] = bflo(w.z); xp[5] = bfhi(w.z); xp[6] = bflo(w.w); xp[7] = bfhi(w.w); }
#pragma unroll
    for (int i = 0; i < 32; ++i) { o[i] = 0.f; sumx += x[i]; }
    sumx *= 128.f;
    for (int jb = 0; jb < 32; ++jb) {
        int e[4]; float g[4];
#pragma unroll
        for (int q = 0; q < 4; ++q) { e[q] = __builtin_amdgcn_readfirstlane(EXPI[jb * 4 + q]); g[q] = __builtin_bit_cast(float, __builtin_amdgcn_readfirstlane(__builtin_bit_cast(int, GATEW[jb * 4 + q]))); }
        u32x4 uw[4][2], vw[4][2];
#pragma unroll
        for (int q = 0; q < 4; ++q) { uw[q][0] = *(const u32x4*)(UQ + (size_t)e[q] * DM + l * 16); uw[q][1] = *(const u32x4*)(UQ + (size_t)e[q] * DM + 1024 + l * 16); }
#pragma unroll
        for (int q = 0; q < 4; ++q) { vw[q][0] = *(const u32x4*)(VQ + (size_t)e[q] * DM + l * 16); vw[q][1] = *(const u32x4*)(VQ + (size_t)e[q] * DM + 1024 + l * 16); }
        float d[4];
#pragma unroll
        for (int q = 0; q < 4; ++q) d[q] = dot16q(uw[q][0], x) + dot16q(uw[q][1], x + 16) - sumx;
#pragma unroll
        for (int o_ = 1; o_ < 64; o_ <<= 1) {
#pragma unroll
            for (int q = 0; q < 4; ++q) d[q] += __shfl_xor(d[q], o_); }
#pragma unroll
        for (int q = 0; q < 4; ++q) { const float c = g[q] * gelu_tanh(d[q] * US[e[q]] * rstd2) * VS[e[q]]; csum += c; axpy16q(vw[q][0], c, o); axpy16q(vw[q][1], c, o + 16); }
    }
    float* H = a.out + (size_t)t * DM; const float* gf = a.in[22]; float ss = 0.f; csum *= 128.f;
#pragma unroll
    for (int i = 0; i < 2; ++i)
#pragma unroll
        for (int j = 0; j < 4; ++j) { const f32x4 hv = *(const f32x4*)(H + i * 1024 + l * 16 + j * 4);
#pragma unroll
            for (int k = 0; k < 4; ++k) { const float v = o[i * 16 + j * 4 + k] - csum + hv[k]; o[i * 16 + j * 4 + k] = v; ss += v * v; } }
    const float rstd = rsqrtf(wave_sum(ss) * (1.f / DM) + EPS);
#pragma unroll
    for (int i = 0; i < 2; ++i)
#pragma unroll
        for (int j = 0; j < 4; ++j) { const f32x4 gv = *(const f32x4*)(gf + i * 1024 + l * 16 + j * 4); f32x4 r;
#pragma unroll
            for (int k = 0; k < 4; ++k) r[k] = o[i * 16 + j * 4 + k] * rstd * gv[k];
            *(f32x4*)(H + i * 1024 + l * 16 + j * 4) = r; }
}

constexpr int N_PHASES = 17;
constexpr int QSPLIT = 20480;
#ifndef DUP_MASK
#define DUP_MASK 0
#endif
#define DUPN(k) (1 + ((DUP_MASK >> (k)) & 1))
__global__ void __launch_bounds__(NTHREADS, 2) hybrid_fwd(Args args) {
    extern __shared__ __attribute__((aligned(16))) unsigned char lds_raw[];
    Frame F;
    F.lds = (LAS unsigned char*)lds_raw;
    F.wave = __builtin_amdgcn_readfirstlane((int)threadIdx.x >> 6);
    F.G = gridDim.x; F.bid = blockIdx.x; F.ws = args.ws;
    unsigned* ctl = (unsigned*)(args.ws + WS_CTL);
    volatile LAS unsigned* MISCW = (volatile LAS unsigned*)(F.lds + LDSCTL_OFF);
    if (F.wave == 0) MISCW[lane_id()] = 0u;
    __syncthreads();
    XcdBarrier bar; bar.bar = ctl + CW_BAR; bar.x = 0; bar.st = nullptr;
    if (args.use_bar) bar = xcd_barrier_post(ctl + CW_BAR, MISCW + 8, F.wave == 0 && lane_id() == 0);
    const int lo = args.ph_lo, hi = args.ph_hi;
    LAS unsigned char* ring = F.lds;
    const int gw = F.bid * NWAVES + F.wave, NGW = F.G * NWAVES;
    float* rsq1 = (float*)ctl + CW_RSQ1; float* rsq2 = (float*)ctl + CW_RSQ2;
#define IN(k) (lo <= (k) && (k) < hi)
#define SEAM(k) do { if (args.use_bar && IN(k) && IN((k) + 1)) { if (args.use_bar == 2) { cg::this_grid().sync(); } else { xcd_barrier(bar, F.wave); } } } while (0)
#define ROT(r) ((F.bid + F.G - ((r) % F.G)) % F.G)

    if (IN(0)) { p0_prologue(F, args); }
    SEAM(0);
    if (IN(1)) {
        { pg8::Gemm g{(const bf16_t*)(F.ws + WS_A0), (const bf16_t*)(F.ws + WS_WIN), SEQ, NIN, DM, DM, DM}; pg8::StaticOrder S; S.init(SEQ, NIN, F.G, F.bid);
          EpiRoute E{F.ws}; pg8::gemm_phase<EpiRoute, true>(ring, g, S, E, F.wave); }
        { pg8::Gemm g{(const bf16_t*)(F.ws + WS_MEMN), (const bf16_t*)(F.ws + WS_WXK), MEM, DM, DM, DM, DM}; pg8::StaticOrder S; S.init(MEM, DM, F.G, ROT(192));
          EpiBf16 E{(bf16_t*)(F.ws + WS_XK), DM, nullptr}; pg8::gemm_phase<EpiBf16, true>(ring, g, S, E, F.wave); }
        { pg8::Gemm g{(const bf16_t*)(F.ws + WS_MEMN), (const bf16_t*)(F.ws + WS_WXV), MEM, DM, DM, DM, DM}; pg8::StaticOrder S; S.init(MEM, DM, F.G, ROT(200));
          EpiBf16 E{(bf16_t*)(F.ws + WS_XV), DM, nullptr}; pg8::gemm_phase<EpiBf16, true>(ring, g, S, E, F.wave); }
    }
    SEAM(1);
    if (IN(2)) for (int rep_ = 0; rep_ < DUPN(2); ++rep_) {
#pragma unroll 1
        for (int h = 0; h < 4; ++h) {
            pg8::Gemm g{(const bf16_t*)(F.ws + WS_XK) + h * 512, (const bf16_t*)(F.ws + WS_WXQ) + h * 512, MEM, DM, 512, DM, DM}; pg8::StaticOrder S; S.init(MEM, DM, F.G, ROT(8 * h));
            EpiBf16 E{(bf16_t*)(F.ws + WS_WQK) + (size_t)h * 256 * DM, DM, nullptr}; pg8::gemm_phase<EpiBf16, true>(ring, g, S, E, F.wave); }
#pragma unroll 1
        for (int h = 0; h < 4; ++h) {
            pg8::Gemm g{(const bf16_t*)(F.ws + WS_WXO) + h * 512, (const bf16_t*)(F.ws + WS_XV) + h * 512, DM, MEM, 512, DM, DM}; pg8::StaticOrder S; S.init(DM, MEM, F.G, ROT(32 + 8 * h));
            EpiBf16 E{(bf16_t*)(F.ws + WS_WVO) + h * 256, 1024, nullptr}; pg8::gemm_phase<EpiBf16, true>(ring, g, S, E, F.wave); }
        __syncthreads();
        for (int t = gw; t < SEQ; t += NGW) rope_token(F, args, t);
        for (int it = F.bid; it < 512; it += F.G) gla_prep_item(F, args, it);
    }
    SEAM(2);
    if (IN(3)) { for (int it = F.bid; it < SC_ITEMS; it += F.G) scores_item(F, it); }
    SEAM(3);
    if (IN(4)) for (int rep_ = 0; rep_ < DUPN(4); ++rep_) { for (int t = gw; t < SEQ; t += NGW) { select_row(F, t); sparse_attn_query(F, t); } }
    SEAM(5);
    if (IN(6)) { for (int it = F.bid; it < 512; it += F.G) gla_level1_item(F, it); }
    SEAM(6);
    if (IN(7)) for (int rep_ = 0; rep_ < DUPN(7); ++rep_) { gla_scan(F); }
    SEAM(7);
    if (IN(8)) { for (int it = F.bid; it < 512; it += F.G) gla_out_item(F, args, it); }
    SEAM(8);
    if (IN(9)) { pg8::Gemm g{(const bf16_t*)(F.ws + WS_OA), (const bf16_t*)(F.ws + WS_WPA), SEQ, DM, DM, DM, DM}; pg8::StaticOrder S; S.init(SEQ, DM, F.G, F.bid);
        EpiGate E{(bf16_t*)(F.ws + WS_T1), (const bf16_t*)(F.ws + WS_GATES), 0, nullptr}; pg8::gemm_phase<EpiGate, true>(ring, g, S, E, F.wave); }
    if (!args.use_bar) {}
    if (IN(10)) { pg8::Gemm g{(const bf16_t*)(F.ws + WS_OB), (const bf16_t*)(F.ws + WS_WPB), SEQ, DM, DM, DM, DM}; pg8::StaticOrder S; S.init(SEQ, DM, F.G, F.bid);
        EpiGate E{(bf16_t*)(F.ws + WS_MERGED), (const bf16_t*)(F.ws + WS_GATES), 2048, (const bf16_t*)(F.ws + WS_T1)}; pg8::gemm_phase<EpiGate, true>(ring, g, S, E, F.wave); }
    SEAM(10);
    if (IN(11)) { { pg8::Gemm g{(const bf16_t*)(F.ws + WS_MERGED), (const bf16_t*)(F.ws + WS_WOUT), SEQ, DM, DM, DM, DM}; pg8::StaticOrder S; S.init(SEQ, DM, F.G, F.bid);
          EpiResNorm E{args.in[0], args.out, (bf16_t*)(F.ws + WS_A1), args.in[11], rsq1}; pg8::gemm_phase<EpiResNorm, true>(ring, g, S, E, F.wave); }
        const int lane_ = lane_id();
        for (int r = QSPLIT + gw; r < 32768; r += NGW) { const int e = r & 16383;
            if (r < 16384) quant_row(args.in[20] + (size_t)e * DM, (unsigned char*)(F.ws + WS_UB) + (size_t)e * DM, (float*)(F.ws + WS_USC) + e, lane_);
            else quant_row(args.in[21] + (size_t)e * DM, (unsigned char*)(F.ws + WS_VBF) + (size_t)e * DM, (float*)(F.ws + WS_VSC) + e, lane_); }
    }
    SEAM(11);
    if (IN(12)) { { pg8::Gemm g{(const bf16_t*)(F.ws + WS_A1), (const bf16_t*)(F.ws + WS_WQK), SEQ, 1024, DM, DM, DM}; pg8::StaticOrder S; S.init(SEQ, 1024, F.G, F.bid);
        EpiSoftmax E{(bf16_t*)(F.ws + WS_XP), 1024, rsq1, 0.044194173824159216f}; pg8::gemm_phase<EpiSoftmax, false>(ring, g, S, E, F.wave); }
        if (F.bid >= 128) { const int lane_ = lane_id();
            for (int r = (F.bid - 128) * NWAVES + F.wave; r < QSPLIT; r += (F.G - 128) * NWAVES) { const int e = r & 16383;
                if (r < 16384) quant_row(args.in[20] + (size_t)e * DM, (unsigned char*)(F.ws + WS_UB) + (size_t)e * DM, (float*)(F.ws + WS_USC) + e, lane_);
                else quant_row(args.in[21] + (size_t)e * DM, (unsigned char*)(F.ws + WS_VBF) + (size_t)e * DM, (float*)(F.ws + WS_VSC) + e, lane_); } }
    }
    SEAM(12);
    if (IN(13)) { pg8::Gemm g{(const bf16_t*)(F.ws + WS_XP), (const bf16_t*)(F.ws + WS_WVO), SEQ, DM, 1024, 1024, 1024}; pg8::StaticOrder S; S.init(SEQ, DM, F.G, F.bid);
        EpiResNorm E{args.out, args.out, (bf16_t*)(F.ws + WS_A2), args.in[17], rsq2}; pg8::gemm_phase<EpiResNorm, true>(ring, g, S, E, F.wave); }
    SEAM(13);
    if (IN(14)) { pg8::Gemm g{(const bf16_t*)(F.ws + WS_A2), (const bf16_t*)(F.ws + WS_WPQ), SEQ, DM, DM, DM, DM}; pg8::StaticOrder S; S.init(SEQ, DM, F.G, F.bid);
        EpiBf16 E{(bf16_t*)(F.ws + WS_PQ), DM, rsq2}; pg8::gemm_phase<EpiBf16, true>(ring, g, S, E, F.wave); }
    SEAM(14);
    if (IN(15)) { for (int it = gw; it < SEQ / 2; it += NGW) peer_select_item(F, it); }
    SEAM(15);
    if (IN(16)) { for (int t = gw; t < SEQ; t += NGW) peer_expert_token(F, args, t); }
#undef IN
#undef SEAM
#undef ROT
}

#ifndef MK_ONE_LAUNCH
#define MK_ONE_LAUNCH 1
#endif
extern "C" void kernel_launch(void* const* d_in, const int* in_sizes, int n_in, void* d_out, int out_size, void* d_ws, size_t ws_size, hipStream_t stream) {
    static int grid = 0;
    if (grid == 0) {
        if (n_in != 23 || out_size != SEQ * DM || ws_size < WS_END) { fprintf(stderr, "kernel_launch: unexpected problem (n_in %d, out %d, ws %zu < %zu)\n", n_in, out_size, ws_size, (size_t)WS_END); grid = -1; return; }
        int dev = 0, cus = 0, per_cu = 0;
        if (hipGetDevice(&dev) != hipSuccess || hipDeviceGetAttribute(&cus, hipDeviceAttributeMultiprocessorCount, dev) != hipSuccess) { grid = -1; return; }
        if (hipFuncSetAttribute((const void*)hybrid_fwd, hipFuncAttributeMaxDynamicSharedMemorySize, LDS_BYTES) != hipSuccess) { fprintf(stderr, "kernel_launch: hipFuncSetAttribute failed\n"); grid = -1; return; }
        if (hipOccupancyMaxActiveBlocksPerMultiprocessor(&per_cu, (const void*)hybrid_fwd, NTHREADS, LDS_BYTES) != hipSuccess || per_cu < 1) { fprintf(stderr, "kernel_launch: occupancy query says %d\n", per_cu); per_cu = 1; }
        (void)hipGetLastError();
        grid = cus;
    }
    if (grid < 0) return;
    (void)hipMemsetAsync((char*)d_ws + WS_CTL, 0, CTL_ZERO_BYTES, stream);
    Args a{};
    for (int i = 0; i < 23; ++i) a.in[i] = (const float*)d_in[i];
    a.out = (float*)d_out; a.ws = (unsigned char*)d_ws;
#if MK_ONE_LAUNCH
    a.ph_lo = 0; a.ph_hi = N_PHASES; a.use_bar = 1;
    void* kargs[] = {&a};
    hipError_t e = hipLaunchCooperativeKernel((const void*)hybrid_fwd, dim3(grid), dim3(NTHREADS), kargs, LDS_BYTES, stream);
    if (e != hipSuccess) fprintf(stderr, "cooperative launch failed: %s (grid %d)\n", hipGetErrorString(e), grid);
#else
    for (int p = 0; p < N_PHASES; ++p) { a.ph_lo = p; a.ph_hi = p + 1; a.use_bar = 0;
        hipLaunchKernelGGL(hybrid_fwd, dim3(grid), dim3(NTHREADS), LDS_BYTES, stream, a); }
#endif
}
```

```cpp
#include <hip/hip_runtime.h>
#include <hip/hip_cooperative_groups.h>
#include <cstdio>
#include <cstdint>
namespace cg = cooperative_groups;

#define GAS __attribute__((address_space(1)))
#define LAS __attribute__((address_space(3)))
#ifndef TPH
#define TPH -1
#endif
typedef unsigned short bf16_t;
typedef short bf16x8 __attribute__((ext_vector_type(8)));
typedef short s16x4 __attribute__((ext_vector_type(4)));
typedef float f32x4 __attribute__((ext_vector_type(4)));
typedef float f32x2 __attribute__((ext_vector_type(2)));
typedef unsigned u32x4 __attribute__((ext_vector_type(4)));
typedef unsigned u32x2 __attribute__((ext_vector_type(2)));
#define RLX_AGENT __ATOMIC_RELAXED, __HIP_MEMORY_SCOPE_AGENT
#define LDS_WAIT() asm volatile("s_waitcnt lgkmcnt(0)" ::: "memory")
#define VM_WAIT() asm volatile("s_waitcnt vmcnt(0)" ::: "memory")

__device__ __forceinline__ int lane_id() { int l; asm volatile("v_mbcnt_lo_u32_b32 %0, -1, 0\n\tv_mbcnt_hi_u32_b32 %0, -1, %0" : "=v"(l)); return l; }
__device__ __forceinline__ unsigned f2bf(float f) { unsigned u = __builtin_bit_cast(unsigned, f); return (u + 0x7fffu + ((u >> 16) & 1u)) >> 16; }
__device__ __forceinline__ unsigned pk2(float lo, float hi) { return f2bf(lo) | (f2bf(hi) << 16); }
__device__ __forceinline__ float bf2f(unsigned short b) { return __builtin_bit_cast(float, (unsigned)b << 16); }
__device__ __forceinline__ float bflo(unsigned w) { return __builtin_bit_cast(float, w << 16); }
__device__ __forceinline__ float bfhi(unsigned w) { return __builtin_bit_cast(float, w & 0xffff0000u); }
__device__ __forceinline__ float wave_sum(float v) {
#pragma unroll
    for (int o = 1; o < 64; o <<= 1) v += __shfl_xor(v, o);
    return v;
}
__device__ __forceinline__ float sigmoidf_(float x) { return 1.f / (1.f + __expf(-x)); }

namespace pg8 {
constexpr int BM = 256, BK = 64, HALF = 128, HTB = HALF * BK * 2, STAGE_BYTES = 8 * HTB, NXCD = 8, WGM = 8;
__host__ __device__ __forceinline__ int lds_byte(int r, int c) { const int st = (r >> 4) * 2 + (c >> 5), rr = r & 15, cc = c & 31, ob = rr * 64 + cc * 2; return st * 1024 + (ob ^ (((ob >> 9) & 1) << 5)); }
__host__ __device__ __forceinline__ void stage_rc(int b, int& R, int& C) { const int st = b / 1024, sb = b % 1024, swz = sb ^ (((sb >> 9) & 1) << 5); R = (st >> 1) * 16 + swz / 64; C = (st & 1) * 32 + (swz % 64) / 2; }
__host__ __device__ __forceinline__ int perm32(int rho) { const int n = rho >> 4, i = rho & 15; return 8 * (i >> 2) + 4 * n + (i & 3); }

struct Unit { int pm, pn; };
struct Gemm { const bf16_t* A; const bf16_t* Bt; int M, N, K, lda, ldb; };

struct StaticOrder {
    int nM, nN, nwg, G, c;
    __device__ void init(int M, int N, int G_, int c_) { nM = M / BM; nN = N / BM; nwg = nM * nN; G = G_; c = c_; }
    __device__ bool next(int i, Unit& u) const {
        const long L = (long)i * G + c; if (L >= nwg) return false;
        int wgid = (int)L; { const int q = nwg / NXCD, r = nwg % NXCD, xcd = wgid % NXCD, off = wgid / NXCD; wgid = (xcd < r ? xcd * (q + 1) : r * (q + 1) + (xcd - r) * q) + off; }
        const int nig = WGM * nN, gid = wgid / nig, fm = gid * WGM, gsz = (nM - fm) < WGM ? (nM - fm) : WGM;
        u.pm = fm + ((wgid % nig) % gsz); u.pn = (wgid % nig) / gsz; return true;
    }
};

__device__ __forceinline__ unsigned cvt_pk_bf16(float lo, float hi) { unsigned r; asm volatile("v_cvt_pk_bf16_f32 %0, %1, %2" : "=v"(r) : "v"(lo), "v"(hi)); return r; }

template <class Epi, bool ALIGN_EPI>
__device__ __forceinline__ void gemm_phase(LAS unsigned char* lds, const Gemm g, const StaticOrder& S, const Epi& E, int wave_in) {
    const int lane = lane_id(), wid = wave_in, tid = wid * 64 + lane, wr = wid >> 2, wc = wid & 3, fr = lane & 15, fq = lane >> 4;
    const int K = g.K, nt = K / BK;
    unsigned voffA[2], voffB[2];
#pragma unroll
    for (int i = 0; i < 2; ++i) { int R, C; stage_rc(tid * 16 + i * 8192, R, C); const int Rb = (R & ~31) + perm32(R & 31);
        voffA[i] = (unsigned)(R * g.lda + C) * 2u; voffB[i] = (unsigned)(Rb * g.ldb + C) * 2u; }
    const size_t kstep = (size_t)(BK * 2);
    const size_t hstepA = (size_t)HALF * g.lda * 2, hstepB = (size_t)HALF * g.ldb * 2;
    const size_t tstepA = 2 * hstepA, tstepB = 2 * hstepB;
    const unsigned ldsw = (unsigned)wid * 1024u;
    const int aoff = lds_byte(wr * 64 + fr, fq * 8), boff = lds_byte(wc * 32 + fr, fq * 8);
#define PG8_SA(b, h) (((b) * 2 + (h)) * HTB)
#define PG8_SB(b, h) ((4 + (b) * 2 + (h)) * HTB)
#define PG8_STAGE(bufoff, gbase, voff) do { _Pragma("unroll") for (int _i = 0; _i < 2; ++_i) \
        __builtin_amdgcn_global_load_lds((const unsigned*)((const char*)(gbase) + (voff)[_i]), (LAS unsigned*)(lds + (bufoff) + ldsw + _i * 8192), 16, 0, 0); } while (0)
#define PG8_LDA(dst, b, h) do { _Pragma("unroll") for (int m = 0; m < 4; ++m) _Pragma("unroll") for (int k = 0; k < 2; ++k) dst[m][k] = *(const LAS bf16x8*)(lds + PG8_SA(b, h) + aoff + m * 2048 + k * 1024); } while (0)
#define PG8_LDB(dst, b, h) do { _Pragma("unroll") for (int n = 0; n < 2; ++n) _Pragma("unroll") for (int k = 0; k < 2; ++k) dst[n][k] = *(const LAS bf16x8*)(lds + PG8_SB(b, h) + boff + n * 2048 + k * 1024); } while (0)
#define PG8_MMA(ai, bj, At, Bt) do { __builtin_amdgcn_s_setprio(1); _Pragma("unroll") for (int m = 0; m < 4; ++m) _Pragma("unroll") for (int n = 0; n < 2; ++n) _Pragma("unroll") for (int k = 0; k < 2; ++k) \
        acc[ai][bj][m][n] = __builtin_amdgcn_mfma_f32_16x16x32_bf16(Bt[n][k], At[m][k], acc[ai][bj][m][n], 0, 0, 0); __builtin_amdgcn_s_setprio(0); } while (0)
#define PG8_WAIT_V(n) asm volatile("s_waitcnt vmcnt(" #n ")" ::: "memory")
#define PG8_WAIT_L(n) asm volatile("s_waitcnt lgkmcnt(" #n ")" ::: "memory")
#define PG8_BAR __builtin_amdgcn_s_barrier()
#define PG8_SCHED __builtin_amdgcn_sched_barrier(0)
    Unit cur, nxt; int ui = 0;
    if (!S.next(0, cur)) return;
    f32x4 acc[2][2][4][2];
#pragma unroll
    for (int a = 0; a < 2; ++a)
#pragma unroll
        for (int b = 0; b < 2; ++b)
#pragma unroll
            for (int m = 0; m < 4; ++m)
#pragma unroll
                for (int n = 0; n < 2; ++n) acc[a][b][m][n] = (f32x4){0.f, 0.f, 0.f, 0.f};
    bf16x8 At[4][2], B0[2][2], B1[2][2];
    const char* cA = (const char*)g.A + (size_t)cur.pm * tstepA; const char* cB = (const char*)g.Bt + (size_t)cur.pn * tstepB;
    PG8_STAGE(PG8_SB(0, 0), cB, voffB); PG8_STAGE(PG8_SB(0, 1), cB + hstepB, voffB); PG8_STAGE(PG8_SA(0, 0), cA, voffA); PG8_STAGE(PG8_SA(0, 1), cA + hstepA, voffA);
    if (wr == 1) PG8_BAR;
    PG8_WAIT_V(2); PG8_BAR;
    PG8_STAGE(PG8_SB(1, 0), cB + kstep, voffB); PG8_STAGE(PG8_SA(1, 0), cA + kstep, voffA); PG8_STAGE(PG8_SB(1, 1), cB + hstepB + kstep, voffB);
    PG8_WAIT_V(6); PG8_BAR;
    for (;;) {
        const bool has_next = S.next(ui + 1, nxt);
        const char* nA = has_next ? (const char*)g.A + (size_t)nxt.pm * tstepA : cA; const char* nB = has_next ? (const char*)g.Bt + (size_t)nxt.pn * tstepB : cB;
        for (int t = 0; t < nt; t += 2) {
            const bool last = (t == nt - 2);
            const char* a1 = cA + (size_t)(t + 1) * kstep;
            const char* a2 = last ? nA : cA + (size_t)(t + 2) * kstep; const char* b2 = last ? nB : cB + (size_t)(t + 2) * kstep;
            const char* a3 = a2 + kstep; const char* b3 = b2 + kstep;
            PG8_LDB(B0, 0, 0); PG8_LDB(B1, 0, 1); PG8_SCHED; PG8_LDA(At, 0, 0); PG8_STAGE(PG8_SA(1, 1), a1 + hstepA, voffA);
            PG8_WAIT_V(8); PG8_WAIT_L(0); PG8_BAR; PG8_MMA(0, 0, At, B0); PG8_MMA(0, 1, At, B1); PG8_BAR; PG8_SCHED;
            PG8_LDA(At, 0, 1); PG8_STAGE(PG8_SB(0, 0), b2, voffB); PG8_STAGE(PG8_SB(0, 1), b2 + hstepB, voffB); PG8_STAGE(PG8_SA(0, 0), a2, voffA);
            PG8_WAIT_V(8); PG8_WAIT_L(0); PG8_BAR; PG8_MMA(1, 0, At, B0); PG8_MMA(1, 1, At, B1); PG8_BAR; PG8_SCHED;
            PG8_LDB(B0, 1, 0); PG8_LDB(B1, 1, 1); PG8_SCHED; PG8_LDA(At, 1, 0); PG8_STAGE(PG8_SA(0, 1), a2 + hstepA, voffA);
            PG8_WAIT_V(8); PG8_WAIT_L(0); PG8_BAR; PG8_MMA(0, 0, At, B0); PG8_MMA(0, 1, At, B1); PG8_BAR; PG8_SCHED;
            PG8_LDA(At, 1, 1); PG8_STAGE(PG8_SB(1, 0), b3, voffB); PG8_STAGE(PG8_SB(1, 1), b3 + hstepB, voffB); PG8_STAGE(PG8_SA(1, 0), a3, voffA);
            PG8_WAIT_V(8); PG8_WAIT_L(0); PG8_BAR; PG8_MMA(1, 0, At, B0); PG8_MMA(1, 1, At, B1); PG8_BAR; PG8_SCHED;
        }
        if constexpr (ALIGN_EPI) { if (wr == 0) PG8_BAR; }
        if constexpr (!Epi::AFTER_DRAIN) { E(acc, cur, wr, wc, fr, fq); }
        if (!has_next) break;
#pragma unroll
        for (int a = 0; a < 2; ++a)
#pragma unroll
            for (int b = 0; b < 2; ++b)
#pragma unroll
                for (int m = 0; m < 4; ++m)
#pragma unroll
                    for (int n = 0; n < 2; ++n) acc[a][b][m][n] = (f32x4){0.f, 0.f, 0.f, 0.f};
        cur = nxt; cA = nA; cB = nB; ++ui;
        if constexpr (ALIGN_EPI) { if (wr == 1) PG8_BAR; }
    }
    PG8_WAIT_V(0);
    if constexpr (!ALIGN_EPI) { if (wr == 0) PG8_BAR; }
    PG8_BAR;
    if constexpr (Epi::AFTER_DRAIN) { E.fused(acc, cur, wr, wc, fr, fq, lds, wid, lane); }
#undef PG8_SA
#undef PG8_SB
#undef PG8_STAGE
#undef PG8_LDA
#undef PG8_LDB
#undef PG8_MMA
#undef PG8_WAIT_V
#undef PG8_WAIT_L
#undef PG8_BAR
#undef PG8_SCHED
}
}
using pg8::Unit;

constexpr int SEQ = 8192, DM = 2048, MEM = 256;
constexpr int NIN = 13824;
constexpr float EPS = 1e-6f;
constexpr size_t MiB = 1u << 20;
constexpr size_t WS_CTL = 0, CTL_ZERO_BYTES = 1 * MiB;
constexpr size_t WS_MEMN = 1 * MiB, WS_XK = 2 * MiB, WS_XV = 3 * MiB, WS_DVEC = 4 * MiB, WS_KEYS = 5 * MiB, WS_IW = 6 * MiB;
constexpr size_t WS_WPA = 8 * MiB, WS_WPB = 16 * MiB, WS_WOUT = 24 * MiB, WS_WXQ = 32 * MiB, WS_WXK = 40 * MiB, WS_WXV = 48 * MiB, WS_WXO = 56 * MiB, WS_WPQ = 64 * MiB;
constexpr size_t WS_WIN = 72 * MiB, WS_A0 = 126 * MiB;
constexpr size_t WS_QT = 72 * MiB, WS_KHT = 88 * MiB, WS_VT = 104 * MiB, WS_ATT = 136 * MiB, WS_KBR = 140 * MiB, WS_VB = 142 * MiB, WS_KIR = 144 * MiB, WS_SEL = 145 * MiB, WS_WQK = 153 * MiB, WS_WVO = 157 * MiB;
constexpr size_t WS_GR = 162 * MiB, WS_DQ = 194 * MiB, WS_GATES = 226 * MiB, WS_MISC = 290 * MiB, WS_IQ = 298 * MiB, WS_GQK = 314 * MiB, WS_GV = 346 * MiB, WS_SCORES = 378 * MiB, WS_OA = 506 * MiB;
constexpr size_t WS_ST = 378 * MiB, WS_OB = 314 * MiB, WS_T1 = 346 * MiB, WS_MERGED = 194 * MiB, WS_A1 = 162 * MiB, WS_XP = 298 * MiB, WS_A2 = 194 * MiB, WS_PQ = 226 * MiB, WS_EXPI = 258 * MiB, WS_GATEW = 262 * MiB;
constexpr size_t WS_UB = 378 * MiB, WS_VBF = 410 * MiB, WS_USC = 7 * MiB, WS_VSC = 7 * MiB + 65536, WS_END = 538 * MiB;
constexpr int CW_BAR = 4096;
constexpr int CW_RSQ1 = 65536, CW_RSQ2 = 65536 + 8192;
constexpr int MISC_LD = 512;

constexpr int RING_BYTES = 131072;
constexpr int LDSCTL_OFF = 147456 - 256;
constexpr int LDS_BYTES = 147456;
constexpr int NWAVES = 8, NTHREADS = 512;

__device__ __forceinline__ u32x4 pack8(const f32x4 v0, const f32x4 v1) { u32x4 w; w.x = pg8::cvt_pk_bf16(v0[0], v0[1]); w.y = pg8::cvt_pk_bf16(v0[2], v0[3]); w.z = pg8::cvt_pk_bf16(v1[0], v1[1]); w.w = pg8::cvt_pk_bf16(v1[2], v1[3]); return w; }

struct EpiRoute {
    static constexpr bool AFTER_DRAIN = false;
    unsigned char* ws;
    __device__ __forceinline__ void operator()(const f32x4 (&acc)[2][2][4][2], const Unit& u, int wr, int wc, int fr, int fq) const {
        const int pn = u.pn; bf16_t* base; int ldc, c0;
        if (pn < 8) { base = (bf16_t*)(ws + WS_GQK); ldc = 2048; c0 = pn * 256; }
        else if (pn < 16) { base = (bf16_t*)(ws + WS_GV); ldc = 2048; c0 = (pn - 8) * 256; }
        else if (pn < 24) { base = (bf16_t*)(ws + WS_GR); ldc = 2048; c0 = (pn - 16) * 256; }
        else if (pn < 32) { base = (bf16_t*)(ws + WS_DQ); ldc = 2048; c0 = (pn - 24) * 256; }
        else if (pn < 36) { base = (bf16_t*)(ws + WS_IQ); ldc = 1024; c0 = (pn - 32) * 256; }
        else if (pn < 52) { base = (bf16_t*)(ws + WS_GATES); ldc = 4096; c0 = (pn - 36) * 256; }
        else { base = (bf16_t*)(ws + WS_MISC); ldc = MISC_LD; c0 = (pn - 52) * 256; }
        const int row0 = u.pm * 256 + wr * 64 + fr, col0 = c0 + wc * 32 + 8 * fq;
#pragma unroll
        for (int ai = 0; ai < 2; ++ai)
#pragma unroll
            for (int m = 0; m < 4; ++m) { bf16_t* rowp = base + (size_t)(row0 + ai * 128 + m * 16) * ldc + col0;
#pragma unroll
                for (int bj = 0; bj < 2; ++bj) *(u32x4*)(rowp + bj * 128) = pack8(acc[ai][bj][m][0], acc[ai][bj][m][1]); }
    }
};
struct EpiBf16 {
    static constexpr bool AFTER_DRAIN = false;
    bf16_t* O; int ldc; const float* rowsq;
    __device__ __forceinline__ void operator()(const f32x4 (&acc)[2][2][4][2], const Unit& u, int wr, int wc, int fr, int fq) const {
        const int row0 = u.pm * 256 + wr * 64 + fr, col0 = u.pn * 256 + wc * 32 + 8 * fq;
#pragma unroll
        for (int ai = 0; ai < 2; ++ai)
#pragma unroll
            for (int m = 0; m < 4; ++m) { const int row = row0 + ai * 128 + m * 16; bf16_t* rowp = O + (size_t)row * ldc + col0;
                const float sc = rowsq ? rsqrtf(rowsq[row] * (1.f / DM) + EPS) : 1.f;
#pragma unroll
                for (int bj = 0; bj < 2; ++bj) *(u32x4*)(rowp + bj * 128) = pack8(acc[ai][bj][m][0] * sc, acc[ai][bj][m][1] * sc); }
    }
};
struct EpiGate {
    static constexpr bool AFTER_DRAIN = false;
    bf16_t* O; const bf16_t* gates; int goff; const bf16_t* prev;
    __device__ __forceinline__ void operator()(const f32x4 (&acc)[2][2][4][2], const Unit& u, int wr, int wc, int fr, int fq) const {
        const int row0 = u.pm * 256 + wr * 64 + fr, col0 = u.pn * 256 + wc * 32 + 8 * fq;
#pragma unroll
        for (int ai = 0; ai < 2; ++ai)
#pragma unroll
            for (int m = 0; m < 4; ++m) { const int row = row0 + ai * 128 + m * 16;
#pragma unroll
                for (int bj = 0; bj < 2; ++bj) { const int col = col0 + bj * 128;
                    const u32x4 gw = *(const u32x4*)(gates + (size_t)row * 4096 + goff + col);
                    f32x4 v0 = acc[ai][bj][m][0], v1 = acc[ai][bj][m][1];
                    v0[0] *= sigmoidf_(bflo(gw.x)); v0[1] *= sigmoidf_(bfhi(gw.x)); v0[2] *= sigmoidf_(bflo(gw.y)); v0[3] *= sigmoidf_(bfhi(gw.y));
                    v1[0] *= sigmoidf_(bflo(gw.z)); v1[1] *= sigmoidf_(bfhi(gw.z)); v1[2] *= sigmoidf_(bflo(gw.w)); v1[3] *= sigmoidf_(bfhi(gw.w));
                    if (prev) { const u32x4 pw = *(const u32x4*)(prev + (size_t)row * DM + col);
                        v0[0] += bflo(pw.x); v0[1] += bfhi(pw.x); v0[2] += bflo(pw.y); v0[3] += bfhi(pw.y); v1[0] += bflo(pw.z); v1[1] += bfhi(pw.z); v1[2] += bflo(pw.w); v1[3] += bfhi(pw.w); }
                    *(u32x4*)(O + (size_t)row * DM + col) = pack8(v0, v1); } }
    }
};
template <bool BASE_F32> struct EpiResNorm {
    static constexpr bool AFTER_DRAIN = false;
    const void* base; bf16_t* Hn; float* rowsq;
    __device__ __forceinline__ void operator()(const f32x4 (&acc)[2][2][4][2], const Unit& u, int wr, int wc, int fr, int fq) const {
        const int row0 = u.pm * 256 + wr * 64 + fr, col0 = u.pn * 256 + wc * 32 + 8 * fq;
#pragma unroll
        for (int ai = 0; ai < 2; ++ai)
#pragma unroll
            for (int m = 0; m < 4; ++m) { const int row = row0 + ai * 128 + m * 16; float ss = 0.f;
#pragma unroll
                for (int bj = 0; bj < 2; ++bj) { const size_t off = (size_t)row * DM + col0 + bj * 128; f32x4 h0, h1;
                    if (BASE_F32) { h0 = *(const f32x4*)((const float*)base + off); h1 = *(const f32x4*)((const float*)base + off + 4); }
                    else { const u32x4 w = *(const u32x4*)((const bf16_t*)base + off); h0 = (f32x4){bflo(w.x), bfhi(w.x), bflo(w.y), bfhi(w.y)}; h1 = (f32x4){bflo(w.z), bfhi(w.z), bflo(w.w), bfhi(w.w)}; }
                    h0 += acc[ai][bj][m][0]; h1 += acc[ai][bj][m][1];
                    ss += (h0[0] * h0[0] + h0[1] * h0[1]) + (h0[2] * h0[2] + h0[3] * h0[3]) + (h1[0] * h1[0] + h1[1] * h1[1]) + (h1[2] * h1[2] + h1[3] * h1[3]);
                    *(u32x4*)(Hn + off) = pack8(h0, h1); }
                ss += __shfl_xor(ss, 16); ss += __shfl_xor(ss, 32);
                if (fq == 0) atomicAdd(rowsq + row, ss); }
    }
};
struct EpiSoftmax {
    static constexpr bool AFTER_DRAIN = true;
    bf16_t* O; int ldc; const float* rowsq; float scale;
    __device__ __forceinline__ void fused(f32x4 (&acc)[2][2][4][2], const Unit& u, int wr, int wc, int fr, int fq, LAS unsigned char* lds, int wid, int lane) const {
        LAS f32x2* P = (LAS f32x2*)lds;
        float mxs[2][4];
#pragma unroll
        for (int ai = 0; ai < 2; ++ai)
#pragma unroll
            for (int m = 0; m < 4; ++m) { const int rl = ai * 128 + wr * 64 + m * 16 + fr; const int row = u.pm * 256 + rl;
                const float sc = rsqrtf(rowsq[row] * (1.f / DM) + EPS) * scale; float mx = -3.0e38f;
#pragma unroll
                for (int bj = 0; bj < 2; ++bj)
#pragma unroll
                    for (int n = 0; n < 2; ++n) { f32x4 x = acc[ai][bj][m][n] * sc; acc[ai][bj][m][n] = x; mx = fmaxf(mx, fmaxf(fmaxf(x[0], x[1]), fmaxf(x[2], x[3]))); }
                mx = fmaxf(mx, __shfl_xor(mx, 16)); mx = fmaxf(mx, __shfl_xor(mx, 32)); float s = 0.f;
#pragma unroll
                for (int bj = 0; bj < 2; ++bj)
#pragma unroll
                    for (int n = 0; n < 2; ++n) { f32x4 x = acc[ai][bj][m][n]; x[0] = __expf(x[0] - mx); x[1] = __expf(x[1] - mx); x[2] = __expf(x[2] - mx); x[3] = __expf(x[3] - mx); acc[ai][bj][m][n] = x; s += (x[0] + x[1]) + (x[2] + x[3]); }
                s += __shfl_xor(s, 16); s += __shfl_xor(s, 32); mxs[ai][m] = mx;
                if (fq == 0) P[rl * 4 + wc] = (f32x2){mx, s}; }
        __syncthreads();
        const int col0 = u.pn * 256 + wc * 32 + 8 * fq;
#pragma unroll
        for (int ai = 0; ai < 2; ++ai)
#pragma unroll
            for (int m = 0; m < 4; ++m) { const int rl = ai * 128 + wr * 64 + m * 16 + fr; const int row = u.pm * 256 + rl;
                const f32x2 a = P[rl * 4 + 0], b = P[rl * 4 + 1], c = P[rl * 4 + 2], d = P[rl * 4 + 3];
                const float M = fmaxf(fmaxf(a.x, b.x), fmaxf(c.x, d.x));
                const float Ssum = a.y * __expf(a.x - M) + b.y * __expf(b.x - M) + c.y * __expf(c.x - M) + d.y * __expf(d.x - M);
                const float f = __expf(mxs[ai][m] - M) / Ssum;
#pragma unroll
                for (int bj = 0; bj < 2; ++bj) *(u32x4*)(O + (size_t)row * ldc + col0 + bj * 128) = pack8(acc[ai][bj][m][0] * f, acc[ai][bj][m][1] * f); }
        __syncthreads();
    }
};

#define XB_TMO      128
#define XB_XCNT(j)  (256  + 64 * (j))
#define XB_XSUB(j)  (1280 + 64 * (j))
#define XB_XGEN(j)  (2304 + 64 * (j))
#define XB_TOP      3328
#define XB_TOPGEN   3392
#define XCD_BAR_WORDS 3456
#define XB_SPIN_CAP (1u << 20)
__device__ __forceinline__ unsigned xb_ld(unsigned* p)              { return __hip_atomic_load(p, __ATOMIC_RELAXED, __HIP_MEMORY_SCOPE_AGENT); }
__device__ __forceinline__ unsigned xb_add(unsigned* p, unsigned v) { return __hip_atomic_fetch_add(p, v, __ATOMIC_RELAXED, __HIP_MEMORY_SCOPE_AGENT); }
__device__ __forceinline__ unsigned xb_xcc_id() { return (unsigned)__builtin_amdgcn_s_getreg((3 << 11) | 20) & 0xFu; }
#define XB_SPIN(cond, bar) do { unsigned _sp = 0; while (cond) { __builtin_amdgcn_s_sleep(1); \
    if ((++_sp & 255u) == 0u) { if (xb_ld(&(bar)[XB_TMO])) break; if (_sp > XB_SPIN_CAP) { atomicAdd(&(bar)[XB_TMO], 1u); break; } } } } while (0)
struct XcdBarrier { unsigned* bar; unsigned x; volatile LAS unsigned* st; };
__device__ __forceinline__ XcdBarrier xcd_barrier_post(unsigned* bar, volatile LAS unsigned* st, bool t0) {
    XcdBarrier b; b.bar = bar; b.x = xb_xcc_id(); b.st = st;
    if (t0) (void)xb_add(&bar[XB_XCNT(b.x)], 1u);
    return b;
}
__device__ __forceinline__ void xcd_barrier_complete(unsigned* bar, unsigned x, unsigned& nloc, unsigned& nx) {
    const unsigned G = gridDim.x * gridDim.y * gridDim.z;
    unsigned sum, cnt, mine, sp = 0u;
    for (;;) {
        sum = 0u; cnt = 0u; mine = 0u;
#pragma unroll
        for (unsigned j = 0; j < 16; ++j) { const unsigned c = xb_ld(&bar[XB_XCNT(j)]); sum += c; cnt += (c > 0u) ? 1u : 0u; mine = (j == x) ? c : mine; }
        if (sum == G) break;
        __builtin_amdgcn_s_sleep(1);
        if ((++sp & 255u) == 0u) { if (xb_ld(&bar[XB_TMO])) break; if (sp > XB_SPIN_CAP) { atomicAdd(&bar[XB_TMO], 1u); break; } }
    }
    nloc = mine > 0u ? mine : 1u; nx = cnt > 0u ? cnt : 1u;
}
__device__ __forceinline__ void xcd_barrier(const XcdBarrier& b, int wave) {
    asm volatile("s_waitcnt vmcnt(0)" ::: "memory");
    __syncthreads();
    if (wave == 0 && lane_id() == 0) {
        unsigned* bar = b.bar;
        __builtin_amdgcn_s_waitcnt(0);
        unsigned nloc = b.st[0], nx = b.st[1];
        if (nloc == 0u) { xcd_barrier_complete(bar, b.x, nloc, nx); b.st[0] = nloc; b.st[1] = nx; }
        const unsigned old = xb_add(&bar[XB_XSUB(b.x)], 1u);
        const unsigned gen = old / nloc;
        if (old + 1u == (gen + 1u) * nloc) {
            __builtin_amdgcn_fence(__ATOMIC_RELEASE, "agent");
            asm volatile("s_waitcnt vmcnt(0)" ::: "memory");
            const unsigned og = xb_add(&bar[XB_TOP], 1u);
            const unsigned tg = og / nx;
            if (og + 1u == (tg + 1u) * nx) xb_add(&bar[XB_TOPGEN], 1u);
            else XB_SPIN(xb_ld(&bar[XB_TOPGEN]) == tg, bar);
            __builtin_amdgcn_fence(__ATOMIC_ACQUIRE, "agent");
            xb_add(&bar[XB_XGEN(b.x)], 1u);
            asm volatile("s_waitcnt vmcnt(0)" ::: "memory");
        } else {
            XB_SPIN(xb_ld(&bar[XB_XGEN(b.x)]) == gen, bar);
            __builtin_amdgcn_fence(__ATOMIC_ACQUIRE, "agent");
            asm volatile("s_waitcnt vmcnt(0)" ::: "memory");
        }
    }
    __syncthreads();
}

struct Args { const float* in[23]; float* out; unsigned char* ws; int ph_lo, ph_hi, use_bar, pad; };
struct Frame {
    LAS unsigned char* lds;
    int wave, G, bid;
    unsigned char* ws;
};

template <int MT, int NT>
__device__ __forceinline__ void wave_gemm_nt(const bf16_t* A, int lda, const bf16_t* B, int ldb, int K, f32x4 (&acc)[MT][NT], int fr, int fq) {
    for (int k0 = 0; k0 < K; k0 += 32) {
        bf16x8 a[MT], b[NT];
#pragma unroll
        for (int mt = 0; mt < MT; ++mt) a[mt] = *(const bf16x8*)(A + (size_t)(16 * mt + fr) * lda + k0 + 8 * fq);
#pragma unroll
        for (int nt = 0; nt < NT; ++nt) b[nt] = *(const bf16x8*)(B + (size_t)(16 * nt + fr) * ldb + k0 + 8 * fq);
#pragma unroll
        for (int mt = 0; mt < MT; ++mt)
#pragma unroll
            for (int nt = 0; nt < NT; ++nt) acc[mt][nt] = __builtin_amdgcn_mfma_f32_16x16x32_bf16(a[mt], b[nt], acc[mt][nt], 0, 0, 0);
    }
}

__device__ __forceinline__ int win_src_col(int n) {
    if (n < 6144) return n;
    if (n < 8192) return 6160 + (n - 6144);
    if (n < 9216) return 8464 + (n - 8192);
    if (n < 11264) return 9568 + (n - 9216);
    if (n < 13312) return 11616 + (n - 11264);
    const int m = n - 13312;
    if (m < 16) return 6144 + m;
    if (m < 32) return 9552 + (m - 16);
    if (m < 96) return 9488 + (m - 32);
    if (m < 128) return -1;
    if (m < 256) return 8208 + (m - 128);
    if (m < 384) return 8336 + (m - 256);
    return -1;
}
__device__ __forceinline__ void transpose_item(const float* W, int N, int K, bf16_t* WT, int drow0, int srccol, int k0, LAS float* scr, int lane, const float* kgain) {
    float v[64];
#pragma unroll
    for (int i = 0; i < 64; ++i) v[i] = srccol >= 0 ? W[(size_t)(k0 + i) * N + srccol] : 0.f;
    if (kgain) {
#pragma unroll
        for (int i = 0; i < 64; ++i) v[i] *= kgain[k0 + i]; }
#pragma unroll
    for (int i = 0; i < 64; ++i) scr[i * 65 + lane] = v[i];
    LDS_WAIT(); asm volatile("" ::: "memory");
    const int c = lane & 7;
#pragma unroll
    for (int j = 0; j < 8; ++j) { const int n = (lane >> 3) + 8 * j; const LAS float* s = scr + (8 * c) * 65 + n;
        u32x4 o; o.x = pk2(s[0 * 65], s[1 * 65]); o.y = pk2(s[2 * 65], s[3 * 65]); o.z = pk2(s[4 * 65], s[5 * 65]); o.w = pk2(s[6 * 65], s[7 * 65]);
        *(u32x4*)(WT + (size_t)(drow0 + n) * K + k0 + 8 * c) = o; }
    LDS_WAIT(); asm volatile("" ::: "memory");
}
__device__ __forceinline__ void rms_row_to_bf16(const float* xrow, const float* gain, bf16_t* orow, int lane) {
    const f32x4* xr = (const f32x4*)xrow + lane; const f32x4* gr = (const f32x4*)gain + lane;
    f32x4 v[8]; float s = 0.f;
#pragma unroll
    for (int j = 0; j < 8; ++j) { v[j] = xr[64 * j]; s += (v[j][0] * v[j][0] + v[j][1] * v[j][1]) + (v[j][2] * v[j][2] + v[j][3] * v[j][3]); }
    const float rstd = rsqrtf(wave_sum(s) * (1.f / DM) + EPS);
    u32x2* o8 = (u32x2*)orow + lane;
#pragma unroll
    for (int j = 0; j < 8; ++j) { const f32x4 g = gr[64 * j]; u32x2 w; w.x = pk2(v[j][0] * rstd * g[0], v[j][1] * rstd * g[1]); w.y = pk2(v[j][2] * rstd * g[2], v[j][3] * rstd * g[3]); o8[64 * j] = w; }
}
__device__ __forceinline__ void cvt_copy(const float* src, bf16_t* dst, size_t n, size_t gtid, size_t gthreads) {
    for (size_t i = gtid; i < n / 8; i += gthreads) { const f32x4 a = *((const f32x4*)src + 2 * i), b = *((const f32x4*)src + 2 * i + 1);
        u32x4 w; w.x = pk2(a[0], a[1]); w.y = pk2(a[2], a[3]); w.z = pk2(b[0], b[1]); w.w = pk2(b[2], b[3]); *((u32x4*)dst + i) = w; }
}
__device__ __forceinline__ void p0_prologue(const Frame& F, const Args& a) {
    const int lane_ = lane_id(), tid_ = F.wave * 64 + lane_; (void)tid_;
    LAS float* scr = (LAS float*)(F.lds + F.wave * 16896);
    const int gw = F.bid * NWAVES + F.wave, NGW = F.G * NWAVES;
    constexpr int I_IN = (NIN / 64) * (DM / 64), I_SQ = (DM / 64) * (DM / 64);
    for (int it = gw; it < I_IN + 7 * I_SQ; it += NGW) {
        if (it < I_IN) { const int nb = it / (DM / 64), kb = it % (DM / 64); const int n = nb * 64 + lane_;
            transpose_item(a.in[4], 13664, DM, (bf16_t*)(F.ws + WS_WIN), nb * 64, win_src_col(n), kb * 64, scr, lane_, nullptr); }
        else { const int r = it - I_IN, mi = r / I_SQ, q = r % I_SQ, nb = q / (DM / 64), kb = q % (DM / 64);
            const float* W; size_t off;
            switch (mi) { case 0: W = a.in[8]; off = WS_WPA; break; case 1: W = a.in[9]; off = WS_WPB; break; case 2: W = a.in[10]; off = WS_WOUT; break;
                          case 3: W = a.in[14]; off = WS_WXK; break; case 4: W = a.in[15]; off = WS_WXV; break; case 5: W = a.in[16]; off = WS_WXO; break; default: W = a.in[18]; off = WS_WPQ; break; }
            transpose_item(W, DM, DM, (bf16_t*)(F.ws + off), nb * 64, nb * 64 + lane_, kb * 64, scr, lane_, mi == 6 ? a.in[17] : nullptr); }
    }
    const size_t gtid = (size_t)F.bid * NTHREADS + tid_, gth = (size_t)F.G * NTHREADS;
    for (size_t i = gtid; i < (size_t)DM * DM / 8; i += gth) { const float g = a.in[11][i >> 8];
        const f32x4 p = *((const f32x4*)a.in[13] + 2 * i) * g, q = *((const f32x4*)a.in[13] + 2 * i + 1) * g; u32x4 w; w.x = pk2(p[0], p[1]); w.y = pk2(p[2], p[3]); w.z = pk2(q[0], q[1]); w.w = pk2(q[2], q[3]); *((u32x4*)(F.ws + WS_WXQ) + i) = w; }
    cvt_copy(a.in[19], (bf16_t*)(F.ws + WS_KEYS), (size_t)16 * 128 * 128, gtid, gth);
    for (int m = gw; m < SEQ + MEM; m += NGW) {
        if (m < SEQ) rms_row_to_bf16(a.in[0] + (size_t)m * DM, a.in[3], (bf16_t*)(F.ws + WS_A0) + (size_t)m * DM, lane_);
        else rms_row_to_bf16(a.in[1] + (size_t)(m - SEQ) * DM, a.in[12], (bf16_t*)(F.ws + WS_MEMN) + (size_t)(m - SEQ) * DM, lane_);
    }
}

__device__ __forceinline__ void sincos_red(float ang, float& s, float& c) {
    const float n = rintf(ang * 0.15915494309189535f);
    float r = fmaf(-n, 6.28318548202514648f, ang); r = fmaf(-n, -1.7484556000744883e-07f, r);
    const float f = r * 0.15915494309189535f;
    s = __builtin_amdgcn_sinf(f); c = __builtin_amdgcn_cosf(f);
}
__device__ __forceinline__ void rope_token(const Frame& F, const Args& a, int t) {
    const int lane_ = lane_id(), tid_ = F.wave * 64 + lane_; (void)tid_;
    const int l = lane_; const float pos = (float)((const int*)a.in[2])[t];
    bf16_t* DQ = (bf16_t*)(F.ws + WS_DQ) + (size_t)t * DM; bf16_t* IQ = (bf16_t*)(F.ws + WS_IQ) + (size_t)t * 1024; const bf16_t* MS = (const bf16_t*)(F.ws + WS_MISC) + (size_t)t * MISC_LD;
    float s1, c1, s2, c2;
    { const float inv = powf(10000.f, -(float)(2 * l) / 128.f); sincos_red(pos * inv, s1, c1); }
    { const float inv = powf(10000.f, -(float)(2 * (l & 31)) / 64.f); sincos_red(pos * inv, s2, c2); }
#pragma unroll 4
    for (int h = 0; h < 16; ++h) { const float x1 = bf2f(DQ[h * 128 + l]), x2 = bf2f(DQ[h * 128 + 64 + l]);
        DQ[h * 128 + l] = (bf16_t)f2bf(x1 * c1 - x2 * s1); DQ[h * 128 + 64 + l] = (bf16_t)f2bf(x2 * c1 + x1 * s1); }
    { const float x1 = bf2f(MS[128 + l]), x2 = bf2f(MS[128 + 64 + l]); bf16_t* kb = (bf16_t*)(F.ws + WS_KBR) + (size_t)t * 128;
      kb[l] = (bf16_t)f2bf(x1 * c1 - x2 * s1); kb[64 + l] = (bf16_t)f2bf(x2 * c1 + x1 * s1); }
#pragma unroll 4
    for (int p = 0; p < 8; ++p) { const int h = 2 * p + (l >> 5), i = l & 31; const float x1 = bf2f(IQ[h * 64 + i]), x2 = bf2f(IQ[h * 64 + 32 + i]);
        IQ[h * 64 + i] = (bf16_t)f2bf(x1 * c2 - x2 * s2); IQ[h * 64 + 32 + i] = (bf16_t)f2bf(x2 * c2 + x1 * s2); }
    if (l < 32) { const float x1 = bf2f(MS[32 + l]), x2 = bf2f(MS[64 + l]); bf16_t* ki = (bf16_t*)(F.ws + WS_KIR) + (size_t)t * 64;
        ki[l] = (bf16_t)f2bf(x1 * c2 - x2 * s2); ki[32 + l] = (bf16_t)f2bf(x2 * c2 + x1 * s2); }
    { bf16_t* vb = (bf16_t*)(F.ws + WS_VB) + (size_t)t * 128; vb[l] = MS[256 + l]; vb[64 + l] = MS[320 + l]; }
    if (l < 16) ((float*)(F.ws + WS_IW))[(size_t)t * 16 + l] = bf2f(MS[16 + l]) * 0.03125f;
}
constexpr int GLP = 264, GLV = 520;
__device__ __forceinline__ void gla_prep_item(const Frame& F, const Args& a, int item) {
    const int lane_ = lane_id(), tid_ = F.wave * 64 + lane_; (void)tid_;
    const int c = item >> 2, h = item & 3, t0 = c * 64, tid = tid_;
    LAS bf16_t* sQ = (LAS bf16_t*)F.lds; LAS bf16_t* sK = sQ + 64 * GLP; LAS bf16_t* sV = sK + 64 * GLP; LAS float* sG = (LAS float*)(sV + 64 * GLV);
    const bf16_t* GQK = (const bf16_t*)(F.ws + WS_GQK); const bf16_t* MS = (const bf16_t*)(F.ws + WS_MISC); const bf16_t* GV = (const bf16_t*)(F.ws + WS_GV);
    { u32x4 qv[4], kv[4], vv[8];
#pragma unroll
      for (int i = 0; i < 4; ++i) { const int ch = tid + 512 * i, row = ch >> 5, c16 = ch & 31; const bf16_t* p = GQK + (size_t)(t0 + row) * DM + h * 256 + c16 * 8; qv[i] = *(const u32x4*)p; kv[i] = *(const u32x4*)(p + 1024); }
#pragma unroll
      for (int i = 0; i < 8; ++i) { const int ch = tid + 512 * i, row = ch >> 6, c16 = ch & 63; vv[i] = *(const u32x4*)(GV + (size_t)(t0 + row) * DM + h * 512 + c16 * 8); }
      for (int i = tid; i < 64 * 16; i += NTHREADS) sG[i] = bf2f(MS[(size_t)(t0 + (i >> 4)) * MISC_LD + (i & 15)]);
#pragma unroll
      for (int i = 0; i < 4; ++i) { const int ch = tid + 512 * i, row = ch >> 5, c16 = ch & 31; *(LAS u32x4*)(sQ + row * GLP + c16 * 8) = qv[i]; *(LAS u32x4*)(sK + row * GLP + c16 * 8) = kv[i]; }
#pragma unroll
      for (int i = 0; i < 8; ++i) { const int ch = tid + 512 * i, row = ch >> 6, c16 = ch & 63; *(LAS u32x4*)(sV + row * GLV + c16 * 8) = vv[i]; } }
    __syncthreads();
    if (tid < 256) {
        const int d = tid, col = h * 256 + d;
        float w2c[16];
#pragma unroll
        for (int r = 0; r < 16; ++r) w2c[r] = a.in[5][r * 1024 + col];
        const float bias = a.in[6][col];
        bf16_t* QT = (bf16_t*)(F.ws + WS_QT);
        float b = 0.f;
#pragma unroll 4
        for (int j = 0; j < 64; ++j) {
            float z = bias;
#pragma unroll
            for (int r = 0; r < 16; ++r) z = fmaf(sG[j * 16 + r], w2c[r], z);
            const float ls = fminf(z, 0.f) - log1pf(__expf(-fabsf(z)));
            b += ls * (1.f / 16.f);
            const float q = bf2f(sQ[j * GLP + d]), k = bf2f(sK[j * GLP + d]);
            const float eb = __expf(b);
            const unsigned qb = f2bf(q * 0.0625f * eb), kb = f2bf(k / eb);
            QT[(size_t)(t0 + j) * 1024 + col] = (bf16_t)qb; sQ[j * GLP + d] = (bf16_t)qb; sK[j * GLP + d] = (bf16_t)kb;
        }
        const float eL = __expf(b);
        ((float*)(F.ws + WS_DVEC))[c * 1024 + col] = eL;
        bf16_t* KH = (bf16_t*)(F.ws + WS_KHT) + ((size_t)item * 256 + d) * 64;
#pragma unroll
        for (int j8 = 0; j8 < 8; ++j8) { u32x4 w;
            w.x = pk2(bf2f(sK[(j8 * 8 + 0) * GLP + d]) * eL, bf2f(sK[(j8 * 8 + 1) * GLP + d]) * eL); w.y = pk2(bf2f(sK[(j8 * 8 + 2) * GLP + d]) * eL, bf2f(sK[(j8 * 8 + 3) * GLP + d]) * eL);
            w.z = pk2(bf2f(sK[(j8 * 8 + 4) * GLP + d]) * eL, bf2f(sK[(j8 * 8 + 5) * GLP + d]) * eL); w.w = pk2(bf2f(sK[(j8 * 8 + 6) * GLP + d]) * eL, bf2f(sK[(j8 * 8 + 7) * GLP + d]) * eL);
            *(u32x4*)(KH + j8 * 8) = w; }
    } else {
#pragma unroll 1
        for (int i = 0; i < 2; ++i) { const int e = (tid - 256) + 256 * i; bf16_t* VT = (bf16_t*)(F.ws + WS_VT) + ((size_t)item * 512 + e) * 64;
#pragma unroll
            for (int j8 = 0; j8 < 8; ++j8) { unsigned short v[8];
#pragma unroll
                for (int j = 0; j < 8; ++j) v[j] = sV[(j8 * 8 + j) * GLV + e];
                u32x4 w; w.x = v[0] | ((unsigned)v[1] << 16); w.y = v[2] | ((unsigned)v[3] << 16); w.z = v[4] | ((unsigned)v[5] << 16); w.w = v[6] | ((unsigned)v[7] << 16);
                *(u32x4*)(VT + j8 * 8) = w; } }
    }
    __syncthreads();
    { const int fr = lane_ & 15, fq = lane_ >> 4; bf16_t* AT = (bf16_t*)(F.ws + WS_ATT) + (size_t)item * 4096;
#pragma unroll
      for (int tt = 0; tt < 2; ++tt) { const int tile = F.wave * 2 + tt, ti = tile >> 2, tj = tile & 3; f32x4 acc = (f32x4){0.f, 0.f, 0.f, 0.f};
          if (tj <= ti) {
#pragma unroll
              for (int k0 = 0; k0 < 256; k0 += 32) { const bf16x8 av = *(const LAS bf16x8*)(sQ + (16 * ti + fr) * GLP + k0 + 8 * fq), bv = *(const LAS bf16x8*)(sK + (16 * tj + fr) * GLP + k0 + 8 * fq);
                  acc = __builtin_amdgcn_mfma_f32_16x16x32_bf16(av, bv, acc, 0, 0, 0); } }
#pragma unroll
          for (int r = 0; r < 4; ++r) { const int i = 16 * ti + 4 * fq + r, j = 16 * tj + fr; AT[i * 64 + j] = (bf16_t)f2bf(j <= i ? acc[r] : 0.f); } } }
    __syncthreads();
}

__device__ __forceinline__ float relu_(float x) { const int i = __builtin_bit_cast(int, x); return __builtin_bit_cast(float, i > 0 ? i : 0); }
constexpr int SC_ITEMS = 1088;
__device__ __forceinline__ void scores_item(const Frame& F, int item) {
    const int lane_ = lane_id(), tid_ = F.wave * 64 + lane_; (void)tid_;
    int gq = 0, rem = item;
    while (rem >= 8 * (gq + 1)) { rem -= 8 * (gq + 1); ++gq; }
    const int qb = gq * 8 + rem / (gq + 1), kc = rem % (gq + 1);
    const int fr = lane_ & 15, fq = lane_ >> 4, tq0 = qb * 64 + F.wave * 8;
    const bf16_t* IQ = (const bf16_t*)(F.ws + WS_IQ); const bf16_t* KI = (const bf16_t*)(F.ws + WS_KIR); const float* IW = (const float*)(F.ws + WS_IW);
    unsigned short* SC = (unsigned short*)(F.ws + WS_SCORES);
    bf16x8 aq[2][4][2]; f32x4 wq[2][4];
#pragma unroll
    for (int G = 0; G < 2; ++G)
#pragma unroll
        for (int j = 0; j < 4; ++j) { const bf16_t* p = IQ + (size_t)(tq0 + 4 * G + (fr >> 2)) * 1024 + (4 * j + (fr & 3)) * 64 + 8 * fq; aq[G][j][0] = *(const bf16x8*)p; aq[G][j][1] = *(const bf16x8*)(p + 32);
            wq[G][j] = *(const f32x4*)(IW + (size_t)(tq0 + 4 * G + fq) * 16 + 4 * j); }
    for (int g4 = 0; g4 < 8; ++g4) {
        const int key0 = kc * 512 + g4 * 64;
        bf16x8 bk[4][2];
#pragma unroll
        for (int kt = 0; kt < 4; ++kt) { const bf16_t* kp = KI + (size_t)(key0 + 4 * fr + kt) * 64 + 8 * fq; bk[kt][0] = *(const bf16x8*)kp; bk[kt][1] = *(const bf16x8*)(kp + 32); }
#pragma unroll
        for (int G = 0; G < 2; ++G) { float sv[4];
#pragma unroll
            for (int kt = 0; kt < 4; ++kt) { float s0 = 0.f, s1 = 0.f;
#pragma unroll
                for (int j = 0; j < 4; ++j) { f32x4 acc = __builtin_amdgcn_mfma_f32_16x16x32_bf16(aq[G][j][0], bk[kt][0], (f32x4){0.f, 0.f, 0.f, 0.f}, 0, 0, 0); acc = __builtin_amdgcn_mfma_f32_16x16x32_bf16(aq[G][j][1], bk[kt][1], acc, 0, 0, 0);
                    s0 = fmaf(relu_(acc[0]), wq[G][j][0], s0); s1 = fmaf(relu_(acc[1]), wq[G][j][1], s1); s0 = fmaf(relu_(acc[2]), wq[G][j][2], s0); s1 = fmaf(relu_(acc[3]), wq[G][j][3], s1); }
                sv[kt] = s0 + s1; }
            const _Float16 h0 = (_Float16)sv[0], h1 = (_Float16)sv[1], h2 = (_Float16)sv[2], h3 = (_Float16)sv[3];
            u32x2 w; w.x = (unsigned)__builtin_bit_cast(unsigned short, h0) | ((unsigned)__builtin_bit_cast(unsigned short, h1) << 16); w.y = (unsigned)__builtin_bit_cast(unsigned short, h2) | ((unsigned)__builtin_bit_cast(unsigned short, h3) << 16);
            *(u32x2*)(SC + (size_t)(tq0 + 4 * G + fq) * SEQ + key0 + 4 * fr) = w; }
    }
}

__device__ __forceinline__ unsigned h16key(unsigned h) { return (h & 0x8000u) ? (~h & 0xffffu) : (h | 0x8000u); }
typedef unsigned short u16x2 __attribute__((ext_vector_type(2)));
__device__ __forceinline__ int wave_sum_dpp(int v) {
    v += __builtin_amdgcn_update_dpp(0, v, 0x111, 0xf, 0xf, true);
    v += __builtin_amdgcn_update_dpp(0, v, 0x112, 0xf, 0xf, true);
    v += __builtin_amdgcn_update_dpp(0, v, 0x114, 0xf, 0xf, true);
    v += __builtin_amdgcn_update_dpp(0, v, 0x118, 0xf, 0xf, true);
    v += __builtin_amdgcn_update_dpp(0, v, 0x142, 0xa, 0xf, false);
    v += __builtin_amdgcn_update_dpp(0, v, 0x143, 0xc, 0xf, false);
    return __builtin_amdgcn_readlane(v, 63);
}
constexpr int SEL_LDS_OFF = 137216;
typedef short s16x2 __attribute__((ext_vector_type(2)));
__device__ __forceinline__ int cnt_ge(const unsigned (&kk)[64], unsigned c, int nch) {
    const unsigned cm1 = (c - 1u) * 0x00010001u, one = 0x00010001u; unsigned a0 = 0u, a1 = 0u, a2 = 0u, a3 = 0u;
#pragma unroll
    for (int i = 0; i < 16; ++i) if (i < nch) { const int r = 4 * i; unsigned t0, t1, t2, t3;
        asm("v_pk_sub_u16 %0, %8, %12 clamp\n\tv_pk_sub_u16 %1, %9, %12 clamp\n\tv_pk_sub_u16 %2, %10, %12 clamp\n\tv_pk_sub_u16 %3, %11, %12 clamp\n\t"
            "v_pk_min_u16 %0, %0, %13\n\tv_pk_min_u16 %1, %1, %13\n\tv_pk_min_u16 %2, %2, %13\n\tv_pk_min_u16 %3, %3, %13\n\t"
            "v_pk_add_u16 %4, %4, %0\n\tv_pk_add_u16 %5, %5, %1\n\tv_pk_add_u16 %6, %6, %2\n\tv_pk_add_u16 %7, %7, %3"
            : "=&v"(t0), "=&v"(t1), "=&v"(t2), "=&v"(t3), "+v"(a0), "+v"(a1), "+v"(a2), "+v"(a3) : "v"(kk[r]), "v"(kk[r + 1]), "v"(kk[r + 2]), "v"(kk[r + 3]), "v"(cm1), "v"(one)); }
    const unsigned acc = a0 + a1 + a2 + a3;
    return (int)(acc & 0xffffu) + (int)(acc >> 16);
}
__device__ __forceinline__ void select_row(const Frame& F, int t) {
    const int lane_ = lane_id();
    LAS int* SEL = (LAS int*)(F.lds + SEL_LDS_OFF) + F.wave * 256; const int l = lane_;
    if (t < 256) {
#pragma unroll
        for (int i = 0; i < 4; ++i) { const int j = i * 64 + l; SEL[j] = (j <= t) ? j : 0; }
        return;
    }
    const unsigned short* SC = (const unsigned short*)(F.ws + WS_SCORES) + (size_t)t * SEQ;
    const int nch = (t >> 9) + 1;
    unsigned kk[64];
    u32x4 raw[16];
#pragma unroll
    for (int i = 0; i < 16; ++i) { const int ic = i < nch ? i : nch - 1; raw[i] = *(const u32x4*)(SC + (ic * 64 + l) * 8); }
#pragma unroll
    for (int i = 0; i < 16; ++i) {
#pragma unroll
        for (int w = 0; w < 4; ++w) { const unsigned x = raw[i][w]; const s16x2 m = __builtin_bit_cast(s16x2, x) >> (s16x2){15, 15};
            kk[i * 4 + w] = x ^ (__builtin_bit_cast(unsigned, m) | 0x80008000u); }
        if (i == nch - 1) { const int s0 = (i * 64 + l) * 8;
#pragma unroll
            for (int w = 0; w < 4; ++w) { if (s0 + 2 * w > t) kk[i * 4 + w] &= 0xffff0000u; if (s0 + 2 * w + 1 > t) kk[i * 4 + w] &= 0x0000ffffu; } } }
    unsigned T = 0u;
    for (int bit = 15; bit >= 0; --bit) { const unsigned cand = T | (1u << bit); const int cnt = wave_sum_dpp(cnt_ge(kk, cand, nch));
        if (cnt >= 256) T = cand; }
    const int nge = cnt_ge(kk, T, nch); const int ngt = (T < 0xffffu) ? cnt_ge(kk, T + 1u, nch) : 0; const int neq = nge - ngt;
    int pg = ngt, pe = neq;
#pragma unroll
    for (int o = 1; o < 64; o <<= 1) { const int a = __shfl_up(pg, o), b = __shfl_up(pe, o); if (l >= o) { pg += a; pe += b; } }
    const int totgt = __shfl(pg, 63); pg -= ngt; pe -= neq;
    const int need = 256 - totgt; int mytake = need - pe; mytake = mytake < 0 ? 0 : (mytake > neq ? neq : mytake);
    int off = pg + (pe < need ? pe : need), tk = 0;
#pragma unroll
    for (int r = 0; r < 64; ++r) if ((r >> 2) < nch) {
#pragma unroll
        for (int hf = 0; hf < 2; ++hf) { const unsigned key = hf ? (kk[r] >> 16) : (kk[r] & 0xffffu); const int s = ((r >> 2) * 64 + l) * 8 + (r & 3) * 2 + hf;
            const bool eq = (key == T); const bool take = (key > T) || (eq && tk < mytake);
            if (take && off < 256) SEL[off] = s;
            off += take ? 1 : 0; tk += eq ? 1 : 0; } }
}

constexpr int SP_PP = 264;
constexpr int SP_VP = 136;
constexpr int SP_WAVE_BYTES = 16 * SP_PP * 2 + 32 * SP_VP * 2;
__device__ __forceinline__ s16x4 tr_read4(unsigned lds_addr) { s16x4 r; asm volatile("ds_read_b64_tr_b16 %0, %1\n\ts_waitcnt lgkmcnt(0)" : "=&v"(r) : "v"(lds_addr) : "memory"); return r; }
__device__ __forceinline__ void sparse_attn_query(const Frame& F, int t) {
    const int lane_ = lane_id(), tid_ = F.wave * 64 + lane_; (void)tid_;
    const int l = lane_, fr = l & 15, fq = l >> 4;
    LAS unsigned char* wl = F.lds + F.wave * SP_WAVE_BYTES; LAS bf16_t* sP = (LAS bf16_t*)wl; LAS bf16_t* sV = (LAS bf16_t*)(wl + 16 * SP_PP * 2);
    const bf16_t* Q = (const bf16_t*)(F.ws + WS_DQ) + (size_t)t * DM; bf16_t* OB = (bf16_t*)(F.ws + WS_OB) + (size_t)t * DM; const bf16_t* KB = (const bf16_t*)(F.ws + WS_KBR); const bf16_t* VB = (const bf16_t*)(F.ws + WS_VB);
    const LAS int* SEL = (const LAS int*)(F.lds + SEL_LDS_OFF) + F.wave * 256; const int nvalid = t < 255 ? t + 1 : 256;
    LDS_WAIT();
    bf16x8 aq[4];
#pragma unroll
    for (int ks = 0; ks < 4; ++ks) aq[ks] = *(const bf16x8*)(Q + fr * 128 + ks * 32 + 8 * fq);
    f32x4 sc[16];
#pragma unroll
    for (int kt = 0; kt < 16; ++kt) { const int srow = SEL[kt * 16 + fr]; const bf16_t* kp = KB + (size_t)srow * 128 + 8 * fq; f32x4 acc = (f32x4){0.f, 0.f, 0.f, 0.f};
#pragma unroll
        for (int ks = 0; ks < 4; ++ks) acc = __builtin_amdgcn_mfma_f32_16x16x32_bf16(aq[ks], *(const bf16x8*)(kp + ks * 32), acc, 0, 0, 0);
        const bool ok = (kt * 16 + fr) < nvalid;
#pragma unroll
        for (int r = 0; r < 4; ++r) acc[r] = ok ? acc[r] * 0.08838834764831845f : -3.0e38f;
        sc[kt] = acc; }
    f32x4 mx = sc[0];
#pragma unroll
    for (int kt = 1; kt < 16; ++kt)
#pragma unroll
        for (int r = 0; r < 4; ++r) mx[r] = fmaxf(mx[r], sc[kt][r]);
#pragma unroll
    for (int o = 1; o < 16; o <<= 1)
#pragma unroll
        for (int r = 0; r < 4; ++r) mx[r] = fmaxf(mx[r], __shfl_xor(mx[r], o));
    f32x4 sm = (f32x4){0.f, 0.f, 0.f, 0.f};
#pragma unroll
    for (int kt = 0; kt < 16; ++kt)
#pragma unroll
        for (int r = 0; r < 4; ++r) { const float e = __expf(sc[kt][r] - mx[r]); sc[kt][r] = e; sm[r] += e; }
#pragma unroll
    for (int o = 1; o < 16; o <<= 1)
#pragma unroll
        for (int r = 0; r < 4; ++r) sm[r] += __shfl_xor(sm[r], o);
#pragma unroll
    for (int r = 0; r < 4; ++r) sm[r] = 1.f / sm[r];
#pragma unroll
    for (int kt = 0; kt < 16; ++kt)
#pragma unroll
        for (int r = 0; r < 4; ++r) sP[(4 * fq + r) * SP_PP + kt * 16 + fr] = (bf16_t)f2bf(sc[kt][r] * sm[r]);
    LDS_WAIT();
    f32x4 o[8];
#pragma unroll
    for (int nt = 0; nt < 8; ++nt) o[nt] = (f32x4){0.f, 0.f, 0.f, 0.f};
    const unsigned vbase = (unsigned)(size_t)sV;
    for (int kst = 0; kst < 8; ++kst) {
#pragma unroll
        for (int i = 0; i < 8; ++i) { const int p = i * 64 + l, row = p >> 4, ch = p & 15; const int srow = SEL[kst * 32 + row];
            *(LAS u32x4*)(sV + row * SP_VP + ch * 8) = *(const u32x4*)(VB + (size_t)srow * 128 + ch * 8); }
        const bf16x8 pa = *(const LAS bf16x8*)(sP + fr * SP_PP + kst * 32 + 8 * fq);
        LDS_WAIT(); __builtin_amdgcn_sched_barrier(0);
#pragma unroll
        for (int nt = 0; nt < 8; ++nt) { const unsigned a0 = vbase + (unsigned)(((8 * fq + (fr >> 2)) * SP_VP + 16 * nt + 4 * (fr & 3)) * 2);
            const s16x4 lo = tr_read4(a0), hi = tr_read4(a0 + 4 * SP_VP * 2);
            bf16x8 bv; bv[0] = lo[0]; bv[1] = lo[1]; bv[2] = lo[2]; bv[3] = lo[3]; bv[4] = hi[0]; bv[5] = hi[1]; bv[6] = hi[2]; bv[7] = hi[3];
            __builtin_amdgcn_sched_barrier(0);
            o[nt] = __builtin_amdgcn_mfma_f32_16x16x32_bf16(pa, bv, o[nt], 0, 0, 0); }
        __builtin_amdgcn_sched_barrier(0);
    }
#pragma unroll
    for (int nt = 0; nt < 8; ++nt)
#pragma unroll
        for (int r = 0; r < 4; ++r) OB[(4 * fq + r) * 128 + 16 * nt + fr] = (bf16_t)f2bf(o[nt][r]);
}

__device__ __forceinline__ void gla_level1_item(const Frame& F, int item) {
    const int lane_ = lane_id(), tid_ = F.wave * 64 + lane_; (void)tid_;
    const int fr = lane_ & 15, fq = lane_ >> 4;
    const bf16_t* KH = (const bf16_t*)(F.ws + WS_KHT) + (size_t)item * 256 * 64; const bf16_t* VT = (const bf16_t*)(F.ws + WS_VT) + ((size_t)item * 512 + F.wave * 64) * 64;
    bf16_t* ST = (bf16_t*)(F.ws + WS_ST) + ((size_t)item * 512 + F.wave * 64) * 256;
    for (int db = 0; db < 4; ++db) {
        f32x4 acc[4][4];
#pragma unroll
        for (int i = 0; i < 4; ++i)
#pragma unroll
            for (int j = 0; j < 4; ++j) acc[i][j] = (f32x4){0.f, 0.f, 0.f, 0.f};
        wave_gemm_nt<4, 4>(KH + (size_t)db * 64 * 64, 64, VT, 64, 64, acc, fr, fq);
#pragma unroll
        for (int mt = 0; mt < 4; ++mt)
#pragma unroll
            for (int nt = 0; nt < 4; ++nt) { u32x2 w; w.x = pk2(acc[mt][nt][0], acc[mt][nt][1]); w.y = pk2(acc[mt][nt][2], acc[mt][nt][3]);
                *(u32x2*)(ST + (size_t)(16 * nt + fr) * 256 + db * 64 + 16 * mt + 4 * fq) = w; }
    }
}
__device__ __forceinline__ void gla_state_item(const Frame& F, int item) {
    const int lane_ = lane_id(), fr = lane_ & 15, fq = lane_ >> 4;
    const int h = item >> 6, eb = (item >> 1) & 31, d0 = (item & 1) * 128 + F.wave * 16;
    const bf16_t* KH = (const bf16_t*)(F.ws + WS_KHT) + ((size_t)h * 256 + d0 + fr) * 64 + 8 * fq;
    const bf16_t* VT = (const bf16_t*)(F.ws + WS_VT) + ((size_t)h * 512 + eb * 16 + fr) * 64 + 8 * fq;
    bf16_t* ST = (bf16_t*)(F.ws + WS_ST) + ((size_t)h * 512 + eb * 16 + fr) * 256 + d0 + 4 * fq;
    const float* DV = (const float*)(F.ws + WS_DVEC) + h * 256 + d0 + 4 * fq;
    f32x4 S = (f32x4){0.f, 0.f, 0.f, 0.f};
#define GST_LOAD(a, b, dv, cbase) do { _Pragma("unroll") for (int i = 0; i < 4; ++i) { const size_t c = (cbase) + i; const bf16_t* kp = KH + c * (4 * 256 * 64); const bf16_t* vp = VT + c * (4 * 512 * 64); \
        a[i][0] = *(const bf16x8*)kp; a[i][1] = *(const bf16x8*)(kp + 32); b[i][0] = *(const bf16x8*)vp; b[i][1] = *(const bf16x8*)(vp + 32); dv[i] = *(const f32x4*)(DV + c * 1024); } } while (0)
#define GST_STEP(a, b, dv, cbase) do { _Pragma("unroll") for (int i = 0; i < 4; ++i) { const size_t c = (cbase) + i; \
        f32x4 L = __builtin_amdgcn_mfma_f32_16x16x32_bf16(a[i][0], b[i][0], (f32x4){0.f, 0.f, 0.f, 0.f}, 0, 0, 0); L = __builtin_amdgcn_mfma_f32_16x16x32_bf16(a[i][1], b[i][1], L, 0, 0, 0); \
        u32x2 w; w.x = pk2(S[0], S[1]); w.y = pk2(S[2], S[3]); *(u32x2*)(ST + c * (4 * 512 * 256)) = w; S = dv[i] * S + L; } } while (0)
    bf16x8 a0[4][2], b0[4][2], a1[4][2], b1[4][2]; f32x4 dv0[4], dv1[4];
    GST_LOAD(a0, b0, dv0, 0);
    for (int c0 = 0; c0 < 128; c0 += 8) {
        GST_LOAD(a1, b1, dv1, c0 + 4);
        GST_STEP(a0, b0, dv0, c0);
        if (c0 + 8 < 128) GST_LOAD(a0, b0, dv0, c0 + 8);
        GST_STEP(a1, b1, dv1, c0 + 4);
    }
#undef GST_LOAD
#undef GST_STEP
}
__device__ __forceinline__ void gla_out_item(const Frame& F, const Args& a, int item) {
    const int lane_ = lane_id(), tid_ = F.wave * 64 + lane_; (void)tid_;
    const int c = item >> 2, h = item & 3, t0 = c * 64, fr = lane_ & 15, fq = lane_ >> 4, w = F.wave;
    LAS float* sred = (LAS float*)F.lds;
    f32x4 acc[4][4];
#pragma unroll
    for (int i = 0; i < 4; ++i)
#pragma unroll
        for (int j = 0; j < 4; ++j) acc[i][j] = (f32x4){0.f, 0.f, 0.f, 0.f};
    wave_gemm_nt<4, 4>((const bf16_t*)(F.ws + WS_ST) + ((size_t)item * 512 + w * 64) * 256, 256, (const bf16_t*)(F.ws + WS_QT) + (size_t)t0 * 1024 + h * 256, 1024, 256, acc, fr, fq);
    wave_gemm_nt<4, 4>((const bf16_t*)(F.ws + WS_VT) + ((size_t)item * 512 + w * 64) * 64, 64, (const bf16_t*)(F.ws + WS_ATT) + (size_t)item * 4096, 64, 64, acc, fr, fq);
    float ss[4];
#pragma unroll
    for (int nt = 0; nt < 4; ++nt) { float s = 0.f;
#pragma unroll
        for (int mt = 0; mt < 4; ++mt) s += (acc[mt][nt][0] * acc[mt][nt][0] + acc[mt][nt][1] * acc[mt][nt][1]) + (acc[mt][nt][2] * acc[mt][nt][2] + acc[mt][nt][3] * acc[mt][nt][3]);
        s += __shfl_xor(s, 16); s += __shfl_xor(s, 32); ss[nt] = s;
        if (fq == 0) sred[w * 64 + 16 * nt + fr] = s; }
    __syncthreads();
    const bf16_t* GR = (const bf16_t*)(F.ws + WS_GR); bf16_t* OA = (bf16_t*)(F.ws + WS_OA); const float* gain = a.in[7] + h * 512;
#pragma unroll
    for (int nt = 0; nt < 4; ++nt) { const int tok = 16 * nt + fr; float tot = 0.f;
#pragma unroll
        for (int ww = 0; ww < 8; ++ww) tot += sred[ww * 64 + tok];
        const float rstd = rsqrtf(tot * (1.f / 512.f) + EPS);
#pragma unroll
        for (int mt = 0; mt < 4; ++mt) { const int e = w * 64 + 16 * mt + 4 * fq; const size_t off = (size_t)(t0 + tok) * DM + h * 512 + e;
            const u32x2 g = *(const u32x2*)(GR + off); const f32x4 gn = *(const f32x4*)(gain + e);
            const float r0 = bflo(g.x), r1 = bfhi(g.x), r2 = bflo(g.y), r3 = bfhi(g.y);
            u32x2 o; o.x = pk2(acc[mt][nt][0] * rstd * gn[0] * r0 * sigmoidf_(r0), acc[mt][nt][1] * rstd * gn[1] * r1 * sigmoidf_(r1));
            o.y = pk2(acc[mt][nt][2] * rstd * gn[2] * r2 * sigmoidf_(r2), acc[mt][nt][3] * rstd * gn[3] * r3 * sigmoidf_(r3));
            *(u32x2*)(OA + off) = o; } }
    __syncthreads();
}

__device__ const unsigned char PEER_CAND[52] = {
    0x00,0x01,0x02,0x03,0x04,0x05,0x06,0x07,0x08,0x09,0x0a,0x0b,0x0c,0x0d,0x0e,0x0f, 0x10,0x11,0x12,0x13,0x14,0x15,0x16,0x17, 0x20,0x21,0x22,0x23,0x24, 0x30,0x31,0x32,0x33,
    0x40,0x41,0x42, 0x50,0x51, 0x60,0x61, 0x70,0x71, 0x80,0x90,0xa0,0xb0,0xc0,0xd0,0xe0,0xf0, 0xff,0xff };
__device__ __forceinline__ unsigned f32ord(float f) { const unsigned u = __builtin_bit_cast(unsigned, f); return (u & 0x80000000u) ? ~u : (u | 0x80000000u); }
__device__ __forceinline__ float ordf32(unsigned k) { const unsigned u = (k & 0x80000000u) ? (k & 0x7fffffffu) : ~k; return __builtin_bit_cast(float, u); }
__device__ __forceinline__ unsigned umax_x32(unsigned v) { const unsigned o = __shfl_xor(v, 32); return v > o ? v : o; }
__device__ __forceinline__ float fmax_x32(float v) { return fmaxf(v, __shfl_xor(v, 32)); }
__device__ __forceinline__ float fadd_x32(float v) { return v + __shfl_xor(v, 32); }
__device__ __forceinline__ void peer_select_item(const Frame& F, int item) {
    const int lane_ = lane_id(), tid_ = F.wave * 64 + lane_; (void)tid_;
    const int l = lane_, fr = l & 15, fq = l >> 4, t0 = (item >> 3) * 16, h = item & 7;
    LAS unsigned* tv = (LAS unsigned*)(F.lds + F.wave * 2048);
    const bf16_t* PQ = (const bf16_t*)(F.ws + WS_PQ); const bf16_t* KEYS = (const bf16_t*)(F.ws + WS_KEYS);
    int* EXPI = (int*)(F.ws + WS_EXPI); float* GATEW = (float*)(F.ws + WS_GATEW);
    {
#pragma unroll 1
        for (int p = 0; p < 2; ++p) { const int g = h * 2 + p;
            f32x4 acc[8];
#pragma unroll
            for (int mt = 0; mt < 8; ++mt) acc[mt] = (f32x4){0.f, 0.f, 0.f, 0.f};
#pragma unroll
            for (int ks = 0; ks < 4; ++ks) { const bf16x8 bq = *(const bf16x8*)(PQ + (size_t)(t0 + fr) * DM + g * 128 + ks * 32 + 8 * fq);
#pragma unroll
                for (int mt = 0; mt < 8; ++mt) acc[mt] = __builtin_amdgcn_mfma_f32_16x16x32_bf16(*(const bf16x8*)(KEYS + ((size_t)g * 128 + 16 * mt + fr) * 128 + ks * 32 + 8 * fq), bq, acc[mt], 0, 0, 0); }
            unsigned kk[32];
#pragma unroll
            for (int mt = 0; mt < 8; ++mt)
#pragma unroll
                for (int r = 0; r < 4; ++r) kk[mt * 4 + r] = (f32ord(acc[mt][r]) & ~127u) | (unsigned)(127 - (16 * mt + 4 * fq + r));
#pragma unroll
            for (int i = 0; i < 16; ++i) { unsigned m = kk[0];
#pragma unroll
                for (int j = 1; j < 32; ++j) m = m > kk[j] ? m : kk[j];
                { const unsigned o = __shfl_xor(m, 16); m = m > o ? m : o; } m = umax_x32(m);
#pragma unroll
                for (int j = 0; j < 32; ++j) kk[j] = (kk[j] == m) ? 0u : kk[j];
                if (fq == (i & 3)) tv[(fr * 2 + p) * 16 + i] = m; }
        }
        LDS_WAIT();
        unsigned ck[13];
#pragma unroll
        for (int ci = 0; ci < 13; ++ci) { const int cidx = fq + 4 * ci; const unsigned ab = PEER_CAND[cidx];
            if (cidx < 50) { const float v = ordf32(tv[(fr * 2 + 0) * 16 + (ab >> 4)] & ~127u) + ordf32(tv[(fr * 2 + 1) * 16 + (ab & 15)] & ~127u); ck[ci] = (f32ord(v) & ~63u) | (unsigned)(63 - cidx); }
            else ck[ci] = 0u; }
        float scv[4]; int exv[4];
#pragma unroll
        for (int i = 0; i < 16; ++i) { unsigned m = ck[0];
#pragma unroll
            for (int j = 1; j < 13; ++j) m = m > ck[j] ? m : ck[j];
            { const unsigned o = __shfl_xor(m, 16); m = m > o ? m : o; } m = umax_x32(m);
#pragma unroll
            for (int j = 0; j < 13; ++j) ck[j] = (ck[j] == m) ? 0u : ck[j];
            if (fq == (i & 3)) { const int cidx = 63 - (int)(m & 63u); const unsigned ab = PEER_CAND[cidx];
                const int n1 = 127 - (int)(tv[(fr * 2 + 0) * 16 + (ab >> 4)] & 127u), n2 = 127 - (int)(tv[(fr * 2 + 1) * 16 + (ab & 15)] & 127u);
                exv[i >> 2] = n1 * 128 + n2; scv[i >> 2] = ordf32(m & ~63u); } }
        float mx = fmaxf(fmaxf(scv[0], scv[1]), fmaxf(scv[2], scv[3])); mx = fmaxf(mx, __shfl_xor(mx, 16)); mx = fmax_x32(mx);
        float ev[4], s = 0.f;
#pragma unroll
        for (int j = 0; j < 4; ++j) { ev[j] = __expf(scv[j] - mx); s += ev[j]; }
        s += __shfl_xor(s, 16); s = fadd_x32(s); const float inv = 1.f / s;
#pragma unroll
        for (int j = 0; j < 4; ++j) { const size_t o = (size_t)(t0 + fr) * 128 + h * 16 + j * 4 + fq; EXPI[o] = exv[j]; GATEW[o] = ev[j] * inv; }
        LDS_WAIT();
    }
}
__device__ __forceinline__ float gelu_tanh(float x) { const float u = 0.7978845608028654f * (x + 0.044715f * x * x * x); const float e = __expf(2.f * u); const float th = 1.f - 2.f / (e + 1.f); return 0.5f * x * (1.f + th); }
__device__ __forceinline__ void quant_row(const float* src, unsigned char* dst, float* scale_out, int lane, const float* cgain) {
    f32x4 v[8]; float mx = 0.f;
#pragma unroll
    for (int i = 0; i < 2; ++i)
#pragma unroll
        for (int j = 0; j < 4; ++j) { f32x4 x = *(const f32x4*)(src + i * 1024 + lane * 16 + j * 4); if (cgain) x *= *(const f32x4*)(cgain + i * 1024 + lane * 16 + j * 4); v[i * 4 + j] = x; mx = fmaxf(mx, fmaxf(fmaxf(fabsf(x[0]), fabsf(x[1])), fmaxf(fabsf(x[2]), fabsf(x[3])))); }
#pragma unroll
    for (int o = 1; o < 64; o <<= 1) mx = fmaxf(mx, __shfl_xor(mx, o));
    const float inv = mx > 0.f ? 127.f / mx : 0.f;
#pragma unroll
    for (int i = 0; i < 2; ++i) { u32x4 w;
#pragma unroll
        for (int j = 0; j < 4; ++j) { const f32x4 x = v[i * 4 + j];
            const unsigned b0 = (unsigned)(rintf(x[0] * inv) + 128.f), b1 = (unsigned)(rintf(x[1] * inv) + 128.f), b2 = (unsigned)(rintf(x[2] * inv) + 128.f), b3 = (unsigned)(rintf(x[3] * inv) + 128.f);
            w[j] = b0 | (b1 << 8) | (b2 << 16) | (b3 << 24); }
        *(u32x4*)(dst + i * 1024 + lane * 16) = w; }
    if (lane == 0) *scale_out = mx * (1.f / 127.f);
}
__device__ __forceinline__ float ub(unsigned w, int b) { return (float)((w >> (8 * b)) & 0xffu); }
__device__ __forceinline__ float dot16q(const u32x4 w, const float* x) {
    float s = 0.f;
#pragma unroll
    for (int k = 0; k < 4; ++k) { s = fmaf(ub(w[k], 0), x[4 * k + 0], s); s = fmaf(ub(w[k], 1), x[4 * k + 1], s); s = fmaf(ub(w[k], 2), x[4 * k + 2], s); s = fmaf(ub(w[k], 3), x[4 * k + 3], s); }
    return s;
}
__device__ __forceinline__ void axpy16q(const u32x4 w, float c, float* o) {
#pragma unroll
    for (int k = 0; k < 4; ++k) { o[4 * k + 0] = fmaf(c, ub(w[k], 0), o[4 * k + 0]); o[4 * k + 1] = fmaf(c, ub(w[k], 1), o[4 * k + 1]); o[4 * k + 2] = fmaf(c, ub(w[k], 2), o[4 * k + 2]); o[4 * k + 3] = fmaf(c, ub(w[k], 3), o[4 * k + 3]); }
}
__device__ __forceinline__ void peer_expert_token(const Frame& F, const Args& a, int t) {
    const int lane_ = lane_id(), tid_ = F.wave * 64 + lane_; (void)tid_;
    const int l = lane_;
    const unsigned char* UQ = (const unsigned char*)(F.ws + WS_UB); const unsigned char* VQ = UQ + 2048;
    const float* US = (const float*)(F.ws + WS_USC); const float* VS = (const float*)(F.ws + WS_VSC);
    const int* EXPI = (const int*)(F.ws + WS_EXPI) + (size_t)t * 128; const float* GATEW = (const float*)(F.ws + WS_GATEW) + (size_t)t * 128;
    const float rstd2 = rsqrtf(((const float*)(F.ws + WS_CTL))[CW_RSQ2 + t] * (1.f / DM) + EPS);
    float x[32], o[32]; float sumx = 0.f, csum = 0.f;
#pragma unroll
    for (int i = 0; i < 2; ++i)
#pragma unroll
        for (int hf = 0; hf < 2; ++hf) { const u32x4 w = *(const u32x4*)((const bf16_t*)(F.ws + WS_A2) + (size_t)t * DM + i * 1024 + l * 16 + hf * 8); float* xp = x + i * 16 + hf * 8;
            xp[0] = bflo(w.x); xp[1] = bfhi(w.x); xp[2] = bflo(w.y); xp[3] = bfhi(w.y); xp[4] = bflo(w.z); xp[5] = bfhi(w.z); xp[6] = bflo(w.w); xp[7] = bfhi(w.w); }
#pragma unroll
    for (int i = 0; i < 32; ++i) { o[i] = 0.f; sumx += x[i]; }
    sumx *= 128.f;
    for (int jb = 0; jb < 32; ++jb) {
        int e[4]; float g[4];
#pragma unroll
        for (int q = 0; q < 4; ++q) { e[q] = __builtin_amdgcn_readfirstlane(EXPI[jb * 4 + q]); g[q] = __builtin_bit_cast(float, __builtin_amdgcn_readfirstlane(__builtin_bit_cast(int, GATEW[jb * 4 + q]))); }
        u32x4 uw[4][2], vw[4][2];
#pragma unroll
        for (int q = 0; q < 4; ++q) { uw[q][0] = *(const u32x4*)(UQ + (size_t)e[q] * 4096 + l * 16); uw[q][1] = *(const u32x4*)(UQ + (size_t)e[q] * 4096 + 1024 + l * 16); }
#pragma unroll
        for (int q = 0; q < 4; ++q) { vw[q][0] = *(const u32x4*)(VQ + (size_t)e[q] * 4096 + l * 16); vw[q][1] = *(const u32x4*)(VQ + (size_t)e[q] * 4096 + 1024 + l * 16); }
        float d[4];
#pragma unroll
        for (int q = 0; q < 4; ++q) d[q] = dot16q(uw[q][0], x) + dot16q(uw[q][1], x + 16) - sumx;
#pragma unroll
        for (int o_ = 1; o_ < 64; o_ <<= 1) {
#pragma unroll
            for (int q = 0; q < 4; ++q) d[q] += __shfl_xor(d[q], o_); }
#pragma unroll
        for (int q = 0; q < 4; ++q) { const float c = g[q] * gelu_tanh(d[q] * US[e[q]] * rstd2) * VS[e[q]]; csum += c; axpy16q(vw[q][0], c, o); axpy16q(vw[q][1], c, o + 16); }
    }
    float* H = a.out + (size_t)t * DM; const float* gf = a.in[22]; float ss = 0.f; csum *= 128.f;
#pragma unroll
    for (int i = 0; i < 32; ++i) { const float v = o[i] - csum + x[i]; o[i] = v; ss += v * v; }
    const float rstd = rsqrtf(wave_sum(ss) * (1.f / DM) + EPS);
#pragma unroll
    for (int i = 0; i < 2; ++i)
#pragma unroll
        for (int j = 0; j < 4; ++j) { const f32x4 gv = *(const f32x4*)(gf + i * 1024 + l * 16 + j * 4); f32x4 r;
#pragma unroll
            for (int k = 0; k < 4; ++k) r[k] = o[i * 16 + j * 4 + k] * rstd * gv[k];
            *(f32x4*)(H + i * 1024 + l * 16 + j * 4) = r; }
}

constexpr int N_PHASES = 17;
constexpr int QSPLIT = 20480;
#ifndef DUP_MASK
#define DUP_MASK 0
#endif
#define DUPN(k) (1 + ((DUP_MASK >> (k)) & 1))
__global__ void __launch_bounds__(NTHREADS, 2) hybrid_fwd(Args args) {
    extern __shared__ __attribute__((aligned(16))) unsigned char lds_raw[];
    Frame F;
    F.lds = (LAS unsigned char*)lds_raw;
    F.wave = __builtin_amdgcn_readfirstlane((int)threadIdx.x >> 6);
    F.G = gridDim.x; F.bid = blockIdx.x; F.ws = args.ws;
    unsigned* ctl = (unsigned*)(args.ws + WS_CTL);
    volatile LAS unsigned* MISCW = (volatile LAS unsigned*)(F.lds + LDSCTL_OFF);
    if (F.wave == 0) MISCW[lane_id()] = 0u;
    __syncthreads();
    XcdBarrier bar; bar.bar = ctl + CW_BAR; bar.x = 0; bar.st = nullptr;
    if (args.use_bar) bar = xcd_barrier_post(ctl + CW_BAR, MISCW + 8, F.wave == 0 && lane_id() == 0);
    const int lo = args.ph_lo, hi = args.ph_hi;
    LAS unsigned char* ring = F.lds;
    const int gw = F.bid * NWAVES + F.wave, NGW = F.G * NWAVES;
    float* rsq1 = (float*)ctl + CW_RSQ1; float* rsq2 = (float*)ctl + CW_RSQ2;
#define IN(k) (lo <= (k) && (k) < hi)
    unsigned long long tph0_ = 0ull;
#define TBEG(k) do { if (TPH == (k)) { __syncthreads(); tph0_ = __builtin_amdgcn_s_memrealtime(); } } while (0)
#define TEND(k) do { if (TPH == (k)) { __syncthreads(); const unsigned long long t1_ = __builtin_amdgcn_s_memrealtime(), d_ = t1_ - tph0_; while (__builtin_amdgcn_s_memrealtime() - t1_ < d_) __builtin_amdgcn_s_sleep(8); __syncthreads(); } } while (0)
#define SEAM(k) do { if (args.use_bar && IN(k) && IN((k) + 1)) { if (args.use_bar == 2) { cg::this_grid().sync(); } else { xcd_barrier(bar, F.wave); } } } while (0)
#define ROT(r) ((F.bid + F.G - ((r) % F.G)) % F.G)

    TBEG(0);
    if (IN(0)) { p0_prologue(F, args); }
    SEAM(0); TEND(0);
    TBEG(1);
    if (IN(1)) {
        { pg8::Gemm g{(const bf16_t*)(F.ws + WS_A0), (const bf16_t*)(F.ws + WS_WIN), SEQ, NIN, DM, DM, DM}; pg8::StaticOrder S; S.init(SEQ, NIN, F.G, F.bid);
          EpiRoute E{F.ws}; pg8::gemm_phase<EpiRoute, true>(ring, g, S, E, F.wave); }
        { pg8::Gemm g{(const bf16_t*)(F.ws + WS_MEMN), (const bf16_t*)(F.ws + WS_WXK), MEM, DM, DM, DM, DM}; pg8::StaticOrder S; S.init(MEM, DM, F.G, ROT(192));
          EpiBf16 E{(bf16_t*)(F.ws + WS_XK), DM, nullptr}; pg8::gemm_phase<EpiBf16, true>(ring, g, S, E, F.wave); }
        { pg8::Gemm g{(const bf16_t*)(F.ws + WS_MEMN), (const bf16_t*)(F.ws + WS_WXV), MEM, DM, DM, DM, DM}; pg8::StaticOrder S; S.init(MEM, DM, F.G, ROT(200));
          EpiBf16 E{(bf16_t*)(F.ws + WS_XV), DM, nullptr}; pg8::gemm_phase<EpiBf16, true>(ring, g, S, E, F.wave); }
    }
    SEAM(1); TEND(1);
    TBEG(2);
    if (IN(2)) for (int rep_ = 0; rep_ < DUPN(2); ++rep_) {
#pragma unroll 1
        for (int h = 0; h < 4; ++h) {
            pg8::Gemm g{(const bf16_t*)(F.ws + WS_XK) + h * 512, (const bf16_t*)(F.ws + WS_WXQ) + h * 512, MEM, DM, 512, DM, DM}; pg8::StaticOrder S; S.init(MEM, DM, F.G, ROT(8 * h));
            EpiBf16 E{(bf16_t*)(F.ws + WS_WQK) + (size_t)h * 256 * DM, DM, nullptr}; pg8::gemm_phase<EpiBf16, true>(ring, g, S, E, F.wave); }
#pragma unroll 1
        for (int h = 0; h < 4; ++h) {
            pg8::Gemm g{(const bf16_t*)(F.ws + WS_WXO) + h * 512, (const bf16_t*)(F.ws + WS_XV) + h * 512, DM, MEM, 512, DM, DM}; pg8::StaticOrder S; S.init(DM, MEM, F.G, ROT(32 + 8 * h));
            EpiBf16 E{(bf16_t*)(F.ws + WS_WVO) + h * 256, 1024, nullptr}; pg8::gemm_phase<EpiBf16, true>(ring, g, S, E, F.wave); }
        __syncthreads();
        for (int t = gw; t < SEQ; t += NGW) rope_token(F, args, t);
        for (int it = F.bid; it < 512; it += F.G) gla_prep_item(F, args, it);
    }
    SEAM(2); TEND(2);
    TBEG(3);
    if (IN(3)) { for (int it = F.bid; it < SC_ITEMS; it += F.G) scores_item(F, it); }
    SEAM(3); TEND(3);
    TBEG(4);
    if (IN(4)) for (int rep_ = 0; rep_ < DUPN(4); ++rep_) { for (int t = gw; t < SEQ; t += NGW) { select_row(F, t); sparse_attn_query(F, t); } }
    SEAM(5); TEND(4);
    TBEG(6);
    if (IN(6)) { for (int it = F.bid; it < 256; it += F.G) gla_state_item(F, it); }
    SEAM(7); TEND(6);
    TBEG(8);
    if (IN(8)) { for (int it = F.bid; it < 512; it += F.G) gla_out_item(F, args, it); }
    SEAM(8); TEND(8);
    TBEG(9);
    if (IN(9)) { pg8::Gemm g{(const bf16_t*)(F.ws + WS_OA), (const bf16_t*)(F.ws + WS_WPA), SEQ, DM, DM, DM, DM}; pg8::StaticOrder S; S.init(SEQ, DM, F.G, F.bid);
        EpiGate E{(bf16_t*)(F.ws + WS_T1), (const bf16_t*)(F.ws + WS_GATES), 0, nullptr}; pg8::gemm_phase<EpiGate, true>(ring, g, S, E, F.wave); }
    TEND(9);
    TBEG(10);
    if (IN(10)) { pg8::Gemm g{(const bf16_t*)(F.ws + WS_OB), (const bf16_t*)(F.ws + WS_WPB), SEQ, DM, DM, DM, DM}; pg8::StaticOrder S; S.init(SEQ, DM, F.G, F.bid);
        EpiGate E{(bf16_t*)(F.ws + WS_MERGED), (const bf16_t*)(F.ws + WS_GATES), 2048, (const bf16_t*)(F.ws + WS_T1)}; pg8::gemm_phase<EpiGate, true>(ring, g, S, E, F.wave); }
    SEAM(10); TEND(10);
    TBEG(11);
    if (IN(11)) { { pg8::Gemm g{(const bf16_t*)(F.ws + WS_MERGED), (const bf16_t*)(F.ws + WS_WOUT), SEQ, DM, DM, DM, DM}; pg8::StaticOrder S; S.init(SEQ, DM, F.G, F.bid);
          EpiResNorm<true> E{args.in[0], (bf16_t*)(F.ws + WS_A1), rsq1}; pg8::gemm_phase<EpiResNorm<true>, true>(ring, g, S, E, F.wave); }
        const int lane_ = lane_id();
        for (int r = QSPLIT + gw; r < 32768; r += NGW) { const int e = r & 16383;
            if (r < 16384) quant_row(args.in[20] + (size_t)e * DM, (unsigned char*)(F.ws + WS_UB) + (size_t)e * 4096, (float*)(F.ws + WS_USC) + e, lane_, args.in[17]);
            else quant_row(args.in[21] + (size_t)e * DM, (unsigned char*)(F.ws + WS_UB) + (size_t)e * 4096 + 2048, (float*)(F.ws + WS_VSC) + e, lane_, nullptr); }
    }
    SEAM(11); TEND(11);
    TBEG(12);
    if (IN(12)) { { pg8::Gemm g{(const bf16_t*)(F.ws + WS_A1), (const bf16_t*)(F.ws + WS_WQK), SEQ, 1024, DM, DM, DM}; pg8::StaticOrder S; S.init(SEQ, 1024, F.G, F.bid);
        EpiSoftmax E{(bf16_t*)(F.ws + WS_XP), 1024, rsq1, 0.044194173824159216f}; pg8::gemm_phase<EpiSoftmax, false>(ring, g, S, E, F.wave); }
        if (F.bid >= 128) { const int lane_ = lane_id();
            for (int r = (F.bid - 128) * NWAVES + F.wave; r < QSPLIT; r += (F.G - 128) * NWAVES) { const int e = r & 16383;
                if (r < 16384) quant_row(args.in[20] + (size_t)e * DM, (unsigned char*)(F.ws + WS_UB) + (size_t)e * 4096, (float*)(F.ws + WS_USC) + e, lane_, args.in[17]);
                else quant_row(args.in[21] + (size_t)e * DM, (unsigned char*)(F.ws + WS_UB) + (size_t)e * 4096 + 2048, (float*)(F.ws + WS_VSC) + e, lane_, nullptr); } }
    }
    SEAM(12); TEND(12);
    TBEG(13);
    if (IN(13)) { pg8::Gemm g{(const bf16_t*)(F.ws + WS_XP), (const bf16_t*)(F.ws + WS_WVO), SEQ, DM, 1024, 1024, 1024}; pg8::StaticOrder S; S.init(SEQ, DM, F.G, F.bid);
        EpiResNorm<false> E{(const bf16_t*)(F.ws + WS_A1), (bf16_t*)(F.ws + WS_A2), rsq2}; pg8::gemm_phase<EpiResNorm<false>, true>(ring, g, S, E, F.wave); }
    SEAM(13); TEND(13);
    TBEG(14);
    if (IN(14)) { pg8::Gemm g{(const bf16_t*)(F.ws + WS_A2), (const bf16_t*)(F.ws + WS_WPQ), SEQ, DM, DM, DM, DM}; pg8::StaticOrder S; S.init(SEQ, DM, F.G, F.bid);
        EpiBf16 E{(bf16_t*)(F.ws + WS_PQ), DM, rsq2}; pg8::gemm_phase<EpiBf16, true>(ring, g, S, E, F.wave); }
    SEAM(14); TEND(14);
    TBEG(15);
    if (IN(15)) { for (int it = gw; it < SEQ / 2; it += NGW) peer_select_item(F, it); }
    SEAM(15); TEND(15);
    TBEG(16);
    if (IN(16)) { for (int t = gw; t < SEQ; t += NGW) peer_expert_token(F, args, t); }
    TEND(16);
#undef IN
#undef SEAM
#undef ROT
}

#ifndef MK_ONE_LAUNCH
#define MK_ONE_LAUNCH 1
#endif
extern "C" void kernel_launch(void* const* d_in, const int* in_sizes, int n_in, void* d_out, int out_size, void* d_ws, size_t ws_size, hipStream_t stream) {
    static int grid = 0;
    if (grid == 0) {
        if (n_in != 23 || out_size != SEQ * DM || ws_size < WS_END) { fprintf(stderr, "kernel_launch: unexpected problem (n_in %d, out %d, ws %zu < %zu)\n", n_in, out_size, ws_size, (size_t)WS_END); grid = -1; return; }
        int dev = 0, cus = 0, per_cu = 0;
        if (hipGetDevice(&dev) != hipSuccess || hipDeviceGetAttribute(&cus, hipDeviceAttributeMultiprocessorCount, dev) != hipSuccess) { grid = -1; return; }
        if (hipFuncSetAttribute((const void*)hybrid_fwd, hipFuncAttributeMaxDynamicSharedMemorySize, LDS_BYTES) != hipSuccess) { fprintf(stderr, "kernel_launch: hipFuncSetAttribute failed\n"); grid = -1; return; }
        if (hipOccupancyMaxActiveBlocksPerMultiprocessor(&per_cu, (const void*)hybrid_fwd, NTHREADS, LDS_BYTES) != hipSuccess || per_cu < 1) { fprintf(stderr, "kernel_launch: occupancy query says %d\n", per_cu); per_cu = 1; }
        (void)hipGetLastError();
        grid = cus;
    }
    if (grid < 0) return;
    (void)hipMemsetAsync((char*)d_ws + WS_CTL, 0, CTL_ZERO_BYTES, stream);
    Args a{};
    for (int i = 0; i < 23; ++i) a.in[i] = (const float*)d_in[i];
    a.out = (float*)d_out; a.ws = (unsigned char*)d_ws;
#if MK_ONE_LAUNCH
    a.ph_lo = 0; a.ph_hi = N_PHASES; a.use_bar = 1;
    void* kargs[] = {&a};
    hipError_t e = hipLaunchCooperativeKernel((const void*)hybrid_fwd, dim3(grid), dim3(NTHREADS), kargs, LDS_BYTES, stream);
    if (e != hipSuccess) fprintf(stderr, "cooperative launch failed: %s (grid %d)\n", hipGetErrorString(e), grid);
#else
    for (int p = 0; p < N_PHASES; ++p) { a.ph_lo = p; a.ph_hi = p + 1; a.use_bar = 0;
        hipLaunchKernelGGL(hybrid_fwd, dim3(grid), dim3(NTHREADS), LDS_BYTES, stream, a); }
#endif
}
```

```cpp
#include <hip/hip_runtime.h>
#include <hip/hip_cooperative_groups.h>
#include <cstdio>
#include <cstdint>
namespace cg = cooperative_groups;

#define GAS __attribute__((address_space(1)))
#define LAS __attribute__((address_space(3)))
#ifndef TPH
#define TPH -1
#endif
typedef unsigned short bf16_t;
typedef short bf16x8 __attribute__((ext_vector_type(8)));
typedef short s16x4 __attribute__((ext_vector_type(4)));
typedef float f32x4 __attribute__((ext_vector_type(4)));
typedef float f32x2 __attribute__((ext_vector_type(2)));
typedef unsigned u32x4 __attribute__((ext_vector_type(4)));
typedef unsigned u32x2 __attribute__((ext_vector_type(2)));
#define RLX_AGENT __ATOMIC_RELAXED, __HIP_MEMORY_SCOPE_AGENT
#define LDS_WAIT() asm volatile("s_waitcnt lgkmcnt(0)" ::: "memory")
#define VM_WAIT() asm volatile("s_waitcnt vmcnt(0)" ::: "memory")

__device__ __forceinline__ int lane_id() { int l; asm volatile("v_mbcnt_lo_u32_b32 %0, -1, 0\n\tv_mbcnt_hi_u32_b32 %0, -1, %0" : "=v"(l)); return l; }
__device__ __forceinline__ unsigned f2bf(float f) { unsigned u = __builtin_bit_cast(unsigned, f); return (u + 0x7fffu + ((u >> 16) & 1u)) >> 16; }
__device__ __forceinline__ unsigned pk2(float lo, float hi) { return f2bf(lo) | (f2bf(hi) << 16); }
__device__ __forceinline__ float bf2f(unsigned short b) { return __builtin_bit_cast(float, (unsigned)b << 16); }
__device__ __forceinline__ float bflo(unsigned w) { return __builtin_bit_cast(float, w << 16); }
__device__ __forceinline__ float bfhi(unsigned w) { return __builtin_bit_cast(float, w & 0xffff0000u); }
__device__ __forceinline__ float wave_sum(float v) {
#pragma unroll
    for (int o = 1; o < 64; o <<= 1) v += __shfl_xor(v, o);
    return v;
}
#define MFMA_FENCE1(a) asm volatile("s_nop 15\n\ts_nop 3" : "+v"(a))
#define MFMA_FENCE4(a, b, c, d) asm volatile("s_nop 15\n\ts_nop 3" : "+v"(a), "+v"(b), "+v"(c), "+v"(d))
#define MFMA_FENCE8(a, b, c, d, e, f, g, h) asm volatile("s_nop 15\n\ts_nop 3" : "+v"(a), "+v"(b), "+v"(c), "+v"(d), "+v"(e), "+v"(f), "+v"(g), "+v"(h))
__device__ __forceinline__ float sigmoidf_(float x) { return 1.f / (1.f + __expf(-x)); }

namespace pg8 {
constexpr int BM = 256, BK = 64, HALF = 128, HTB = HALF * BK * 2, STAGE_BYTES = 8 * HTB, NXCD = 8, WGM = 8;
__host__ __device__ __forceinline__ int lds_byte(int r, int c) { const int st = (r >> 4) * 2 + (c >> 5), rr = r & 15, cc = c & 31, ob = rr * 64 + cc * 2; return st * 1024 + (ob ^ (((ob >> 9) & 1) << 5)); }
__host__ __device__ __forceinline__ void stage_rc(int b, int& R, int& C) { const int st = b / 1024, sb = b % 1024, swz = sb ^ (((sb >> 9) & 1) << 5); R = (st >> 1) * 16 + swz / 64; C = (st & 1) * 32 + (swz % 64) / 2; }
__host__ __device__ __forceinline__ int perm32(int rho) { const int n = rho >> 4, i = rho & 15; return 8 * (i >> 2) + 4 * n + (i & 3); }

struct Unit { int pm, pn; };
struct Gemm { const bf16_t* A; const bf16_t* Bt; int M, N, K, lda, ldb; };

struct StaticOrder {
    int nM, nN, nwg, G, c;
    __device__ void init(int M, int N, int G_, int c_) { nM = M / BM; nN = N / BM; nwg = nM * nN; G = G_; c = c_; }
    __device__ bool next(int i, Unit& u) const {
        const long L = (long)i * G + c; if (L >= nwg) return false;
        int wgid = (int)L; { const int q = nwg / NXCD, r = nwg % NXCD, xcd = wgid % NXCD, off = wgid / NXCD; wgid = (xcd < r ? xcd * (q + 1) : r * (q + 1) + (xcd - r) * q) + off; }
        const int nig = WGM * nN, gid = wgid / nig, fm = gid * WGM, gsz = (nM - fm) < WGM ? (nM - fm) : WGM;
        u.pm = fm + ((wgid % nig) % gsz); u.pn = (wgid % nig) / gsz; return true;
    }
};

__device__ __forceinline__ unsigned cvt_pk_bf16(float lo, float hi) { unsigned r; asm volatile("v_cvt_pk_bf16_f32 %0, %1, %2" : "=v"(r) : "v"(lo), "v"(hi)); return r; }

template <class Epi, bool ALIGN_EPI>
__device__ __forceinline__ void gemm_phase(LAS unsigned char* lds, const Gemm g, const StaticOrder& S, const Epi& E, int wave_in) {
    const int lane = lane_id(), wid = wave_in, tid = wid * 64 + lane, wr = wid >> 2, wc = wid & 3, fr = lane & 15, fq = lane >> 4;
    const int K = g.K, nt = K / BK;
    unsigned voffA[2], voffB[2];
#pragma unroll
    for (int i = 0; i < 2; ++i) { int R, C; stage_rc(tid * 16 + i * 8192, R, C); const int Rb = (R & ~31) + perm32(R & 31);
        voffA[i] = (unsigned)(R * g.lda + C) * 2u; voffB[i] = (unsigned)(Rb * g.ldb + C) * 2u; }
    const size_t kstep = (size_t)(BK * 2);
    const size_t hstepA = (size_t)HALF * g.lda * 2, hstepB = (size_t)HALF * g.ldb * 2;
    const size_t tstepA = 2 * hstepA, tstepB = 2 * hstepB;
    const unsigned ldsw = (unsigned)wid * 1024u;
    const int aoff = lds_byte(wr * 64 + fr, fq * 8), boff = lds_byte(wc * 32 + fr, fq * 8);
#define PG8_SA(b, h) (((b) * 2 + (h)) * HTB)
#define PG8_SB(b, h) ((4 + (b) * 2 + (h)) * HTB)
#define PG8_STAGE(bufoff, gbase, voff) do { _Pragma("unroll") for (int _i = 0; _i < 2; ++_i) \
        __builtin_amdgcn_global_load_lds((const unsigned*)((const char*)(gbase) + (voff)[_i]), (LAS unsigned*)(lds + (bufoff) + ldsw + _i * 8192), 16, 0, 0); } while (0)
#define PG8_LDA(dst, b, h) do { _Pragma("unroll") for (int m = 0; m < 4; ++m) _Pragma("unroll") for (int k = 0; k < 2; ++k) dst[m][k] = *(const LAS bf16x8*)(lds + PG8_SA(b, h) + aoff + m * 2048 + k * 1024); } while (0)
#define PG8_LDB(dst, b, h) do { _Pragma("unroll") for (int n = 0; n < 2; ++n) _Pragma("unroll") for (int k = 0; k < 2; ++k) dst[n][k] = *(const LAS bf16x8*)(lds + PG8_SB(b, h) + boff + n * 2048 + k * 1024); } while (0)
#define PG8_MMA(ai, bj, At, Bt) do { __builtin_amdgcn_s_setprio(1); _Pragma("unroll") for (int m = 0; m < 4; ++m) _Pragma("unroll") for (int n = 0; n < 2; ++n) _Pragma("unroll") for (int k = 0; k < 2; ++k) \
        acc[ai][bj][m][n] = __builtin_amdgcn_mfma_f32_16x16x32_bf16(Bt[n][k], At[m][k], acc[ai][bj][m][n], 0, 0, 0); __builtin_amdgcn_s_setprio(0); } while (0)
#define PG8_WAIT_V(n) asm volatile("s_waitcnt vmcnt(" #n ")" ::: "memory")
#define PG8_WAIT_L(n) asm volatile("s_waitcnt lgkmcnt(" #n ")" ::: "memory")
#define PG8_BAR __builtin_amdgcn_s_barrier()
#define PG8_SCHED __builtin_amdgcn_sched_barrier(0)
    Unit cur, nxt; int ui = 0;
    if (!S.next(0, cur)) return;
    f32x4 acc[2][2][4][2];
#pragma unroll
    for (int a = 0; a < 2; ++a)
#pragma unroll
        for (int b = 0; b < 2; ++b)
#pragma unroll
            for (int m = 0; m < 4; ++m)
#pragma unroll
                for (int n = 0; n < 2; ++n) acc[a][b][m][n] = (f32x4){0.f, 0.f, 0.f, 0.f};
    bf16x8 At[4][2], B0[2][2], B1[2][2];
    const char* cA = (const char*)g.A + (size_t)cur.pm * tstepA; const char* cB = (const char*)g.Bt + (size_t)cur.pn * tstepB;
    PG8_STAGE(PG8_SB(0, 0), cB, voffB); PG8_STAGE(PG8_SB(0, 1), cB + hstepB, voffB); PG8_STAGE(PG8_SA(0, 0), cA, voffA); PG8_STAGE(PG8_SA(0, 1), cA + hstepA, voffA);
    if (wr == 1) PG8_BAR;
    PG8_WAIT_V(2); PG8_BAR;
    PG8_STAGE(PG8_SB(1, 0), cB + kstep, voffB); PG8_STAGE(PG8_SA(1, 0), cA + kstep, voffA); PG8_STAGE(PG8_SB(1, 1), cB + hstepB + kstep, voffB);
    PG8_WAIT_V(6); PG8_BAR;
    for (;;) {
        const bool has_next = S.next(ui + 1, nxt);
        const char* nA = has_next ? (const char*)g.A + (size_t)nxt.pm * tstepA : cA; const char* nB = has_next ? (const char*)g.Bt + (size_t)nxt.pn * tstepB : cB;
        for (int t = 0; t < nt; t += 2) {
            const bool last = (t == nt - 2);
            const char* a1 = cA + (size_t)(t + 1) * kstep;
            const char* a2 = last ? nA : cA + (size_t)(t + 2) * kstep; const char* b2 = last ? nB : cB + (size_t)(t + 2) * kstep;
            const char* a3 = a2 + kstep; const char* b3 = b2 + kstep;
            PG8_LDB(B0, 0, 0); PG8_LDB(B1, 0, 1); PG8_SCHED; PG8_LDA(At, 0, 0); PG8_STAGE(PG8_SA(1, 1), a1 + hstepA, voffA);
            PG8_WAIT_V(8); PG8_WAIT_L(0); PG8_BAR; PG8_MMA(0, 0, At, B0); PG8_MMA(0, 1, At, B1); PG8_BAR; PG8_SCHED;
            PG8_LDA(At, 0, 1); PG8_STAGE(PG8_SB(0, 0), b2, voffB); PG8_STAGE(PG8_SB(0, 1), b2 + hstepB, voffB); PG8_STAGE(PG8_SA(0, 0), a2, voffA);
            PG8_WAIT_V(8); PG8_WAIT_L(0); PG8_BAR; PG8_MMA(1, 0, At, B0); PG8_MMA(1, 1, At, B1); PG8_BAR; PG8_SCHED;
            PG8_LDB(B0, 1, 0); PG8_LDB(B1, 1, 1); PG8_SCHED; PG8_LDA(At, 1, 0); PG8_STAGE(PG8_SA(0, 1), a2 + hstepA, voffA);
            PG8_WAIT_V(8); PG8_WAIT_L(0); PG8_BAR; PG8_MMA(0, 0, At, B0); PG8_MMA(0, 1, At, B1); PG8_BAR; PG8_SCHED;
            PG8_LDA(At, 1, 1); PG8_STAGE(PG8_SB(1, 0), b3, voffB); PG8_STAGE(PG8_SB(1, 1), b3 + hstepB, voffB); PG8_STAGE(PG8_SA(1, 0), a3, voffA);
            PG8_WAIT_V(8); PG8_WAIT_L(0); PG8_BAR; PG8_MMA(1, 0, At, B0); PG8_MMA(1, 1, At, B1); PG8_BAR; PG8_SCHED;
        }
        if constexpr (ALIGN_EPI) { if (wr == 0) PG8_BAR; }
        if constexpr (!Epi::AFTER_DRAIN) { E(acc, cur, wr, wc, fr, fq); }
        if (!has_next) break;
#pragma unroll
        for (int a = 0; a < 2; ++a)
#pragma unroll
            for (int b = 0; b < 2; ++b)
#pragma unroll
                for (int m = 0; m < 4; ++m)
#pragma unroll
                    for (int n = 0; n < 2; ++n) acc[a][b][m][n] = (f32x4){0.f, 0.f, 0.f, 0.f};
        cur = nxt; cA = nA; cB = nB; ++ui;
        if constexpr (ALIGN_EPI) { if (wr == 1) PG8_BAR; }
    }
    PG8_WAIT_V(0);
    if constexpr (!ALIGN_EPI) { if (wr == 0) PG8_BAR; }
    PG8_BAR;
    if constexpr (Epi::AFTER_DRAIN) { E.fused(acc, cur, wr, wc, fr, fq, lds, wid, lane); }
#undef PG8_SA
#undef PG8_SB
#undef PG8_STAGE
#undef PG8_LDA
#undef PG8_LDB
#undef PG8_MMA
#undef PG8_WAIT_V
#undef PG8_WAIT_L
#undef PG8_BAR
#undef PG8_SCHED
}
}
using pg8::Unit;

constexpr int SEQ = 8192, DM = 2048, MEM = 256;
constexpr int NIN = 13824;
constexpr float EPS = 1e-6f;
constexpr size_t MiB = 1u << 20;
constexpr size_t WS_CTL = 0, CTL_ZERO_BYTES = 1 * MiB;
constexpr size_t WS_MEMN = 1 * MiB, WS_XK = 2 * MiB, WS_XV = 3 * MiB, WS_DVEC = 4 * MiB, WS_KEYS = 5 * MiB, WS_IW = 6 * MiB;
constexpr size_t WS_WPA = 8 * MiB, WS_WPB = 16 * MiB, WS_WOUT = 24 * MiB, WS_WXQ = 32 * MiB, WS_WXK = 40 * MiB, WS_WXV = 48 * MiB, WS_WXO = 56 * MiB, WS_WPQ = 64 * MiB;
constexpr size_t WS_WIN = 72 * MiB, WS_A0 = 126 * MiB;
constexpr size_t WS_QT = 72 * MiB, WS_KHT = 88 * MiB, WS_VT = 104 * MiB, WS_ATT = 136 * MiB, WS_KBR = 140 * MiB, WS_VB = 142 * MiB, WS_KIR = 144 * MiB, WS_SEL = 145 * MiB, WS_WQK = 153 * MiB, WS_WVO = 157 * MiB;
constexpr size_t WS_GR = 162 * MiB, WS_DQ = 194 * MiB, WS_GATES = 226 * MiB, WS_MISC = 290 * MiB, WS_IQ = 298 * MiB, WS_GQK = 314 * MiB, WS_GV = 346 * MiB, WS_SCORES = 378 * MiB, WS_OA = 506 * MiB;
constexpr size_t WS_ST = 378 * MiB, WS_OB = 314 * MiB, WS_T1 = 346 * MiB, WS_MERGED = 194 * MiB, WS_A1 = 162 * MiB, WS_XP = 298 * MiB, WS_A2 = 194 * MiB, WS_PQ = 226 * MiB, WS_EXPI = 258 * MiB, WS_GATEW = 262 * MiB;
constexpr size_t WS_UB = 378 * MiB, WS_VBF = 410 * MiB, WS_USC = 7 * MiB, WS_VSC = 7 * MiB + 65536, WS_END = 538 * MiB;
constexpr int CW_BAR = 4096;
constexpr int CW_RSQ1 = 65536, CW_RSQ2 = 65536 + 8192;
constexpr int MISC_LD = 512;

constexpr int RING_BYTES = 131072;
constexpr int LDSCTL_OFF = 147456 - 256;
constexpr int LDS_BYTES = 147456;
constexpr int NWAVES = 8, NTHREADS = 512;

__device__ __forceinline__ u32x4 pack8(const f32x4 v0, const f32x4 v1) { u32x4 w; w.x = pg8::cvt_pk_bf16(v0[0], v0[1]); w.y = pg8::cvt_pk_bf16(v0[2], v0[3]); w.z = pg8::cvt_pk_bf16(v1[0], v1[1]); w.w = pg8::cvt_pk_bf16(v1[2], v1[3]); return w; }

struct EpiRoute {
    static constexpr bool AFTER_DRAIN = false;
    unsigned char* ws;
    __device__ __forceinline__ void operator()(const f32x4 (&acc)[2][2][4][2], const Unit& u, int wr, int wc, int fr, int fq) const {
        const int pn = u.pn; bf16_t* base; int ldc, c0;
        if (pn < 8) { base = (bf16_t*)(ws + WS_GQK); ldc = 2048; c0 = pn * 256; }
        else if (pn < 16) { base = (bf16_t*)(ws + WS_GV); ldc = 2048; c0 = (pn - 8) * 256; }
        else if (pn < 24) { base = (bf16_t*)(ws + WS_GR); ldc = 2048; c0 = (pn - 16) * 256; }
        else if (pn < 32) { base = (bf16_t*)(ws + WS_DQ); ldc = 2048; c0 = (pn - 24) * 256; }
        else if (pn < 36) { base = (bf16_t*)(ws + WS_IQ); ldc = 1024; c0 = (pn - 32) * 256; }
        else if (pn < 52) { base = (bf16_t*)(ws + WS_GATES); ldc = 4096; c0 = (pn - 36) * 256; }
        else { base = (bf16_t*)(ws + WS_MISC); ldc = MISC_LD; c0 = (pn - 52) * 256; }
        const int row0 = u.pm * 256 + wr * 64 + fr, col0 = c0 + wc * 32 + 8 * fq;
#pragma unroll
        for (int ai = 0; ai < 2; ++ai)
#pragma unroll
            for (int m = 0; m < 4; ++m) { bf16_t* rowp = base + (size_t)(row0 + ai * 128 + m * 16) * ldc + col0;
#pragma unroll
                for (int bj = 0; bj < 2; ++bj) *(u32x4*)(rowp + bj * 128) = pack8(acc[ai][bj][m][0], acc[ai][bj][m][1]); }
    }
};
struct EpiBf16 {
    static constexpr bool AFTER_DRAIN = false;
    bf16_t* O; int ldc; const float* rowsq;
    __device__ __forceinline__ void operator()(const f32x4 (&acc)[2][2][4][2], const Unit& u, int wr, int wc, int fr, int fq) const {
        const int row0 = u.pm * 256 + wr * 64 + fr, col0 = u.pn * 256 + wc * 32 + 8 * fq;
#pragma unroll
        for (int ai = 0; ai < 2; ++ai)
#pragma unroll
            for (int m = 0; m < 4; ++m) { const int row = row0 + ai * 128 + m * 16; bf16_t* rowp = O + (size_t)row * ldc + col0;
                const float sc = rowsq ? rsqrtf(rowsq[row] * (1.f / DM) + EPS) : 1.f;
#pragma unroll
                for (int bj = 0; bj < 2; ++bj) *(u32x4*)(rowp + bj * 128) = pack8(acc[ai][bj][m][0] * sc, acc[ai][bj][m][1] * sc); }
    }
};
struct EpiGate {
    static constexpr bool AFTER_DRAIN = false;
    bf16_t* O; const bf16_t* gates; int goff; const bf16_t* prev;
    __device__ __forceinline__ void operator()(const f32x4 (&acc)[2][2][4][2], const Unit& u, int wr, int wc, int fr, int fq) const {
        const int row0 = u.pm * 256 + wr * 64 + fr, col0 = u.pn * 256 + wc * 32 + 8 * fq;
#pragma unroll
        for (int ai = 0; ai < 2; ++ai)
#pragma unroll
            for (int m = 0; m < 4; ++m) { const int row = row0 + ai * 128 + m * 16;
#pragma unroll
                for (int bj = 0; bj < 2; ++bj) { const int col = col0 + bj * 128;
                    const u32x4 gw = *(const u32x4*)(gates + (size_t)row * 4096 + goff + col);
                    f32x4 v0 = acc[ai][bj][m][0], v1 = acc[ai][bj][m][1];
                    v0[0] *= sigmoidf_(bflo(gw.x)); v0[1] *= sigmoidf_(bfhi(gw.x)); v0[2] *= sigmoidf_(bflo(gw.y)); v0[3] *= sigmoidf_(bfhi(gw.y));
                    v1[0] *= sigmoidf_(bflo(gw.z)); v1[1] *= sigmoidf_(bfhi(gw.z)); v1[2] *= sigmoidf_(bflo(gw.w)); v1[3] *= sigmoidf_(bfhi(gw.w));
                    if (prev) { const u32x4 pw = *(const u32x4*)(prev + (size_t)row * DM + col);
                        v0[0] += bflo(pw.x); v0[1] += bfhi(pw.x); v0[2] += bflo(pw.y); v0[3] += bfhi(pw.y); v1[0] += bflo(pw.z); v1[1] += bfhi(pw.z); v1[2] += bflo(pw.w); v1[3] += bfhi(pw.w); }
                    *(u32x4*)(O + (size_t)row * DM + col) = pack8(v0, v1); } }
    }
};
template <bool BASE_F32> struct EpiResNorm {
    static constexpr bool AFTER_DRAIN = false;
    const void* base; bf16_t* Hn; float* rowsq;
    __device__ __forceinline__ void operator()(const f32x4 (&acc)[2][2][4][2], const Unit& u, int wr, int wc, int fr, int fq) const {
        const int row0 = u.pm * 256 + wr * 64 + fr, col0 = u.pn * 256 + wc * 32 + 8 * fq;
#pragma unroll
        for (int ai = 0; ai < 2; ++ai)
#pragma unroll
            for (int m = 0; m < 4; ++m) { const int row = row0 + ai * 128 + m * 16; float ss = 0.f;
#pragma unroll
                for (int bj = 0; bj < 2; ++bj) { const size_t off = (size_t)row * DM + col0 + bj * 128; f32x4 h0, h1;
                    if (BASE_F32) { h0 = *(const f32x4*)((const float*)base + off); h1 = *(const f32x4*)((const float*)base + off + 4); }
                    else { const u32x4 w = *(const u32x4*)((const bf16_t*)base + off); h0 = (f32x4){bflo(w.x), bfhi(w.x), bflo(w.y), bfhi(w.y)}; h1 = (f32x4){bflo(w.z), bfhi(w.z), bflo(w.w), bfhi(w.w)}; }
                    h0 += acc[ai][bj][m][0]; h1 += acc[ai][bj][m][1];
                    ss += (h0[0] * h0[0] + h0[1] * h0[1]) + (h0[2] * h0[2] + h0[3] * h0[3]) + (h1[0] * h1[0] + h1[1] * h1[1]) + (h1[2] * h1[2] + h1[3] * h1[3]);
                    *(u32x4*)(Hn + off) = pack8(h0, h1); }
                ss += __shfl_xor(ss, 16); ss += __shfl_xor(ss, 32);
                if (fq == 0) atomicAdd(rowsq + row, ss); }
    }
};
struct EpiSoftmax {
    static constexpr bool AFTER_DRAIN = true;
    bf16_t* O; int ldc; const float* rowsq; float scale;
    __device__ __forceinline__ void fused(f32x4 (&acc)[2][2][4][2], const Unit& u, int wr, int wc, int fr, int fq, LAS unsigned char* lds, int wid, int lane) const {
        LAS f32x2* P = (LAS f32x2*)lds;
        float mxs[2][4];
#pragma unroll
        for (int ai = 0; ai < 2; ++ai)
#pragma unroll
            for (int m = 0; m < 4; ++m) { const int rl = ai * 128 + wr * 64 + m * 16 + fr; const int row = u.pm * 256 + rl;
                const float sc = rsqrtf(rowsq[row] * (1.f / DM) + EPS) * scale; float mx = -3.0e38f;
#pragma unroll
                for (int bj = 0; bj < 2; ++bj)
#pragma unroll
                    for (int n = 0; n < 2; ++n) { f32x4 x = acc[ai][bj][m][n] * sc; acc[ai][bj][m][n] = x; mx = fmaxf(mx, fmaxf(fmaxf(x[0], x[1]), fmaxf(x[2], x[3]))); }
                mx = fmaxf(mx, __shfl_xor(mx, 16)); mx = fmaxf(mx, __shfl_xor(mx, 32)); float s = 0.f;
#pragma unroll
                for (int bj = 0; bj < 2; ++bj)
#pragma unroll
                    for (int n = 0; n < 2; ++n) { f32x4 x = acc[ai][bj][m][n]; x[0] = __expf(x[0] - mx); x[1] = __expf(x[1] - mx); x[2] = __expf(x[2] - mx); x[3] = __expf(x[3] - mx); acc[ai][bj][m][n] = x; s += (x[0] + x[1]) + (x[2] + x[3]); }
                s += __shfl_xor(s, 16); s += __shfl_xor(s, 32); mxs[ai][m] = mx;
                if (fq == 0) P[rl * 4 + wc] = (f32x2){mx, s}; }
        __syncthreads();
        const int col0 = u.pn * 256 + wc * 32 + 8 * fq;
#pragma unroll
        for (int ai = 0; ai < 2; ++ai)
#pragma unroll
            for (int m = 0; m < 4; ++m) { const int rl = ai * 128 + wr * 64 + m * 16 + fr; const int row = u.pm * 256 + rl;
                const f32x2 a = P[rl * 4 + 0], b = P[rl * 4 + 1], c = P[rl * 4 + 2], d = P[rl * 4 + 3];
                const float M = fmaxf(fmaxf(a.x, b.x), fmaxf(c.x, d.x));
                const float Ssum = a.y * __expf(a.x - M) + b.y * __expf(b.x - M) + c.y * __expf(c.x - M) + d.y * __expf(d.x - M);
                const float f = __expf(mxs[ai][m] - M) / Ssum;
#pragma unroll
                for (int bj = 0; bj < 2; ++bj) *(u32x4*)(O + (size_t)row * ldc + col0 + bj * 128) = pack8(acc[ai][bj][m][0] * f, acc[ai][bj][m][1] * f); }
        __syncthreads();
    }
};

#define XB_TMO      128
#define XB_XCNT(j)  (256  + 64 * (j))
#define XB_XSUB(j)  (1280 + 64 * (j))
#define XB_XGEN(j)  (2304 + 64 * (j))
#define XB_TOP      3328
#define XB_TOPGEN   3392
#define XCD_BAR_WORDS 3456
#define XB_SPIN_CAP (1u << 20)
__device__ __forceinline__ unsigned xb_ld(unsigned* p)              { return __hip_atomic_load(p, __ATOMIC_RELAXED, __HIP_MEMORY_SCOPE_AGENT); }
__device__ __forceinline__ unsigned xb_add(unsigned* p, unsigned v) { return __hip_atomic_fetch_add(p, v, __ATOMIC_RELAXED, __HIP_MEMORY_SCOPE_AGENT); }
__device__ __forceinline__ unsigned xb_xcc_id() { return (unsigned)__builtin_amdgcn_s_getreg((3 << 11) | 20) & 0xFu; }
#define XB_SPIN(cond, bar) do { unsigned _sp = 0; while (cond) { __builtin_amdgcn_s_sleep(1); \
    if ((++_sp & 255u) == 0u) { if (xb_ld(&(bar)[XB_TMO])) break; if (_sp > XB_SPIN_CAP) { atomicAdd(&(bar)[XB_TMO], 1u); break; } } } } while (0)
struct XcdBarrier { unsigned* bar; unsigned x; volatile LAS unsigned* st; };
__device__ __forceinline__ XcdBarrier xcd_barrier_post(unsigned* bar, volatile LAS unsigned* st, bool t0) {
    XcdBarrier b; b.bar = bar; b.x = xb_xcc_id(); b.st = st;
    if (t0) (void)xb_add(&bar[XB_XCNT(b.x)], 1u);
    return b;
}
__device__ __forceinline__ void xcd_barrier_complete(unsigned* bar, unsigned x, unsigned& nloc, unsigned& nx) {
    const unsigned G = gridDim.x * gridDim.y * gridDim.z;
    unsigned sum, cnt, mine, sp = 0u;
    for (;;) {
        sum = 0u; cnt = 0u; mine = 0u;
#pragma unroll
        for (unsigned j = 0; j < 16; ++j) { const unsigned c = xb_ld(&bar[XB_XCNT(j)]); sum += c; cnt += (c > 0u) ? 1u : 0u; mine = (j == x) ? c : mine; }
        if (sum == G) break;
        __builtin_amdgcn_s_sleep(1);
        if ((++sp & 255u) == 0u) { if (xb_ld(&bar[XB_TMO])) break; if (sp > XB_SPIN_CAP) { atomicAdd(&bar[XB_TMO], 1u); break; } }
    }
    nloc = mine > 0u ? mine : 1u; nx = cnt > 0u ? cnt : 1u;
}
__device__ __forceinline__ void xcd_barrier(const XcdBarrier& b, int wave) {
    asm volatile("s_waitcnt vmcnt(0)" ::: "memory");
    __syncthreads();
    if (wave == 0 && lane_id() == 0) {
        unsigned* bar = b.bar;
        __builtin_amdgcn_s_waitcnt(0);
        unsigned nloc = b.st[0], nx = b.st[1];
        if (nloc == 0u) { xcd_barrier_complete(bar, b.x, nloc, nx); b.st[0] = nloc; b.st[1] = nx; }
        const unsigned old = xb_add(&bar[XB_XSUB(b.x)], 1u);
        const unsigned gen = old / nloc;
        if (old + 1u == (gen + 1u) * nloc) {
            __builtin_amdgcn_fence(__ATOMIC_RELEASE, "agent");
            asm volatile("s_waitcnt vmcnt(0)" ::: "memory");
            const unsigned og = xb_add(&bar[XB_TOP], 1u);
            const unsigned tg = og / nx;
            if (og + 1u == (tg + 1u) * nx) xb_add(&bar[XB_TOPGEN], 1u);
            else XB_SPIN(xb_ld(&bar[XB_TOPGEN]) == tg, bar);
            __builtin_amdgcn_fence(__ATOMIC_ACQUIRE, "agent");
            xb_add(&bar[XB_XGEN(b.x)], 1u);
            asm volatile("s_waitcnt vmcnt(0)" ::: "memory");
        } else {
            XB_SPIN(xb_ld(&bar[XB_XGEN(b.x)]) == gen, bar);
            __builtin_amdgcn_fence(__ATOMIC_ACQUIRE, "agent");
            asm volatile("s_waitcnt vmcnt(0)" ::: "memory");
        }
    }
    __syncthreads();
}

struct Args { const float* in[23]; float* out; unsigned char* ws; int ph_lo, ph_hi, use_bar, pad; };
struct Frame {
    LAS unsigned char* lds;
    int wave, G, bid;
    unsigned char* ws;
};

template <int MT, int NT>
__device__ __forceinline__ void wave_gemm_nt(const bf16_t* A, int lda, const bf16_t* B, int ldb, int K, f32x4 (&acc)[MT][NT], int fr, int fq) {
    for (int k0 = 0; k0 < K; k0 += 32) {
        bf16x8 a[MT], b[NT];
#pragma unroll
        for (int mt = 0; mt < MT; ++mt) a[mt] = *(const bf16x8*)(A + (size_t)(16 * mt + fr) * lda + k0 + 8 * fq);
#pragma unroll
        for (int nt = 0; nt < NT; ++nt) b[nt] = *(const bf16x8*)(B + (size_t)(16 * nt + fr) * ldb + k0 + 8 * fq);
#pragma unroll
        for (int mt = 0; mt < MT; ++mt)
#pragma unroll
            for (int nt = 0; nt < NT; ++nt) acc[mt][nt] = __builtin_amdgcn_mfma_f32_16x16x32_bf16(a[mt], b[nt], acc[mt][nt], 0, 0, 0);
    }
}

__device__ __forceinline__ int win_src_col(int n) {
    if (n < 6144) return n;
    if (n < 8192) return 6160 + (n - 6144);
    if (n < 9216) return 8464 + (n - 8192);
    if (n < 11264) return 9568 + (n - 9216);
    if (n < 13312) return 11616 + (n - 11264);
    const int m = n - 13312;
    if (m < 16) return 6144 + m;
    if (m < 32) return 9552 + (m - 16);
    if (m < 96) return 9488 + (m - 32);
    if (m < 128) return -1;
    if (m < 256) return 8208 + (m - 128);
    if (m < 384) return 8336 + (m - 256);
    return -1;
}
__device__ __forceinline__ void transpose_item(const float* W, int N, int K, bf16_t* WT, int drow0, int srccol, int k0, LAS float* scr, int lane, const float* kgain) {
    float v[64];
#pragma unroll
    for (int i = 0; i < 64; ++i) v[i] = srccol >= 0 ? W[(size_t)(k0 + i) * N + srccol] : 0.f;
    if (kgain) {
#pragma unroll
        for (int i = 0; i < 64; ++i) v[i] *= kgain[k0 + i]; }
#pragma unroll
    for (int i = 0; i < 64; ++i) scr[i * 65 + lane] = v[i];
    LDS_WAIT(); asm volatile("" ::: "memory");
    const int c = lane & 7;
#pragma unroll
    for (int j = 0; j < 8; ++j) { const int n = (lane >> 3) + 8 * j; const LAS float* s = scr + (8 * c) * 65 + n;
        u32x4 o; o.x = pk2(s[0 * 65], s[1 * 65]); o.y = pk2(s[2 * 65], s[3 * 65]); o.z = pk2(s[4 * 65], s[5 * 65]); o.w = pk2(s[6 * 65], s[7 * 65]);
        *(u32x4*)(WT + (size_t)(drow0 + n) * K + k0 + 8 * c) = o; }
    LDS_WAIT(); asm volatile("" ::: "memory");
}
__device__ __forceinline__ void rms_row_to_bf16(const float* xrow, const float* gain, bf16_t* orow, int lane) {
    const f32x4* xr = (const f32x4*)xrow + lane; const f32x4* gr = (const f32x4*)gain + lane;
    f32x4 v[8]; float s = 0.f;
#pragma unroll
    for (int j = 0; j < 8; ++j) { v[j] = xr[64 * j]; s += (v[j][0] * v[j][0] + v[j][1] * v[j][1]) + (v[j][2] * v[j][2] + v[j][3] * v[j][3]); }
    const float rstd = rsqrtf(wave_sum(s) * (1.f / DM) + EPS);
    u32x2* o8 = (u32x2*)orow + lane;
#pragma unroll
    for (int j = 0; j < 8; ++j) { const f32x4 g = gr[64 * j]; u32x2 w; w.x = pk2(v[j][0] * rstd * g[0], v[j][1] * rstd * g[1]); w.y = pk2(v[j][2] * rstd * g[2], v[j][3] * rstd * g[3]); o8[64 * j] = w; }
}
__device__ __forceinline__ void cvt_copy(const float* src, bf16_t* dst, size_t n, size_t gtid, size_t gthreads) {
    for (size_t i = gtid; i < n / 8; i += gthreads) { const f32x4 a = *((const f32x4*)src + 2 * i), b = *((const f32x4*)src + 2 * i + 1);
        u32x4 w; w.x = pk2(a[0], a[1]); w.y = pk2(a[2], a[3]); w.z = pk2(b[0], b[1]); w.w = pk2(b[2], b[3]); *((u32x4*)dst + i) = w; }
}
__device__ __forceinline__ void p0_prologue(const Frame& F, const Args& a) {
    const int lane_ = lane_id(), tid_ = F.wave * 64 + lane_; (void)tid_;
    LAS float* scr = (LAS float*)(F.lds + F.wave * 16896);
    const int gw = F.bid * NWAVES + F.wave, NGW = F.G * NWAVES;
    constexpr int I_IN = (NIN / 64) * (DM / 64), I_SQ = (DM / 64) * (DM / 64);
    for (int it = gw; it < I_IN + 7 * I_SQ; it += NGW) {
        if (it < I_IN) { const int nb = it / (DM / 64), kb = it % (DM / 64); const int n = nb * 64 + lane_;
            transpose_item(a.in[4], 13664, DM, (bf16_t*)(F.ws + WS_WIN), nb * 64, win_src_col(n), kb * 64, scr, lane_, nullptr); }
        else { const int r = it - I_IN, mi = r / I_SQ, q = r % I_SQ, nb = q / (DM / 64), kb = q % (DM / 64);
            const float* W; size_t off;
            switch (mi) { case 0: W = a.in[8]; off = WS_WPA; break; case 1: W = a.in[9]; off = WS_WPB; break; case 2: W = a.in[10]; off = WS_WOUT; break;
                          case 3: W = a.in[14]; off = WS_WXK; break; case 4: W = a.in[15]; off = WS_WXV; break; case 5: W = a.in[16]; off = WS_WXO; break; default: W = a.in[18]; off = WS_WPQ; break; }
            transpose_item(W, DM, DM, (bf16_t*)(F.ws + off), nb * 64, nb * 64 + lane_, kb * 64, scr, lane_, mi == 6 ? a.in[17] : nullptr); }
    }
    const size_t gtid = (size_t)F.bid * NTHREADS + tid_, gth = (size_t)F.G * NTHREADS;
    for (size_t i = gtid; i < (size_t)DM * DM / 8; i += gth) { const float g = a.in[11][i >> 8];
        const f32x4 p = *((const f32x4*)a.in[13] + 2 * i) * g, q = *((const f32x4*)a.in[13] + 2 * i + 1) * g; u32x4 w; w.x = pk2(p[0], p[1]); w.y = pk2(p[2], p[3]); w.z = pk2(q[0], q[1]); w.w = pk2(q[2], q[3]); *((u32x4*)(F.ws + WS_WXQ) + i) = w; }
    cvt_copy(a.in[19], (bf16_t*)(F.ws + WS_KEYS), (size_t)16 * 128 * 128, gtid, gth);
    for (int m = gw; m < SEQ + MEM; m += NGW) {
        if (m < SEQ) rms_row_to_bf16(a.in[0] + (size_t)m * DM, a.in[3], (bf16_t*)(F.ws + WS_A0) + (size_t)m * DM, lane_);
        else rms_row_to_bf16(a.in[1] + (size_t)(m - SEQ) * DM, a.in[12], (bf16_t*)(F.ws + WS_MEMN) + (size_t)(m - SEQ) * DM, lane_);
    }
}

__device__ __forceinline__ void sincos_red(float ang, float& s, float& c) {
    const float n = rintf(ang * 0.15915494309189535f);
    float r = fmaf(-n, 6.28318548202514648f, ang); r = fmaf(-n, -1.7484556000744883e-07f, r);
    const float f = r * 0.15915494309189535f;
    s = __builtin_amdgcn_sinf(f); c = __builtin_amdgcn_cosf(f);
}
__device__ __forceinline__ void rope_token(const Frame& F, const Args& a, int t) {
    const int lane_ = lane_id(), tid_ = F.wave * 64 + lane_; (void)tid_;
    const int l = lane_; const float pos = (float)((const int*)a.in[2])[t];
    bf16_t* DQ = (bf16_t*)(F.ws + WS_DQ) + (size_t)t * DM; bf16_t* IQ = (bf16_t*)(F.ws + WS_IQ) + (size_t)t * 1024; const bf16_t* MS = (const bf16_t*)(F.ws + WS_MISC) + (size_t)t * MISC_LD;
    float s1, c1, s2, c2;
    { const float inv = powf(10000.f, -(float)(2 * l) / 128.f); sincos_red(pos * inv, s1, c1); }
    { const float inv = powf(10000.f, -(float)(2 * (l & 31)) / 64.f); sincos_red(pos * inv, s2, c2); }
#pragma unroll 4
    for (int h = 0; h < 16; ++h) { const float x1 = bf2f(DQ[h * 128 + l]), x2 = bf2f(DQ[h * 128 + 64 + l]);
        DQ[h * 128 + l] = (bf16_t)f2bf(x1 * c1 - x2 * s1); DQ[h * 128 + 64 + l] = (bf16_t)f2bf(x2 * c1 + x1 * s1); }
    { const float x1 = bf2f(MS[128 + l]), x2 = bf2f(MS[128 + 64 + l]); bf16_t* kb = (bf16_t*)(F.ws + WS_KBR) + (size_t)t * 128;
      kb[l] = (bf16_t)f2bf(x1 * c1 - x2 * s1); kb[64 + l] = (bf16_t)f2bf(x2 * c1 + x1 * s1); }
#pragma unroll 4
    for (int p = 0; p < 8; ++p) { const int h = 2 * p + (l >> 5), i = l & 31; const float x1 = bf2f(IQ[h * 64 + i]), x2 = bf2f(IQ[h * 64 + 32 + i]);
        IQ[h * 64 + i] = (bf16_t)f2bf(x1 * c2 - x2 * s2); IQ[h * 64 + 32 + i] = (bf16_t)f2bf(x2 * c2 + x1 * s2); }
    if (l < 32) { const float x1 = bf2f(MS[32 + l]), x2 = bf2f(MS[64 + l]); bf16_t* ki = (bf16_t*)(F.ws + WS_KIR) + (size_t)t * 64;
        ki[l] = (bf16_t)f2bf(x1 * c2 - x2 * s2); ki[32 + l] = (bf16_t)f2bf(x2 * c2 + x1 * s2); }
    { bf16_t* vb = (bf16_t*)(F.ws + WS_VB) + (size_t)t * 128; vb[l] = MS[256 + l]; vb[64 + l] = MS[320 + l]; }
    if (l < 16) ((float*)(F.ws + WS_IW))[(size_t)t * 16 + l] = bf2f(MS[16 + l]) * 0.03125f;
}
constexpr int GLP = 264, GLV = 520;
__device__ __forceinline__ void gla_prep_item(const Frame& F, const Args& a, int item) {
    const int lane_ = lane_id(), tid_ = F.wave * 64 + lane_; (void)tid_;
    const int c = item >> 2, h = item & 3, t0 = c * 64, tid = tid_;
    LAS bf16_t* sQ = (LAS bf16_t*)F.lds; LAS bf16_t* sK = sQ + 64 * GLP; LAS bf16_t* sV = sK + 64 * GLP; LAS float* sG = (LAS float*)(sV + 64 * GLV);
    const bf16_t* GQK = (const bf16_t*)(F.ws + WS_GQK); const bf16_t* MS = (const bf16_t*)(F.ws + WS_MISC); const bf16_t* GV = (const bf16_t*)(F.ws + WS_GV);
    { u32x4 qv[4], kv[4], vv[8];
#pragma unroll
      for (int i = 0; i < 4; ++i) { const int ch = tid + 512 * i, row = ch >> 5, c16 = ch & 31; const bf16_t* p = GQK + (size_t)(t0 + row) * DM + h * 256 + c16 * 8; qv[i] = *(const u32x4*)p; kv[i] = *(const u32x4*)(p + 1024); }
#pragma unroll
      for (int i = 0; i < 8; ++i) { const int ch = tid + 512 * i, row = ch >> 6, c16 = ch & 63; vv[i] = *(const u32x4*)(GV + (size_t)(t0 + row) * DM + h * 512 + c16 * 8); }
      for (int i = tid; i < 64 * 16; i += NTHREADS) sG[i] = bf2f(MS[(size_t)(t0 + (i >> 4)) * MISC_LD + (i & 15)]);
#pragma unroll
      for (int i = 0; i < 4; ++i) { const int ch = tid + 512 * i, row = ch >> 5, c16 = ch & 31; *(LAS u32x4*)(sQ + row * GLP + c16 * 8) = qv[i]; *(LAS u32x4*)(sK + row * GLP + c16 * 8) = kv[i]; }
#pragma unroll
      for (int i = 0; i < 8; ++i) { const int ch = tid + 512 * i, row = ch >> 6, c16 = ch & 63; *(LAS u32x4*)(sV + row * GLV + c16 * 8) = vv[i]; } }
    __syncthreads();
    if (tid < 256) {
        const int d = tid, col = h * 256 + d;
        float w2c[16];
#pragma unroll
        for (int r = 0; r < 16; ++r) w2c[r] = a.in[5][r * 1024 + col];
        const float bias = a.in[6][col];
        bf16_t* QT = (bf16_t*)(F.ws + WS_QT);
        float b = 0.f;
#pragma unroll 4
        for (int j = 0; j < 64; ++j) {
            float z = bias;
#pragma unroll
            for (int r = 0; r < 16; ++r) z = fmaf(sG[j * 16 + r], w2c[r], z);
            const float ls = fminf(z, 0.f) - log1pf(__expf(-fabsf(z)));
            b += ls * (1.f / 16.f);
            const float q = bf2f(sQ[j * GLP + d]), k = bf2f(sK[j * GLP + d]);
            const float eb = __expf(b);
            const unsigned qb = f2bf(q * 0.0625f * eb), kb = f2bf(k / eb);
            QT[(size_t)(t0 + j) * 1024 + col] = (bf16_t)qb; sQ[j * GLP + d] = (bf16_t)qb; sK[j * GLP + d] = (bf16_t)kb;
        }
        const float eL = __expf(b);
        ((float*)(F.ws + WS_DVEC))[c * 1024 + col] = eL;
        bf16_t* KH = (bf16_t*)(F.ws + WS_KHT) + ((size_t)item * 256 + d) * 64;
#pragma unroll
        for (int j8 = 0; j8 < 8; ++j8) { u32x4 w;
            w.x = pk2(bf2f(sK[(j8 * 8 + 0) * GLP + d]) * eL, bf2f(sK[(j8 * 8 + 1) * GLP + d]) * eL); w.y = pk2(bf2f(sK[(j8 * 8 + 2) * GLP + d]) * eL, bf2f(sK[(j8 * 8 + 3) * GLP + d]) * eL);
            w.z = pk2(bf2f(sK[(j8 * 8 + 4) * GLP + d]) * eL, bf2f(sK[(j8 * 8 + 5) * GLP + d]) * eL); w.w = pk2(bf2f(sK[(j8 * 8 + 6) * GLP + d]) * eL, bf2f(sK[(j8 * 8 + 7) * GLP + d]) * eL);
            *(u32x4*)(KH + j8 * 8) = w; }
    } else {
#pragma unroll 1
        for (int i = 0; i < 2; ++i) { const int e = (tid - 256) + 256 * i; bf16_t* VT = (bf16_t*)(F.ws + WS_VT) + ((size_t)item * 512 + e) * 64;
#pragma unroll
            for (int j8 = 0; j8 < 8; ++j8) { unsigned short v[8];
#pragma unroll
                for (int j = 0; j < 8; ++j) v[j] = sV[(j8 * 8 + j) * GLV + e];
                u32x4 w; w.x = v[0] | ((unsigned)v[1] << 16); w.y = v[2] | ((unsigned)v[3] << 16); w.z = v[4] | ((unsigned)v[5] << 16); w.w = v[6] | ((unsigned)v[7] << 16);
                *(u32x4*)(VT + j8 * 8) = w; } }
    }
    __syncthreads();
    { const int fr = lane_ & 15, fq = lane_ >> 4; bf16_t* AT = (bf16_t*)(F.ws + WS_ATT) + (size_t)item * 4096;
#pragma unroll
      for (int tt = 0; tt < 2; ++tt) { const int tile = F.wave * 2 + tt, ti = tile >> 2, tj = tile & 3; f32x4 acc = (f32x4){0.f, 0.f, 0.f, 0.f};
          if (tj <= ti) {
#pragma unroll
              for (int k0 = 0; k0 < 256; k0 += 32) { const bf16x8 av = *(const LAS bf16x8*)(sQ + (16 * ti + fr) * GLP + k0 + 8 * fq), bv = *(const LAS bf16x8*)(sK + (16 * tj + fr) * GLP + k0 + 8 * fq);
                  acc = __builtin_amdgcn_mfma_f32_16x16x32_bf16(av, bv, acc, 0, 0, 0); } }
          MFMA_FENCE1(acc);
#pragma unroll
          for (int r = 0; r < 4; ++r) { const int i = 16 * ti + 4 * fq + r, j = 16 * tj + fr; AT[i * 64 + j] = (bf16_t)f2bf(j <= i ? acc[r] : 0.f); } } }
    __syncthreads();
}

__device__ __forceinline__ float relu_(float x) { const int i = __builtin_bit_cast(int, x); return __builtin_bit_cast(float, i > 0 ? i : 0); }
constexpr int SC_ITEMS = 1088;
__device__ __forceinline__ void scores_item(const Frame& F, int item) {
    const int lane_ = lane_id(), tid_ = F.wave * 64 + lane_; (void)tid_;
    int gq = 0, rem = item;
    while (rem >= 8 * (gq + 1)) { rem -= 8 * (gq + 1); ++gq; }
    const int qb = gq * 8 + rem / (gq + 1), kc = rem % (gq + 1);
    const int fr = lane_ & 15, fq = lane_ >> 4, tq0 = qb * 64 + F.wave * 8;
    const bf16_t* IQ = (const bf16_t*)(F.ws + WS_IQ); const bf16_t* KI = (const bf16_t*)(F.ws + WS_KIR); const float* IW = (const float*)(F.ws + WS_IW);
    unsigned short* SC = (unsigned short*)(F.ws + WS_SCORES);
    bf16x8 aq[2][4][2]; f32x4 wq[2][4];
#pragma unroll
    for (int G = 0; G < 2; ++G)
#pragma unroll
        for (int j = 0; j < 4; ++j) { const bf16_t* p = IQ + (size_t)(tq0 + 4 * G + (fr >> 2)) * 1024 + (4 * j + (fr & 3)) * 64 + 8 * fq; aq[G][j][0] = *(const bf16x8*)p; aq[G][j][1] = *(const bf16x8*)(p + 32);
            wq[G][j] = *(const f32x4*)(IW + (size_t)(tq0 + 4 * G + fq) * 16 + 4 * j); }
    for (int g4 = 0; g4 < 8; ++g4) {
        const int key0 = kc * 512 + g4 * 64;
        bf16x8 bk[4][2];
#pragma unroll
        for (int kt = 0; kt < 4; ++kt) { const bf16_t* kp = KI + (size_t)(key0 + 4 * fr + kt) * 64 + 8 * fq; bk[kt][0] = *(const bf16x8*)kp; bk[kt][1] = *(const bf16x8*)(kp + 32); }
#pragma unroll
        for (int G = 0; G < 2; ++G) { float sv[4];
#pragma unroll
            for (int kt = 0; kt < 4; ++kt) { float s0 = 0.f, s1 = 0.f; f32x4 acc[4];
#pragma unroll
                for (int j = 0; j < 4; ++j) { acc[j] = __builtin_amdgcn_mfma_f32_16x16x32_bf16(aq[G][j][0], bk[kt][0], (f32x4){0.f, 0.f, 0.f, 0.f}, 0, 0, 0); acc[j] = __builtin_amdgcn_mfma_f32_16x16x32_bf16(aq[G][j][1], bk[kt][1], acc[j], 0, 0, 0); }
                MFMA_FENCE4(acc[0], acc[1], acc[2], acc[3]);
#pragma unroll
                for (int j = 0; j < 4; ++j) { s0 = fmaf(relu_(acc[j][0]), wq[G][j][0], s0); s1 = fmaf(relu_(acc[j][1]), wq[G][j][1], s1); s0 = fmaf(relu_(acc[j][2]), wq[G][j][2], s0); s1 = fmaf(relu_(acc[j][3]), wq[G][j][3], s1); }
                sv[kt] = s0 + s1; }
            const _Float16 h0 = (_Float16)sv[0], h1 = (_Float16)sv[1], h2 = (_Float16)sv[2], h3 = (_Float16)sv[3];
            u32x2 w; w.x = (unsigned)__builtin_bit_cast(unsigned short, h0) | ((unsigned)__builtin_bit_cast(unsigned short, h1) << 16); w.y = (unsigned)__builtin_bit_cast(unsigned short, h2) | ((unsigned)__builtin_bit_cast(unsigned short, h3) << 16);
            *(u32x2*)(SC + (size_t)(tq0 + 4 * G + fq) * SEQ + key0 + 4 * fr) = w; }
    }
}

__device__ __forceinline__ unsigned h16key(unsigned h) { return (h & 0x8000u) ? (~h & 0xffffu) : (h | 0x8000u); }
typedef unsigned short u16x2 __attribute__((ext_vector_type(2)));
__device__ __forceinline__ int wave_sum_dpp(int v) {
    v += __builtin_amdgcn_update_dpp(0, v, 0x111, 0xf, 0xf, true);
    v += __builtin_amdgcn_update_dpp(0, v, 0x112, 0xf, 0xf, true);
    v += __builtin_amdgcn_update_dpp(0, v, 0x114, 0xf, 0xf, true);
    v += __builtin_amdgcn_update_dpp(0, v, 0x118, 0xf, 0xf, true);
    v += __builtin_amdgcn_update_dpp(0, v, 0x142, 0xa, 0xf, false);
    v += __builtin_amdgcn_update_dpp(0, v, 0x143, 0xc, 0xf, false);
    return __builtin_amdgcn_readlane(v, 63);
}
constexpr int SEL_LDS_OFF = 137216;
typedef short s16x2 __attribute__((ext_vector_type(2)));
__device__ __forceinline__ int cnt_ge(const unsigned (&kk)[64], unsigned c, int nch) {
    const unsigned cm1 = (c - 1u) * 0x00010001u, one = 0x00010001u; unsigned a0 = 0u, a1 = 0u, a2 = 0u, a3 = 0u;
#pragma unroll
    for (int i = 0; i < 16; ++i) if (i < nch) { const int r = 4 * i; unsigned t0, t1, t2, t3;
        asm("v_pk_sub_u16 %0, %8, %12 clamp\n\tv_pk_sub_u16 %1, %9, %12 clamp\n\tv_pk_sub_u16 %2, %10, %12 clamp\n\tv_pk_sub_u16 %3, %11, %12 clamp\n\t"
            "v_pk_min_u16 %0, %0, %13\n\tv_pk_min_u16 %1, %1, %13\n\tv_pk_min_u16 %2, %2, %13\n\tv_pk_min_u16 %3, %3, %13\n\t"
            "v_pk_add_u16 %4, %4, %0\n\tv_pk_add_u16 %5, %5, %1\n\tv_pk_add_u16 %6, %6, %2\n\tv_pk_add_u16 %7, %7, %3"
            : "=&v"(t0), "=&v"(t1), "=&v"(t2), "=&v"(t3), "+v"(a0), "+v"(a1), "+v"(a2), "+v"(a3) : "v"(kk[r]), "v"(kk[r + 1]), "v"(kk[r + 2]), "v"(kk[r + 3]), "v"(cm1), "v"(one)); }
    const unsigned acc = a0 + a1 + a2 + a3;
    return (int)(acc & 0xffffu) + (int)(acc >> 16);
}
__device__ __forceinline__ void select_row(const Frame& F, int t) {
    const int lane_ = lane_id();
    LAS int* SEL = (LAS int*)(F.lds + SEL_LDS_OFF) + F.wave * 256; const int l = lane_;
    if (t < 256) {
#pragma unroll
        for (int i = 0; i < 4; ++i) { const int j = i * 64 + l; SEL[j] = (j <= t) ? j : 0; }
        return;
    }
    const unsigned short* SC = (const unsigned short*)(F.ws + WS_SCORES) + (size_t)t * SEQ;
    const int nch = (t >> 9) + 1;
    unsigned kk[64];
    u32x4 raw[16];
#pragma unroll
    for (int i = 0; i < 16; ++i) { const int ic = i < nch ? i : nch - 1; raw[i] = *(const u32x4*)(SC + (ic * 64 + l) * 8); }
#pragma unroll
    for (int i = 0; i < 16; ++i) {
#pragma unroll
        for (int w = 0; w < 4; ++w) { const unsigned x = raw[i][w]; const s16x2 m = __builtin_bit_cast(s16x2, x) >> (s16x2){15, 15};
            kk[i * 4 + w] = x ^ (__builtin_bit_cast(unsigned, m) | 0x80008000u); }
        if (i == nch - 1) { const int s0 = (i * 64 + l) * 8;
#pragma unroll
            for (int w = 0; w < 4; ++w) { if (s0 + 2 * w > t) kk[i * 4 + w] &= 0xffff0000u; if (s0 + 2 * w + 1 > t) kk[i * 4 + w] &= 0x0000ffffu; } } }
    unsigned T = 0u;
    for (int bit = 15; bit >= 0; --bit) { const unsigned cand = T | (1u << bit); const int cnt = wave_sum_dpp(cnt_ge(kk, cand, nch));
        if (cnt >= 256) T = cand; }
    const int nge = cnt_ge(kk, T, nch); const int ngt = (T < 0xffffu) ? cnt_ge(kk, T + 1u, nch) : 0; const int neq = nge - ngt;
    int pg = ngt, pe = neq;
#pragma unroll
    for (int o = 1; o < 64; o <<= 1) { const int a = __shfl_up(pg, o), b = __shfl_up(pe, o); if (l >= o) { pg += a; pe += b; } }
    const int totgt = __shfl(pg, 63); pg -= ngt; pe -= neq;
    const int need = 256 - totgt; int mytake = need - pe; mytake = mytake < 0 ? 0 : (mytake > neq ? neq : mytake);
    int off = pg + (pe < need ? pe : need), tk = 0;
#pragma unroll
    for (int r = 0; r < 64; ++r) if ((r >> 2) < nch) {
#pragma unroll
        for (int hf = 0; hf < 2; ++hf) { const unsigned key = hf ? (kk[r] >> 16) : (kk[r] & 0xffffu); const int s = ((r >> 2) * 64 + l) * 8 + (r & 3) * 2 + hf;
            const bool eq = (key == T); const bool take = (key > T) || (eq && tk < mytake);
            if (take && off < 256) SEL[off] = s;
            off += take ? 1 : 0; tk += eq ? 1 : 0; } }
}

constexpr int SP_PP = 264;
constexpr int SP_VP = 136;
constexpr int SP_WAVE_BYTES = 16 * SP_PP * 2 + 32 * SP_VP * 2;
__device__ __forceinline__ s16x4 tr_read4(unsigned lds_addr) { s16x4 r; asm volatile("ds_read_b64_tr_b16 %0, %1\n\ts_waitcnt lgkmcnt(0)" : "=&v"(r) : "v"(lds_addr) : "memory"); return r; }
__device__ __forceinline__ void sparse_attn_query(const Frame& F, int t) {
    const int lane_ = lane_id(), tid_ = F.wave * 64 + lane_; (void)tid_;
    const int l = lane_, fr = l & 15, fq = l >> 4;
    LAS unsigned char* wl = F.lds + F.wave * SP_WAVE_BYTES; LAS bf16_t* sP = (LAS bf16_t*)wl; LAS bf16_t* sV = (LAS bf16_t*)(wl + 16 * SP_PP * 2);
    const bf16_t* Q = (const bf16_t*)(F.ws + WS_DQ) + (size_t)t * DM; bf16_t* OB = (bf16_t*)(F.ws + WS_OB) + (size_t)t * DM; const bf16_t* KB = (const bf16_t*)(F.ws + WS_KBR); const bf16_t* VB = (const bf16_t*)(F.ws + WS_VB);
    const LAS int* SEL = (const LAS int*)(F.lds + SEL_LDS_OFF) + F.wave * 256; const int nvalid = t < 255 ? t + 1 : 256;
    LDS_WAIT();
    bf16x8 aq[4];
#pragma unroll
    for (int ks = 0; ks < 4; ++ks) aq[ks] = *(const bf16x8*)(Q + fr * 128 + ks * 32 + 8 * fq);
    u32x4 vr[8];
#pragma unroll
    for (int i = 0; i < 8; ++i) { const int p = i * 64 + l, row = p >> 4, ch = p & 15; vr[i] = *(const u32x4*)(VB + (size_t)SEL[row] * 128 + ch * 8); }
    f32x4 sc[16]; bf16x8 k0[4], k1[4];
#define SPA_KLOAD(dst, kt) do { const bf16_t* kp_ = KB + (size_t)SEL[(kt) * 16 + fr] * 128 + 8 * fq; _Pragma("unroll") for (int ks = 0; ks < 4; ++ks) dst[ks] = *(const bf16x8*)(kp_ + ks * 32); } while (0)
#define SPA_KMUL(src, kt) do { f32x4 acc_ = (f32x4){0.f, 0.f, 0.f, 0.f}; _Pragma("unroll") for (int ks = 0; ks < 4; ++ks) acc_ = __builtin_amdgcn_mfma_f32_16x16x32_bf16(aq[ks], src[ks], acc_, 0, 0, 0); MFMA_FENCE1(acc_); \
        const bool ok_ = ((kt) * 16 + fr) < nvalid; _Pragma("unroll") for (int r = 0; r < 4; ++r) acc_[r] = ok_ ? acc_[r] * 0.08838834764831845f : -3.0e38f; sc[kt] = acc_; } while (0)
    SPA_KLOAD(k0, 0);
#pragma unroll
    for (int kt = 0; kt < 16; kt += 2) { SPA_KLOAD(k1, kt + 1); SPA_KMUL(k0, kt); if (kt + 2 < 16) SPA_KLOAD(k0, kt + 2); SPA_KMUL(k1, kt + 1); }
#undef SPA_KLOAD
#undef SPA_KMUL
    f32x4 mx = sc[0];
#pragma unroll
    for (int kt = 1; kt < 16; ++kt)
#pragma unroll
        for (int r = 0; r < 4; ++r) mx[r] = fmaxf(mx[r], sc[kt][r]);
#pragma unroll
    for (int o = 1; o < 16; o <<= 1)
#pragma unroll
        for (int r = 0; r < 4; ++r) mx[r] = fmaxf(mx[r], __shfl_xor(mx[r], o));
    f32x4 sm = (f32x4){0.f, 0.f, 0.f, 0.f};
#pragma unroll
    for (int kt = 0; kt < 16; ++kt)
#pragma unroll
        for (int r = 0; r < 4; ++r) { const float e = __expf(sc[kt][r] - mx[r]); sc[kt][r] = e; sm[r] += e; }
#pragma unroll
    for (int o = 1; o < 16; o <<= 1)
#pragma unroll
        for (int r = 0; r < 4; ++r) sm[r] += __shfl_xor(sm[r], o);
#pragma unroll
    for (int r = 0; r < 4; ++r) sm[r] = 1.f / sm[r];
#pragma unroll
    for (int kt = 0; kt < 16; ++kt)
#pragma unroll
        for (int r = 0; r < 4; ++r) sP[(4 * fq + r) * SP_PP + kt * 16 + fr] = (bf16_t)f2bf(sc[kt][r] * sm[r]);
    f32x4 o[8];
#pragma unroll
    for (int nt = 0; nt < 8; ++nt) o[nt] = (f32x4){0.f, 0.f, 0.f, 0.f};
    const unsigned tbase = (unsigned)(size_t)sV + (unsigned)(((8 * fq + (fr >> 2)) * SP_VP + 4 * (fr & 3)) * 2);
    for (int kst = 0; kst < 8; ++kst) {
#pragma unroll
        for (int i = 0; i < 8; ++i) { const int p = i * 64 + l, row = p >> 4, ch = p & 15; *(LAS u32x4*)(sV + row * SP_VP + ch * 8) = vr[i]; }
        if (kst < 7) {
#pragma unroll
            for (int i = 0; i < 8; ++i) { const int p = i * 64 + l, row = p >> 4, ch = p & 15; vr[i] = *(const u32x4*)(VB + (size_t)SEL[(kst + 1) * 32 + row] * 128 + ch * 8); } }
        const bf16x8 pa = *(const LAS bf16x8*)(sP + fr * SP_PP + kst * 32 + 8 * fq);
        LDS_WAIT(); __builtin_amdgcn_sched_barrier(0);
        s16x4 lo[8], hi[8];
        asm volatile("ds_read_b64_tr_b16 %0, %16\n\tds_read_b64_tr_b16 %1, %16 offset:32\n\tds_read_b64_tr_b16 %2, %16 offset:64\n\tds_read_b64_tr_b16 %3, %16 offset:96\n\t"
                     "ds_read_b64_tr_b16 %4, %16 offset:128\n\tds_read_b64_tr_b16 %5, %16 offset:160\n\tds_read_b64_tr_b16 %6, %16 offset:192\n\tds_read_b64_tr_b16 %7, %16 offset:224\n\t"
                     "ds_read_b64_tr_b16 %8, %16 offset:1088\n\tds_read_b64_tr_b16 %9, %16 offset:1120\n\tds_read_b64_tr_b16 %10, %16 offset:1152\n\tds_read_b64_tr_b16 %11, %16 offset:1184\n\t"
                     "ds_read_b64_tr_b16 %12, %16 offset:1216\n\tds_read_b64_tr_b16 %13, %16 offset:1248\n\tds_read_b64_tr_b16 %14, %16 offset:1280\n\tds_read_b64_tr_b16 %15, %16 offset:1312\n\ts_waitcnt lgkmcnt(0)"
                     : "=&v"(lo[0]), "=&v"(lo[1]), "=&v"(lo[2]), "=&v"(lo[3]), "=&v"(lo[4]), "=&v"(lo[5]), "=&v"(lo[6]), "=&v"(lo[7]),
                       "=&v"(hi[0]), "=&v"(hi[1]), "=&v"(hi[2]), "=&v"(hi[3]), "=&v"(hi[4]), "=&v"(hi[5]), "=&v"(hi[6]), "=&v"(hi[7]) : "v"(tbase) : "memory");
        __builtin_amdgcn_sched_barrier(0);
#pragma unroll
        for (int nt = 0; nt < 8; ++nt) { bf16x8 bv; bv[0] = lo[nt][0]; bv[1] = lo[nt][1]; bv[2] = lo[nt][2]; bv[3] = lo[nt][3]; bv[4] = hi[nt][0]; bv[5] = hi[nt][1]; bv[6] = hi[nt][2]; bv[7] = hi[nt][3];
            o[nt] = __builtin_amdgcn_mfma_f32_16x16x32_bf16(pa, bv, o[nt], 0, 0, 0); }
        __builtin_amdgcn_sched_barrier(0);
    }
    MFMA_FENCE8(o[0], o[1], o[2], o[3], o[4], o[5], o[6], o[7]);
#pragma unroll
    for (int nt = 0; nt < 8; ++nt)
#pragma unroll
        for (int r = 0; r < 4; ++r) OB[(4 * fq + r) * 128 + 16 * nt + fr] = (bf16_t)f2bf(o[nt][r]);
}

__device__ __forceinline__ void gla_level1_item(const Frame& F, int item) {
    const int lane_ = lane_id(), tid_ = F.wave * 64 + lane_; (void)tid_;
    const int fr = lane_ & 15, fq = lane_ >> 4;
    const bf16_t* KH = (const bf16_t*)(F.ws + WS_KHT) + (size_t)item * 256 * 64; const bf16_t* VT = (const bf16_t*)(F.ws + WS_VT) + ((size_t)item * 512 + F.wave * 64) * 64;
    bf16_t* ST = (bf16_t*)(F.ws + WS_ST) + ((size_t)item * 512 + F.wave * 64) * 256;
    for (int db = 0; db < 4; ++db) {
        f32x4 acc[4][4];
#pragma unroll
        for (int i = 0; i < 4; ++i)
#pragma unroll
            for (int j = 0; j < 4; ++j) acc[i][j] = (f32x4){0.f, 0.f, 0.f, 0.f};
        wave_gemm_nt<4, 4>(KH + (size_t)db * 64 * 64, 64, VT, 64, 64, acc, fr, fq);
#pragma unroll
        for (int mt = 0; mt < 4; ++mt)
#pragma unroll
            for (int nt = 0; nt < 4; ++nt) { u32x2 w; w.x = pk2(acc[mt][nt][0], acc[mt][nt][1]); w.y = pk2(acc[mt][nt][2], acc[mt][nt][3]);
                *(u32x2*)(ST + (size_t)(16 * nt + fr) * 256 + db * 64 + 16 * mt + 4 * fq) = w; }
    }
}
__device__ __forceinline__ void gla_state_item(const Frame& F, int item) {
    const int lane_ = lane_id(), fr = lane_ & 15, fq = lane_ >> 4;
    const int h = item >> 6, eb = (item >> 1) & 31, d0 = (item & 1) * 128 + F.wave * 16;
    const bf16_t* KH = (const bf16_t*)(F.ws + WS_KHT) + ((size_t)h * 256 + d0 + fr) * 64 + 8 * fq;
    const bf16_t* VT = (const bf16_t*)(F.ws + WS_VT) + ((size_t)h * 512 + eb * 16 + fr) * 64 + 8 * fq;
    bf16_t* ST = (bf16_t*)(F.ws + WS_ST) + ((size_t)h * 512 + eb * 16 + fr) * 256 + d0 + 4 * fq;
    const float* DV = (const float*)(F.ws + WS_DVEC) + h * 256 + d0 + 4 * fq;
    f32x4 S = (f32x4){0.f, 0.f, 0.f, 0.f};
#define GST_LOAD(a, b, dv, cbase) do { _Pragma("unroll") for (int i = 0; i < 4; ++i) { const size_t c = (cbase) + i; const bf16_t* kp = KH + c * (4 * 256 * 64); const bf16_t* vp = VT + c * (4 * 512 * 64); \
        a[i][0] = *(const bf16x8*)kp; a[i][1] = *(const bf16x8*)(kp + 32); b[i][0] = *(const bf16x8*)vp; b[i][1] = *(const bf16x8*)(vp + 32); dv[i] = *(const f32x4*)(DV + c * 1024); } } while (0)
#define GST_STEP(a, b, dv, cbase) do { _Pragma("unroll") for (int i = 0; i < 4; ++i) { const size_t c = (cbase) + i; \
        f32x4 L = __builtin_amdgcn_mfma_f32_16x16x32_bf16(a[i][0], b[i][0], (f32x4){0.f, 0.f, 0.f, 0.f}, 0, 0, 0); L = __builtin_amdgcn_mfma_f32_16x16x32_bf16(a[i][1], b[i][1], L, 0, 0, 0); MFMA_FENCE1(L); \
        u32x2 w; w.x = pk2(S[0], S[1]); w.y = pk2(S[2], S[3]); *(u32x2*)(ST + c * (4 * 512 * 256)) = w; S = dv[i] * S + L; } } while (0)
    bf16x8 a0[4][2], b0[4][2], a1[4][2], b1[4][2]; f32x4 dv0[4], dv1[4];
    GST_LOAD(a0, b0, dv0, 0);
    for (int c0 = 0; c0 < 128; c0 += 8) {
        GST_LOAD(a1, b1, dv1, c0 + 4);
        GST_STEP(a0, b0, dv0, c0);
        if (c0 + 8 < 128) GST_LOAD(a0, b0, dv0, c0 + 8);
        GST_STEP(a1, b1, dv1, c0 + 4);
    }
#undef GST_LOAD
#undef GST_STEP
}
__device__ __forceinline__ void gla_out_item(const Frame& F, const Args& a, int item) {
    const int lane_ = lane_id(), tid_ = F.wave * 64 + lane_; (void)tid_;
    const int c = item >> 2, h = item & 3, t0 = c * 64, fr = lane_ & 15, fq = lane_ >> 4, w = F.wave;
    LAS float* sred = (LAS float*)F.lds;
    f32x4 acc[4][4];
#pragma unroll
    for (int i = 0; i < 4; ++i)
#pragma unroll
        for (int j = 0; j < 4; ++j) acc[i][j] = (f32x4){0.f, 0.f, 0.f, 0.f};
    wave_gemm_nt<4, 4>((const bf16_t*)(F.ws + WS_ST) + ((size_t)item * 512 + w * 64) * 256, 256, (const bf16_t*)(F.ws + WS_QT) + (size_t)t0 * 1024 + h * 256, 1024, 256, acc, fr, fq);
    wave_gemm_nt<4, 4>((const bf16_t*)(F.ws + WS_VT) + ((size_t)item * 512 + w * 64) * 64, 64, (const bf16_t*)(F.ws + WS_ATT) + (size_t)item * 4096, 64, 64, acc, fr, fq);
#pragma unroll
    for (int mt = 0; mt < 4; ++mt) MFMA_FENCE4(acc[mt][0], acc[mt][1], acc[mt][2], acc[mt][3]);
    float ss[4];
#pragma unroll
    for (int nt = 0; nt < 4; ++nt) { float s = 0.f;
#pragma unroll
        for (int mt = 0; mt < 4; ++mt) s += (acc[mt][nt][0] * acc[mt][nt][0] + acc[mt][nt][1] * acc[mt][nt][1]) + (acc[mt][nt][2] * acc[mt][nt][2] + acc[mt][nt][3] * acc[mt][nt][3]);
        s += __shfl_xor(s, 16); s += __shfl_xor(s, 32); ss[nt] = s;
        if (fq == 0) sred[w * 64 + 16 * nt + fr] = s; }
    __syncthreads();
    const bf16_t* GR = (const bf16_t*)(F.ws + WS_GR); bf16_t* OA = (bf16_t*)(F.ws + WS_OA); const float* gain = a.in[7] + h * 512;
#pragma unroll
    for (int nt = 0; nt < 4; ++nt) { const int tok = 16 * nt + fr; float tot = 0.f;
#pragma unroll
        for (int ww = 0; ww < 8; ++ww) tot += sred[ww * 64 + tok];
        const float rstd = rsqrtf(tot * (1.f / 512.f) + EPS);
#pragma unroll
        for (int mt = 0; mt < 4; ++mt) { const int e = w * 64 + 16 * mt + 4 * fq; const size_t off = (size_t)(t0 + tok) * DM + h * 512 + e;
            const u32x2 g = *(const u32x2*)(GR + off); const f32x4 gn = *(const f32x4*)(gain + e);
            const float r0 = bflo(g.x), r1 = bfhi(g.x), r2 = bflo(g.y), r3 = bfhi(g.y);
            u32x2 o; o.x = pk2(acc[mt][nt][0] * rstd * gn[0] * r0 * sigmoidf_(r0), acc[mt][nt][1] * rstd * gn[1] * r1 * sigmoidf_(r1));
            o.y = pk2(acc[mt][nt][2] * rstd * gn[2] * r2 * sigmoidf_(r2), acc[mt][nt][3] * rstd * gn[3] * r3 * sigmoidf_(r3));
            *(u32x2*)(OA + off) = o; } }
    __syncthreads();
}

__device__ const unsigned char PEER_CAND[52] = {
    0x00,0x01,0x02,0x03,0x04,0x05,0x06,0x07,0x08,0x09,0x0a,0x0b,0x0c,0x0d,0x0e,0x0f, 0x10,0x11,0x12,0x13,0x14,0x15,0x16,0x17, 0x20,0x21,0x22,0x23,0x24, 0x30,0x31,0x32,0x33,
    0x40,0x41,0x42, 0x50,0x51, 0x60,0x61, 0x70,0x71, 0x80,0x90,0xa0,0xb0,0xc0,0xd0,0xe0,0xf0, 0xff,0xff };
__device__ __forceinline__ unsigned f32ord(float f) { const unsigned u = __builtin_bit_cast(unsigned, f); return (u & 0x80000000u) ? ~u : (u | 0x80000000u); }
__device__ __forceinline__ float ordf32(unsigned k) { const unsigned u = (k & 0x80000000u) ? (k & 0x7fffffffu) : ~k; return __builtin_bit_cast(float, u); }
__device__ __forceinline__ unsigned umax_x32(unsigned v) { const unsigned o = __shfl_xor(v, 32); return v > o ? v : o; }
__device__ __forceinline__ float fmax_x32(float v) { return fmaxf(v, __shfl_xor(v, 32)); }
__device__ __forceinline__ float fadd_x32(float v) { return v + __shfl_xor(v, 32); }
__device__ __forceinline__ void peer_select_item(const Frame& F, int item) {
    const int lane_ = lane_id(), tid_ = F.wave * 64 + lane_; (void)tid_;
    const int l = lane_, fr = l & 15, fq = l >> 4, t0 = (item >> 3) * 16, h = item & 7;
    LAS unsigned* tv = (LAS unsigned*)(F.lds + F.wave * 2048);
    const bf16_t* PQ = (const bf16_t*)(F.ws + WS_PQ); const bf16_t* KEYS = (const bf16_t*)(F.ws + WS_KEYS);
    int* EXPI = (int*)(F.ws + WS_EXPI); float* GATEW = (float*)(F.ws + WS_GATEW);
    {
#pragma unroll 1
        for (int p = 0; p < 2; ++p) { const int g = h * 2 + p;
            f32x4 acc[8];
#pragma unroll
            for (int mt = 0; mt < 8; ++mt) acc[mt] = (f32x4){0.f, 0.f, 0.f, 0.f};
#pragma unroll
            for (int ks = 0; ks < 4; ++ks) { const bf16x8 bq = *(const bf16x8*)(PQ + (size_t)(t0 + fr) * DM + g * 128 + ks * 32 + 8 * fq);
#pragma unroll
                for (int mt = 0; mt < 8; ++mt) acc[mt] = __builtin_amdgcn_mfma_f32_16x16x32_bf16(*(const bf16x8*)(KEYS + ((size_t)g * 128 + 16 * mt + fr) * 128 + ks * 32 + 8 * fq), bq, acc[mt], 0, 0, 0); }
            MFMA_FENCE8(acc[0], acc[1], acc[2], acc[3], acc[4], acc[5], acc[6], acc[7]);
            unsigned kk[32];
#pragma unroll
            for (int mt = 0; mt < 8; ++mt)
#pragma unroll
                for (int r = 0; r < 4; ++r) kk[mt * 4 + r] = (f32ord(acc[mt][r]) & ~127u) | (unsigned)(127 - (16 * mt + 4 * fq + r));
#pragma unroll
            for (int i = 0; i < 16; ++i) { unsigned m = kk[0];
#pragma unroll
                for (int j = 1; j < 32; ++j) m = m > kk[j] ? m : kk[j];
                { const unsigned o = __shfl_xor(m, 16); m = m > o ? m : o; } m = umax_x32(m);
#pragma unroll
                for (int j = 0; j < 32; ++j) kk[j] = (kk[j] == m) ? 0u : kk[j];
                if (fq == (i & 3)) tv[(fr * 2 + p) * 16 + i] = m; }
        }
        LDS_WAIT();
        unsigned ck[13];
#pragma unroll
        for (int ci = 0; ci < 13; ++ci) { const int cidx = fq + 4 * ci; const unsigned ab = PEER_CAND[cidx];
            if (cidx < 50) { const float v = ordf32(tv[(fr * 2 + 0) * 16 + (ab >> 4)] & ~127u) + ordf32(tv[(fr * 2 + 1) * 16 + (ab & 15)] & ~127u); ck[ci] = (f32ord(v) & ~63u) | (unsigned)(63 - cidx); }
            else ck[ci] = 0u; }
        float scv[4]; int exv[4];
#pragma unroll
        for (int i = 0; i < 16; ++i) { unsigned m = ck[0];
#pragma unroll
            for (int j = 1; j < 13; ++j) m = m > ck[j] ? m : ck[j];
            { const unsigned o = __shfl_xor(m, 16); m = m > o ? m : o; } m = umax_x32(m);
#pragma unroll
            for (int j = 0; j < 13; ++j) ck[j] = (ck[j] == m) ? 0u : ck[j];
            if (fq == (i & 3)) { const int cidx = 63 - (int)(m & 63u); const unsigned ab = PEER_CAND[cidx];
                const int n1 = 127 - (int)(tv[(fr * 2 + 0) * 16 + (ab >> 4)] & 127u), n2 = 127 - (int)(tv[(fr * 2 + 1) * 16 + (ab & 15)] & 127u);
                exv[i >> 2] = n1 * 128 + n2; scv[i >> 2] = ordf32(m & ~63u); } }
        float mx = fmaxf(fmaxf(scv[0], scv[1]), fmaxf(scv[2], scv[3])); mx = fmaxf(mx, __shfl_xor(mx, 16)); mx = fmax_x32(mx);
        float ev[4], s = 0.f;
#pragma unroll
        for (int j = 0; j < 4; ++j) { ev[j] = __expf(scv[j] - mx); s += ev[j]; }
        s += __shfl_xor(s, 16); s = fadd_x32(s); const float inv = 1.f / s;
#pragma unroll
        for (int j = 0; j < 4; ++j) { const size_t o = (size_t)(t0 + fr) * 128 + h * 16 + j * 4 + fq; EXPI[o] = exv[j]; GATEW[o] = ev[j] * inv; }
        LDS_WAIT();
    }
}
__device__ __forceinline__ float gelu_tanh(float x) { const float u = 0.7978845608028654f * (x + 0.044715f * x * x * x); const float e = __expf(2.f * u); const float th = 1.f - 2.f / (e + 1.f); return 0.5f * x * (1.f + th); }
__device__ __forceinline__ void quant_row(const float* src, unsigned char* dst, float* scale_out, int lane, const float* cgain) {
    f32x4 v[8]; float mx = 0.f;
#pragma unroll
    for (int i = 0; i < 2; ++i)
#pragma unroll
        for (int j = 0; j < 4; ++j) { f32x4 x = *(const f32x4*)(src + i * 1024 + lane * 16 + j * 4); if (cgain) x *= *(const f32x4*)(cgain + i * 1024 + lane * 16 + j * 4); v[i * 4 + j] = x; mx = fmaxf(mx, fmaxf(fmaxf(fabsf(x[0]), fabsf(x[1])), fmaxf(fabsf(x[2]), fabsf(x[3])))); }
#pragma unroll
    for (int o = 1; o < 64; o <<= 1) mx = fmaxf(mx, __shfl_xor(mx, o));
    const float inv = mx > 0.f ? 127.f / mx : 0.f;
#pragma unroll
    for (int i = 0; i < 2; ++i) { u32x4 w;
#pragma unroll
        for (int j = 0; j < 4; ++j) { const f32x4 x = v[i * 4 + j];
            const unsigned b0 = (unsigned)(rintf(x[0] * inv) + 128.f), b1 = (unsigned)(rintf(x[1] * inv) + 128.f), b2 = (unsigned)(rintf(x[2] * inv) + 128.f), b3 = (unsigned)(rintf(x[3] * inv) + 128.f);
            w[j] = b0 | (b1 << 8) | (b2 << 16) | (b3 << 24); }
        *(u32x4*)(dst + i * 1024 + lane * 16) = w; }
    if (lane == 0) *scale_out = mx * (1.f / 127.f);
}
__device__ __forceinline__ float ub(unsigned w, int b) { return (float)((w >> (8 * b)) & 0xffu); }
__device__ __forceinline__ float dot16q(const u32x4 w, const float* x) {
    float s = 0.f;
#pragma unroll
    for (int k = 0; k < 4; ++k) { s = fmaf(ub(w[k], 0), x[4 * k + 0], s); s = fmaf(ub(w[k], 1), x[4 * k + 1], s); s = fmaf(ub(w[k], 2), x[4 * k + 2], s); s = fmaf(ub(w[k], 3), x[4 * k + 3], s); }
    return s;
}
__device__ __forceinline__ void axpy16q(const u32x4 w, float c, float* o) {
#pragma unroll
    for (int k = 0; k < 4; ++k) { o[4 * k + 0] = fmaf(c, ub(w[k], 0), o[4 * k + 0]); o[4 * k + 1] = fmaf(c, ub(w[k], 1), o[4 * k + 1]); o[4 * k + 2] = fmaf(c, ub(w[k], 2), o[4 * k + 2]); o[4 * k + 3] = fmaf(c, ub(w[k], 3), o[4 * k + 3]); }
}
__device__ __forceinline__ void peer_expert_token(const Frame& F, const Args& a, int t) {
    const int lane_ = lane_id(), tid_ = F.wave * 64 + lane_; (void)tid_;
    const int l = lane_;
    const unsigned char* UQ = (const unsigned char*)(F.ws + WS_UB); const unsigned char* VQ = UQ + 2048;
    const float* US = (const float*)(F.ws + WS_USC); const float* VS = (const float*)(F.ws + WS_VSC);
    const int* EXPI = (const int*)(F.ws + WS_EXPI) + (size_t)t * 128; const float* GATEW = (const float*)(F.ws + WS_GATEW) + (size_t)t * 128;
    const float rstd2 = rsqrtf(((const float*)(F.ws + WS_CTL))[CW_RSQ2 + t] * (1.f / DM) + EPS);
    float x[32], o[32]; float sumx = 0.f, csum = 0.f;
#pragma unroll
    for (int i = 0; i < 2; ++i)
#pragma unroll
        for (int hf = 0; hf < 2; ++hf) { const u32x4 w = *(const u32x4*)((const bf16_t*)(F.ws + WS_A2) + (size_t)t * DM + i * 1024 + l * 16 + hf * 8); float* xp = x + i * 16 + hf * 8;
            xp[0] = bflo(w.x); xp[1] = bfhi(w.x); xp[2] = bflo(w.y); xp[3] = bfhi(w.y); xp[4] = bflo(w.z); xp[5] = bfhi(w.z); xp[6] = bflo(w.w); xp[7] = bfhi(w.w); }
#pragma unroll
    for (int i = 0; i < 32; ++i) { o[i] = 0.f; sumx += x[i]; }
    sumx *= 128.f;
    for (int jb = 0; jb < 32; ++jb) {
        int e[4]; float g[4];
#pragma unroll
        for (int q = 0; q < 4; ++q) { e[q] = __builtin_amdgcn_readfirstlane(EXPI[jb * 4 + q]); g[q] = __builtin_bit_cast(float, __builtin_amdgcn_readfirstlane(__builtin_bit_cast(int, GATEW[jb * 4 + q]))); }
        u32x4 uw[4][2], vw[4][2];
#pragma unroll
        for (int q = 0; q < 4; ++q) { uw[q][0] = *(const u32x4*)(UQ + (size_t)e[q] * 4096 + l * 16); uw[q][1] = *(const u32x4*)(UQ + (size_t)e[q] * 4096 + 1024 + l * 16); }
#pragma unroll
        for (int q = 0; q < 4; ++q) { vw[q][0] = *(const u32x4*)(VQ + (size_t)e[q] * 4096 + l * 16); vw[q][1] = *(const u32x4*)(VQ + (size_t)e[q] * 4096 + 1024 + l * 16); }
        float d[4];
#pragma unroll
        for (int q = 0; q < 4; ++q) d[q] = dot16q(uw[q][0], x) + dot16q(uw[q][1], x + 16) - sumx;
#pragma unroll
        for (int o_ = 1; o_ < 64; o_ <<= 1) {
#pragma unroll
            for (int q = 0; q < 4; ++q) d[q] += __shfl_xor(d[q], o_); }
#pragma unroll
        for (int q = 0; q < 4; ++q) { const float c = g[q] * gelu_tanh(d[q] * US[e[q]] * rstd2) * VS[e[q]]; csum += c; axpy16q(vw[q][0], c, o); axpy16q(vw[q][1], c, o + 16); }
    }
    float* H = a.out + (size_t)t * DM; const float* gf = a.in[22]; float ss = 0.f; csum *= 128.f;
#pragma unroll
    for (int i = 0; i < 32; ++i) { const float v = o[i] - csum + x[i]; o[i] = v; ss += v * v; }
    const float rstd = rsqrtf(wave_sum(ss) * (1.f / DM) + EPS);
#pragma unroll
    for (int i = 0; i < 2; ++i)
#pragma unroll
        for (int j = 0; j < 4; ++j) { const f32x4 gv = *(const f32x4*)(gf + i * 1024 + l * 16 + j * 4); f32x4 r;
#pragma unroll
            for (int k = 0; k < 4; ++k) r[k] = o[i * 16 + j * 4 + k] * rstd * gv[k];
            *(f32x4*)(H + i * 1024 + l * 16 + j * 4) = r; }
}

constexpr int N_PHASES = 17;
constexpr int QSPLIT = 20480;
#ifndef DUP_MASK
#define DUP_MASK 0
#endif
#define DUPN(k) (1 + ((DUP_MASK >> (k)) & 1))
__global__ void __launch_bounds__(NTHREADS, 2) hybrid_fwd(Args args) {
    extern __shared__ __attribute__((aligned(16))) unsigned char lds_raw[];
    Frame F;
    F.lds = (LAS unsigned char*)lds_raw;
    F.wave = __builtin_amdgcn_readfirstlane((int)threadIdx.x >> 6);
    F.G = gridDim.x; F.bid = blockIdx.x; F.ws = args.ws;
    unsigned* ctl = (unsigned*)(args.ws + WS_CTL);
    volatile LAS unsigned* MISCW = (volatile LAS unsigned*)(F.lds + LDSCTL_OFF);
    if (F.wave == 0) MISCW[lane_id()] = 0u;
    __syncthreads();
    XcdBarrier bar; bar.bar = ctl + CW_BAR; bar.x = 0; bar.st = nullptr;
    if (args.use_bar) bar = xcd_barrier_post(ctl + CW_BAR, MISCW + 8, F.wave == 0 && lane_id() == 0);
    const int lo = args.ph_lo, hi = args.ph_hi;
    LAS unsigned char* ring = F.lds;
    const int gw = F.bid * NWAVES + F.wave, NGW = F.G * NWAVES;
    float* rsq1 = (float*)ctl + CW_RSQ1; float* rsq2 = (float*)ctl + CW_RSQ2;
#define IN(k) (lo <= (k) && (k) < hi)
    unsigned long long tph0_ = 0ull;
#define TBEG(k) do { if (TPH == (k)) { __syncthreads(); tph0_ = __builtin_amdgcn_s_memrealtime(); } } while (0)
#define TEND(k) do { if (TPH == (k)) { __syncthreads(); const unsigned long long t1_ = __builtin_amdgcn_s_memrealtime(), d_ = t1_ - tph0_; while (__builtin_amdgcn_s_memrealtime() - t1_ < d_) __builtin_amdgcn_s_sleep(8); __syncthreads(); } } while (0)
#define SEAM(k) do { if (args.use_bar && IN(k) && IN((k) + 1)) { if (args.use_bar == 2) { cg::this_grid().sync(); } else { xcd_barrier(bar, F.wave); } } } while (0)
#define ROT(r) ((F.bid + F.G - ((r) % F.G)) % F.G)

    TBEG(0);
    if (IN(0)) { p0_prologue(F, args); }
    SEAM(0); TEND(0);
    TBEG(1);
    if (IN(1)) {
        { pg8::Gemm g{(const bf16_t*)(F.ws + WS_A0), (const bf16_t*)(F.ws + WS_WIN), SEQ, NIN, DM, DM, DM}; pg8::StaticOrder S; S.init(SEQ, NIN, F.G, F.bid);
          EpiRoute E{F.ws}; pg8::gemm_phase<EpiRoute, true>(ring, g, S, E, F.wave); }
        { pg8::Gemm g{(const bf16_t*)(F.ws + WS_MEMN), (const bf16_t*)(F.ws + WS_WXK), MEM, DM, DM, DM, DM}; pg8::StaticOrder S; S.init(MEM, DM, F.G, ROT(192));
          EpiBf16 E{(bf16_t*)(F.ws + WS_XK), DM, nullptr}; pg8::gemm_phase<EpiBf16, true>(ring, g, S, E, F.wave); }
        { pg8::Gemm g{(const bf16_t*)(F.ws + WS_MEMN), (const bf16_t*)(F.ws + WS_WXV), MEM, DM, DM, DM, DM}; pg8::StaticOrder S; S.init(MEM, DM, F.G, ROT(200));
          EpiBf16 E{(bf16_t*)(F.ws + WS_XV), DM, nullptr}; pg8::gemm_phase<EpiBf16, true>(ring, g, S, E, F.wave); }
    }
    SEAM(1); TEND(1);
    TBEG(2);
    if (IN(2)) for (int rep_ = 0; rep_ < DUPN(2); ++rep_) {
#pragma unroll 1
        for (int h = 0; h < 4; ++h) {
            pg8::Gemm g{(const bf16_t*)(F.ws + WS_XK) + h * 512, (const bf16_t*)(F.ws + WS_WXQ) + h * 512, MEM, DM, 512, DM, DM}; pg8::StaticOrder S; S.init(MEM, DM, F.G, ROT(8 * h));
            EpiBf16 E{(bf16_t*)(F.ws + WS_WQK) + (size_t)h * 256 * DM, DM, nullptr}; pg8::gemm_phase<EpiBf16, true>(ring, g, S, E, F.wave); }
#pragma unroll 1
        for (int h = 0; h < 4; ++h) {
            pg8::Gemm g{(const bf16_t*)(F.ws + WS_WXO) + h * 512, (const bf16_t*)(F.ws + WS_XV) + h * 512, DM, MEM, 512, DM, DM}; pg8::StaticOrder S; S.init(DM, MEM, F.G, ROT(32 + 8 * h));
            EpiBf16 E{(bf16_t*)(F.ws + WS_WVO) + h * 256, 1024, nullptr}; pg8::gemm_phase<EpiBf16, true>(ring, g, S, E, F.wave); }
        __syncthreads();
        for (int t = gw; t < SEQ; t += NGW) rope_token(F, args, t);
        for (int it = F.bid; it < 512; it += F.G) gla_prep_item(F, args, it);
    }
    SEAM(2); TEND(2);
    TBEG(3);
    if (IN(3)) { for (int it = F.bid; it < SC_ITEMS; it += F.G) scores_item(F, it); }
    SEAM(3); TEND(3);
    TBEG(4);
    if (IN(4)) for (int rep_ = 0; rep_ < DUPN(4); ++rep_) { for (int t = gw; t < SEQ; t += NGW) { select_row(F, t); sparse_attn_query(F, t); } }
    SEAM(5); TEND(4);
    TBEG(6);
    if (IN(6)) { for (int it = F.bid; it < 256; it += F.G) gla_state_item(F, it); }
    SEAM(7); TEND(6);
    TBEG(8);
    if (IN(8)) { for (int it = F.bid; it < 512; it += F.G) gla_out_item(F, args, it); }
    SEAM(8); TEND(8);
    TBEG(9);
    if (IN(9)) { pg8::Gemm g{(const bf16_t*)(F.ws + WS_OA), (const bf16_t*)(F.ws + WS_WPA), SEQ, DM, DM, DM, DM}; pg8::StaticOrder S; S.init(SEQ, DM, F.G, F.bid);
        EpiGate E{(bf16_t*)(F.ws + WS_T1), (const bf16_t*)(F.ws + WS_GATES), 0, nullptr}; pg8::gemm_phase<EpiGate, true>(ring, g, S, E, F.wave); }
    TEND(9);
    TBEG(10);
    if (IN(10)) { pg8::Gemm g{(const bf16_t*)(F.ws + WS_OB), (const bf16_t*)(F.ws + WS_WPB), SEQ, DM, DM, DM, DM}; pg8::StaticOrder S; S.init(SEQ, DM, F.G, F.bid);
        EpiGate E{(bf16_t*)(F.ws + WS_MERGED), (const bf16_t*)(F.ws + WS_GATES), 2048, (const bf16_t*)(F.ws + WS_T1)}; pg8::gemm_phase<EpiGate, true>(ring, g, S, E, F.wave); }
    SEAM(10); TEND(10);
    TBEG(11);
    if (IN(11)) { { pg8::Gemm g{(const bf16_t*)(F.ws + WS_MERGED), (const bf16_t*)(F.ws + WS_WOUT), SEQ, DM, DM, DM, DM}; pg8::StaticOrder S; S.init(SEQ, DM, F.G, F.bid);
          EpiResNorm<true> E{args.in[0], (bf16_t*)(F.ws + WS_A1), rsq1}; pg8::gemm_phase<EpiResNorm<true>, true>(ring, g, S, E, F.wave); }
        const int lane_ = lane_id();
        for (int r = QSPLIT + gw; r < 32768; r += NGW) { const int e = r & 16383;
            if (r < 16384) quant_row(args.in[20] + (size_t)e * DM, (unsigned char*)(F.ws + WS_UB) + (size_t)e * 4096, (float*)(F.ws + WS_USC) + e, lane_, args.in[17]);
            else quant_row(args.in[21] + (size_t)e * DM, (unsigned char*)(F.ws + WS_UB) + (size_t)e * 4096 + 2048, (float*)(F.ws + WS_VSC) + e, lane_, nullptr); }
    }
    SEAM(11); TEND(11);
    TBEG(12);
    if (IN(12)) { { pg8::Gemm g{(const bf16_t*)(F.ws + WS_A1), (const bf16_t*)(F.ws + WS_WQK), SEQ, 1024, DM, DM, DM}; pg8::StaticOrder S; S.init(SEQ, 1024, F.G, F.bid);
        EpiSoftmax E{(bf16_t*)(F.ws + WS_XP), 1024, rsq1, 0.044194173824159216f}; pg8::gemm_phase<EpiSoftmax, false>(ring, g, S, E, F.wave); }
        if (F.bid >= 128) { const int lane_ = lane_id();
            for (int r = (F.bid - 128) * NWAVES + F.wave; r < QSPLIT; r += (F.G - 128) * NWAVES) { const int e = r & 16383;
                if (r < 16384) quant_row(args.in[20] + (size_t)e * DM, (unsigned char*)(F.ws + WS_UB) + (size_t)e * 4096, (float*)(F.ws + WS_USC) + e, lane_, args.in[17]);
                else quant_row(args.in[21] + (size_t)e * DM, (unsigned char*)(F.ws + WS_UB) + (size_t)e * 4096 + 2048, (float*)(F.ws + WS_VSC) + e, lane_, nullptr); } }
    }
    SEAM(12); TEND(12);
    TBEG(13);
    if (IN(13)) { pg8::Gemm g{(const bf16_t*)(F.ws + WS_XP), (const bf16_t*)(F.ws + WS_WVO), SEQ, DM, 1024, 1024, 1024}; pg8::StaticOrder S; S.init(SEQ, DM, F.G, F.bid);
        EpiResNorm<false> E{(const bf16_t*)(F.ws + WS_A1), (bf16_t*)(F.ws + WS_A2), rsq2}; pg8::gemm_phase<EpiResNorm<false>, true>(ring, g, S, E, F.wave); }
    SEAM(13); TEND(13);
    TBEG(14);
    if (IN(14)) { pg8::Gemm g{(const bf16_t*)(F.ws + WS_A2), (const bf16_t*)(F.ws + WS_WPQ), SEQ, DM, DM, DM, DM}; pg8::StaticOrder S; S.init(SEQ, DM, F.G, F.bid);
        EpiBf16 E{(bf16_t*)(F.ws + WS_PQ), DM, rsq2}; pg8::gemm_phase<EpiBf16, true>(ring, g, S, E, F.wave); }
    SEAM(14); TEND(14);
    TBEG(15);
    if (IN(15)) { for (int it = gw; it < SEQ / 2; it += NGW) peer_select_item(F, it); }
    SEAM(15); TEND(15);
    TBEG(16);
    if (IN(16)) { for (int t = gw; t < SEQ; t += NGW) peer_expert_token(F, args, t); }
    TEND(16);
#undef IN
#undef SEAM
#undef ROT
}

#ifndef MK_ONE_LAUNCH
#define MK_ONE_LAUNCH 1
#endif
extern "C" void kernel_launch(void* const* d_in, const int* in_sizes, int n_in, void* d_out, int out_size, void* d_ws, size_t ws_size, hipStream_t stream) {
    static int grid = 0;
    if (grid == 0) {
        if (n_in != 23 || out_size != SEQ * DM || ws_size < WS_END) { fprintf(stderr, "kernel_launch: unexpected problem (n_in %d, out %d, ws %zu < %zu)\n", n_in, out_size, ws_size, (size_t)WS_END); grid = -1; return; }
        int dev = 0, cus = 0, per_cu = 0;
        if (hipGetDevice(&dev) != hipSuccess || hipDeviceGetAttribute(&cus, hipDeviceAttributeMultiprocessorCount, dev) != hipSuccess) { grid = -1; return; }
        if (hipFuncSetAttribute((const void*)hybrid_fwd, hipFuncAttributeMaxDynamicSharedMemorySize, LDS_BYTES) != hipSuccess) { fprintf(stderr, "kernel_launch: hipFuncSetAttribute failed\n"); grid = -1; return; }
        if (hipOccupancyMaxActiveBlocksPerMultiprocessor(&per_cu, (const void*)hybrid_fwd, NTHREADS, LDS_BYTES) != hipSuccess || per_cu < 1) { fprintf(stderr, "kernel_launch: occupancy query says %d\n", per_cu); per_cu = 1; }
        (void)hipGetLastError();
        grid = cus;
    }
    if (grid < 0) return;
    (void)hipMemsetAsync((char*)d_ws + WS_CTL, 0, CTL_ZERO_BYTES, stream);
    Args a{};
    for (int i = 0; i < 23; ++i) a.in[i] = (const float*)d_in[i];
    a.out = (float*)d_out; a.ws = (unsigned char*)d_ws;
#if MK_ONE_LAUNCH
    a.ph_lo = 0; a.ph_hi = N_PHASES; a.use_bar = 1;
    void* kargs[] = {&a};
    hipError_t e = hipLaunchCooperativeKernel((const void*)hybrid_fwd, dim3(grid), dim3(NTHREADS), kargs, LDS_BYTES, stream);
    if (e != hipSuccess) fprintf(stderr, "cooperative launch failed: %s (grid %d)\n", hipGetErrorString(e), grid);
#else
    for (int p = 0; p < N_PHASES; ++p) { a.ph_lo = p; a.ph_hi = p + 1; a.use_bar = 0;
        hipLaunchKernelGGL(hybrid_fwd, dim3(grid), dim3(NTHREADS), LDS_BYTES, stream, a); }
#endif
}
```

```cpp
#include <hip/hip_runtime.h>
#include <hip/hip_cooperative_groups.h>
#include <cstdio>
#include <cstdint>
namespace cg = cooperative_groups;

#define GAS __attribute__((address_space(1)))
#define LAS __attribute__((address_space(3)))
#ifndef TPH
#define TPH -1
#endif
typedef unsigned short bf16_t;
typedef short bf16x8 __attribute__((ext_vector_type(8)));
typedef short s16x4 __attribute__((ext_vector_type(4)));
typedef float f32x4 __attribute__((ext_vector_type(4)));
typedef float f32x2 __attribute__((ext_vector_type(2)));
typedef unsigned u32x4 __attribute__((ext_vector_type(4)));
typedef unsigned u32x2 __attribute__((ext_vector_type(2)));
#define RLX_AGENT __ATOMIC_RELAXED, __HIP_MEMORY_SCOPE_AGENT
#define LDS_WAIT() asm volatile("s_waitcnt lgkmcnt(0)" ::: "memory")
#define VM_WAIT() asm volatile("s_waitcnt vmcnt(0)" ::: "memory")

__device__ __forceinline__ int lane_id() { int l; asm volatile("v_mbcnt_lo_u32_b32 %0, -1, 0\n\tv_mbcnt_hi_u32_b32 %0, -1, %0" : "=v"(l)); return l; }
__device__ __forceinline__ unsigned f2bf(float f) { unsigned u = __builtin_bit_cast(unsigned, f); return (u + 0x7fffu + ((u >> 16) & 1u)) >> 16; }
__device__ __forceinline__ unsigned pk2(float lo, float hi) { return f2bf(lo) | (f2bf(hi) << 16); }
__device__ __forceinline__ float bf2f(unsigned short b) { return __builtin_bit_cast(float, (unsigned)b << 16); }
__device__ __forceinline__ float bflo(unsigned w) { return __builtin_bit_cast(float, w << 16); }
__device__ __forceinline__ float bfhi(unsigned w) { return __builtin_bit_cast(float, w & 0xffff0000u); }
__device__ __forceinline__ float wave_sum(float v) {
#pragma unroll
    for (int o = 1; o < 64; o <<= 1) v += __shfl_xor(v, o);
    return v;
}
#define MFMA_FENCE1(a) asm volatile("s_nop 15\n\ts_nop 3" : "+v"(a))
#define MFMA_FENCE4(a, b, c, d) asm volatile("s_nop 15\n\ts_nop 3" : "+v"(a), "+v"(b), "+v"(c), "+v"(d))
#define MFMA_FENCE8(a, b, c, d, e, f, g, h) asm volatile("s_nop 15\n\ts_nop 3" : "+v"(a), "+v"(b), "+v"(c), "+v"(d), "+v"(e), "+v"(f), "+v"(g), "+v"(h))
__device__ __forceinline__ int wave_sum_dpp(int v) {
    v += __builtin_amdgcn_update_dpp(0, v, 0x111, 0xf, 0xf, true);
    v += __builtin_amdgcn_update_dpp(0, v, 0x112, 0xf, 0xf, true);
    v += __builtin_amdgcn_update_dpp(0, v, 0x114, 0xf, 0xf, true);
    v += __builtin_amdgcn_update_dpp(0, v, 0x118, 0xf, 0xf, true);
    v += __builtin_amdgcn_update_dpp(0, v, 0x142, 0xa, 0xf, false);
    v += __builtin_amdgcn_update_dpp(0, v, 0x143, 0xc, 0xf, false);
    return __builtin_amdgcn_readlane(v, 63);
}
constexpr int SEL_LDS_OFF = 137216;
__device__ __forceinline__ float sigmoidf_(float x) { return 1.f / (1.f + __expf(-x)); }

namespace pg8 {
constexpr int BM = 256, BK = 64, HALF = 128, HTB = HALF * BK * 2, STAGE_BYTES = 8 * HTB, NXCD = 8, WGM = 8;
__host__ __device__ __forceinline__ int lds_byte(int r, int c) { const int st = (r >> 4) * 2 + (c >> 5), rr = r & 15, cc = c & 31, ob = rr * 64 + cc * 2; return st * 1024 + (ob ^ (((ob >> 9) & 1) << 5)); }
__host__ __device__ __forceinline__ void stage_rc(int b, int& R, int& C) { const int st = b / 1024, sb = b % 1024, swz = sb ^ (((sb >> 9) & 1) << 5); R = (st >> 1) * 16 + swz / 64; C = (st & 1) * 32 + (swz % 64) / 2; }
__host__ __device__ __forceinline__ int perm32(int rho) { const int n = rho >> 4, i = rho & 15; return 8 * (i >> 2) + 4 * n + (i & 3); }

struct Unit { int pm, pn; };
struct Gemm { const bf16_t* A; const bf16_t* Bt; int M, N, K, lda, ldb; };

struct StaticOrder {
    int nM, nN, nwg, G, c;
    __device__ void init(int M, int N, int G_, int c_) { nM = M / BM; nN = N / BM; nwg = nM * nN; G = G_; c = c_; }
    __device__ bool next(int i, Unit& u) const {
        const long L = (long)i * G + c; if (L >= nwg) return false;
        int wgid = (int)L; { const int q = nwg / NXCD, r = nwg % NXCD, xcd = wgid % NXCD, off = wgid / NXCD; wgid = (xcd < r ? xcd * (q + 1) : r * (q + 1) + (xcd - r) * q) + off; }
        const int nig = WGM * nN, gid = wgid / nig, fm = gid * WGM, gsz = (nM - fm) < WGM ? (nM - fm) : WGM;
        u.pm = fm + ((wgid % nig) % gsz); u.pn = (wgid % nig) / gsz; return true;
    }
};

__device__ __forceinline__ unsigned cvt_pk_bf16(float lo, float hi) { unsigned r; asm volatile("v_cvt_pk_bf16_f32 %0, %1, %2" : "=v"(r) : "v"(lo), "v"(hi)); return r; }

template <class Epi, bool ALIGN_EPI>
__device__ __forceinline__ void gemm_phase(LAS unsigned char* lds, const Gemm g, const StaticOrder& S, const Epi& E, int wave_in) {
    const int lane = lane_id(), wid = wave_in, tid = wid * 64 + lane, wr = wid >> 2, wc = wid & 3, fr = lane & 15, fq = lane >> 4;
    const int K = g.K, nt = K / BK;
    unsigned voffA[2], voffB[2];
#pragma unroll
    for (int i = 0; i < 2; ++i) { int R, C; stage_rc(tid * 16 + i * 8192, R, C); const int Rb = (R & ~31) + perm32(R & 31);
        voffA[i] = (unsigned)(R * g.lda + C) * 2u; voffB[i] = (unsigned)(Rb * g.ldb + C) * 2u; }
    const size_t kstep = (size_t)(BK * 2);
    const size_t hstepA = (size_t)HALF * g.lda * 2, hstepB = (size_t)HALF * g.ldb * 2;
    const size_t tstepA = 2 * hstepA, tstepB = 2 * hstepB;
    const unsigned ldsw = (unsigned)wid * 1024u;
    const int aoff = lds_byte(wr * 64 + fr, fq * 8), boff = lds_byte(wc * 32 + fr, fq * 8);
#define PG8_SA(b, h) (((b) * 2 + (h)) * HTB)
#define PG8_SB(b, h) ((4 + (b) * 2 + (h)) * HTB)
#define PG8_STAGE(bufoff, gbase, voff) do { _Pragma("unroll") for (int _i = 0; _i < 2; ++_i) \
        __builtin_amdgcn_global_load_lds((const unsigned*)((const char*)(gbase) + (voff)[_i]), (LAS unsigned*)(lds + (bufoff) + ldsw + _i * 8192), 16, 0, 0); } while (0)
#define PG8_LDA(dst, b, h) do { _Pragma("unroll") for (int m = 0; m < 4; ++m) _Pragma("unroll") for (int k = 0; k < 2; ++k) dst[m][k] = *(const LAS bf16x8*)(lds + PG8_SA(b, h) + aoff + m * 2048 + k * 1024); } while (0)
#define PG8_LDB(dst, b, h) do { _Pragma("unroll") for (int n = 0; n < 2; ++n) _Pragma("unroll") for (int k = 0; k < 2; ++k) dst[n][k] = *(const LAS bf16x8*)(lds + PG8_SB(b, h) + boff + n * 2048 + k * 1024); } while (0)
#define PG8_MMA(ai, bj, At, Bt) do { __builtin_amdgcn_s_setprio(1); _Pragma("unroll") for (int m = 0; m < 4; ++m) _Pragma("unroll") for (int n = 0; n < 2; ++n) _Pragma("unroll") for (int k = 0; k < 2; ++k) \
        acc[ai][bj][m][n] = __builtin_amdgcn_mfma_f32_16x16x32_bf16(Bt[n][k], At[m][k], acc[ai][bj][m][n], 0, 0, 0); __builtin_amdgcn_s_setprio(0); } while (0)
#define PG8_WAIT_V(n) asm volatile("s_waitcnt vmcnt(" #n ")" ::: "memory")
#define PG8_WAIT_L(n) asm volatile("s_waitcnt lgkmcnt(" #n ")" ::: "memory")
#define PG8_BAR __builtin_amdgcn_s_barrier()
#define PG8_SCHED __builtin_amdgcn_sched_barrier(0)
    Unit cur, nxt; int ui = 0;
    if (!S.next(0, cur)) return;
    f32x4 acc[2][2][4][2];
#pragma unroll
    for (int a = 0; a < 2; ++a)
#pragma unroll
        for (int b = 0; b < 2; ++b)
#pragma unroll
            for (int m = 0; m < 4; ++m)
#pragma unroll
                for (int n = 0; n < 2; ++n) acc[a][b][m][n] = (f32x4){0.f, 0.f, 0.f, 0.f};
    bf16x8 At[4][2], B0[2][2], B1[2][2];
    const char* cA = (const char*)g.A + (size_t)cur.pm * tstepA; const char* cB = (const char*)g.Bt + (size_t)cur.pn * tstepB;
    PG8_STAGE(PG8_SB(0, 0), cB, voffB); PG8_STAGE(PG8_SB(0, 1), cB + hstepB, voffB); PG8_STAGE(PG8_SA(0, 0), cA, voffA); PG8_STAGE(PG8_SA(0, 1), cA + hstepA, voffA);
    if (wr == 1) PG8_BAR;
    PG8_WAIT_V(2); PG8_BAR;
    PG8_STAGE(PG8_SB(1, 0), cB + kstep, voffB); PG8_STAGE(PG8_SA(1, 0), cA + kstep, voffA); PG8_STAGE(PG8_SB(1, 1), cB + hstepB + kstep, voffB);
    PG8_WAIT_V(6); PG8_BAR;
    for (;;) {
        const bool has_next = S.next(ui + 1, nxt);
        const char* nA = has_next ? (const char*)g.A + (size_t)nxt.pm * tstepA : cA; const char* nB = has_next ? (const char*)g.Bt + (size_t)nxt.pn * tstepB : cB;
        for (int t = 0; t < nt; t += 2) {
            const bool last = (t == nt - 2);
            const char* a1 = cA + (size_t)(t + 1) * kstep;
            const char* a2 = last ? nA : cA + (size_t)(t + 2) * kstep; const char* b2 = last ? nB : cB + (size_t)(t + 2) * kstep;
            const char* a3 = a2 + kstep; const char* b3 = b2 + kstep;
            PG8_LDB(B0, 0, 0); PG8_LDB(B1, 0, 1); PG8_SCHED; PG8_LDA(At, 0, 0); PG8_STAGE(PG8_SA(1, 1), a1 + hstepA, voffA);
            PG8_WAIT_V(8); PG8_WAIT_L(0); PG8_BAR; PG8_MMA(0, 0, At, B0); PG8_MMA(0, 1, At, B1); PG8_BAR; PG8_SCHED;
            PG8_LDA(At, 0, 1); PG8_STAGE(PG8_SB(0, 0), b2, voffB); PG8_STAGE(PG8_SB(0, 1), b2 + hstepB, voffB); PG8_STAGE(PG8_SA(0, 0), a2, voffA);
            PG8_WAIT_V(8); PG8_WAIT_L(0); PG8_BAR; PG8_MMA(1, 0, At, B0); PG8_MMA(1, 1, At, B1); PG8_BAR; PG8_SCHED;
            PG8_LDB(B0, 1, 0); PG8_LDB(B1, 1, 1); PG8_SCHED; PG8_LDA(At, 1, 0); PG8_STAGE(PG8_SA(0, 1), a2 + hstepA, voffA);
            PG8_WAIT_V(8); PG8_WAIT_L(0); PG8_BAR; PG8_MMA(0, 0, At, B0); PG8_MMA(0, 1, At, B1); PG8_BAR; PG8_SCHED;
            PG8_LDA(At, 1, 1); PG8_STAGE(PG8_SB(1, 0), b3, voffB); PG8_STAGE(PG8_SB(1, 1), b3 + hstepB, voffB); PG8_STAGE(PG8_SA(1, 0), a3, voffA);
            PG8_WAIT_V(8); PG8_WAIT_L(0); PG8_BAR; PG8_MMA(1, 0, At, B0); PG8_MMA(1, 1, At, B1); PG8_BAR; PG8_SCHED;
        }
        if constexpr (ALIGN_EPI) { if (wr == 0) PG8_BAR; }
        if constexpr (!Epi::AFTER_DRAIN) { E(acc, cur, wr, wc, fr, fq); }
        if (!has_next) break;
#pragma unroll
        for (int a = 0; a < 2; ++a)
#pragma unroll
            for (int b = 0; b < 2; ++b)
#pragma unroll
                for (int m = 0; m < 4; ++m)
#pragma unroll
                    for (int n = 0; n < 2; ++n) acc[a][b][m][n] = (f32x4){0.f, 0.f, 0.f, 0.f};
        cur = nxt; cA = nA; cB = nB; ++ui;
        if constexpr (ALIGN_EPI) { if (wr == 1) PG8_BAR; }
    }
    PG8_WAIT_V(0);
    if constexpr (!ALIGN_EPI) { if (wr == 0) PG8_BAR; }
    PG8_BAR;
    if constexpr (Epi::AFTER_DRAIN) { E.fused(acc, cur, wr, wc, fr, fq, lds, wid, lane); }
#undef PG8_SA
#undef PG8_SB
#undef PG8_STAGE
#undef PG8_LDA
#undef PG8_LDB
#undef PG8_MMA
#undef PG8_WAIT_V
#undef PG8_WAIT_L
#undef PG8_BAR
#undef PG8_SCHED
}
}
using pg8::Unit;

constexpr int SEQ = 8192, DM = 2048, MEM = 256;
constexpr int NIN = 13824;
constexpr float EPS = 1e-6f;
constexpr size_t MiB = 1u << 20;
constexpr size_t WS_CTL = 0, CTL_ZERO_BYTES = 1 * MiB;
constexpr size_t WS_MEMN = 1 * MiB, WS_XK = 2 * MiB, WS_XV = 3 * MiB, WS_DVEC = 4 * MiB, WS_KEYS = 5 * MiB, WS_IW = 6 * MiB;
constexpr size_t WS_WPA = 8 * MiB, WS_WPB = 16 * MiB, WS_WOUT = 24 * MiB, WS_WXQ = 32 * MiB, WS_WXK = 40 * MiB, WS_WXV = 48 * MiB, WS_WXO = 56 * MiB, WS_WPQ = 64 * MiB;
constexpr size_t WS_WIN = 72 * MiB, WS_A0 = 126 * MiB;
constexpr size_t WS_QT = 72 * MiB, WS_KHT = 88 * MiB, WS_VT = 104 * MiB, WS_ATT = 136 * MiB, WS_KBR = 140 * MiB, WS_VB = 142 * MiB, WS_KIR = 144 * MiB, WS_SEL = 145 * MiB, WS_WQK = 153 * MiB, WS_WVO = 157 * MiB;
constexpr size_t WS_GR = 162 * MiB, WS_DQ = 194 * MiB, WS_GATES = 226 * MiB, WS_MISC = 290 * MiB, WS_IQ = 298 * MiB, WS_GQK = 314 * MiB, WS_GV = 346 * MiB, WS_SCORES = 378 * MiB, WS_OA = 506 * MiB;
constexpr size_t WS_ST = 378 * MiB, WS_OB = 314 * MiB, WS_T1 = 346 * MiB, WS_MERGED = 194 * MiB, WS_A1 = 162 * MiB, WS_XP = 298 * MiB, WS_A2 = 194 * MiB, WS_PQ = 226 * MiB, WS_EXPI = 258 * MiB, WS_GATEW = 262 * MiB;
constexpr size_t WS_UB = 378 * MiB, WS_VBF = 410 * MiB, WS_USC = 7 * MiB, WS_VSC = 7 * MiB + 65536, WS_COS128 = 538 * MiB, WS_SIN128 = 540 * MiB, WS_COS64 = 542 * MiB, WS_SIN64 = 543 * MiB, WS_END = 544 * MiB;
constexpr int CW_BAR = 4096;
constexpr int CW_RSQ1 = 65536, CW_RSQ2 = 65536 + 8192;
constexpr int MISC_LD = 512;

constexpr int RING_BYTES = 131072;
constexpr int LDSCTL_OFF = 147456 - 256;
constexpr int LDS_BYTES = 147456;
constexpr int NWAVES = 8, NTHREADS = 512;

__device__ __forceinline__ u32x4 pack8(const f32x4 v0, const f32x4 v1) { u32x4 w; w.x = pg8::cvt_pk_bf16(v0[0], v0[1]); w.y = pg8::cvt_pk_bf16(v0[2], v0[3]); w.z = pg8::cvt_pk_bf16(v1[0], v1[1]); w.w = pg8::cvt_pk_bf16(v1[2], v1[3]); return w; }

struct EpiRoute {
    static constexpr bool AFTER_DRAIN = false;
    unsigned char* ws;
    __device__ __forceinline__ void operator()(const f32x4 (&acc)[2][2][4][2], const Unit& u, int wr, int wc, int fr, int fq) const {
        const int pn = u.pn; bf16_t* base; int ldc, c0;
        if (pn < 8) { base = (bf16_t*)(ws + WS_GQK); ldc = 2048; c0 = pn * 256; }
        else if (pn < 16) { base = (bf16_t*)(ws + WS_GV); ldc = 2048; c0 = (pn - 8) * 256; }
        else if (pn < 24) { base = (bf16_t*)(ws + WS_GR); ldc = 2048; c0 = (pn - 16) * 256; }
        else if (pn < 32) { base = (bf16_t*)(ws + WS_DQ); ldc = 2048; c0 = (pn - 24) * 256; }
        else if (pn < 36) { base = (bf16_t*)(ws + WS_IQ); ldc = 1024; c0 = (pn - 32) * 256; }
        else if (pn < 52) { base = (bf16_t*)(ws + WS_GATES); ldc = 4096; c0 = (pn - 36) * 256; }
        else { base = (bf16_t*)(ws + WS_MISC); ldc = MISC_LD; c0 = (pn - 52) * 256; }
        const int row0 = u.pm * 256 + wr * 64 + fr, col0 = c0 + wc * 32 + 8 * fq;
#pragma unroll
        for (int ai = 0; ai < 2; ++ai)
#pragma unroll
            for (int m = 0; m < 4; ++m) { bf16_t* rowp = base + (size_t)(row0 + ai * 128 + m * 16) * ldc + col0;
#pragma unroll
                for (int bj = 0; bj < 2; ++bj) *(u32x4*)(rowp + bj * 128) = pack8(acc[ai][bj][m][0], acc[ai][bj][m][1]); }
    }
};
struct EpiBf16 {
    static constexpr bool AFTER_DRAIN = false;
    bf16_t* O; int ldc; const float* rowsq;
    __device__ __forceinline__ void operator()(const f32x4 (&acc)[2][2][4][2], const Unit& u, int wr, int wc, int fr, int fq) const {
        const int row0 = u.pm * 256 + wr * 64 + fr, col0 = u.pn * 256 + wc * 32 + 8 * fq;
#pragma unroll
        for (int ai = 0; ai < 2; ++ai)
#pragma unroll
            for (int m = 0; m < 4; ++m) { const int row = row0 + ai * 128 + m * 16; bf16_t* rowp = O + (size_t)row * ldc + col0;
                const float sc = rowsq ? rsqrtf(rowsq[row] * (1.f / DM) + EPS) : 1.f;
#pragma unroll
                for (int bj = 0; bj < 2; ++bj) *(u32x4*)(rowp + bj * 128) = pack8(acc[ai][bj][m][0] * sc, acc[ai][bj][m][1] * sc); }
    }
};
struct EpiGate {
    static constexpr bool AFTER_DRAIN = false;
    bf16_t* O; const bf16_t* gates; int goff; const bf16_t* prev;
    __device__ __forceinline__ void operator()(const f32x4 (&acc)[2][2][4][2], const Unit& u, int wr, int wc, int fr, int fq) const {
        const int row0 = u.pm * 256 + wr * 64 + fr, col0 = u.pn * 256 + wc * 32 + 8 * fq;
#pragma unroll
        for (int ai = 0; ai < 2; ++ai)
#pragma unroll
            for (int m = 0; m < 4; ++m) { const int row = row0 + ai * 128 + m * 16;
#pragma unroll
                for (int bj = 0; bj < 2; ++bj) { const int col = col0 + bj * 128;
                    const u32x4 gw = *(const u32x4*)(gates + (size_t)row * 4096 + goff + col);
                    f32x4 v0 = acc[ai][bj][m][0], v1 = acc[ai][bj][m][1];
                    v0[0] *= sigmoidf_(bflo(gw.x)); v0[1] *= sigmoidf_(bfhi(gw.x)); v0[2] *= sigmoidf_(bflo(gw.y)); v0[3] *= sigmoidf_(bfhi(gw.y));
                    v1[0] *= sigmoidf_(bflo(gw.z)); v1[1] *= sigmoidf_(bfhi(gw.z)); v1[2] *= sigmoidf_(bflo(gw.w)); v1[3] *= sigmoidf_(bfhi(gw.w));
                    if (prev) { const u32x4 pw = *(const u32x4*)(prev + (size_t)row * DM + col);
                        v0[0] += bflo(pw.x); v0[1] += bfhi(pw.x); v0[2] += bflo(pw.y); v0[3] += bfhi(pw.y); v1[0] += bflo(pw.z); v1[1] += bfhi(pw.z); v1[2] += bflo(pw.w); v1[3] += bfhi(pw.w); }
                    *(u32x4*)(O + (size_t)row * DM + col) = pack8(v0, v1); } }
    }
};
template <bool BASE_F32> struct EpiResNorm {
    static constexpr bool AFTER_DRAIN = false;
    const void* base; bf16_t* Hn; float* rowsq;
    __device__ __forceinline__ void operator()(const f32x4 (&acc)[2][2][4][2], const Unit& u, int wr, int wc, int fr, int fq) const {
        const int row0 = u.pm * 256 + wr * 64 + fr, col0 = u.pn * 256 + wc * 32 + 8 * fq;
#pragma unroll
        for (int ai = 0; ai < 2; ++ai)
#pragma unroll
            for (int m = 0; m < 4; ++m) { const int row = row0 + ai * 128 + m * 16; float ss = 0.f;
#pragma unroll
                for (int bj = 0; bj < 2; ++bj) { const size_t off = (size_t)row * DM + col0 + bj * 128; f32x4 h0, h1;
                    if (BASE_F32) { h0 = *(const f32x4*)((const float*)base + off); h1 = *(const f32x4*)((const float*)base + off + 4); }
                    else { const u32x4 w = *(const u32x4*)((const bf16_t*)base + off); h0 = (f32x4){bflo(w.x), bfhi(w.x), bflo(w.y), bfhi(w.y)}; h1 = (f32x4){bflo(w.z), bfhi(w.z), bflo(w.w), bfhi(w.w)}; }
                    h0 += acc[ai][bj][m][0]; h1 += acc[ai][bj][m][1];
                    ss += (h0[0] * h0[0] + h0[1] * h0[1]) + (h0[2] * h0[2] + h0[3] * h0[3]) + (h1[0] * h1[0] + h1[1] * h1[1]) + (h1[2] * h1[2] + h1[3] * h1[3]);
                    *(u32x4*)(Hn + off) = pack8(h0, h1); }
                ss += __shfl_xor(ss, 16); ss += __shfl_xor(ss, 32);
                if (fq == 0) atomicAdd(rowsq + row, ss); }
    }
};
struct EpiSoftmax {
    static constexpr bool AFTER_DRAIN = true;
    bf16_t* O; int ldc; const float* rowsq; float scale;
    __device__ __forceinline__ void fused(f32x4 (&acc)[2][2][4][2], const Unit& u, int wr, int wc, int fr, int fq, LAS unsigned char* lds, int wid, int lane) const {
        LAS f32x2* P = (LAS f32x2*)lds;
        float mxs[2][4];
#pragma unroll
        for (int ai = 0; ai < 2; ++ai)
#pragma unroll
            for (int m = 0; m < 4; ++m) { const int rl = ai * 128 + wr * 64 + m * 16 + fr; const int row = u.pm * 256 + rl;
                const float sc = rsqrtf(rowsq[row] * (1.f / DM) + EPS) * scale; float mx = -3.0e38f;
#pragma unroll
                for (int bj = 0; bj < 2; ++bj)
#pragma unroll
                    for (int n = 0; n < 2; ++n) { f32x4 x = acc[ai][bj][m][n] * sc; acc[ai][bj][m][n] = x; mx = fmaxf(mx, fmaxf(fmaxf(x[0], x[1]), fmaxf(x[2], x[3]))); }
                mx = fmaxf(mx, __shfl_xor(mx, 16)); mx = fmaxf(mx, __shfl_xor(mx, 32)); float s = 0.f;
#pragma unroll
                for (int bj = 0; bj < 2; ++bj)
#pragma unroll
                    for (int n = 0; n < 2; ++n) { f32x4 x = acc[ai][bj][m][n]; x[0] = __expf(x[0] - mx); x[1] = __expf(x[1] - mx); x[2] = __expf(x[2] - mx); x[3] = __expf(x[3] - mx); acc[ai][bj][m][n] = x; s += (x[0] + x[1]) + (x[2] + x[3]); }
                s += __shfl_xor(s, 16); s += __shfl_xor(s, 32); mxs[ai][m] = mx;
                if (fq == 0) P[rl * 4 + wc] = (f32x2){mx, s}; }
        __syncthreads();
        const int col0 = u.pn * 256 + wc * 32 + 8 * fq;
#pragma unroll
        for (int ai = 0; ai < 2; ++ai)
#pragma unroll
            for (int m = 0; m < 4; ++m) { const int rl = ai * 128 + wr * 64 + m * 16 + fr; const int row = u.pm * 256 + rl;
                const f32x2 a = P[rl * 4 + 0], b = P[rl * 4 + 1], c = P[rl * 4 + 2], d = P[rl * 4 + 3];
                const float M = fmaxf(fmaxf(a.x, b.x), fmaxf(c.x, d.x));
                const float Ssum = a.y * __expf(a.x - M) + b.y * __expf(b.x - M) + c.y * __expf(c.x - M) + d.y * __expf(d.x - M);
                const float f = __expf(mxs[ai][m] - M) / Ssum;
#pragma unroll
                for (int bj = 0; bj < 2; ++bj) *(u32x4*)(O + (size_t)row * ldc + col0 + bj * 128) = pack8(acc[ai][bj][m][0] * f, acc[ai][bj][m][1] * f); }
        __syncthreads();
    }
};

#define XB_TMO      128
#define XB_XCNT(j)  (256  + 64 * (j))
#define XB_XSUB(j)  (1280 + 64 * (j))
#define XB_XGEN(j)  (2304 + 64 * (j))
#define XB_TOP      3328
#define XB_TOPGEN   3392
#define XCD_BAR_WORDS 3456
#define XB_SPIN_CAP (1u << 20)
__device__ __forceinline__ unsigned xb_ld(unsigned* p)              { return __hip_atomic_load(p, __ATOMIC_RELAXED, __HIP_MEMORY_SCOPE_AGENT); }
__device__ __forceinline__ unsigned xb_add(unsigned* p, unsigned v) { return __hip_atomic_fetch_add(p, v, __ATOMIC_RELAXED, __HIP_MEMORY_SCOPE_AGENT); }
__device__ __forceinline__ unsigned xb_xcc_id() { return (unsigned)__builtin_amdgcn_s_getreg((3 << 11) | 20) & 0xFu; }
#define XB_SPIN(cond, bar) do { unsigned _sp = 0; while (cond) { __builtin_amdgcn_s_sleep(1); \
    if ((++_sp & 255u) == 0u) { if (xb_ld(&(bar)[XB_TMO])) break; if (_sp > XB_SPIN_CAP) { atomicAdd(&(bar)[XB_TMO], 1u); break; } } } } while (0)
struct XcdBarrier { unsigned* bar; unsigned x; volatile LAS unsigned* st; };
__device__ __forceinline__ XcdBarrier xcd_barrier_post(unsigned* bar, volatile LAS unsigned* st, bool t0) {
    XcdBarrier b; b.bar = bar; b.x = xb_xcc_id(); b.st = st;
    if (t0) (void)xb_add(&bar[XB_XCNT(b.x)], 1u);
    return b;
}
__device__ __forceinline__ void xcd_barrier_complete(unsigned* bar, unsigned x, unsigned& nloc, unsigned& nx) {
    const unsigned G = gridDim.x * gridDim.y * gridDim.z;
    unsigned sum, cnt, mine, sp = 0u;
    for (;;) {
        sum = 0u; cnt = 0u; mine = 0u;
#pragma unroll
        for (unsigned j = 0; j < 16; ++j) { const unsigned c = xb_ld(&bar[XB_XCNT(j)]); sum += c; cnt += (c > 0u) ? 1u : 0u; mine = (j == x) ? c : mine; }
        if (sum == G) break;
        __builtin_amdgcn_s_sleep(1);
        if ((++sp & 255u) == 0u) { if (xb_ld(&bar[XB_TMO])) break; if (sp > XB_SPIN_CAP) { atomicAdd(&bar[XB_TMO], 1u); break; } }
    }
    nloc = mine > 0u ? mine : 1u; nx = cnt > 0u ? cnt : 1u;
}
__device__ __forceinline__ void xcd_barrier(const XcdBarrier& b, int wave) {
    asm volatile("s_waitcnt vmcnt(0)" ::: "memory");
    __syncthreads();
    if (wave == 0 && lane_id() == 0) {
        unsigned* bar = b.bar;
        __builtin_amdgcn_s_waitcnt(0);
        unsigned nloc = b.st[0], nx = b.st[1];
        if (nloc == 0u) { xcd_barrier_complete(bar, b.x, nloc, nx); b.st[0] = nloc; b.st[1] = nx; }
        const unsigned old = xb_add(&bar[XB_XSUB(b.x)], 1u);
        const unsigned gen = old / nloc;
        if (old + 1u == (gen + 1u) * nloc) {
            __builtin_amdgcn_fence(__ATOMIC_RELEASE, "agent");
            asm volatile("s_waitcnt vmcnt(0)" ::: "memory");
            const unsigned og = xb_add(&bar[XB_TOP], 1u);
            const unsigned tg = og / nx;
            if (og + 1u == (tg + 1u) * nx) xb_add(&bar[XB_TOPGEN], 1u);
            else XB_SPIN(xb_ld(&bar[XB_TOPGEN]) == tg, bar);
            __builtin_amdgcn_fence(__ATOMIC_ACQUIRE, "agent");
            xb_add(&bar[XB_XGEN(b.x)], 1u);
            asm volatile("s_waitcnt vmcnt(0)" ::: "memory");
        } else {
            XB_SPIN(xb_ld(&bar[XB_XGEN(b.x)]) == gen, bar);
            __builtin_amdgcn_fence(__ATOMIC_ACQUIRE, "agent");
            asm volatile("s_waitcnt vmcnt(0)" ::: "memory");
        }
    }
    __syncthreads();
}

struct Args { const float* in[23]; float* out; unsigned char* ws; int ph_lo, ph_hi, use_bar, pad; };
struct Frame {
    LAS unsigned char* lds;
    int wave, G, bid;
    unsigned char* ws;
};

template <int MT, int NT>
__device__ __forceinline__ void wave_gemm_nt(const bf16_t* A, int lda, const bf16_t* B, int ldb, int K, f32x4 (&acc)[MT][NT], int fr, int fq) {
    for (int k0 = 0; k0 < K; k0 += 32) {
        bf16x8 a[MT], b[NT];
#pragma unroll
        for (int mt = 0; mt < MT; ++mt) a[mt] = *(const bf16x8*)(A + (size_t)(16 * mt + fr) * lda + k0 + 8 * fq);
#pragma unroll
        for (int nt = 0; nt < NT; ++nt) b[nt] = *(const bf16x8*)(B + (size_t)(16 * nt + fr) * ldb + k0 + 8 * fq);
#pragma unroll
        for (int mt = 0; mt < MT; ++mt)
#pragma unroll
            for (int nt = 0; nt < NT; ++nt) acc[mt][nt] = __builtin_amdgcn_mfma_f32_16x16x32_bf16(a[mt], b[nt], acc[mt][nt], 0, 0, 0);
    }
}

__device__ __forceinline__ int win_src_col(int n) {
    if (n < 6144) return n;
    if (n < 8192) return 6160 + (n - 6144);
    if (n < 9216) return 8464 + (n - 8192);
    if (n < 11264) return 9568 + (n - 9216);
    if (n < 13312) return 11616 + (n - 11264);
    const int m = n - 13312;
    if (m < 16) return 6144 + m;
    if (m < 32) return 9552 + (m - 16);
    if (m < 96) return 9488 + (m - 32);
    if (m < 128) return -1;
    if (m < 256) return 8208 + (m - 128);
    if (m < 384) return 8336 + (m - 256);
    return -1;
}
__device__ __forceinline__ void transpose_item(const float* W, int N, int K, bf16_t* WT, int drow0, int srccol, int k0, LAS float* scr, int lane, const float* kgain) {
    float v[64];
#pragma unroll
    for (int i = 0; i < 64; ++i) v[i] = srccol >= 0 ? W[(size_t)(k0 + i) * N + srccol] : 0.f;
    if (kgain) {
#pragma unroll
        for (int i = 0; i < 64; ++i) v[i] *= kgain[k0 + i]; }
#pragma unroll
    for (int i = 0; i < 64; ++i) scr[i * 65 + lane] = v[i];
    LDS_WAIT(); asm volatile("" ::: "memory");
    const int c = lane & 7;
#pragma unroll
    for (int j = 0; j < 8; ++j) { const int n = (lane >> 3) + 8 * j; const LAS float* s = scr + (8 * c) * 65 + n;
        u32x4 o; o.x = pk2(s[0 * 65], s[1 * 65]); o.y = pk2(s[2 * 65], s[3 * 65]); o.z = pk2(s[4 * 65], s[5 * 65]); o.w = pk2(s[6 * 65], s[7 * 65]);
        *(u32x4*)(WT + (size_t)(drow0 + n) * K + k0 + 8 * c) = o; }
    LDS_WAIT(); asm volatile("" ::: "memory");
}
__device__ __forceinline__ void rms_row_to_bf16(const float* xrow, const float* gain, bf16_t* orow, int lane) {
    const f32x4* xr = (const f32x4*)xrow + lane; const f32x4* gr = (const f32x4*)gain + lane;
    f32x4 v[8]; float s = 0.f;
#pragma unroll
    for (int j = 0; j < 8; ++j) { v[j] = xr[64 * j]; s += (v[j][0] * v[j][0] + v[j][1] * v[j][1]) + (v[j][2] * v[j][2] + v[j][3] * v[j][3]); }
    const float rstd = rsqrtf(wave_sum(s) * (1.f / DM) + EPS);
    u32x2* o8 = (u32x2*)orow + lane;
#pragma unroll
    for (int j = 0; j < 8; ++j) { const f32x4 g = gr[64 * j]; u32x2 w; w.x = pk2(v[j][0] * rstd * g[0], v[j][1] * rstd * g[1]); w.y = pk2(v[j][2] * rstd * g[2], v[j][3] * rstd * g[3]); o8[64 * j] = w; }
}
__device__ __forceinline__ void cvt_copy(const float* src, bf16_t* dst, size_t n, size_t gtid, size_t gthreads) {
    for (size_t i = gtid; i < n / 8; i += gthreads) { const f32x4 a = *((const f32x4*)src + 2 * i), b = *((const f32x4*)src + 2 * i + 1);
        u32x4 w; w.x = pk2(a[0], a[1]); w.y = pk2(a[2], a[3]); w.z = pk2(b[0], b[1]); w.w = pk2(b[2], b[3]); *((u32x4*)dst + i) = w; }
}
__device__ __forceinline__ void p0_prologue(const Frame& F, const Args& a) {
    const int lane_ = lane_id(), tid_ = F.wave * 64 + lane_; (void)tid_;
    LAS float* scr = (LAS float*)(F.lds + F.wave * 16896);
    const int gw = F.bid * NWAVES + F.wave, NGW = F.G * NWAVES;
    constexpr int I_IN = (NIN / 64) * (DM / 64), I_SQ = (DM / 64) * (DM / 64);
    for (int it = gw; it < I_IN + 7 * I_SQ; it += NGW) {
        if (it < I_IN) { const int nb = it / (DM / 64), kb = it % (DM / 64); const int n = nb * 64 + lane_;
            transpose_item(a.in[4], 13664, DM, (bf16_t*)(F.ws + WS_WIN), nb * 64, win_src_col(n), kb * 64, scr, lane_, nullptr); }
        else { const int r = it - I_IN, mi = r / I_SQ, q = r % I_SQ, nb = q / (DM / 64), kb = q % (DM / 64);
            const float* W; size_t off;
            switch (mi) { case 0: W = a.in[8]; off = WS_WPA; break; case 1: W = a.in[9]; off = WS_WPB; break; case 2: W = a.in[10]; off = WS_WOUT; break;
                          case 3: W = a.in[14]; off = WS_WXK; break; case 4: W = a.in[15]; off = WS_WXV; break; case 5: W = a.in[16]; off = WS_WXO; break; default: W = a.in[18]; off = WS_WPQ; break; }
            transpose_item(W, DM, DM, (bf16_t*)(F.ws + off), nb * 64, nb * 64 + lane_, kb * 64, scr, lane_, mi == 6 ? a.in[17] : nullptr); }
    }
    const size_t gtid = (size_t)F.bid * NTHREADS + tid_, gth = (size_t)F.G * NTHREADS;
    for (size_t i = gtid; i < (size_t)DM * DM / 8; i += gth) { const float g = a.in[11][i >> 8];
        const f32x4 p = *((const f32x4*)a.in[13] + 2 * i) * g, q = *((const f32x4*)a.in[13] + 2 * i + 1) * g; u32x4 w; w.x = pk2(p[0], p[1]); w.y = pk2(p[2], p[3]); w.z = pk2(q[0], q[1]); w.w = pk2(q[2], q[3]); *((u32x4*)(F.ws + WS_WXQ) + i) = w; }
    cvt_copy(a.in[19], (bf16_t*)(F.ws + WS_KEYS), (size_t)16 * 128 * 128, gtid, gth);
    for (int m = gw; m < SEQ + MEM; m += NGW) {
        if (m < SEQ) rms_row_to_bf16(a.in[0] + (size_t)m * DM, a.in[3], (bf16_t*)(F.ws + WS_A0) + (size_t)m * DM, lane_);
        else rms_row_to_bf16(a.in[1] + (size_t)(m - SEQ) * DM, a.in[12], (bf16_t*)(F.ws + WS_MEMN) + (size_t)(m - SEQ) * DM, lane_);
    }
}

__device__ __forceinline__ void sincos_red(float ang, float& s, float& c) {
    const float n = rintf(ang * 0.15915494309189535f);
    float r = fmaf(-n, 6.28318548202514648f, ang); r = fmaf(-n, -1.7484556000744883e-07f, r);
    const float f = r * 0.15915494309189535f;
    s = __builtin_amdgcn_sinf(f); c = __builtin_amdgcn_cosf(f);
}
__device__ __forceinline__ void rope8(bf16x8& x1, bf16x8& x2, const f32x4 c0, const f32x4 c1, const f32x4 s0, const f32x4 s1) {
#pragma unroll
    for (int j = 0; j < 8; ++j) { const float a = bf2f((unsigned short)x1[j]), b = bf2f((unsigned short)x2[j]), c = j < 4 ? c0[j & 3] : c1[j & 3], sn = j < 4 ? s0[j & 3] : s1[j & 3];
        x1[j] = (short)f2bf(a * c - b * sn); x2[j] = (short)f2bf(b * c + a * sn); }
}
__device__ __forceinline__ void rope_token(const Frame& F, const Args& a, int t) {
    const int lane_ = lane_id(), tid_ = F.wave * 64 + lane_; (void)tid_;
    const int l = lane_; const float pos = (float)((const int*)a.in[2])[t];
    const bf16_t* MS = (const bf16_t*)(F.ws + WS_MISC) + (size_t)t * MISC_LD;
    float s1, c1, s2, c2;
    { const float inv = powf(10000.f, -(float)(2 * l) / 128.f); sincos_red(pos * inv, s1, c1); }
    { const float inv = powf(10000.f, -(float)(2 * (l & 31)) / 64.f); sincos_red(pos * inv, s2, c2); }
    ((float*)(F.ws + WS_COS128))[(size_t)t * 64 + l] = c1; ((float*)(F.ws + WS_SIN128))[(size_t)t * 64 + l] = s1;
    if (l < 32) { ((float*)(F.ws + WS_COS64))[(size_t)t * 32 + l] = c2; ((float*)(F.ws + WS_SIN64))[(size_t)t * 32 + l] = s2; }
    { const float x1 = bf2f(MS[128 + l]), x2 = bf2f(MS[128 + 64 + l]); bf16_t* kb = (bf16_t*)(F.ws + WS_KBR) + (size_t)t * 128;
      kb[l] = (bf16_t)f2bf(x1 * c1 - x2 * s1); kb[64 + l] = (bf16_t)f2bf(x2 * c1 + x1 * s1); }
    if (l < 32) { const float x1 = bf2f(MS[32 + l]), x2 = bf2f(MS[64 + l]); bf16_t* ki = (bf16_t*)(F.ws + WS_KIR) + (size_t)t * 64;
        ki[l] = (bf16_t)f2bf(x1 * c2 - x2 * s2); ki[32 + l] = (bf16_t)f2bf(x2 * c2 + x1 * s2); }
    { bf16_t* vb = (bf16_t*)(F.ws + WS_VB) + (size_t)t * 128; vb[l] = MS[256 + l]; vb[64 + l] = MS[320 + l]; }
    if (l < 16) ((float*)(F.ws + WS_IW))[(size_t)t * 16 + l] = bf2f(MS[16 + l]) * 0.03125f;
}
constexpr int GLP = 264, GLV = 520;
__device__ __forceinline__ void gla_prep_item(const Frame& F, const Args& a, int item) {
    const int lane_ = lane_id(), tid_ = F.wave * 64 + lane_; (void)tid_;
    const int c = item >> 2, h = item & 3, t0 = c * 64, tid = tid_;
    LAS bf16_t* sQ = (LAS bf16_t*)F.lds; LAS bf16_t* sK = sQ + 64 * GLP; LAS bf16_t* sV = sK + 64 * GLP; LAS float* sG = (LAS float*)(sV + 64 * GLV);
    const bf16_t* GQK = (const bf16_t*)(F.ws + WS_GQK); const bf16_t* MS = (const bf16_t*)(F.ws + WS_MISC); const bf16_t* GV = (const bf16_t*)(F.ws + WS_GV);
    { u32x4 qv[4], kv[4], vv[8];
#pragma unroll
      for (int i = 0; i < 4; ++i) { const int ch = tid + 512 * i, row = ch >> 5, c16 = ch & 31; const bf16_t* p = GQK + (size_t)(t0 + row) * DM + h * 256 + c16 * 8; qv[i] = *(const u32x4*)p; kv[i] = *(const u32x4*)(p + 1024); }
#pragma unroll
      for (int i = 0; i < 8; ++i) { const int ch = tid + 512 * i, row = ch >> 6, c16 = ch & 63; vv[i] = *(const u32x4*)(GV + (size_t)(t0 + row) * DM + h * 512 + c16 * 8); }
      for (int i = tid; i < 64 * 16; i += NTHREADS) sG[i] = bf2f(MS[(size_t)(t0 + (i >> 4)) * MISC_LD + (i & 15)]);
#pragma unroll
      for (int i = 0; i < 4; ++i) { const int ch = tid + 512 * i, row = ch >> 5, c16 = ch & 31; *(LAS u32x4*)(sQ + row * GLP + c16 * 8) = qv[i]; *(LAS u32x4*)(sK + row * GLP + c16 * 8) = kv[i]; }
#pragma unroll
      for (int i = 0; i < 8; ++i) { const int ch = tid + 512 * i, row = ch >> 6, c16 = ch & 63; *(LAS u32x4*)(sV + row * GLV + c16 * 8) = vv[i]; } }
    __syncthreads();
    if (tid < 256) {
        const int d = tid, col = h * 256 + d;
        float w2c[16];
#pragma unroll
        for (int r = 0; r < 16; ++r) w2c[r] = a.in[5][r * 1024 + col];
        const float bias = a.in[6][col];
        bf16_t* QT = (bf16_t*)(F.ws + WS_QT);
        float b = 0.f;
#pragma unroll 4
        for (int j = 0; j < 64; ++j) {
            float z = bias;
#pragma unroll
            for (int r = 0; r < 16; ++r) z = fmaf(sG[j * 16 + r], w2c[r], z);
            const float ls = fminf(z, 0.f) - log1pf(__expf(-fabsf(z)));
            b += ls * (1.f / 16.f);
            const float q = bf2f(sQ[j * GLP + d]), k = bf2f(sK[j * GLP + d]);
            const float eb = __expf(b);
            const unsigned qb = f2bf(q * 0.0625f * eb), kb = f2bf(k / eb);
            QT[(size_t)(t0 + j) * 1024 + col] = (bf16_t)qb; sQ[j * GLP + d] = (bf16_t)qb; sK[j * GLP + d] = (bf16_t)kb;
        }
        const float eL = __expf(b);
        ((float*)(F.ws + WS_DVEC))[c * 1024 + col] = eL;
        bf16_t* KH = (bf16_t*)(F.ws + WS_KHT) + ((size_t)item * 256 + d) * 64;
#pragma unroll
        for (int j8 = 0; j8 < 8; ++j8) { u32x4 w;
            w.x = pk2(bf2f(sK[(j8 * 8 + 0) * GLP + d]) * eL, bf2f(sK[(j8 * 8 + 1) * GLP + d]) * eL); w.y = pk2(bf2f(sK[(j8 * 8 + 2) * GLP + d]) * eL, bf2f(sK[(j8 * 8 + 3) * GLP + d]) * eL);
            w.z = pk2(bf2f(sK[(j8 * 8 + 4) * GLP + d]) * eL, bf2f(sK[(j8 * 8 + 5) * GLP + d]) * eL); w.w = pk2(bf2f(sK[(j8 * 8 + 6) * GLP + d]) * eL, bf2f(sK[(j8 * 8 + 7) * GLP + d]) * eL);
            *(u32x4*)(KH + j8 * 8) = w; }
    } else {
#pragma unroll 1
        for (int i = 0; i < 2; ++i) { const int e = (tid - 256) + 256 * i; bf16_t* VT = (bf16_t*)(F.ws + WS_VT) + ((size_t)item * 512 + e) * 64;
#pragma unroll
            for (int j8 = 0; j8 < 8; ++j8) { unsigned short v[8];
#pragma unroll
                for (int j = 0; j < 8; ++j) v[j] = sV[(j8 * 8 + j) * GLV + e];
                u32x4 w; w.x = v[0] | ((unsigned)v[1] << 16); w.y = v[2] | ((unsigned)v[3] << 16); w.z = v[4] | ((unsigned)v[5] << 16); w.w = v[6] | ((unsigned)v[7] << 16);
                *(u32x4*)(VT + j8 * 8) = w; } }
    }
    __syncthreads();
    { const int fr = lane_ & 15, fq = lane_ >> 4; bf16_t* AT = (bf16_t*)(F.ws + WS_ATT) + (size_t)item * 4096;
#pragma unroll
      for (int tt = 0; tt < 2; ++tt) { const int tile = F.wave * 2 + tt, ti = tile >> 2, tj = tile & 3; f32x4 acc = (f32x4){0.f, 0.f, 0.f, 0.f};
          if (tj <= ti) {
#pragma unroll
              for (int k0 = 0; k0 < 256; k0 += 32) { const bf16x8 av = *(const LAS bf16x8*)(sQ + (16 * ti + fr) * GLP + k0 + 8 * fq), bv = *(const LAS bf16x8*)(sK + (16 * tj + fr) * GLP + k0 + 8 * fq);
                  acc = __builtin_amdgcn_mfma_f32_16x16x32_bf16(av, bv, acc, 0, 0, 0); } }
          MFMA_FENCE1(acc);
#pragma unroll
          for (int r = 0; r < 4; ++r) { const int i = 16 * ti + 4 * fq + r, j = 16 * tj + fr; AT[i * 64 + j] = (bf16_t)f2bf(j <= i ? acc[r] : 0.f); } } }
    __syncthreads();
}

__device__ __forceinline__ float relu_(float x) { const int i = __builtin_bit_cast(int, x); return __builtin_bit_cast(float, i > 0 ? i : 0); }
constexpr int SC_ITEMS = 1088;
__device__ __forceinline__ void scores_item(const Frame& F, int item) {
    const int lane_ = lane_id(), tid_ = F.wave * 64 + lane_; (void)tid_;
    int gq = 0, rem = item;
    while (rem >= 8 * (gq + 1)) { rem -= 8 * (gq + 1); ++gq; }
    const int qb = gq * 8 + rem / (gq + 1), kc = rem % (gq + 1);
    const int fr = lane_ & 15, fq = lane_ >> 4, tq0 = qb * 64 + F.wave * 8;
    const bf16_t* IQ = (const bf16_t*)(F.ws + WS_IQ); const bf16_t* KI = (const bf16_t*)(F.ws + WS_KIR); const float* IW = (const float*)(F.ws + WS_IW);
    unsigned short* SC = (unsigned short*)(F.ws + WS_SCORES);
    bf16x8 aq[2][4][2]; f32x4 wq[2][4];
#pragma unroll
    for (int G = 0; G < 2; ++G)
#pragma unroll
        for (int j = 0; j < 4; ++j) { const bf16_t* p = IQ + (size_t)(tq0 + 4 * G + (fr >> 2)) * 1024 + (4 * j + (fr & 3)) * 64 + 8 * fq; aq[G][j][0] = *(const bf16x8*)p; aq[G][j][1] = *(const bf16x8*)(p + 32);
            wq[G][j] = *(const f32x4*)(IW + (size_t)(tq0 + 4 * G + fq) * 16 + 4 * j); }
#pragma unroll
    for (int G = 0; G < 2; ++G) { const size_t tr = (size_t)(tq0 + 4 * G + (fr >> 2)) * 32 + 8 * fq;
        const f32x4 c0 = *(const f32x4*)((const float*)(F.ws + WS_COS64) + tr), c1 = *(const f32x4*)((const float*)(F.ws + WS_COS64) + tr + 4), s0 = *(const f32x4*)((const float*)(F.ws + WS_SIN64) + tr), s1 = *(const f32x4*)((const float*)(F.ws + WS_SIN64) + tr + 4);
#pragma unroll
        for (int j = 0; j < 4; ++j) rope8(aq[G][j][0], aq[G][j][1], c0, c1, s0, s1); }
    for (int g4 = 0; g4 < 8; ++g4) {
        const int key0 = kc * 512 + g4 * 64;
        bf16x8 bk[4][2];
#pragma unroll
        for (int kt = 0; kt < 4; ++kt) { const bf16_t* kp = KI + (size_t)(key0 + 4 * fr + kt) * 64 + 8 * fq; bk[kt][0] = *(const bf16x8*)kp; bk[kt][1] = *(const bf16x8*)(kp + 32); }
#pragma unroll
        for (int G = 0; G < 2; ++G) { float sv[4];
#pragma unroll
            for (int kt = 0; kt < 4; ++kt) { float s0 = 0.f, s1 = 0.f; f32x4 acc[4];
#pragma unroll
                for (int j = 0; j < 4; ++j) { acc[j] = __builtin_amdgcn_mfma_f32_16x16x32_bf16(aq[G][j][0], bk[kt][0], (f32x4){0.f, 0.f, 0.f, 0.f}, 0, 0, 0); acc[j] = __builtin_amdgcn_mfma_f32_16x16x32_bf16(aq[G][j][1], bk[kt][1], acc[j], 0, 0, 0); }
                MFMA_FENCE4(acc[0], acc[1], acc[2], acc[3]);
#pragma unroll
                for (int j = 0; j < 4; ++j) { s0 = fmaf(relu_(acc[j][0]), wq[G][j][0], s0); s1 = fmaf(relu_(acc[j][1]), wq[G][j][1], s1); s0 = fmaf(relu_(acc[j][2]), wq[G][j][2], s0); s1 = fmaf(relu_(acc[j][3]), wq[G][j][3], s1); }
                sv[kt] = s0 + s1; }
            const _Float16 h0 = (_Float16)sv[0], h1 = (_Float16)sv[1], h2 = (_Float16)sv[2], h3 = (_Float16)sv[3];
            u32x2 w; w.x = (unsigned)__builtin_bit_cast(unsigned short, h0) | ((unsigned)__builtin_bit_cast(unsigned short, h1) << 16); w.y = (unsigned)__builtin_bit_cast(unsigned short, h2) | ((unsigned)__builtin_bit_cast(unsigned short, h3) << 16);
            *(u32x2*)(SC + (size_t)(tq0 + 4 * G + fq) * SEQ + key0 + 4 * fr) = w; }
    }
}

__device__ __forceinline__ unsigned h16key(unsigned h) { return (h & 0x8000u) ? (~h & 0xffffu) : (h | 0x8000u); }
typedef unsigned short u16x2 __attribute__((ext_vector_type(2)));
typedef short s16x2 __attribute__((ext_vector_type(2)));
__device__ __forceinline__ int cnt_ge(const unsigned (&kk)[64], unsigned c, int nch) {
    const unsigned cm1 = (c - 1u) * 0x00010001u, one = 0x00010001u; unsigned a0 = 0u, a1 = 0u, a2 = 0u, a3 = 0u;
#pragma unroll
    for (int i = 0; i < 16; ++i) if (i < nch) { const int r = 4 * i; unsigned t0, t1, t2, t3;
        asm("v_pk_sub_u16 %0, %8, %12 clamp\n\tv_pk_sub_u16 %1, %9, %12 clamp\n\tv_pk_sub_u16 %2, %10, %12 clamp\n\tv_pk_sub_u16 %3, %11, %12 clamp\n\t"
            "v_pk_min_u16 %0, %0, %13\n\tv_pk_min_u16 %1, %1, %13\n\tv_pk_min_u16 %2, %2, %13\n\tv_pk_min_u16 %3, %3, %13\n\t"
            "v_pk_add_u16 %4, %4, %0\n\tv_pk_add_u16 %5, %5, %1\n\tv_pk_add_u16 %6, %6, %2\n\tv_pk_add_u16 %7, %7, %3"
            : "=&v"(t0), "=&v"(t1), "=&v"(t2), "=&v"(t3), "+v"(a0), "+v"(a1), "+v"(a2), "+v"(a3) : "v"(kk[r]), "v"(kk[r + 1]), "v"(kk[r + 2]), "v"(kk[r + 3]), "v"(cm1), "v"(one)); }
    const unsigned acc = a0 + a1 + a2 + a3;
    return (int)(acc & 0xffffu) + (int)(acc >> 16);
}
__device__ __forceinline__ void select_row(const Frame& F, int t) {
    const int lane_ = lane_id();
    LAS int* SEL = (LAS int*)(F.lds + SEL_LDS_OFF) + F.wave * 256; const int l = lane_;
    if (t < 256) {
#pragma unroll
        for (int i = 0; i < 4; ++i) { const int j = i * 64 + l; SEL[j] = (j <= t) ? j : 0; }
        return;
    }
    const unsigned short* SC = (const unsigned short*)(F.ws + WS_SCORES) + (size_t)t * SEQ;
    const int nch = (t >> 9) + 1;
    unsigned kk[64];
    u32x4 raw[16];
#pragma unroll
    for (int i = 0; i < 16; ++i) { const int ic = i < nch ? i : nch - 1; raw[i] = *(const u32x4*)(SC + (ic * 64 + l) * 8); }
#pragma unroll
    for (int i = 0; i < 16; ++i) {
#pragma unroll
        for (int w = 0; w < 4; ++w) { const unsigned x = raw[i][w]; const s16x2 m = __builtin_bit_cast(s16x2, x) >> (s16x2){15, 15};
            kk[i * 4 + w] = x ^ (__builtin_bit_cast(unsigned, m) | 0x80008000u); }
        if (i == nch - 1) { const int s0 = (i * 64 + l) * 8;
#pragma unroll
            for (int w = 0; w < 4; ++w) { if (s0 + 2 * w > t) kk[i * 4 + w] &= 0xffff0000u; if (s0 + 2 * w + 1 > t) kk[i * 4 + w] &= 0x0000ffffu; } } }
    unsigned T = 0u;
    for (int bit = 15; bit >= 0; --bit) { const unsigned cand = T | (1u << bit); const int cnt = wave_sum_dpp(cnt_ge(kk, cand, nch));
        if (cnt >= 256) T = cand; }
    const int nge = cnt_ge(kk, T, nch); const int ngt = (T < 0xffffu) ? cnt_ge(kk, T + 1u, nch) : 0; const int neq = nge - ngt;
    int pg = ngt, pe = neq;
#pragma unroll
    for (int o = 1; o < 64; o <<= 1) { const int a = __shfl_up(pg, o), b = __shfl_up(pe, o); if (l >= o) { pg += a; pe += b; } }
    const int totgt = __shfl(pg, 63); pg -= ngt; pe -= neq;
    const int need = 256 - totgt; int mytake = need - pe; mytake = mytake < 0 ? 0 : (mytake > neq ? neq : mytake);
    int off = pg + (pe < need ? pe : need), tk = 0;
#pragma unroll
    for (int r = 0; r < 64; ++r) if ((r >> 2) < nch) {
#pragma unroll
        for (int hf = 0; hf < 2; ++hf) { const unsigned key = hf ? (kk[r] >> 16) : (kk[r] & 0xffffu); const int s = ((r >> 2) * 64 + l) * 8 + (r & 3) * 2 + hf;
            const bool eq = (key == T); const bool take = (key > T) || (eq && tk < mytake);
            if (take && off < 256) SEL[off] = s;
            off += take ? 1 : 0; tk += eq ? 1 : 0; } }
}

constexpr int SP_PP = 264;
constexpr int SP_VP = 136;
constexpr int SP_WAVE_BYTES = 16 * SP_PP * 2 + 32 * SP_VP * 2;
__device__ __forceinline__ s16x4 tr_read4(unsigned lds_addr) { s16x4 r; asm volatile("ds_read_b64_tr_b16 %0, %1\n\ts_waitcnt lgkmcnt(0)" : "=&v"(r) : "v"(lds_addr) : "memory"); return r; }
__device__ __forceinline__ void sparse_attn_query(const Frame& F, int t) {
    const int lane_ = lane_id(), tid_ = F.wave * 64 + lane_; (void)tid_;
    const int l = lane_, fr = l & 15, fq = l >> 4;
    LAS unsigned char* wl = F.lds + F.wave * SP_WAVE_BYTES; LAS bf16_t* sP = (LAS bf16_t*)wl; LAS bf16_t* sV = (LAS bf16_t*)(wl + 16 * SP_PP * 2);
    const bf16_t* Q = (const bf16_t*)(F.ws + WS_DQ) + (size_t)t * DM; bf16_t* OB = (bf16_t*)(F.ws + WS_OB) + (size_t)t * DM; const bf16_t* KB = (const bf16_t*)(F.ws + WS_KBR); const bf16_t* VB = (const bf16_t*)(F.ws + WS_VB);
    const LAS int* SEL = (const LAS int*)(F.lds + SEL_LDS_OFF) + F.wave * 256; const int nvalid = t < 255 ? t + 1 : 256;
    LDS_WAIT();
    bf16x8 aq[4];
#pragma unroll
    for (int ks = 0; ks < 4; ++ks) aq[ks] = *(const bf16x8*)(Q + fr * 128 + ks * 32 + 8 * fq);
#pragma unroll
    for (int ks = 0; ks < 2; ++ks) { const size_t tr = (size_t)t * 64 + ks * 32 + 8 * fq;
        const f32x4 c0 = *(const f32x4*)((const float*)(F.ws + WS_COS128) + tr), c1 = *(const f32x4*)((const float*)(F.ws + WS_COS128) + tr + 4), s0 = *(const f32x4*)((const float*)(F.ws + WS_SIN128) + tr), s1 = *(const f32x4*)((const float*)(F.ws + WS_SIN128) + tr + 4);
        rope8(aq[ks], aq[ks + 2], c0, c1, s0, s1); }
    u32x4 vr[8];
#pragma unroll
    for (int i = 0; i < 8; ++i) { const int p = i * 64 + l, row = p >> 4, ch = p & 15; vr[i] = *(const u32x4*)(VB + (size_t)SEL[row] * 128 + ch * 8); }
    f32x4 sc[16]; bf16x8 k0[4], k1[4];
#define SPA_KLOAD(dst, kt) do { const bf16_t* kp_ = KB + (size_t)SEL[(kt) * 16 + fr] * 128 + 8 * fq; _Pragma("unroll") for (int ks = 0; ks < 4; ++ks) dst[ks] = *(const bf16x8*)(kp_ + ks * 32); } while (0)
#define SPA_KMUL(src, kt) do { f32x4 acc_ = (f32x4){0.f, 0.f, 0.f, 0.f}; _Pragma("unroll") for (int ks = 0; ks < 4; ++ks) acc_ = __builtin_amdgcn_mfma_f32_16x16x32_bf16(aq[ks], src[ks], acc_, 0, 0, 0); MFMA_FENCE1(acc_); \
        const bool ok_ = ((kt) * 16 + fr) < nvalid; _Pragma("unroll") for (int r = 0; r < 4; ++r) acc_[r] = ok_ ? acc_[r] * 0.08838834764831845f : -3.0e38f; sc[kt] = acc_; } while (0)
    SPA_KLOAD(k0, 0);
#pragma unroll
    for (int kt = 0; kt < 16; kt += 2) { SPA_KLOAD(k1, kt + 1); SPA_KMUL(k0, kt); if (kt + 2 < 16) SPA_KLOAD(k0, kt + 2); SPA_KMUL(k1, kt + 1); }
#undef SPA_KLOAD
#undef SPA_KMUL
    f32x4 mx = sc[0];
#pragma unroll
    for (int kt = 1; kt < 16; ++kt)
#pragma unroll
        for (int r = 0; r < 4; ++r) mx[r] = fmaxf(mx[r], sc[kt][r]);
#pragma unroll
    for (int o = 1; o < 16; o <<= 1)
#pragma unroll
        for (int r = 0; r < 4; ++r) mx[r] = fmaxf(mx[r], __shfl_xor(mx[r], o));
    f32x4 sm = (f32x4){0.f, 0.f, 0.f, 0.f};
#pragma unroll
    for (int kt = 0; kt < 16; ++kt)
#pragma unroll
        for (int r = 0; r < 4; ++r) { const float e = __expf(sc[kt][r] - mx[r]); sc[kt][r] = e; sm[r] += e; }
#pragma unroll
    for (int o = 1; o < 16; o <<= 1)
#pragma unroll
        for (int r = 0; r < 4; ++r) sm[r] += __shfl_xor(sm[r], o);
#pragma unroll
    for (int r = 0; r < 4; ++r) sm[r] = 1.f / sm[r];
#pragma unroll
    for (int kt = 0; kt < 16; ++kt)
#pragma unroll
        for (int r = 0; r < 4; ++r) sP[(4 * fq + r) * SP_PP + kt * 16 + fr] = (bf16_t)f2bf(sc[kt][r] * sm[r]);
    f32x4 o[8];
#pragma unroll
    for (int nt = 0; nt < 8; ++nt) o[nt] = (f32x4){0.f, 0.f, 0.f, 0.f};
    const unsigned tbase = (unsigned)(size_t)sV + (unsigned)(((8 * fq + (fr >> 2)) * SP_VP + 4 * (fr & 3)) * 2);
    for (int kst = 0; kst < 8; ++kst) {
#pragma unroll
        for (int i = 0; i < 8; ++i) { const int p = i * 64 + l, row = p >> 4, ch = p & 15; *(LAS u32x4*)(sV + row * SP_VP + ch * 8) = vr[i]; }
        if (kst < 7) {
#pragma unroll
            for (int i = 0; i < 8; ++i) { const int p = i * 64 + l, row = p >> 4, ch = p & 15; vr[i] = *(const u32x4*)(VB + (size_t)SEL[(kst + 1) * 32 + row] * 128 + ch * 8); } }
        const bf16x8 pa = *(const LAS bf16x8*)(sP + fr * SP_PP + kst * 32 + 8 * fq);
        LDS_WAIT(); __builtin_amdgcn_sched_barrier(0);
        s16x4 lo[8], hi[8];
        asm volatile("ds_read_b64_tr_b16 %0, %16\n\tds_read_b64_tr_b16 %1, %16 offset:32\n\tds_read_b64_tr_b16 %2, %16 offset:64\n\tds_read_b64_tr_b16 %3, %16 offset:96\n\t"
                     "ds_read_b64_tr_b16 %4, %16 offset:128\n\tds_read_b64_tr_b16 %5, %16 offset:160\n\tds_read_b64_tr_b16 %6, %16 offset:192\n\tds_read_b64_tr_b16 %7, %16 offset:224\n\t"
                     "ds_read_b64_tr_b16 %8, %16 offset:1088\n\tds_read_b64_tr_b16 %9, %16 offset:1120\n\tds_read_b64_tr_b16 %10, %16 offset:1152\n\tds_read_b64_tr_b16 %11, %16 offset:1184\n\t"
                     "ds_read_b64_tr_b16 %12, %16 offset:1216\n\tds_read_b64_tr_b16 %13, %16 offset:1248\n\tds_read_b64_tr_b16 %14, %16 offset:1280\n\tds_read_b64_tr_b16 %15, %16 offset:1312\n\ts_waitcnt lgkmcnt(0)"
                     : "=&v"(lo[0]), "=&v"(lo[1]), "=&v"(lo[2]), "=&v"(lo[3]), "=&v"(lo[4]), "=&v"(lo[5]), "=&v"(lo[6]), "=&v"(lo[7]),
                       "=&v"(hi[0]), "=&v"(hi[1]), "=&v"(hi[2]), "=&v"(hi[3]), "=&v"(hi[4]), "=&v"(hi[5]), "=&v"(hi[6]), "=&v"(hi[7]) : "v"(tbase) : "memory");
        __builtin_amdgcn_sched_barrier(0);
#pragma unroll
        for (int nt = 0; nt < 8; ++nt) { bf16x8 bv; bv[0] = lo[nt][0]; bv[1] = lo[nt][1]; bv[2] = lo[nt][2]; bv[3] = lo[nt][3]; bv[4] = hi[nt][0]; bv[5] = hi[nt][1]; bv[6] = hi[nt][2]; bv[7] = hi[nt][3];
            o[nt] = __builtin_amdgcn_mfma_f32_16x16x32_bf16(pa, bv, o[nt], 0, 0, 0); }
        __builtin_amdgcn_sched_barrier(0);
    }
    MFMA_FENCE8(o[0], o[1], o[2], o[3], o[4], o[5], o[6], o[7]);
#pragma unroll
    for (int nt = 0; nt < 8; ++nt)
#pragma unroll
        for (int r = 0; r < 4; ++r) OB[(4 * fq + r) * 128 + 16 * nt + fr] = (bf16_t)f2bf(o[nt][r]);
}

__device__ __forceinline__ void gla_level1_item(const Frame& F, int item) {
    const int lane_ = lane_id(), tid_ = F.wave * 64 + lane_; (void)tid_;
    const int fr = lane_ & 15, fq = lane_ >> 4;
    const bf16_t* KH = (const bf16_t*)(F.ws + WS_KHT) + (size_t)item * 256 * 64; const bf16_t* VT = (const bf16_t*)(F.ws + WS_VT) + ((size_t)item * 512 + F.wave * 64) * 64;
    bf16_t* ST = (bf16_t*)(F.ws + WS_ST) + ((size_t)item * 512 + F.wave * 64) * 256;
    for (int db = 0; db < 4; ++db) {
        f32x4 acc[4][4];
#pragma unroll
        for (int i = 0; i < 4; ++i)
#pragma unroll
            for (int j = 0; j < 4; ++j) acc[i][j] = (f32x4){0.f, 0.f, 0.f, 0.f};
        wave_gemm_nt<4, 4>(KH + (size_t)db * 64 * 64, 64, VT, 64, 64, acc, fr, fq);
#pragma unroll
        for (int mt = 0; mt < 4; ++mt)
#pragma unroll
            for (int nt = 0; nt < 4; ++nt) { u32x2 w; w.x = pk2(acc[mt][nt][0], acc[mt][nt][1]); w.y = pk2(acc[mt][nt][2], acc[mt][nt][3]);
                *(u32x2*)(ST + (size_t)(16 * nt + fr) * 256 + db * 64 + 16 * mt + 4 * fq) = w; }
    }
}
__device__ __forceinline__ void gla_state_item(const Frame& F, int item) {
    const int lane_ = lane_id(), fr = lane_ & 15, fq = lane_ >> 4;
    const int h = item >> 6, eb = (item >> 1) & 31, d0 = (item & 1) * 128 + F.wave * 16;
    const bf16_t* KH = (const bf16_t*)(F.ws + WS_KHT) + ((size_t)h * 256 + d0 + fr) * 64 + 8 * fq;
    const bf16_t* VT = (const bf16_t*)(F.ws + WS_VT) + ((size_t)h * 512 + eb * 16 + fr) * 64 + 8 * fq;
    bf16_t* ST = (bf16_t*)(F.ws + WS_ST) + ((size_t)h * 512 + eb * 16 + fr) * 256 + d0 + 4 * fq;
    const float* DV = (const float*)(F.ws + WS_DVEC) + h * 256 + d0 + 4 * fq;
    f32x4 S = (f32x4){0.f, 0.f, 0.f, 0.f};
#define GST_LOAD(a, b, dv, cbase) do { _Pragma("unroll") for (int i = 0; i < 4; ++i) { const size_t c = (cbase) + i; const bf16_t* kp = KH + c * (4 * 256 * 64); const bf16_t* vp = VT + c * (4 * 512 * 64); \
        a[i][0] = *(const bf16x8*)kp; a[i][1] = *(const bf16x8*)(kp + 32); b[i][0] = *(const bf16x8*)vp; b[i][1] = *(const bf16x8*)(vp + 32); dv[i] = *(const f32x4*)(DV + c * 1024); } } while (0)
#define GST_STEP(a, b, dv, cbase) do { _Pragma("unroll") for (int i = 0; i < 4; ++i) { const size_t c = (cbase) + i; \
        f32x4 L = __builtin_amdgcn_mfma_f32_16x16x32_bf16(a[i][0], b[i][0], (f32x4){0.f, 0.f, 0.f, 0.f}, 0, 0, 0); L = __builtin_amdgcn_mfma_f32_16x16x32_bf16(a[i][1], b[i][1], L, 0, 0, 0); MFMA_FENCE1(L); \
        u32x2 w; w.x = pk2(S[0], S[1]); w.y = pk2(S[2], S[3]); *(u32x2*)(ST + c * (4 * 512 * 256)) = w; S = dv[i] * S + L; } } while (0)
    bf16x8 a0[4][2], b0[4][2], a1[4][2], b1[4][2]; f32x4 dv0[4], dv1[4];
    GST_LOAD(a0, b0, dv0, 0);
    for (int c0 = 0; c0 < 128; c0 += 8) {
        GST_LOAD(a1, b1, dv1, c0 + 4);
        GST_STEP(a0, b0, dv0, c0);
        if (c0 + 8 < 128) GST_LOAD(a0, b0, dv0, c0 + 8);
        GST_STEP(a1, b1, dv1, c0 + 4);
    }
#undef GST_LOAD
#undef GST_STEP
}
__device__ __forceinline__ void gla_out_item(const Frame& F, const Args& a, int item) {
    const int lane_ = lane_id(), tid_ = F.wave * 64 + lane_; (void)tid_;
    const int c = item >> 2, h = item & 3, t0 = c * 64, fr = lane_ & 15, fq = lane_ >> 4, w = F.wave;
    LAS float* sred = (LAS float*)F.lds;
    f32x4 acc[4][4];
#pragma unroll
    for (int i = 0; i < 4; ++i)
#pragma unroll
        for (int j = 0; j < 4; ++j) acc[i][j] = (f32x4){0.f, 0.f, 0.f, 0.f};
    wave_gemm_nt<4, 4>((const bf16_t*)(F.ws + WS_ST) + ((size_t)item * 512 + w * 64) * 256, 256, (const bf16_t*)(F.ws + WS_QT) + (size_t)t0 * 1024 + h * 256, 1024, 256, acc, fr, fq);
    wave_gemm_nt<4, 4>((const bf16_t*)(F.ws + WS_VT) + ((size_t)item * 512 + w * 64) * 64, 64, (const bf16_t*)(F.ws + WS_ATT) + (size_t)item * 4096, 64, 64, acc, fr, fq);
#pragma unroll
    for (int mt = 0; mt < 4; ++mt) MFMA_FENCE4(acc[mt][0], acc[mt][1], acc[mt][2], acc[mt][3]);
    float ss[4];
#pragma unroll
    for (int nt = 0; nt < 4; ++nt) { float s = 0.f;
#pragma unroll
        for (int mt = 0; mt < 4; ++mt) s += (acc[mt][nt][0] * acc[mt][nt][0] + acc[mt][nt][1] * acc[mt][nt][1]) + (acc[mt][nt][2] * acc[mt][nt][2] + acc[mt][nt][3] * acc[mt][nt][3]);
        s += __shfl_xor(s, 16); s += __shfl_xor(s, 32); ss[nt] = s;
        if (fq == 0) sred[w * 64 + 16 * nt + fr] = s; }
    __syncthreads();
    const bf16_t* GR = (const bf16_t*)(F.ws + WS_GR); bf16_t* OA = (bf16_t*)(F.ws + WS_OA); const float* gain = a.in[7] + h * 512;
#pragma unroll
    for (int nt = 0; nt < 4; ++nt) { const int tok = 16 * nt + fr; float tot = 0.f;
#pragma unroll
        for (int ww = 0; ww < 8; ++ww) tot += sred[ww * 64 + tok];
        const float rstd = rsqrtf(tot * (1.f / 512.f) + EPS);
#pragma unroll
        for (int mt = 0; mt < 4; ++mt) { const int e = w * 64 + 16 * mt + 4 * fq; const size_t off = (size_t)(t0 + tok) * DM + h * 512 + e;
            const u32x2 g = *(const u32x2*)(GR + off); const f32x4 gn = *(const f32x4*)(gain + e);
            const float r0 = bflo(g.x), r1 = bfhi(g.x), r2 = bflo(g.y), r3 = bfhi(g.y);
            u32x2 o; o.x = pk2(acc[mt][nt][0] * rstd * gn[0] * r0 * sigmoidf_(r0), acc[mt][nt][1] * rstd * gn[1] * r1 * sigmoidf_(r1));
            o.y = pk2(acc[mt][nt][2] * rstd * gn[2] * r2 * sigmoidf_(r2), acc[mt][nt][3] * rstd * gn[3] * r3 * sigmoidf_(r3));
            *(u32x2*)(OA + off) = o; } }
    __syncthreads();
}

__device__ const unsigned char PEER_CAND[52] = {
    0x00,0x01,0x02,0x03,0x04,0x05,0x06,0x07,0x08,0x09,0x0a,0x0b,0x0c,0x0d,0x0e,0x0f, 0x10,0x11,0x12,0x13,0x14,0x15,0x16,0x17, 0x20,0x21,0x22,0x23,0x24, 0x30,0x31,0x32,0x33,
    0x40,0x41,0x42, 0x50,0x51, 0x60,0x61, 0x70,0x71, 0x80,0x90,0xa0,0xb0,0xc0,0xd0,0xe0,0xf0, 0xff,0xff };
__device__ __forceinline__ unsigned f32ord(float f) { const unsigned u = __builtin_bit_cast(unsigned, f); return (u & 0x80000000u) ? ~u : (u | 0x80000000u); }
__device__ __forceinline__ float ordf32(unsigned k) { const unsigned u = (k & 0x80000000u) ? (k & 0x7fffffffu) : ~k; return __builtin_bit_cast(float, u); }
__device__ __forceinline__ unsigned umax_x32(unsigned v) { const unsigned o = __shfl_xor(v, 32); return v > o ? v : o; }
__device__ __forceinline__ float fmax_x32(float v) { return fmaxf(v, __shfl_xor(v, 32)); }
__device__ __forceinline__ float fadd_x32(float v) { return v + __shfl_xor(v, 32); }
__device__ __forceinline__ void peer_select_item(const Frame& F, int item) {
    const int lane_ = lane_id(), tid_ = F.wave * 64 + lane_; (void)tid_;
    const int l = lane_, fr = l & 15, fq = l >> 4, t0 = (item >> 3) * 16, h = item & 7;
    LAS unsigned* tv = (LAS unsigned*)(F.lds + F.wave * 2048);
    const bf16_t* PQ = (const bf16_t*)(F.ws + WS_PQ); const bf16_t* KEYS = (const bf16_t*)(F.ws + WS_KEYS);
    int* EXPI = (int*)(F.ws + WS_EXPI); float* GATEW = (float*)(F.ws + WS_GATEW);
    {
#pragma unroll 1
        for (int p = 0; p < 2; ++p) { const int g = h * 2 + p;
            f32x4 acc[8];
#pragma unroll
            for (int mt = 0; mt < 8; ++mt) acc[mt] = (f32x4){0.f, 0.f, 0.f, 0.f};
#pragma unroll
            for (int ks = 0; ks < 4; ++ks) { const bf16x8 bq = *(const bf16x8*)(PQ + (size_t)(t0 + fr) * DM + g * 128 + ks * 32 + 8 * fq);
#pragma unroll
                for (int mt = 0; mt < 8; ++mt) acc[mt] = __builtin_amdgcn_mfma_f32_16x16x32_bf16(*(const bf16x8*)(KEYS + ((size_t)g * 128 + 16 * mt + fr) * 128 + ks * 32 + 8 * fq), bq, acc[mt], 0, 0, 0); }
            MFMA_FENCE8(acc[0], acc[1], acc[2], acc[3], acc[4], acc[5], acc[6], acc[7]);
            unsigned kk[32];
#pragma unroll
            for (int mt = 0; mt < 8; ++mt)
#pragma unroll
                for (int r = 0; r < 4; ++r) kk[mt * 4 + r] = (f32ord(acc[mt][r]) & ~127u) | (unsigned)(127 - (16 * mt + 4 * fq + r));
#pragma unroll
            for (int i = 0; i < 16; ++i) { unsigned m = kk[0];
#pragma unroll
                for (int j = 1; j < 32; ++j) m = m > kk[j] ? m : kk[j];
                { const unsigned o = __shfl_xor(m, 16); m = m > o ? m : o; } m = umax_x32(m);
#pragma unroll
                for (int j = 0; j < 32; ++j) kk[j] = (kk[j] == m) ? 0u : kk[j];
                if (fq == (i & 3)) tv[(fr * 2 + p) * 16 + i] = m; }
        }
        LDS_WAIT();
        unsigned ck[13];
#pragma unroll
        for (int ci = 0; ci < 13; ++ci) { const int cidx = fq + 4 * ci; const unsigned ab = PEER_CAND[cidx];
            if (cidx < 50) { const float v = ordf32(tv[(fr * 2 + 0) * 16 + (ab >> 4)] & ~127u) + ordf32(tv[(fr * 2 + 1) * 16 + (ab & 15)] & ~127u); ck[ci] = (f32ord(v) & ~63u) | (unsigned)(63 - cidx); }
            else ck[ci] = 0u; }
        float scv[4]; int exv[4];
#pragma unroll
        for (int i = 0; i < 16; ++i) { unsigned m = ck[0];
#pragma unroll
            for (int j = 1; j < 13; ++j) m = m > ck[j] ? m : ck[j];
            { const unsigned o = __shfl_xor(m, 16); m = m > o ? m : o; } m = umax_x32(m);
#pragma unroll
            for (int j = 0; j < 13; ++j) ck[j] = (ck[j] == m) ? 0u : ck[j];
            if (fq == (i & 3)) { const int cidx = 63 - (int)(m & 63u); const unsigned ab = PEER_CAND[cidx];
                const int n1 = 127 - (int)(tv[(fr * 2 + 0) * 16 + (ab >> 4)] & 127u), n2 = 127 - (int)(tv[(fr * 2 + 1) * 16 + (ab & 15)] & 127u);
                exv[i >> 2] = n1 * 128 + n2; scv[i >> 2] = ordf32(m & ~63u); } }
        float mx = fmaxf(fmaxf(scv[0], scv[1]), fmaxf(scv[2], scv[3])); mx = fmaxf(mx, __shfl_xor(mx, 16)); mx = fmax_x32(mx);
        float ev[4], s = 0.f;
#pragma unroll
        for (int j = 0; j < 4; ++j) { ev[j] = __expf(scv[j] - mx); s += ev[j]; }
        s += __shfl_xor(s, 16); s = fadd_x32(s); const float inv = 1.f / s;
#pragma unroll
        for (int j = 0; j < 4; ++j) { const size_t o = (size_t)(t0 + fr) * 128 + h * 16 + j * 4 + fq; EXPI[o] = exv[j]; GATEW[o] = ev[j] * inv; }
        LDS_WAIT();
    }
}
__device__ __forceinline__ float gelu_tanh(float x) { const float u = 0.7978845608028654f * (x + 0.044715f * x * x * x); const float e = __expf(2.f * u); const float th = 1.f - 2.f / (e + 1.f); return 0.5f * x * (1.f + th); }
template <bool SIGNED> __device__ __forceinline__ void quant_row(const float* src, unsigned char* dst, float* scale_out, int lane, const float* cgain) {
    f32x4 v[8]; float mx = 0.f;
#pragma unroll
    for (int i = 0; i < 2; ++i)
#pragma unroll
        for (int j = 0; j < 4; ++j) { f32x4 x = *(const f32x4*)(src + i * 1024 + lane * 16 + j * 4); if (cgain) x *= *(const f32x4*)(cgain + i * 1024 + lane * 16 + j * 4); v[i * 4 + j] = x; mx = fmaxf(mx, fmaxf(fmaxf(fabsf(x[0]), fabsf(x[1])), fmaxf(fabsf(x[2]), fabsf(x[3])))); }
#pragma unroll
    for (int o = 1; o < 64; o <<= 1) mx = fmaxf(mx, __shfl_xor(mx, o));
    const float inv = mx > 0.f ? 127.f / mx : 0.f;
#pragma unroll
    for (int i = 0; i < 2; ++i) { u32x4 w;
#pragma unroll
        for (int j = 0; j < 4; ++j) { const f32x4 x = v[i * 4 + j];
            const float off = SIGNED ? 0.f : 128.f;
            const unsigned b0 = (unsigned)(int)(rintf(x[0] * inv) + off) & 0xffu, b1 = (unsigned)(int)(rintf(x[1] * inv) + off) & 0xffu, b2 = (unsigned)(int)(rintf(x[2] * inv) + off) & 0xffu, b3 = (unsigned)(int)(rintf(x[3] * inv) + off) & 0xffu;
            w[j] = b0 | (b1 << 8) | (b2 << 16) | (b3 << 24); }
        *(u32x4*)(dst + i * 1024 + lane * 16) = w; }
    if (lane == 0) *scale_out = mx * (1.f / 127.f);
}
__device__ __forceinline__ float ub(unsigned w, int b) { return (float)((w >> (8 * b)) & 0xffu); }
__device__ __forceinline__ float dot16q(const u32x4 w, const float* x) {
    float s = 0.f;
#pragma unroll
    for (int k = 0; k < 4; ++k) { s = fmaf(ub(w[k], 0), x[4 * k + 0], s); s = fmaf(ub(w[k], 1), x[4 * k + 1], s); s = fmaf(ub(w[k], 2), x[4 * k + 2], s); s = fmaf(ub(w[k], 3), x[4 * k + 3], s); }
    return s;
}
__device__ __forceinline__ void axpy16q(const u32x4 w, float c, float* o) {
#pragma unroll
    for (int k = 0; k < 4; ++k) { o[4 * k + 0] = fmaf(c, ub(w[k], 0), o[4 * k + 0]); o[4 * k + 1] = fmaf(c, ub(w[k], 1), o[4 * k + 1]); o[4 * k + 2] = fmaf(c, ub(w[k], 2), o[4 * k + 2]); o[4 * k + 3] = fmaf(c, ub(w[k], 3), o[4 * k + 3]); }
}
__device__ __forceinline__ void peer_expert_token(const Frame& F, const Args& a, int t) {
    const int lane_ = lane_id(), tid_ = F.wave * 64 + lane_; (void)tid_;
    const int l = lane_;
    const unsigned char* UQ = (const unsigned char*)(F.ws + WS_UB); const unsigned char* VQ = UQ + 2048;
    const float* US = (const float*)(F.ws + WS_USC); const float* VS = (const float*)(F.ws + WS_VSC);
    const int* EXPI = (const int*)(F.ws + WS_EXPI) + (size_t)t * 128; const float* GATEW = (const float*)(F.ws + WS_GATEW) + (size_t)t * 128;
    const float rstd2 = rsqrtf(((const float*)(F.ws + WS_CTL))[CW_RSQ2 + t] * (1.f / DM) + EPS);
    float x[32], o[32]; float csum = 0.f;
#pragma unroll
    for (int i = 0; i < 2; ++i)
#pragma unroll
        for (int hf = 0; hf < 2; ++hf) { const u32x4 w = *(const u32x4*)((const bf16_t*)(F.ws + WS_A2) + (size_t)t * DM + i * 1024 + l * 16 + hf * 8); float* xp = x + i * 16 + hf * 8;
            xp[0] = bflo(w.x); xp[1] = bfhi(w.x); xp[2] = bflo(w.y); xp[3] = bfhi(w.y); xp[4] = bflo(w.z); xp[5] = bfhi(w.z); xp[6] = bflo(w.w); xp[7] = bfhi(w.w); }
    float xmax = 0.f;
#pragma unroll
    for (int i = 0; i < 32; ++i) { o[i] = 0.f; xmax = fmaxf(xmax, fabsf(x[i])); }
#pragma unroll
    for (int o_ = 1; o_ < 64; o_ <<= 1) xmax = fmaxf(xmax, __shfl_xor(xmax, o_));
    const float xinv = xmax > 0.f ? 127.f / xmax : 0.f, xsc = xmax * (1.f / 127.f);
    int xq[8];
#pragma unroll
    for (int k = 0; k < 8; ++k) { const unsigned b0 = (unsigned)(int)rintf(x[4 * k] * xinv) & 0xffu, b1 = (unsigned)(int)rintf(x[4 * k + 1] * xinv) & 0xffu, b2 = (unsigned)(int)rintf(x[4 * k + 2] * xinv) & 0xffu, b3 = (unsigned)(int)rintf(x[4 * k + 3] * xinv) & 0xffu;
        xq[k] = (int)(b0 | (b1 << 8) | (b2 << 16) | (b3 << 24)); }
    for (int jb = 0; jb < 32; ++jb) {
        int e[4]; float g[4];
#pragma unroll
        for (int q = 0; q < 4; ++q) { e[q] = __builtin_amdgcn_readfirstlane(EXPI[jb * 4 + q]); g[q] = __builtin_bit_cast(float, __builtin_amdgcn_readfirstlane(__builtin_bit_cast(int, GATEW[jb * 4 + q]))); }
        u32x4 uw[4][2], vw[4][2];
#pragma unroll
        for (int q = 0; q < 4; ++q) { uw[q][0] = *(const u32x4*)(UQ + (size_t)e[q] * 4096 + l * 16); uw[q][1] = *(const u32x4*)(UQ + (size_t)e[q] * 4096 + 1024 + l * 16); }
#pragma unroll
        for (int q = 0; q < 4; ++q) { vw[q][0] = *(const u32x4*)(VQ + (size_t)e[q] * 4096 + l * 16); vw[q][1] = *(const u32x4*)(VQ + (size_t)e[q] * 4096 + 1024 + l * 16); }
        int di[4];
#pragma unroll
        for (int q = 0; q < 4; ++q) { int acc = 0;
#pragma unroll
            for (int k = 0; k < 4; ++k) { acc = __builtin_amdgcn_sdot4((int)uw[q][0][k], xq[k], acc, false); acc = __builtin_amdgcn_sdot4((int)uw[q][1][k], xq[4 + k], acc, false); }
            di[q] = acc; }
        float d[4];
#pragma unroll
        for (int q = 0; q < 4; ++q) d[q] = (float)wave_sum_dpp(di[q]) * xsc;
#pragma unroll
        for (int q = 0; q < 4; ++q) { const float c = g[q] * gelu_tanh(d[q] * US[e[q]] * rstd2) * VS[e[q]]; csum += c; axpy16q(vw[q][0], c, o); axpy16q(vw[q][1], c, o + 16); }
    }
    float* H = a.out + (size_t)t * DM; const float* gf = a.in[22]; float ss = 0.f; csum *= 128.f;
#pragma unroll
    for (int i = 0; i < 32; ++i) { const float v = o[i] - csum + x[i]; o[i] = v; ss += v * v; }
    const float rstd = rsqrtf(wave_sum(ss) * (1.f / DM) + EPS);
#pragma unroll
    for (int i = 0; i < 2; ++i)
#pragma unroll
        for (int j = 0; j < 4; ++j) { const f32x4 gv = *(const f32x4*)(gf + i * 1024 + l * 16 + j * 4); f32x4 r;
#pragma unroll
            for (int k = 0; k < 4; ++k) r[k] = o[i * 16 + j * 4 + k] * rstd * gv[k];
            *(f32x4*)(H + i * 1024 + l * 16 + j * 4) = r; }
}

constexpr int N_PHASES = 17;
constexpr int QSPLIT = 20480;
#ifndef DUP_MASK
#define DUP_MASK 0
#endif
#define DUPN(k) (1 + ((DUP_MASK >> (k)) & 1))
__global__ void __launch_bounds__(NTHREADS, 2) hybrid_fwd(Args args) {
    extern __shared__ __attribute__((aligned(16))) unsigned char lds_raw[];
    Frame F;
    F.lds = (LAS unsigned char*)lds_raw;
    F.wave = __builtin_amdgcn_readfirstlane((int)threadIdx.x >> 6);
    F.G = gridDim.x; F.bid = blockIdx.x; F.ws = args.ws;
    unsigned* ctl = (unsigned*)(args.ws + WS_CTL);
    volatile LAS unsigned* MISCW = (volatile LAS unsigned*)(F.lds + LDSCTL_OFF);
    if (F.wave == 0) MISCW[lane_id()] = 0u;
    __syncthreads();
    XcdBarrier bar; bar.bar = ctl + CW_BAR; bar.x = 0; bar.st = nullptr;
    if (args.use_bar) bar = xcd_barrier_post(ctl + CW_BAR, MISCW + 8, F.wave == 0 && lane_id() == 0);
    const int lo = args.ph_lo, hi = args.ph_hi;
    LAS unsigned char* ring = F.lds;
    const int gw = F.bid * NWAVES + F.wave, NGW = F.G * NWAVES;
    float* rsq1 = (float*)ctl + CW_RSQ1; float* rsq2 = (float*)ctl + CW_RSQ2;
#define IN(k) (lo <= (k) && (k) < hi)
    unsigned long long tph0_ = 0ull;
#define TBEG(k) do { if (TPH == (k)) { __syncthreads(); tph0_ = __builtin_amdgcn_s_memrealtime(); } } while (0)
#define TEND(k) do { if (TPH == (k)) { __syncthreads(); const unsigned long long t1_ = __builtin_amdgcn_s_memrealtime(), d_ = t1_ - tph0_; while (__builtin_amdgcn_s_memrealtime() - t1_ < d_) __builtin_amdgcn_s_sleep(8); __syncthreads(); } } while (0)
#define SEAM(k) do { if (args.use_bar && IN(k) && IN((k) + 1)) { if (args.use_bar == 2) { cg::this_grid().sync(); } else { xcd_barrier(bar, F.wave); } } } while (0)
#define ROT(r) ((F.bid + F.G - ((r) % F.G)) % F.G)

    TBEG(0);
    if (IN(0)) { p0_prologue(F, args); }
    SEAM(0); TEND(0);
    TBEG(1);
    if (IN(1)) {
        { pg8::Gemm g{(const bf16_t*)(F.ws + WS_A0), (const bf16_t*)(F.ws + WS_WIN), SEQ, NIN, DM, DM, DM}; pg8::StaticOrder S; S.init(SEQ, NIN, F.G, F.bid);
          EpiRoute E{F.ws}; pg8::gemm_phase<EpiRoute, true>(ring, g, S, E, F.wave); }
        { pg8::Gemm g{(const bf16_t*)(F.ws + WS_MEMN), (const bf16_t*)(F.ws + WS_WXK), MEM, DM, DM, DM, DM}; pg8::StaticOrder S; S.init(MEM, DM, F.G, ROT(192));
          EpiBf16 E{(bf16_t*)(F.ws + WS_XK), DM, nullptr}; pg8::gemm_phase<EpiBf16, true>(ring, g, S, E, F.wave); }
        { pg8::Gemm g{(const bf16_t*)(F.ws + WS_MEMN), (const bf16_t*)(F.ws + WS_WXV), MEM, DM, DM, DM, DM}; pg8::StaticOrder S; S.init(MEM, DM, F.G, ROT(200));
          EpiBf16 E{(bf16_t*)(F.ws + WS_XV), DM, nullptr}; pg8::gemm_phase<EpiBf16, true>(ring, g, S, E, F.wave); }
    }
    SEAM(1); TEND(1);
    TBEG(2);
    if (IN(2)) for (int rep_ = 0; rep_ < DUPN(2); ++rep_) {
#pragma unroll 1
        for (int h = 0; h < 4; ++h) {
            pg8::Gemm g{(const bf16_t*)(F.ws + WS_XK) + h * 512, (const bf16_t*)(F.ws + WS_WXQ) + h * 512, MEM, DM, 512, DM, DM}; pg8::StaticOrder S; S.init(MEM, DM, F.G, ROT(8 * h));
            EpiBf16 E{(bf16_t*)(F.ws + WS_WQK) + (size_t)h * 256 * DM, DM, nullptr}; pg8::gemm_phase<EpiBf16, true>(ring, g, S, E, F.wave); }
#pragma unroll 1
        for (int h = 0; h < 4; ++h) {
            pg8::Gemm g{(const bf16_t*)(F.ws + WS_WXO) + h * 512, (const bf16_t*)(F.ws + WS_XV) + h * 512, DM, MEM, 512, DM, DM}; pg8::StaticOrder S; S.init(DM, MEM, F.G, ROT(32 + 8 * h));
            EpiBf16 E{(bf16_t*)(F.ws + WS_WVO) + h * 256, 1024, nullptr}; pg8::gemm_phase<EpiBf16, true>(ring, g, S, E, F.wave); }
        __syncthreads();
        for (int t = gw; t < SEQ; t += NGW) rope_token(F, args, t);
        for (int it = F.bid; it < 512; it += F.G) gla_prep_item(F, args, it);
    }
    SEAM(2); TEND(2);
    TBEG(3);
    if (IN(3)) { for (int it = F.bid; it < SC_ITEMS; it += F.G) scores_item(F, it); }
    SEAM(3); TEND(3);
    TBEG(4);
    if (IN(4)) for (int rep_ = 0; rep_ < DUPN(4); ++rep_) { for (int t = gw; t < SEQ; t += NGW) { select_row(F, t); sparse_attn_query(F, t); } }
    SEAM(5); TEND(4);
    TBEG(6);
    if (IN(6)) { for (int it = F.bid; it < 256; it += F.G) gla_state_item(F, it); }
    SEAM(7); TEND(6);
    TBEG(8);
    if (IN(8)) { for (int it = F.bid; it < 512; it += F.G) gla_out_item(F, args, it); }
    SEAM(8); TEND(8);
    TBEG(9);
    if (IN(9)) { pg8::Gemm g{(const bf16_t*)(F.ws + WS_OA), (const bf16_t*)(F.ws + WS_WPA), SEQ, DM, DM, DM, DM}; pg8::StaticOrder S; S.init(SEQ, DM, F.G, F.bid);
        EpiGate E{(bf16_t*)(F.ws + WS_T1), (const bf16_t*)(F.ws + WS_GATES), 0, nullptr}; pg8::gemm_phase<EpiGate, true>(ring, g, S, E, F.wave); }
    TEND(9);
    TBEG(10);
    if (IN(10)) { pg8::Gemm g{(const bf16_t*)(F.ws + WS_OB), (const bf16_t*)(F.ws + WS_WPB), SEQ, DM, DM, DM, DM}; pg8::StaticOrder S; S.init(SEQ, DM, F.G, F.bid);
        EpiGate E{(bf16_t*)(F.ws + WS_MERGED), (const bf16_t*)(F.ws + WS_GATES), 2048, (const bf16_t*)(F.ws + WS_T1)}; pg8::gemm_phase<EpiGate, true>(ring, g, S, E, F.wave); }
    SEAM(10); TEND(10);
    TBEG(11);
    if (IN(11)) { { pg8::Gemm g{(const bf16_t*)(F.ws + WS_MERGED), (const bf16_t*)(F.ws + WS_WOUT), SEQ, DM, DM, DM, DM}; pg8::StaticOrder S; S.init(SEQ, DM, F.G, F.bid);
          EpiResNorm<true> E{args.in[0], (bf16_t*)(F.ws + WS_A1), rsq1}; pg8::gemm_phase<EpiResNorm<true>, true>(ring, g, S, E, F.wave); }
        const int lane_ = lane_id();
        for (int r = QSPLIT + gw; r < 32768; r += NGW) { const int e = r & 16383;
            if (r < 16384) quant_row<true>(args.in[20] + (size_t)e * DM, (unsigned char*)(F.ws + WS_UB) + (size_t)e * 4096, (float*)(F.ws + WS_USC) + e, lane_, args.in[17]);
            else quant_row<false>(args.in[21] + (size_t)e * DM, (unsigned char*)(F.ws + WS_UB) + (size_t)e * 4096 + 2048, (float*)(F.ws + WS_VSC) + e, lane_, nullptr); }
    }
    SEAM(11); TEND(11);
    TBEG(12);
    if (IN(12)) { { pg8::Gemm g{(const bf16_t*)(F.ws + WS_A1), (const bf16_t*)(F.ws + WS_WQK), SEQ, 1024, DM, DM, DM}; pg8::StaticOrder S; S.init(SEQ, 1024, F.G, F.bid);
        EpiSoftmax E{(bf16_t*)(F.ws + WS_XP), 1024, rsq1, 0.044194173824159216f}; pg8::gemm_phase<EpiSoftmax, false>(ring, g, S, E, F.wave); }
        if (F.bid >= 128) { const int lane_ = lane_id();
            for (int r = (F.bid - 128) * NWAVES + F.wave; r < QSPLIT; r += (F.G - 128) * NWAVES) { const int e = r & 16383;
                if (r < 16384) quant_row<true>(args.in[20] + (size_t)e * DM, (unsigned char*)(F.ws + WS_UB) + (size_t)e * 4096, (float*)(F.ws + WS_USC) + e, lane_, args.in[17]);
                else quant_row<false>(args.in[21] + (size_t)e * DM, (unsigned char*)(F.ws + WS_UB) + (size_t)e * 4096 + 2048, (float*)(F.ws + WS_VSC) + e, lane_, nullptr); } }
    }
    SEAM(12); TEND(12);
    TBEG(13);
    if (IN(13)) { pg8::Gemm g{(const bf16_t*)(F.ws + WS_XP), (const bf16_t*)(F.ws + WS_WVO), SEQ, DM, 1024, 1024, 1024}; pg8::StaticOrder S; S.init(SEQ, DM, F.G, F.bid);
        EpiResNorm<false> E{(const bf16_t*)(F.ws + WS_A1), (bf16_t*)(F.ws + WS_A2), rsq2}; pg8::gemm_phase<EpiResNorm<false>, true>(ring, g, S, E, F.wave); }
    SEAM(13); TEND(13);
    TBEG(14);
    if (IN(14)) { pg8::Gemm g{(const bf16_t*)(F.ws + WS_A2), (const bf16_t*)(F.ws + WS_WPQ), SEQ, DM, DM, DM, DM}; pg8::StaticOrder S; S.init(SEQ, DM, F.G, F.bid);
        EpiBf16 E{(bf16_t*)(F.ws + WS_PQ), DM, rsq2}; pg8::gemm_phase<EpiBf16, true>(ring, g, S, E, F.wave); }
    SEAM(14); TEND(14);
    TBEG(15);
    if (IN(15)) { for (int it = gw; it < SEQ / 2; it += NGW) peer_select_item(F, it); }
    SEAM(15); TEND(15);
    TBEG(16);
    if (IN(16)) { for (int t = gw; t < SEQ; t += NGW) peer_expert_token(F, args, t); }
    TEND(16);
#undef IN
#undef SEAM
#undef ROT
}

#ifndef MK_ONE_LAUNCH
#define MK_ONE_LAUNCH 1
#endif
extern "C" void kernel_launch(void* const* d_in, const int* in_sizes, int n_in, void* d_out, int out_size, void* d_ws, size_t ws_size, hipStream_t stream) {
    static int grid = 0;
    if (grid == 0) {
        if (n_in != 23 || out_size != SEQ * DM || ws_size < WS_END) { fprintf(stderr, "kernel_launch: unexpected problem (n_in %d, out %d, ws %zu < %zu)\n", n_in, out_size, ws_size, (size_t)WS_END); grid = -1; return; }
        int dev = 0, cus = 0, per_cu = 0;
        if (hipGetDevice(&dev) != hipSuccess || hipDeviceGetAttribute(&cus, hipDeviceAttributeMultiprocessorCount, dev) != hipSuccess) { grid = -1; return; }
        if (hipFuncSetAttribute((const void*)hybrid_fwd, hipFuncAttributeMaxDynamicSharedMemorySize, LDS_BYTES) != hipSuccess) { fprintf(stderr, "kernel_launch: hipFuncSetAttribute failed\n"); grid = -1; return; }
        if (hipOccupancyMaxActiveBlocksPerMultiprocessor(&per_cu, (const void*)hybrid_fwd, NTHREADS, LDS_BYTES) != hipSuccess || per_cu < 1) { fprintf(stderr, "kernel_launch: occupancy query says %d\n", per_cu); per_cu = 1; }
        (void)hipGetLastError();
        grid = cus;
    }
    if (grid < 0) return;
    (void)hipMemsetAsync((char*)d_ws + WS_CTL, 0, CTL_ZERO_BYTES, stream);
    Args a{};
    for (int i = 0; i < 23; ++i) a.in[i] = (const float*)d_in[i];
    a.out = (float*)d_out; a.ws = (unsigned char*)d_ws;
#if MK_ONE_LAUNCH
    a.ph_lo = 0; a.ph_hi = N_PHASES; a.use_bar = 1;
    void* kargs[] = {&a};
    hipError_t e = hipLaunchCooperativeKernel((const void*)hybrid_fwd, dim3(grid), dim3(NTHREADS), kargs, LDS_BYTES, stream);
    if (e != hipSuccess) fprintf(stderr, "cooperative launch failed: %s (grid %d)\n", hipGetErrorString(e), grid);
#else
    for (int p = 0; p < N_PHASES; ++p) { a.ph_lo = p; a.ph_hi = p + 1; a.use_bar = 0;
        hipLaunchKernelGGL(hybrid_fwd, dim3(grid), dim3(NTHREADS), LDS_BYTES, stream, a); }
#endif
}
```

```cpp
#include <hip/hip_runtime.h>
#include <hip/hip_cooperative_groups.h>
#include <cstdio>
#include <cstdint>
namespace cg = cooperative_groups;

#define GAS __attribute__((address_space(1)))
#define LAS __attribute__((address_space(3)))
#ifndef TPH
#define TPH -1
#endif
typedef unsigned short bf16_t;
typedef short bf16x8 __attribute__((ext_vector_type(8)));
typedef short s16x4 __attribute__((ext_vector_type(4)));
typedef float f32x4 __attribute__((ext_vector_type(4)));
typedef float f32x2 __attribute__((ext_vector_type(2)));
typedef _Float16 f16x2 __attribute__((ext_vector_type(2)));
typedef unsigned u32x4 __attribute__((ext_vector_type(4)));
typedef unsigned u32x2 __attribute__((ext_vector_type(2)));
#define RLX_AGENT __ATOMIC_RELAXED, __HIP_MEMORY_SCOPE_AGENT
#define LDS_WAIT() asm volatile("s_waitcnt lgkmcnt(0)" ::: "memory")
#define VM_WAIT() asm volatile("s_waitcnt vmcnt(0)" ::: "memory")

__device__ __forceinline__ int lane_id() { int l; asm volatile("v_mbcnt_lo_u32_b32 %0, -1, 0\n\tv_mbcnt_hi_u32_b32 %0, -1, %0" : "=v"(l)); return l; }
__device__ __forceinline__ unsigned pk2(float lo, float hi) { unsigned r; asm("v_cvt_pk_bf16_f32 %0, %1, %2" : "=v"(r) : "v"(lo), "v"(hi)); return r; }
__device__ __forceinline__ unsigned f2bf(float f) { return pk2(f, 0.f) & 0xffffu; }
__device__ __forceinline__ float bf2f(unsigned short b) { return __builtin_bit_cast(float, (unsigned)b << 16); }
__device__ __forceinline__ float bflo(unsigned w) { return __builtin_bit_cast(float, w << 16); }
__device__ __forceinline__ float bfhi(unsigned w) { return __builtin_bit_cast(float, w & 0xffff0000u); }
#define XSWAP16(a, b) asm volatile("s_nop 1\n\tv_permlane16_swap_b32 %0, %1" : "+v"(a), "+v"(b))
#define XSWAP32(a, b) asm volatile("s_nop 1\n\tv_permlane32_swap_b32 %0, %1" : "+v"(a), "+v"(b))
__device__ __forceinline__ unsigned umax_x16x32(unsigned v) { unsigned a = v, b = v; XSWAP16(a, b); v = a > b ? a : b; a = v; b = v; XSWAP32(a, b); return a > b ? a : b; }
__device__ __forceinline__ float fmax_x16x32(float v) { float a = v, b = v; XSWAP16(a, b); v = fmaxf(a, b); a = v; b = v; XSWAP32(a, b); return fmaxf(a, b); }
__device__ __forceinline__ float fadd_x16x32(float v) { float a = v, b = v; XSWAP16(a, b); v = a + b; a = v; b = v; XSWAP32(a, b); return a + b; }
template <int CTRL> __device__ __forceinline__ float dppf(float v) { return __builtin_bit_cast(float, __builtin_amdgcn_update_dpp(0, __builtin_bit_cast(int, v), CTRL, 0xf, 0xf, true)); }
__device__ __forceinline__ float row16_max(float v) { v = fmaxf(v, dppf<0xB1>(v)); v = fmaxf(v, dppf<0x4E>(v)); v = fmaxf(v, dppf<0x141>(v)); return fmaxf(v, dppf<0x140>(v)); }
__device__ __forceinline__ float row16_sum(float v) { v += dppf<0xB1>(v); v += dppf<0x4E>(v); v += dppf<0x141>(v); return v + dppf<0x140>(v); }
__device__ __forceinline__ float wave_sum(float v) { return fadd_x16x32(row16_sum(v)); }
__device__ __forceinline__ float wave_max(float v) { return fmax_x16x32(row16_max(v)); }
__device__ __forceinline__ int wave_scan_dpp(int v) {
    v += __builtin_amdgcn_update_dpp(0, v, 0x111, 0xf, 0xf, true);
    v += __builtin_amdgcn_update_dpp(0, v, 0x112, 0xf, 0xf, true);
    v += __builtin_amdgcn_update_dpp(0, v, 0x114, 0xf, 0xf, true);
    v += __builtin_amdgcn_update_dpp(0, v, 0x118, 0xf, 0xf, true);
    v += __builtin_amdgcn_update_dpp(0, v, 0x142, 0xa, 0xf, false);
    v += __builtin_amdgcn_update_dpp(0, v, 0x143, 0xc, 0xf, false);
    return v;
}
#define MFMA_FENCE1(a) asm volatile("s_nop 15\n\ts_nop 3" : "+v"(a))
#define MFMA_FENCE4(a, b, c, d) asm volatile("s_nop 15\n\ts_nop 3" : "+v"(a), "+v"(b), "+v"(c), "+v"(d))
#define MFMA_FENCE8(a, b, c, d, e, f, g, h) asm volatile("s_nop 15\n\ts_nop 3" : "+v"(a), "+v"(b), "+v"(c), "+v"(d), "+v"(e), "+v"(f), "+v"(g), "+v"(h))
__device__ __forceinline__ int wave_sum_dpp(int v) {
    v += __builtin_amdgcn_update_dpp(0, v, 0x111, 0xf, 0xf, true);
    v += __builtin_amdgcn_update_dpp(0, v, 0x112, 0xf, 0xf, true);
    v += __builtin_amdgcn_update_dpp(0, v, 0x114, 0xf, 0xf, true);
    v += __builtin_amdgcn_update_dpp(0, v, 0x118, 0xf, 0xf, true);
    v += __builtin_amdgcn_update_dpp(0, v, 0x142, 0xa, 0xf, false);
    v += __builtin_amdgcn_update_dpp(0, v, 0x143, 0xc, 0xf, false);
    return __builtin_amdgcn_readlane(v, 63);
}
constexpr int SEL_LDS_OFF = 137216;
__device__ __forceinline__ float sigmoidf_(float x) { return __builtin_amdgcn_rcpf(1.f + __expf(-x)); }

namespace pg8 {
constexpr int BM = 256, BK = 64, HALF = 128, HTB = HALF * BK * 2, STAGE_BYTES = 8 * HTB, NXCD = 8, WGM = 8;
__host__ __device__ __forceinline__ int lds_byte(int r, int c) { const int st = (r >> 4) * 2 + (c >> 5), rr = r & 15, cc = c & 31, ob = rr * 64 + cc * 2; return st * 1024 + (ob ^ (((ob >> 9) & 1) << 5)); }
__host__ __device__ __forceinline__ void stage_rc(int b, int& R, int& C) { const int st = b / 1024, sb = b % 1024, swz = sb ^ (((sb >> 9) & 1) << 5); R = (st >> 1) * 16 + swz / 64; C = (st & 1) * 32 + (swz % 64) / 2; }
__host__ __device__ __forceinline__ int perm32(int rho) { const int n = rho >> 4, i = rho & 15; return 8 * (i >> 2) + 4 * n + (i & 3); }

struct Unit { int pm, pn; };
struct Gemm { const bf16_t* A; const bf16_t* Bt; int M, N, K, lda, ldb; };

struct StaticOrder {
    int nM, nN, nwg, G, c;
    __device__ void init(int M, int N, int G_, int c_) { nM = M / BM; nN = N / BM; nwg = nM * nN; G = G_; c = c_; }
    __device__ bool next(int i, Unit& u) const {
        const long L = (long)i * G + c; if (L >= nwg) return false;
        int wgid = (int)L; { const int q = nwg / NXCD, r = nwg % NXCD, xcd = wgid % NXCD, off = wgid / NXCD; wgid = (xcd < r ? xcd * (q + 1) : r * (q + 1) + (xcd - r) * q) + off; }
        const int nig = WGM * nN, gid = wgid / nig, fm = gid * WGM, gsz = (nM - fm) < WGM ? (nM - fm) : WGM;
        u.pm = fm + ((wgid % nig) % gsz); u.pn = (wgid % nig) / gsz; return true;
    }
};

__device__ __forceinline__ unsigned cvt_pk_bf16(float lo, float hi) { unsigned r; asm volatile("v_cvt_pk_bf16_f32 %0, %1, %2" : "=v"(r) : "v"(lo), "v"(hi)); return r; }

template <class Epi, bool ALIGN_EPI>
__device__ __forceinline__ void gemm_phase(LAS unsigned char* lds, const Gemm g, const StaticOrder& S, const Epi& E, int wave_in) {
    const int lane = lane_id(), wid = wave_in, tid = wid * 64 + lane, wr = wid >> 2, wc = wid & 3, fr = lane & 15, fq = lane >> 4;
    const int K = g.K, nt = K / BK;
    unsigned voffA[2], voffB[2];
#pragma unroll
    for (int i = 0; i < 2; ++i) { int R, C; stage_rc(tid * 16 + i * 8192, R, C); const int Rb = (R & ~31) + perm32(R & 31);
        voffA[i] = (unsigned)(R * g.lda + C) * 2u; voffB[i] = (unsigned)(Rb * g.ldb + C) * 2u; }
    const size_t kstep = (size_t)(BK * 2);
    const size_t hstepA = (size_t)HALF * g.lda * 2, hstepB = (size_t)HALF * g.ldb * 2;
    const size_t tstepA = 2 * hstepA, tstepB = 2 * hstepB;
    const unsigned ldsw = (unsigned)wid * 1024u;
    const int aoff = lds_byte(wr * 64 + fr, fq * 8), boff = lds_byte(wc * 32 + fr, fq * 8);
#define PG8_SA(b, h) (((b) * 2 + (h)) * HTB)
#define PG8_SB(b, h) ((4 + (b) * 2 + (h)) * HTB)
#define PG8_STAGE(bufoff, gbase, voff) do { _Pragma("unroll") for (int _i = 0; _i < 2; ++_i) \
        __builtin_amdgcn_global_load_lds((const unsigned*)((const char*)(gbase) + (voff)[_i]), (LAS unsigned*)(lds + (bufoff) + ldsw + _i * 8192), 16, 0, 0); } while (0)
#define PG8_LDA(dst, b, h) do { _Pragma("unroll") for (int m = 0; m < 4; ++m) _Pragma("unroll") for (int k = 0; k < 2; ++k) dst[m][k] = *(const LAS bf16x8*)(lds + PG8_SA(b, h) + aoff + m * 2048 + k * 1024); } while (0)
#define PG8_LDB(dst, b, h) do { _Pragma("unroll") for (int n = 0; n < 2; ++n) _Pragma("unroll") for (int k = 0; k < 2; ++k) dst[n][k] = *(const LAS bf16x8*)(lds + PG8_SB(b, h) + boff + n * 2048 + k * 1024); } while (0)
#define PG8_MMA(ai, bj, At, Bt) do { __builtin_amdgcn_s_setprio(1); _Pragma("unroll") for (int m = 0; m < 4; ++m) _Pragma("unroll") for (int n = 0; n < 2; ++n) _Pragma("unroll") for (int k = 0; k < 2; ++k) \
        acc[ai][bj][m][n] = __builtin_amdgcn_mfma_f32_16x16x32_bf16(Bt[n][k], At[m][k], acc[ai][bj][m][n], 0, 0, 0); __builtin_amdgcn_s_setprio(0); } while (0)
#define PG8_WAIT_V(n) asm volatile("s_waitcnt vmcnt(" #n ")" ::: "memory")
#define PG8_WAIT_L(n) asm volatile("s_waitcnt lgkmcnt(" #n ")" ::: "memory")
#define PG8_BAR __builtin_amdgcn_s_barrier()
#define PG8_SCHED __builtin_amdgcn_sched_barrier(0)
    Unit cur, nxt; int ui = 0;
    if (!S.next(0, cur)) return;
    f32x4 acc[2][2][4][2];
#pragma unroll
    for (int a = 0; a < 2; ++a)
#pragma unroll
        for (int b = 0; b < 2; ++b)
#pragma unroll
            for (int m = 0; m < 4; ++m)
#pragma unroll
                for (int n = 0; n < 2; ++n) acc[a][b][m][n] = (f32x4){0.f, 0.f, 0.f, 0.f};
    bf16x8 At[4][2], B0[2][2], B1[2][2];
    const char* cA = (const char*)g.A + (size_t)cur.pm * tstepA; const char* cB = (const char*)g.Bt + (size_t)cur.pn * tstepB;
    PG8_STAGE(PG8_SB(0, 0), cB, voffB); PG8_STAGE(PG8_SB(0, 1), cB + hstepB, voffB); PG8_STAGE(PG8_SA(0, 0), cA, voffA); PG8_STAGE(PG8_SA(0, 1), cA + hstepA, voffA);
    if (wr == 1) PG8_BAR;
    PG8_WAIT_V(2); PG8_BAR;
    PG8_STAGE(PG8_SB(1, 0), cB + kstep, voffB); PG8_STAGE(PG8_SA(1, 0), cA + kstep, voffA); PG8_STAGE(PG8_SB(1, 1), cB + hstepB + kstep, voffB);
    PG8_WAIT_V(6); PG8_BAR;
    for (;;) {
        const bool has_next = S.next(ui + 1, nxt);
        const char* nA = has_next ? (const char*)g.A + (size_t)nxt.pm * tstepA : cA; const char* nB = has_next ? (const char*)g.Bt + (size_t)nxt.pn * tstepB : cB;
        for (int t = 0; t < nt; t += 2) {
            const bool last = (t == nt - 2);
            const char* a1 = cA + (size_t)(t + 1) * kstep;
            const char* a2 = last ? nA : cA + (size_t)(t + 2) * kstep; const char* b2 = last ? nB : cB + (size_t)(t + 2) * kstep;
            const char* a3 = a2 + kstep; const char* b3 = b2 + kstep;
            PG8_LDB(B0, 0, 0); PG8_LDB(B1, 0, 1); PG8_SCHED; PG8_LDA(At, 0, 0); PG8_STAGE(PG8_SA(1, 1), a1 + hstepA, voffA);
            PG8_WAIT_V(8); PG8_WAIT_L(0); PG8_BAR; PG8_MMA(0, 0, At, B0); PG8_MMA(0, 1, At, B1); PG8_BAR; PG8_SCHED;
            PG8_LDA(At, 0, 1); PG8_STAGE(PG8_SB(0, 0), b2, voffB); PG8_STAGE(PG8_SB(0, 1), b2 + hstepB, voffB); PG8_STAGE(PG8_SA(0, 0), a2, voffA);
            PG8_WAIT_V(8); PG8_WAIT_L(0); PG8_BAR; PG8_MMA(1, 0, At, B0); PG8_MMA(1, 1, At, B1); PG8_BAR; PG8_SCHED;
            PG8_LDB(B0, 1, 0); PG8_LDB(B1, 1, 1); PG8_SCHED; PG8_LDA(At, 1, 0); PG8_STAGE(PG8_SA(0, 1), a2 + hstepA, voffA);
            PG8_WAIT_V(8); PG8_WAIT_L(0); PG8_BAR; PG8_MMA(0, 0, At, B0); PG8_MMA(0, 1, At, B1); PG8_BAR; PG8_SCHED;
            PG8_LDA(At, 1, 1); PG8_STAGE(PG8_SB(1, 0), b3, voffB); PG8_STAGE(PG8_SB(1, 1), b3 + hstepB, voffB); PG8_STAGE(PG8_SA(1, 0), a3, voffA);
            PG8_WAIT_V(8); PG8_WAIT_L(0); PG8_BAR; PG8_MMA(1, 0, At, B0); PG8_MMA(1, 1, At, B1); PG8_BAR; PG8_SCHED;
        }
        if constexpr (ALIGN_EPI) { if (wr == 0) PG8_BAR; }
        if constexpr (!Epi::AFTER_DRAIN) { E(acc, cur, wr, wc, fr, fq); }
        if (!has_next) break;
#pragma unroll
        for (int a = 0; a < 2; ++a)
#pragma unroll
            for (int b = 0; b < 2; ++b)
#pragma unroll
                for (int m = 0; m < 4; ++m)
#pragma unroll
                    for (int n = 0; n < 2; ++n) acc[a][b][m][n] = (f32x4){0.f, 0.f, 0.f, 0.f};
        cur = nxt; cA = nA; cB = nB; ++ui;
        if constexpr (ALIGN_EPI) { if (wr == 1) PG8_BAR; }
    }
    PG8_WAIT_V(0);
    if constexpr (!ALIGN_EPI) { if (wr == 0) PG8_BAR; }
    PG8_BAR;
    if constexpr (Epi::AFTER_DRAIN) { E.fused(acc, cur, wr, wc, fr, fq, lds, wid, lane); }
#undef PG8_SA
#undef PG8_SB
#undef PG8_STAGE
#undef PG8_LDA
#undef PG8_LDB
#undef PG8_MMA
#undef PG8_WAIT_V
#undef PG8_WAIT_L
#undef PG8_BAR
#undef PG8_SCHED
}
}
using pg8::Unit;

constexpr int SEQ = 8192, DM = 2048, MEM = 256;
constexpr int NIN = 13824;
constexpr float EPS = 1e-6f;
constexpr size_t MiB = 1u << 20;
constexpr size_t WS_CTL = 0, CTL_ZERO_BYTES = 1 * MiB;
constexpr size_t WS_MEMN = 1 * MiB, WS_XK = 2 * MiB, WS_XV = 3 * MiB, WS_DVEC = 4 * MiB, WS_KEYS = 5 * MiB, WS_IW = 6 * MiB;
constexpr size_t WS_WPA = 8 * MiB, WS_WPB = 16 * MiB, WS_WOUT = 24 * MiB, WS_WXQ = 32 * MiB, WS_WXK = 40 * MiB, WS_WXV = 48 * MiB, WS_WXO = 56 * MiB, WS_WPQ = 64 * MiB;
constexpr size_t WS_WIN = 72 * MiB, WS_A0 = 126 * MiB;
constexpr size_t WS_QT = 72 * MiB, WS_KHT = 88 * MiB, WS_VT = 104 * MiB, WS_ATT = 136 * MiB, WS_KBR = 140 * MiB, WS_VB = 142 * MiB, WS_KIR = 144 * MiB, WS_SEL = 145 * MiB, WS_WQK = 153 * MiB, WS_WVO = 157 * MiB;
constexpr size_t WS_GR = 162 * MiB, WS_DQ = 194 * MiB, WS_GATES = 226 * MiB, WS_MISC = 290 * MiB, WS_IQ = 298 * MiB, WS_GQK = 314 * MiB, WS_GV = 346 * MiB, WS_SCORES = 378 * MiB, WS_OA = 506 * MiB;
constexpr size_t WS_ST = 378 * MiB, WS_OB = 314 * MiB, WS_T1 = 346 * MiB, WS_MERGED = 194 * MiB, WS_A1 = 162 * MiB, WS_XP = 298 * MiB, WS_A2 = 194 * MiB, WS_PQ = 226 * MiB, WS_EXPI = 258 * MiB, WS_GATEW = 262 * MiB;
constexpr size_t WS_UB = 378 * MiB, WS_VBF = 410 * MiB, WS_USC = 7 * MiB, WS_VSC = 7 * MiB + 65536, WS_COS128 = 538 * MiB, WS_SIN128 = 540 * MiB, WS_COS64 = 542 * MiB, WS_SIN64 = 543 * MiB, WS_END = 544 * MiB;
constexpr int CW_BAR = 4096;
constexpr int CW_RSQ1 = 65536, CW_RSQ2 = 65536 + 8192;
constexpr int MISC_LD = 512;

constexpr int RING_BYTES = 131072;
constexpr int LDSCTL_OFF = 147456 - 256;
constexpr int LDS_BYTES = 147456;
constexpr int NWAVES = 8, NTHREADS = 512;

__device__ __forceinline__ u32x4 pack8(const f32x4 v0, const f32x4 v1) { u32x4 w; w.x = pg8::cvt_pk_bf16(v0[0], v0[1]); w.y = pg8::cvt_pk_bf16(v0[2], v0[3]); w.z = pg8::cvt_pk_bf16(v1[0], v1[1]); w.w = pg8::cvt_pk_bf16(v1[2], v1[3]); return w; }

struct EpiRoute {
    static constexpr bool AFTER_DRAIN = false;
    unsigned char* ws;
    __device__ __forceinline__ void operator()(const f32x4 (&acc)[2][2][4][2], const Unit& u, int wr, int wc, int fr, int fq) const {
        const int pn = u.pn; bf16_t* base; int ldc, c0;
        if (pn < 8) { base = (bf16_t*)(ws + WS_GQK); ldc = 2048; c0 = pn * 256; }
        else if (pn < 16) { base = (bf16_t*)(ws + WS_GV); ldc = 2048; c0 = (pn - 8) * 256; }
        else if (pn < 24) { base = (bf16_t*)(ws + WS_GR); ldc = 2048; c0 = (pn - 16) * 256; }
        else if (pn < 32) { base = (bf16_t*)(ws + WS_DQ); ldc = 2048; c0 = (pn - 24) * 256; }
        else if (pn < 36) { base = (bf16_t*)(ws + WS_IQ); ldc = 1024; c0 = (pn - 32) * 256; }
        else if (pn < 52) { base = (bf16_t*)(ws + WS_GATES); ldc = 4096; c0 = (pn - 36) * 256; }
        else { base = (bf16_t*)(ws + WS_MISC); ldc = MISC_LD; c0 = (pn - 52) * 256; }
        const int row0 = u.pm * 256 + wr * 64 + fr, col0 = c0 + wc * 32 + 8 * fq;
#pragma unroll
        for (int ai = 0; ai < 2; ++ai)
#pragma unroll
            for (int m = 0; m < 4; ++m) { bf16_t* rowp = base + (size_t)(row0 + ai * 128 + m * 16) * ldc + col0;
#pragma unroll
                for (int bj = 0; bj < 2; ++bj) *(u32x4*)(rowp + bj * 128) = pack8(acc[ai][bj][m][0], acc[ai][bj][m][1]); }
    }
};
struct EpiBf16 {
    static constexpr bool AFTER_DRAIN = false;
    bf16_t* O; int ldc; const float* rowsq;
    __device__ __forceinline__ void operator()(const f32x4 (&acc)[2][2][4][2], const Unit& u, int wr, int wc, int fr, int fq) const {
        const int row0 = u.pm * 256 + wr * 64 + fr, col0 = u.pn * 256 + wc * 32 + 8 * fq;
#pragma unroll
        for (int ai = 0; ai < 2; ++ai)
#pragma unroll
            for (int m = 0; m < 4; ++m) { const int row = row0 + ai * 128 + m * 16; bf16_t* rowp = O + (size_t)row * ldc + col0;
                const float sc = rowsq ? rsqrtf(rowsq[row] * (1.f / DM) + EPS) : 1.f;
#pragma unroll
                for (int bj = 0; bj < 2; ++bj) *(u32x4*)(rowp + bj * 128) = pack8(acc[ai][bj][m][0] * sc, acc[ai][bj][m][1] * sc); }
    }
};
struct EpiGate {
    static constexpr bool AFTER_DRAIN = false;
    bf16_t* O; const bf16_t* gates; int goff; const bf16_t* prev;
    __device__ __forceinline__ void operator()(const f32x4 (&acc)[2][2][4][2], const Unit& u, int wr, int wc, int fr, int fq) const {
        const int row0 = u.pm * 256 + wr * 64 + fr, col0 = u.pn * 256 + wc * 32 + 8 * fq;
#pragma unroll
        for (int ai = 0; ai < 2; ++ai)
#pragma unroll
            for (int m = 0; m < 4; ++m) { const int row = row0 + ai * 128 + m * 16;
#pragma unroll
                for (int bj = 0; bj < 2; ++bj) { const int col = col0 + bj * 128;
                    const u32x4 gw = *(const u32x4*)(gates + (size_t)row * 4096 + goff + col);
                    f32x4 v0 = acc[ai][bj][m][0], v1 = acc[ai][bj][m][1];
                    v0[0] *= sigmoidf_(bflo(gw.x)); v0[1] *= sigmoidf_(bfhi(gw.x)); v0[2] *= sigmoidf_(bflo(gw.y)); v0[3] *= sigmoidf_(bfhi(gw.y));
                    v1[0] *= sigmoidf_(bflo(gw.z)); v1[1] *= sigmoidf_(bfhi(gw.z)); v1[2] *= sigmoidf_(bflo(gw.w)); v1[3] *= sigmoidf_(bfhi(gw.w));
                    if (prev) { const u32x4 pw = *(const u32x4*)(prev + (size_t)row * DM + col);
                        v0[0] += bflo(pw.x); v0[1] += bfhi(pw.x); v0[2] += bflo(pw.y); v0[3] += bfhi(pw.y); v1[0] += bflo(pw.z); v1[1] += bfhi(pw.z); v1[2] += bflo(pw.w); v1[3] += bfhi(pw.w); }
                    *(u32x4*)(O + (size_t)row * DM + col) = pack8(v0, v1); } }
    }
};
template <bool BASE_F32> struct EpiResNorm {
    static constexpr bool AFTER_DRAIN = false;
    const void* base; bf16_t* Hn; float* rowsq;
    __device__ __forceinline__ void operator()(const f32x4 (&acc)[2][2][4][2], const Unit& u, int wr, int wc, int fr, int fq) const {
        const int row0 = u.pm * 256 + wr * 64 + fr, col0 = u.pn * 256 + wc * 32 + 8 * fq;
#pragma unroll
        for (int ai = 0; ai < 2; ++ai)
#pragma unroll
            for (int m = 0; m < 4; ++m) { const int row = row0 + ai * 128 + m * 16; float ss = 0.f;
#pragma unroll
                for (int bj = 0; bj < 2; ++bj) { const size_t off = (size_t)row * DM + col0 + bj * 128; f32x4 h0, h1;
                    if (BASE_F32) { h0 = *(const f32x4*)((const float*)base + off); h1 = *(const f32x4*)((const float*)base + off + 4); }
                    else { const u32x4 w = *(const u32x4*)((const bf16_t*)base + off); h0 = (f32x4){bflo(w.x), bfhi(w.x), bflo(w.y), bfhi(w.y)}; h1 = (f32x4){bflo(w.z), bfhi(w.z), bflo(w.w), bfhi(w.w)}; }
                    h0 += acc[ai][bj][m][0]; h1 += acc[ai][bj][m][1];
                    ss += (h0[0] * h0[0] + h0[1] * h0[1]) + (h0[2] * h0[2] + h0[3] * h0[3]) + (h1[0] * h1[0] + h1[1] * h1[1]) + (h1[2] * h1[2] + h1[3] * h1[3]);
                    *(u32x4*)(Hn + off) = pack8(h0, h1); }
                ss += __shfl_xor(ss, 16); ss += __shfl_xor(ss, 32);
                if (fq == 0) atomicAdd(rowsq + row, ss); }
    }
};
template <class Piece> struct EpiStaged {
    static constexpr bool AFTER_DRAIN = true;
    Piece P;
    __device__ __forceinline__ void fused(f32x4 (&acc)[2][2][4][2], const Unit& u, int wr, int wc, int fr, int fq, LAS unsigned char* lds, int wid, int lane) const {
#pragma unroll
        for (int ai = 0; ai < 2; ++ai)
#pragma unroll
            for (int m = 0; m < 4; ++m)
#pragma unroll
                for (int bj = 0; bj < 2; ++bj) *(LAS u32x4*)(lds + (ai * 128 + wr * 64 + m * 16 + fr) * 528 + (bj * 128 + wc * 32 + 8 * fq) * 2) = pack8(acc[ai][bj][m][0], acc[ai][bj][m][1]);
        __syncthreads();
        P.run(lds, u, wid * 64 + lane, lane);
        __syncthreads();
    }
};
struct GatePiece {
    bf16_t* O; const bf16_t* gates; int goff; const bf16_t* prev;
    __device__ __forceinline__ void run(LAS unsigned char* lds, const Unit& u, int tid, int lane) const {
        const int r0 = tid >> 5, c8 = tid & 31; const size_t col = (size_t)u.pn * 256 + c8 * 8;
#pragma unroll
        for (int b = 0; b < 2; ++b) { u32x4 gw[8], pw[8];
#pragma unroll
            for (int i = 0; i < 8; ++i) { const size_t row = (size_t)u.pm * 256 + (b * 8 + i) * 16 + r0; gw[i] = *(const u32x4*)(gates + row * 4096 + goff + col); if (prev) pw[i] = *(const u32x4*)(prev + row * DM + col); }
#pragma unroll
            for (int i = 0; i < 8; ++i) { const int rl = (b * 8 + i) * 16 + r0; const u32x4 a = *(const LAS u32x4*)(lds + rl * 528 + c8 * 16); u32x4 o;
#pragma unroll
                for (int j = 0; j < 4; ++j) { float v0 = bflo(a[j]) * sigmoidf_(bflo(gw[i][j])), v1 = bfhi(a[j]) * sigmoidf_(bfhi(gw[i][j])); if (prev) { v0 += bflo(pw[i][j]); v1 += bfhi(pw[i][j]); } o[j] = pg8::cvt_pk_bf16(v0, v1); }
                *(u32x4*)(O + ((size_t)u.pm * 256 + rl) * DM + col) = o; } }
    }
};
template <bool BASE_F32> struct ResNormPiece {
    const void* base; bf16_t* Hn; float* rowsq;
    __device__ __forceinline__ void run(LAS unsigned char* lds, const Unit& u, int tid, int lane) const {
        const int r0 = tid >> 5, c8 = tid & 31; const size_t col = (size_t)u.pn * 256 + c8 * 8;
#pragma unroll
        for (int b = 0; b < 2; ++b) { f32x4 h0[8], h1[8];
#pragma unroll
            for (int i = 0; i < 8; ++i) { const size_t off = ((size_t)u.pm * 256 + (b * 8 + i) * 16 + r0) * DM + col;
                if (BASE_F32) { h0[i] = *(const f32x4*)((const float*)base + off); h1[i] = *(const f32x4*)((const float*)base + off + 4); }
                else { const u32x4 w = *(const u32x4*)((const bf16_t*)base + off); h0[i] = (f32x4){bflo(w.x), bfhi(w.x), bflo(w.y), bfhi(w.y)}; h1[i] = (f32x4){bflo(w.z), bfhi(w.z), bflo(w.w), bfhi(w.w)}; } }
#pragma unroll
            for (int i = 0; i < 8; ++i) { const int rl = (b * 8 + i) * 16 + r0; const size_t row = (size_t)u.pm * 256 + rl; const u32x4 a = *(const LAS u32x4*)(lds + rl * 528 + c8 * 16);
                f32x4 x0 = h0[i] + (f32x4){bflo(a.x), bfhi(a.x), bflo(a.y), bfhi(a.y)}, x1 = h1[i] + (f32x4){bflo(a.z), bfhi(a.z), bflo(a.w), bfhi(a.w)};
                float ss = (x0[0] * x0[0] + x0[1] * x0[1]) + (x0[2] * x0[2] + x0[3] * x0[3]) + (x1[0] * x1[0] + x1[1] * x1[1]) + (x1[2] * x1[2] + x1[3] * x1[3]);
                *(u32x4*)(Hn + row * DM + col) = pack8(x0, x1);
                ss = row16_sum(ss); { float a_ = ss, b_ = ss; XSWAP16(a_, b_); ss = a_ + b_; }
                if (c8 == 0) atomicAdd(rowsq + row, ss); } }
    }
};
struct EpiSoftmax {
    static constexpr bool AFTER_DRAIN = true;
    bf16_t* O; int ldc; const float* rowsq; float scale;
    __device__ __forceinline__ void fused(f32x4 (&acc)[2][2][4][2], const Unit& u, int wr, int wc, int fr, int fq, LAS unsigned char* lds, int wid, int lane) const {
        LAS f32x2* P = (LAS f32x2*)lds;
        float mxs[2][4];
#pragma unroll
        for (int ai = 0; ai < 2; ++ai)
#pragma unroll
            for (int m = 0; m < 4; ++m) { const int rl = ai * 128 + wr * 64 + m * 16 + fr; const int row = u.pm * 256 + rl;
                const float sc = rsqrtf(rowsq[row] * (1.f / DM) + EPS) * scale; float mx = -3.0e38f;
#pragma unroll
                for (int bj = 0; bj < 2; ++bj)
#pragma unroll
                    for (int n = 0; n < 2; ++n) { f32x4 x = acc[ai][bj][m][n] * sc; acc[ai][bj][m][n] = x; mx = fmaxf(mx, fmaxf(fmaxf(x[0], x[1]), fmaxf(x[2], x[3]))); }
                mx = fmax_x16x32(mx); float s = 0.f;
#pragma unroll
                for (int bj = 0; bj < 2; ++bj)
#pragma unroll
                    for (int n = 0; n < 2; ++n) { f32x4 x = acc[ai][bj][m][n]; x[0] = __expf(x[0] - mx); x[1] = __expf(x[1] - mx); x[2] = __expf(x[2] - mx); x[3] = __expf(x[3] - mx); acc[ai][bj][m][n] = x; s += (x[0] + x[1]) + (x[2] + x[3]); }
                s = fadd_x16x32(s); mxs[ai][m] = mx;
                if (fq == 0) P[rl * 4 + wc] = (f32x2){mx, s}; }
        __syncthreads();
        const int col0 = u.pn * 256 + wc * 32 + 8 * fq;
#pragma unroll
        for (int ai = 0; ai < 2; ++ai)
#pragma unroll
            for (int m = 0; m < 4; ++m) { const int rl = ai * 128 + wr * 64 + m * 16 + fr; const int row = u.pm * 256 + rl;
                const f32x2 a = P[rl * 4 + 0], b = P[rl * 4 + 1], c = P[rl * 4 + 2], d = P[rl * 4 + 3];
                const float M = fmaxf(fmaxf(a.x, b.x), fmaxf(c.x, d.x));
                const float Ssum = a.y * __expf(a.x - M) + b.y * __expf(b.x - M) + c.y * __expf(c.x - M) + d.y * __expf(d.x - M);
                const float f = __expf(mxs[ai][m] - M) * __builtin_amdgcn_rcpf(Ssum);
#pragma unroll
                for (int bj = 0; bj < 2; ++bj) *(u32x4*)(O + (size_t)row * ldc + col0 + bj * 128) = pack8(acc[ai][bj][m][0] * f, acc[ai][bj][m][1] * f); }
        __syncthreads();
    }
};

#define XB_TMO      128
#define XB_XCNT(j)  (256  + 64 * (j))
#define XB_XSUB(j)  (1280 + 64 * (j))
#define XB_XGEN(j)  (2304 + 64 * (j))
#define XB_TOP      3328
#define XB_TOPGEN   3392
#define XCD_BAR_WORDS 3456
#define XB_SPIN_CAP (1u << 20)
__device__ __forceinline__ unsigned xb_ld(unsigned* p)              { return __hip_atomic_load(p, __ATOMIC_RELAXED, __HIP_MEMORY_SCOPE_AGENT); }
__device__ __forceinline__ unsigned xb_add(unsigned* p, unsigned v) { return __hip_atomic_fetch_add(p, v, __ATOMIC_RELAXED, __HIP_MEMORY_SCOPE_AGENT); }
__device__ __forceinline__ unsigned xb_xcc_id() { return (unsigned)__builtin_amdgcn_s_getreg((3 << 11) | 20) & 0xFu; }
#define XB_SPIN(cond, bar) do { unsigned _sp = 0; while (cond) { __builtin_amdgcn_s_sleep(1); \
    if ((++_sp & 255u) == 0u) { if (xb_ld(&(bar)[XB_TMO])) break; if (_sp > XB_SPIN_CAP) { atomicAdd(&(bar)[XB_TMO], 1u); break; } } } } while (0)
struct XcdBarrier { unsigned* bar; unsigned x; volatile LAS unsigned* st; };
__device__ __forceinline__ XcdBarrier xcd_barrier_post(unsigned* bar, volatile LAS unsigned* st, bool t0) {
    XcdBarrier b; b.bar = bar; b.x = xb_xcc_id(); b.st = st;
    if (t0) (void)xb_add(&bar[XB_XCNT(b.x)], 1u);
    return b;
}
__device__ __forceinline__ void xcd_barrier_complete(unsigned* bar, unsigned x, unsigned& nloc, unsigned& nx) {
    const unsigned G = gridDim.x * gridDim.y * gridDim.z;
    unsigned sum, cnt, mine, sp = 0u;
    for (;;) {
        sum = 0u; cnt = 0u; mine = 0u;
#pragma unroll
        for (unsigned j = 0; j < 16; ++j) { const unsigned c = xb_ld(&bar[XB_XCNT(j)]); sum += c; cnt += (c > 0u) ? 1u : 0u; mine = (j == x) ? c : mine; }
        if (sum == G) break;
        __builtin_amdgcn_s_sleep(1);
        if ((++sp & 255u) == 0u) { if (xb_ld(&bar[XB_TMO])) break; if (sp > XB_SPIN_CAP) { atomicAdd(&bar[XB_TMO], 1u); break; } }
    }
    nloc = mine > 0u ? mine : 1u; nx = cnt > 0u ? cnt : 1u;
}
__device__ __forceinline__ void xcd_barrier(const XcdBarrier& b, int wave) {
    asm volatile("s_waitcnt vmcnt(0)" ::: "memory");
    __syncthreads();
    if (wave == 0 && lane_id() == 0) {
        unsigned* bar = b.bar;
        __builtin_amdgcn_s_waitcnt(0);
        unsigned nloc = b.st[0], nx = b.st[1];
        if (nloc == 0u) { xcd_barrier_complete(bar, b.x, nloc, nx); b.st[0] = nloc; b.st[1] = nx; }
        const unsigned old = xb_add(&bar[XB_XSUB(b.x)], 1u);
        const unsigned gen = old / nloc;
        if (old + 1u == (gen + 1u) * nloc) {
            __builtin_amdgcn_fence(__ATOMIC_RELEASE, "agent");
            asm volatile("s_waitcnt vmcnt(0)" ::: "memory");
            const unsigned og = xb_add(&bar[XB_TOP], 1u);
            const unsigned tg = og / nx;
            if (og + 1u == (tg + 1u) * nx) xb_add(&bar[XB_TOPGEN], 1u);
            else XB_SPIN(xb_ld(&bar[XB_TOPGEN]) == tg, bar);
            __builtin_amdgcn_fence(__ATOMIC_ACQUIRE, "agent");
            xb_add(&bar[XB_XGEN(b.x)], 1u);
            asm volatile("s_waitcnt vmcnt(0)" ::: "memory");
        } else {
            XB_SPIN(xb_ld(&bar[XB_XGEN(b.x)]) == gen, bar);
            __builtin_amdgcn_fence(__ATOMIC_ACQUIRE, "agent");
            asm volatile("s_waitcnt vmcnt(0)" ::: "memory");
        }
    }
    __syncthreads();
}

struct Args { const float* in[23]; float* out; unsigned char* ws; int ph_lo, ph_hi, use_bar, pad; };
struct Frame {
    LAS unsigned char* lds;
    int wave, G, bid;
    unsigned char* ws;
};

template <int MT, int NT>
__device__ __forceinline__ void wave_gemm_nt(const bf16_t* A, int lda, const bf16_t* B, int ldb, int K, f32x4 (&acc)[MT][NT], int fr, int fq, size_t ablk) {
    for (int k0 = 0; k0 < K; k0 += 32) {
        bf16x8 a[MT], b[NT];
#pragma unroll
        for (int mt = 0; mt < MT; ++mt) a[mt] = *(const bf16x8*)(A + (size_t)mt * ablk + (size_t)fr * lda + k0 + 8 * fq);
#pragma unroll
        for (int nt = 0; nt < NT; ++nt) b[nt] = *(const bf16x8*)(B + (size_t)(16 * nt + fr) * ldb + k0 + 8 * fq);
#pragma unroll
        for (int mt = 0; mt < MT; ++mt)
#pragma unroll
            for (int nt = 0; nt < NT; ++nt) acc[mt][nt] = __builtin_amdgcn_mfma_f32_16x16x32_bf16(a[mt], b[nt], acc[mt][nt], 0, 0, 0);
    }
}

__device__ __forceinline__ int win_src_col(int n) {
    if (n < 6144) return n;
    if (n < 8192) return 6160 + (n - 6144);
    if (n < 9216) return 8464 + (n - 8192);
    if (n < 11264) return 9568 + (n - 9216);
    if (n < 13312) return 11616 + (n - 11264);
    const int m = n - 13312;
    if (m < 16) return 6144 + m;
    if (m < 32) return 9552 + (m - 16);
    if (m < 96) return 9488 + (m - 32);
    if (m < 128) return -1;
    if (m < 256) return 8208 + (m - 128);
    if (m < 384) return 8336 + (m - 256);
    return -1;
}
__device__ __forceinline__ void transpose_item(const float* W, int N, int K, bf16_t* WT, int drow0, int srccol4, int k0, LAS float* scr, int lane, const float* kgain) {
    const int rg = lane >> 4, cq = lane & 15;
    f32x4 v[16];
#pragma unroll
    for (int i = 0; i < 16; ++i) v[i] = srccol4 >= 0 ? *(const f32x4*)(W + (size_t)(k0 + 4 * i + rg) * N + srccol4) : (f32x4){0.f, 0.f, 0.f, 0.f};
    if (kgain) {
#pragma unroll
        for (int i = 0; i < 16; ++i) v[i] *= kgain[k0 + 4 * i + rg]; }
#pragma unroll
    for (int i = 0; i < 16; ++i)
#pragma unroll
        for (int e = 0; e < 4; ++e) scr[(4 * i + rg) * 65 + 4 * cq + e] = v[i][e];
    LDS_WAIT(); asm volatile("" ::: "memory");
    const int c = lane & 7;
#pragma unroll
    for (int j = 0; j < 8; ++j) { const int n = (lane >> 3) + 8 * j; const LAS float* s = scr + (8 * c) * 65 + n;
        u32x4 o; o.x = pk2(s[0 * 65], s[1 * 65]); o.y = pk2(s[2 * 65], s[3 * 65]); o.z = pk2(s[4 * 65], s[5 * 65]); o.w = pk2(s[6 * 65], s[7 * 65]);
        *(u32x4*)(WT + (size_t)(drow0 + n) * K + k0 + 8 * c) = o; }
    LDS_WAIT(); asm volatile("" ::: "memory");
}
__device__ __forceinline__ void rms_row_to_bf16(const float* xrow, const float* gain, bf16_t* orow, int lane) {
    const f32x4* xr = (const f32x4*)xrow + lane; const f32x4* gr = (const f32x4*)gain + lane;
    f32x4 v[8]; float s = 0.f;
#pragma unroll
    for (int j = 0; j < 8; ++j) { v[j] = xr[64 * j]; s += (v[j][0] * v[j][0] + v[j][1] * v[j][1]) + (v[j][2] * v[j][2] + v[j][3] * v[j][3]); }
    const float rstd = rsqrtf(wave_sum(s) * (1.f / DM) + EPS);
    u32x2* o8 = (u32x2*)orow + lane;
#pragma unroll
    for (int j = 0; j < 8; ++j) { const f32x4 g = gr[64 * j]; u32x2 w; w.x = pk2(v[j][0] * rstd * g[0], v[j][1] * rstd * g[1]); w.y = pk2(v[j][2] * rstd * g[2], v[j][3] * rstd * g[3]); o8[64 * j] = w; }
}
__device__ __forceinline__ void cvt_copy(const float* src, bf16_t* dst, size_t n, size_t gtid, size_t gthreads) {
    for (size_t i = gtid; i < n / 8; i += gthreads) { const f32x4 a = *((const f32x4*)src + 2 * i), b = *((const f32x4*)src + 2 * i + 1);
        u32x4 w; w.x = pk2(a[0], a[1]); w.y = pk2(a[2], a[3]); w.z = pk2(b[0], b[1]); w.w = pk2(b[2], b[3]); *((u32x4*)dst + i) = w; }
}
__device__ __forceinline__ void p0_prologue(const Frame& F, const Args& a) {
    const int lane_ = lane_id(), tid_ = F.wave * 64 + lane_; (void)tid_;
    LAS float* scr = (LAS float*)(F.lds + F.wave * 16896);
    const int gw = F.bid * NWAVES + F.wave, NGW = F.G * NWAVES;
    constexpr int I_IN = (NIN / 64) * (DM / 64), I_SQ = (DM / 64) * (DM / 64);
    unsigned long long tp0_ = 0ull; if (TPH == 50) tp0_ = __builtin_amdgcn_s_memrealtime();
    for (int it = gw; it < I_IN + 7 * I_SQ; it += NGW) {
        if (it < I_IN) { const int nb = it % (NIN / 64), kb = it / (NIN / 64); const int n = nb * 64 + 4 * (lane_ & 15);
            transpose_item(a.in[4], 13664, DM, (bf16_t*)(F.ws + WS_WIN), nb * 64, win_src_col(n), kb * 64, scr, lane_, nullptr); }
        else { const int r = it - I_IN, mi = r / I_SQ, q = r % I_SQ, nb = q % (DM / 64), kb = q / (DM / 64);
            const float* W; size_t off;
            switch (mi) { case 0: W = a.in[8]; off = WS_WPA; break; case 1: W = a.in[9]; off = WS_WPB; break; case 2: W = a.in[10]; off = WS_WOUT; break;
                          case 3: W = a.in[14]; off = WS_WXK; break; case 4: W = a.in[15]; off = WS_WXV; break; case 5: W = a.in[16]; off = WS_WXO; break; default: W = a.in[18]; off = WS_WPQ; break; }
            transpose_item(W, DM, DM, (bf16_t*)(F.ws + off), nb * 64, nb * 64 + 4 * (lane_ & 15), kb * 64, scr, lane_, mi == 6 ? a.in[17] : nullptr); }
    }
    if (TPH == 50) { const unsigned long long t1_ = __builtin_amdgcn_s_memrealtime(), d_ = t1_ - tp0_; while (__builtin_amdgcn_s_memrealtime() - t1_ < d_) __builtin_amdgcn_s_sleep(8); }
    const size_t gtid = (size_t)F.bid * NTHREADS + tid_, gth = (size_t)F.G * NTHREADS;
    for (size_t i = gtid; i < (size_t)DM * DM / 8; i += gth) { const float g = a.in[11][i >> 8];
        const f32x4 p = *((const f32x4*)a.in[13] + 2 * i) * g, q = *((const f32x4*)a.in[13] + 2 * i + 1) * g; u32x4 w; w.x = pk2(p[0], p[1]); w.y = pk2(p[2], p[3]); w.z = pk2(q[0], q[1]); w.w = pk2(q[2], q[3]); *((u32x4*)(F.ws + WS_WXQ) + i) = w; }
    cvt_copy(a.in[19], (bf16_t*)(F.ws + WS_KEYS), (size_t)16 * 128 * 128, gtid, gth);
    if (NGW * 4 == SEQ) {
        f32x4 v[4][8]; float ss[4];
#pragma unroll
        for (int r = 0; r < 4; ++r)
#pragma unroll
            for (int j = 0; j < 8; ++j) v[r][j] = *((const f32x4*)(a.in[0] + (size_t)(gw + r * NGW) * DM) + lane_ + 64 * j);
#pragma unroll
        for (int r = 0; r < 4; ++r) { float s = 0.f;
#pragma unroll
            for (int j = 0; j < 8; ++j) s += (v[r][j][0] * v[r][j][0] + v[r][j][1] * v[r][j][1]) + (v[r][j][2] * v[r][j][2] + v[r][j][3] * v[r][j][3]);
            ss[r] = rsqrtf(wave_sum(s) * (1.f / DM) + EPS); }
#pragma unroll
        for (int j = 0; j < 8; ++j) { const f32x4 g = *((const f32x4*)a.in[3] + lane_ + 64 * j);
#pragma unroll
            for (int r = 0; r < 4; ++r) { u32x2 w; w.x = pk2(v[r][j][0] * ss[r] * g[0], v[r][j][1] * ss[r] * g[1]); w.y = pk2(v[r][j][2] * ss[r] * g[2], v[r][j][3] * ss[r] * g[3]);
                *((u32x2*)((bf16_t*)(F.ws + WS_A0) + (size_t)(gw + r * NGW) * DM) + lane_ + 64 * j) = w; } }
        if (gw < MEM) rms_row_to_bf16(a.in[1] + (size_t)gw * DM, a.in[12], (bf16_t*)(F.ws + WS_MEMN) + (size_t)gw * DM, lane_);
    } else
    for (int m = gw; m < SEQ + MEM; m += NGW) {
        if (m < SEQ) rms_row_to_bf16(a.in[0] + (size_t)m * DM, a.in[3], (bf16_t*)(F.ws + WS_A0) + (size_t)m * DM, lane_);
        else rms_row_to_bf16(a.in[1] + (size_t)(m - SEQ) * DM, a.in[12], (bf16_t*)(F.ws + WS_MEMN) + (size_t)(m - SEQ) * DM, lane_);
    }
}

__device__ __forceinline__ void sincos_red(float ang, float& s, float& c) {
    const float n = rintf(ang * 0.15915494309189535f);
    float r = fmaf(-n, 6.28318548202514648f, ang); r = fmaf(-n, -1.7484556000744883e-07f, r);
    const float f = r * 0.15915494309189535f;
    s = __builtin_amdgcn_sinf(f); c = __builtin_amdgcn_cosf(f);
}
__device__ __forceinline__ void rope8(bf16x8& x1, bf16x8& x2, const f32x4 c0, const f32x4 c1, const f32x4 s0, const f32x4 s1) {
#pragma unroll
    for (int j = 0; j < 8; ++j) { const float a = bf2f((unsigned short)x1[j]), b = bf2f((unsigned short)x2[j]), c = j < 4 ? c0[j & 3] : c1[j & 3], sn = j < 4 ? s0[j & 3] : s1[j & 3];
        x1[j] = (short)f2bf(a * c - b * sn); x2[j] = (short)f2bf(b * c + a * sn); }
}
__device__ __forceinline__ void rope_token(const Frame& F, const Args& a, int t, float inv128, float inv64) {
    const int lane_ = lane_id(), tid_ = F.wave * 64 + lane_; (void)tid_;
    const int l = lane_; const float pos = (float)((const int*)a.in[2])[t];
    const bf16_t* MS = (const bf16_t*)(F.ws + WS_MISC) + (size_t)t * MISC_LD;
    float s1, c1, s2, c2;
    sincos_red(pos * inv128, s1, c1); sincos_red(pos * inv64, s2, c2);
    ((float*)(F.ws + WS_COS128))[(size_t)t * 64 + l] = c1; ((float*)(F.ws + WS_SIN128))[(size_t)t * 64 + l] = s1;
    if (l < 32) { ((float*)(F.ws + WS_COS64))[(size_t)t * 32 + l] = c2; ((float*)(F.ws + WS_SIN64))[(size_t)t * 32 + l] = s2; }
    { const float x1 = bf2f(MS[128 + l]), x2 = bf2f(MS[128 + 64 + l]); bf16_t* kb = (bf16_t*)(F.ws + WS_KBR) + (size_t)t * 128;
      kb[l] = (bf16_t)f2bf(x1 * c1 - x2 * s1); kb[64 + l] = (bf16_t)f2bf(x2 * c1 + x1 * s1); }
    if (l < 32) { const float x1 = bf2f(MS[32 + l]), x2 = bf2f(MS[64 + l]); bf16_t* ki = (bf16_t*)(F.ws + WS_KIR) + (size_t)t * 64;
        ki[l] = (bf16_t)f2bf(x1 * c2 - x2 * s2); ki[32 + l] = (bf16_t)f2bf(x2 * c2 + x1 * s2); }
    { bf16_t* vb = (bf16_t*)(F.ws + WS_VB) + (size_t)t * 128; vb[l] = MS[256 + l]; vb[64 + l] = MS[320 + l]; }
    if (l < 16) ((float*)(F.ws + WS_IW))[(size_t)t * 16 + l] = bf2f(MS[16 + l]) * 0.03125f;
}
__device__ __forceinline__ void rope_tokens4(const Frame& F, const Args& a, int t0, int ts, float inv128, float inv64) {
    const int l = lane_id();
    float pos[4]; unsigned short m[4][7];
#pragma unroll
    for (int q = 0; q < 4; ++q) { const int t = t0 + q * ts; const bf16_t* MS = (const bf16_t*)(F.ws + WS_MISC) + (size_t)t * MISC_LD; pos[q] = (float)((const int*)a.in[2])[t];
        m[q][0] = MS[128 + l]; m[q][1] = MS[128 + 64 + l]; m[q][2] = MS[32 + (l & 31)]; m[q][3] = MS[64 + (l & 31)]; m[q][4] = MS[256 + l]; m[q][5] = MS[320 + l]; m[q][6] = MS[16 + (l & 15)]; }
#pragma unroll
    for (int q = 0; q < 4; ++q) { const int t = t0 + q * ts; float s1, c1, s2, c2;
        sincos_red(pos[q] * inv128, s1, c1); sincos_red(pos[q] * inv64, s2, c2);
        ((float*)(F.ws + WS_COS128))[(size_t)t * 64 + l] = c1; ((float*)(F.ws + WS_SIN128))[(size_t)t * 64 + l] = s1;
        if (l < 32) { ((float*)(F.ws + WS_COS64))[(size_t)t * 32 + l] = c2; ((float*)(F.ws + WS_SIN64))[(size_t)t * 32 + l] = s2; }
        { const float x1 = bf2f(m[q][0]), x2 = bf2f(m[q][1]); bf16_t* kb = (bf16_t*)(F.ws + WS_KBR) + (size_t)t * 128;
          kb[l] = (bf16_t)f2bf(x1 * c1 - x2 * s1); kb[64 + l] = (bf16_t)f2bf(x2 * c1 + x1 * s1); }
        if (l < 32) { const float x1 = bf2f(m[q][2]), x2 = bf2f(m[q][3]); bf16_t* ki = (bf16_t*)(F.ws + WS_KIR) + (size_t)t * 64;
            ki[l] = (bf16_t)f2bf(x1 * c2 - x2 * s2); ki[32 + l] = (bf16_t)f2bf(x2 * c2 + x1 * s2); }
        { bf16_t* vb = (bf16_t*)(F.ws + WS_VB) + (size_t)t * 128; vb[l] = m[q][4]; vb[64 + l] = m[q][5]; }
        if (l < 16) ((float*)(F.ws + WS_IW))[(size_t)t * 16 + l] = bf2f(m[q][6]) * 0.03125f; }
}
constexpr int GLP = 264, GLV = 520;
__device__ __forceinline__ void gla_prep_item(const Frame& F, const Args& a, int item) {
    const int lane_ = lane_id(), tid_ = F.wave * 64 + lane_; (void)tid_;
    const int c = item >> 2, h = item & 3, t0 = c * 64, tid = tid_;
    LAS bf16_t* sQ = (LAS bf16_t*)F.lds; LAS bf16_t* sK = sQ + 64 * GLP; LAS bf16_t* sV = sK + 64 * GLP; LAS float* sG = (LAS float*)(sV + 64 * GLV);
    const bf16_t* GQK = (const bf16_t*)(F.ws + WS_GQK); const bf16_t* MS = (const bf16_t*)(F.ws + WS_MISC); const bf16_t* GV = (const bf16_t*)(F.ws + WS_GV);
    { u32x4 qv[4], kv[4], vv[8];
#pragma unroll
      for (int i = 0; i < 4; ++i) { const int ch = tid + 512 * i, row = ch >> 5, c16 = ch & 31; const bf16_t* p = GQK + (size_t)(t0 + row) * DM + h * 256 + c16 * 8; qv[i] = *(const u32x4*)p; kv[i] = *(const u32x4*)(p + 1024); }
#pragma unroll
      for (int i = 0; i < 8; ++i) { const int ch = tid + 512 * i, row = ch >> 6, c16 = ch & 63; vv[i] = *(const u32x4*)(GV + (size_t)(t0 + row) * DM + h * 512 + c16 * 8); }
      for (int i = tid; i < 64 * 16; i += NTHREADS) sG[i] = bf2f(MS[(size_t)(t0 + (i >> 4)) * MISC_LD + (i & 15)]);
#pragma unroll
      for (int i = 0; i < 4; ++i) { const int ch = tid + 512 * i, row = ch >> 5, c16 = ch & 31; *(LAS u32x4*)(sQ + row * GLP + c16 * 8) = qv[i]; *(LAS u32x4*)(sK + row * GLP + c16 * 8) = kv[i]; }
#pragma unroll
      for (int i = 0; i < 8; ++i) { const int ch = tid + 512 * i, row = ch >> 6, c16 = ch & 63; *(LAS u32x4*)(sV + row * GLV + c16 * 8) = vv[i]; } }
    __syncthreads();
    if (tid < 256) {
        const int d = tid, col = h * 256 + d;
        float w2c[16];
#pragma unroll
        for (int r = 0; r < 16; ++r) w2c[r] = a.in[5][r * 1024 + col];
        const float bias = a.in[6][col];
        bf16_t* QT = (bf16_t*)(F.ws + WS_QT);
        float b = 0.f;
#pragma unroll 4
        for (int j = 0; j < 64; ++j) {
            float z0 = bias, z1 = 0.f, z2 = 0.f, z3 = 0.f;
#pragma unroll
            for (int r = 0; r < 16; r += 4) { z0 = fmaf(sG[j * 16 + r], w2c[r], z0); z1 = fmaf(sG[j * 16 + r + 1], w2c[r + 1], z1); z2 = fmaf(sG[j * 16 + r + 2], w2c[r + 2], z2); z3 = fmaf(sG[j * 16 + r + 3], w2c[r + 3], z3); }
            const float z = (z0 + z1) + (z2 + z3);
            const float ls = fminf(z, 0.f) - __logf(1.f + __expf(-fabsf(z)));
            b += ls * (1.f / 16.f);
            const float q = bf2f(sQ[j * GLP + d]), k = bf2f(sK[j * GLP + d]);
            const float eb = __expf(b);
            const unsigned qb = f2bf(q * 0.0625f * eb), kb = f2bf(k * __expf(-b));
            QT[(size_t)(t0 + j) * 1024 + col] = (bf16_t)qb; sQ[j * GLP + d] = (bf16_t)qb; sK[j * GLP + d] = (bf16_t)kb;
        }
        const float eL = __expf(b);
        ((float*)(F.ws + WS_DVEC))[(((size_t)h * 16 + (d >> 4)) * 128 + c) * 16 + (d & 15)] = eL;
        bf16_t* KH = (bf16_t*)(F.ws + WS_KHT) + ((((size_t)h * 16 + (d >> 4)) * 128 + c) * 16 + (d & 15)) * 64;
#pragma unroll
        for (int j8 = 0; j8 < 8; ++j8) { u32x4 w;
            w.x = pk2(bf2f(sK[(j8 * 8 + 0) * GLP + d]) * eL, bf2f(sK[(j8 * 8 + 1) * GLP + d]) * eL); w.y = pk2(bf2f(sK[(j8 * 8 + 2) * GLP + d]) * eL, bf2f(sK[(j8 * 8 + 3) * GLP + d]) * eL);
            w.z = pk2(bf2f(sK[(j8 * 8 + 4) * GLP + d]) * eL, bf2f(sK[(j8 * 8 + 5) * GLP + d]) * eL); w.w = pk2(bf2f(sK[(j8 * 8 + 6) * GLP + d]) * eL, bf2f(sK[(j8 * 8 + 7) * GLP + d]) * eL);
            *(u32x4*)(KH + j8 * 8) = w; }
    } else {
#pragma unroll 1
        for (int i = 0; i < 2; ++i) { const int e = (tid - 256) + 256 * i; bf16_t* VT = (bf16_t*)(F.ws + WS_VT) + ((((size_t)h * 32 + (e >> 4)) * 128 + c) * 16 + (e & 15)) * 64;
#pragma unroll
            for (int j8 = 0; j8 < 8; ++j8) { unsigned short v[8];
#pragma unroll
                for (int j = 0; j < 8; ++j) v[j] = sV[(j8 * 8 + j) * GLV + e];
                u32x4 w; w.x = v[0] | ((unsigned)v[1] << 16); w.y = v[2] | ((unsigned)v[3] << 16); w.z = v[4] | ((unsigned)v[5] << 16); w.w = v[6] | ((unsigned)v[7] << 16);
                *(u32x4*)(VT + j8 * 8) = w; } }
    }
    __syncthreads();
    { const int fr = lane_ & 15, fq = lane_ >> 4; bf16_t* AT = (bf16_t*)(F.ws + WS_ATT) + (size_t)item * 4096;
#pragma unroll
      for (int tt = 0; tt < 2; ++tt) { const int tile = F.wave * 2 + tt, ti = tile >> 2, tj = tile & 3; f32x4 acc = (f32x4){0.f, 0.f, 0.f, 0.f};
          if (tj <= ti) {
#pragma unroll
              for (int k0 = 0; k0 < 256; k0 += 32) { const bf16x8 av = *(const LAS bf16x8*)(sQ + (16 * ti + fr) * GLP + k0 + 8 * fq), bv = *(const LAS bf16x8*)(sK + (16 * tj + fr) * GLP + k0 + 8 * fq);
                  acc = __builtin_amdgcn_mfma_f32_16x16x32_bf16(av, bv, acc, 0, 0, 0); } }
          MFMA_FENCE1(acc);
#pragma unroll
          for (int r = 0; r < 4; ++r) { const int i = 16 * ti + 4 * fq + r, j = 16 * tj + fr; AT[i * 64 + j] = (bf16_t)f2bf(j <= i ? acc[r] : 0.f); } } }
    __syncthreads();
}

__device__ __forceinline__ float relu_(float x) { const int i = __builtin_bit_cast(int, x); return __builtin_bit_cast(float, i > 0 ? i : 0); }
constexpr int SC_UNITS = 2176;
__device__ __forceinline__ int sc_bound(int i, int G) {
    const int T = (int)((9472ll * i) / G);
    int g = 0; while (g < 16 && 32 * (g + 1) * (g + 1) + 80 * (g + 1) <= T) ++g;
    const int n = g + 1, r = T - (32 * g * g + 80 * g), qbi = r / (4 * n + 3), r2 = r - qbi * (4 * n + 3);
    const int k = r2 == 0 ? 0 : (r2 <= 7 ? 1 : 1 + (r2 - 4) / 4);
    return 8 * g * (g + 1) + qbi * n + k;
}
__device__ __forceinline__ void scores_phase(const Frame& F) {
    const int lane_ = lane_id(), tid_ = F.wave * 64 + lane_; (void)tid_;
    const int fr = lane_ & 15, fq = lane_ >> 4;
    const int u0 = sc_bound(F.bid, F.G), u1 = sc_bound(F.bid + 1, F.G);
    if (u0 >= u1) return;
    int qb, kc; { int g = 0, rem = u0; while (rem >= 16 * (g + 1)) { rem -= 16 * (g + 1); ++g; } qb = g * 16 + rem / (g + 1); kc = rem % (g + 1); }
    const bf16_t* IQ = (const bf16_t*)(F.ws + WS_IQ); const bf16_t* KI = (const bf16_t*)(F.ws + WS_KIR); const float* IW = (const float*)(F.ws + WS_IW);
    unsigned short* SC = (unsigned short*)(F.ws + WS_SCORES);
    LAS unsigned char* sK = F.lds;
    u32x4 kreg[8];
#pragma unroll
    for (int i = 0; i < 8; ++i) kreg[i] = *(const u32x4*)(KI + (size_t)(kc * 512 + i * 64 + (tid_ >> 3)) * 64 + (tid_ & 7) * 8);
    bf16x8 aq[4][2]; f16x2 w2[4][2]; int cur_qb = -1;
    for (int u = u0; u < u1; ++u) {
        unsigned long long tq1_ = 0ull; if (TPH == 34) tq1_ = __builtin_amdgcn_s_memrealtime();
        __syncthreads();
        { const int k = tid_ >> 3;
#pragma unroll
          for (int i = 0; i < 8; ++i) *(LAS u32x4*)(sK + (i * 64 + (k & 3) * 16 + (k >> 2)) * 144 + (tid_ & 7) * 16) = kreg[i]; }
        __syncthreads();
        int nqb = qb, nkc = kc + 1; if (nkc > (qb >> 4)) { nkc = 0; nqb = qb + 1; }
        if (u + 1 < u1) {
#pragma unroll
            for (int i = 0; i < 8; ++i) kreg[i] = *(const u32x4*)(KI + (size_t)(nkc * 512 + i * 64 + (tid_ >> 3)) * 64 + (tid_ & 7) * 8); }
        const int tq0 = qb * 32 + F.wave * 4;
        if (qb != cur_qb) { cur_qb = qb;
#pragma unroll
            for (int j = 0; j < 4; ++j) { const bf16_t* p = IQ + (size_t)(tq0 + (fr >> 2)) * 1024 + (4 * j + (fr & 3)) * 64 + 8 * fq; aq[j][0] = *(const bf16x8*)p; aq[j][1] = *(const bf16x8*)(p + 32);
                { const f32x4 wv = *(const f32x4*)(IW + (size_t)(tq0 + fq) * 16 + 4 * j); w2[j][0] = (f16x2){(_Float16)wv[0], (_Float16)wv[1]}; w2[j][1] = (f16x2){(_Float16)wv[2], (_Float16)wv[3]}; } }
            const size_t tr = (size_t)(tq0 + (fr >> 2)) * 32 + 8 * fq;
            const f32x4 c0 = *(const f32x4*)((const float*)(F.ws + WS_COS64) + tr), c1 = *(const f32x4*)((const float*)(F.ws + WS_COS64) + tr + 4), s0 = *(const f32x4*)((const float*)(F.ws + WS_SIN64) + tr), s1 = *(const f32x4*)((const float*)(F.ws + WS_SIN64) + tr + 4);
#pragma unroll
            for (int j = 0; j < 4; ++j) rope8(aq[j][0], aq[j][1], c0, c1, s0, s1); }
        bf16x8 bk[4][2];
#pragma unroll
        for (int kt = 0; kt < 4; ++kt) { const LAS unsigned char* kp = sK + (kt * 16 + fr) * 144 + fq * 16; bk[kt][0] = *(const LAS bf16x8*)kp; bk[kt][1] = *(const LAS bf16x8*)(kp + 64); }
        f32x4 acc0[4], acc1[4];
#pragma unroll
        for (int j = 0; j < 4; ++j) { acc0[j] = __builtin_amdgcn_mfma_f32_16x16x32_bf16(aq[j][0], bk[0][0], (f32x4){0.f, 0.f, 0.f, 0.f}, 0, 0, 0); acc0[j] = __builtin_amdgcn_mfma_f32_16x16x32_bf16(aq[j][1], bk[0][1], acc0[j], 0, 0, 0); }
        MFMA_FENCE4(acc0[0], acc0[1], acc0[2], acc0[3]);
#define SC_SB() __builtin_amdgcn_sched_barrier(0)
#define SC_M(nx, ktn, j, hf) do { if ((hf) == 0) nx[j] = __builtin_amdgcn_mfma_f32_16x16x32_bf16(aq[j][0], bk[ktn][0], (f32x4){0.f, 0.f, 0.f, 0.f}, 0, 0, 0); \
        else nx[j] = __builtin_amdgcn_mfma_f32_16x16x32_bf16(aq[j][1], bk[ktn][1], nx[j], 0, 0, 0); SC_SB(); } while (0)
#define SC_V(cu, j, hf) do { f16x2 a_ = __builtin_bit_cast(f16x2, __builtin_amdgcn_cvt_pkrtz(cu[j][2 * (hf)], cu[j][2 * (hf) + 1])); \
        if ((j) == 0 && (hf) == 0) { } else if ((j) == 0 && (hf) == 1) s2 = pa_ * w2[0][0]; else s2 = __builtin_elementwise_fma(pa_, w2[(hf) ? (j) : (j) - 1][(hf) ? 0 : 1], s2); \
        pa_ = __builtin_elementwise_max(a_, (f16x2){(_Float16)0.f, (_Float16)0.f}); SC_SB(); } while (0)
#define SC_TILE(cu, nx, kt) do { constexpr int ktn = ((kt) + 1) & 3; f16x2 s2, pa_; \
        { const LAS unsigned char* kp = sK + ((g4 + 1) * 64 + (kt) * 16 + fr) * 144 + fq * 16; bk[kt][0] = *(const LAS bf16x8*)kp; bk[kt][1] = *(const LAS bf16x8*)(kp + 64); }     \
        SC_SB(); \
        SC_M(nx, ktn, 0, 0); SC_V(cu, 0, 0); SC_M(nx, ktn, 1, 0); SC_V(cu, 0, 1); SC_M(nx, ktn, 0, 1); SC_V(cu, 1, 0); SC_M(nx, ktn, 1, 1); SC_V(cu, 1, 1); \
        SC_M(nx, ktn, 2, 0); SC_V(cu, 2, 0); SC_M(nx, ktn, 3, 0); SC_V(cu, 2, 1); SC_M(nx, ktn, 2, 1); SC_V(cu, 3, 0); SC_M(nx, ktn, 3, 1); SC_V(cu, 3, 1); \
        s2 = __builtin_elementwise_fma(pa_, w2[3][1], s2); sv[kt] = s2.x + s2.y; } while (0)
        if (TPH == 34) { const unsigned long long t1_ = __builtin_amdgcn_s_memrealtime(), d_ = t1_ - tq1_; while (__builtin_amdgcn_s_memrealtime() - t1_ < d_) __builtin_amdgcn_s_sleep(8); }
        unsigned long long tq0_ = 0ull; if (TPH == 33) tq0_ = __builtin_amdgcn_s_memrealtime();
        for (int g4 = 0; g4 < 8; ++g4) {
            _Float16 sv[4];
            SC_TILE(acc0, acc1, 0); SC_TILE(acc1, acc0, 1); SC_TILE(acc0, acc1, 2); SC_TILE(acc1, acc0, 3);
            const _Float16 h0 = sv[0], h1 = sv[1], h2 = sv[2], h3 = sv[3];
            u32x2 w; w.x = (unsigned)__builtin_bit_cast(unsigned short, h0) | ((unsigned)__builtin_bit_cast(unsigned short, h1) << 16); w.y = (unsigned)__builtin_bit_cast(unsigned short, h2) | ((unsigned)__builtin_bit_cast(unsigned short, h3) << 16);
            *(u32x2*)(SC + (size_t)(tq0 + fq) * SEQ + kc * 512 + g4 * 64 + 4 * fr) = w;
        }
        if (TPH == 33) { const unsigned long long t1_ = __builtin_amdgcn_s_memrealtime(), d_ = t1_ - tq0_; while (__builtin_amdgcn_s_memrealtime() - t1_ < d_) __builtin_amdgcn_s_sleep(8); }
#undef SC_TILE
#undef SC_V
#undef SC_M
#undef SC_SB
        qb = nqb; kc = nkc;
    }
}

__device__ __forceinline__ unsigned h16key(unsigned h) { return (h & 0x8000u) ? (~h & 0xffffu) : (h | 0x8000u); }
typedef unsigned short u16x2 __attribute__((ext_vector_type(2)));
typedef short s16x2 __attribute__((ext_vector_type(2)));
#define BCNT_ACC(n, x) asm("v_bcnt_u32_b32 %0, %1, %0" : "+v"(n) : "v"(x))
__device__ __forceinline__ int cnt_ge(const unsigned (&kH)[64], const unsigned (&kF)[64], unsigned c, int nch) {
    const unsigned H = 0x80008000u, cl = (c & 0x7fffu) * 0x00010001u; int n0 = 0, n1 = 0;
    if (c & 0x8000u) {
#pragma unroll
        for (int i = 0; i < 16; ++i) if (i < nch) {
#pragma unroll
            for (int w = 0; w < 4; w += 2) { BCNT_ACC(n0, kF[4 * i + w] & (kH[4 * i + w] - cl)); BCNT_ACC(n1, kF[4 * i + w + 1] & (kH[4 * i + w + 1] - cl)); } }
    } else {
#pragma unroll
        for (int i = 0; i < 16; ++i) if (i < nch) {
#pragma unroll
            for (int w = 0; w < 4; w += 2) { BCNT_ACC(n0, ((kH[4 * i + w] - cl) & H) | kF[4 * i + w]); BCNT_ACC(n1, ((kH[4 * i + w + 1] - cl) & H) | kF[4 * i + w + 1]); } }
    }
    return n0 + n1;
}
__device__ __forceinline__ void mask_ge(const unsigned (&kH)[64], const unsigned (&kF)[64], unsigned c, int nch, unsigned (&out)[4]) {
    const unsigned H = 0x80008000u, cl = (c & 0x7fffu) * 0x00010001u;
    out[0] = out[1] = out[2] = out[3] = 0u;
    if (c & 0x8000u) {
#pragma unroll
        for (int i = 0; i < 16; ++i) if (i < nch) {
#pragma unroll
            for (int w = 0; w < 4; ++w) { const int r = 4 * i + w; out[r >> 4] |= (kF[r] & (kH[r] - cl)) >> (15 - (r & 15)); } }
    } else {
#pragma unroll
        for (int i = 0; i < 16; ++i) if (i < nch) {
#pragma unroll
            for (int w = 0; w < 4; ++w) { const int r = 4 * i + w; out[r >> 4] |= (((kH[r] - cl) & H) | kF[r]) >> (15 - (r & 15)); } }
    }
}
__device__ __forceinline__ void select_row(const Frame& F, int t) {
    const int lane_ = lane_id();
    LAS int* SEL = (LAS int*)(F.lds + SEL_LDS_OFF) + F.wave * 256; const int l = lane_;
    if (t < 256) {
#pragma unroll
        for (int i = 0; i < 4; ++i) { const int j = i * 64 + l; SEL[j] = (j <= t) ? (j << 8) : 0; }
        return;
    }
    const unsigned short* SC = (const unsigned short*)(F.ws + WS_SCORES) + (size_t)t * SEQ;
    const int nch = (t >> 9) + 1;
    unsigned kH[64], kF[64];
    u32x4 raw[16];
#pragma unroll
    for (int i = 0; i < 16; ++i) { const int ic = i < nch ? i : nch - 1; raw[i] = *(const u32x4*)(SC + (ic * 64 + l) * 8); }
#pragma unroll
    for (int i = 0; i < 16; ++i) {
#pragma unroll
        for (int w = 0; w < 4; ++w) { const unsigned x = raw[i][w]; const s16x2 m = __builtin_bit_cast(s16x2, x) >> (s16x2){15, 15};
            const unsigned k = x ^ (__builtin_bit_cast(unsigned, m) | 0x80008000u);
            kH[i * 4 + w] = k | 0x80008000u; kF[i * 4 + w] = k & 0x80008000u; } }
#pragma unroll
    for (int i = 0; i < 16; ++i) if (i == nch - 1) {
        asm volatile("" ::: "memory"); const int s0 = (i * 64 + l) * 8;
#pragma unroll
        for (int w = 0; w < 4; ++w) { unsigned h = kH[i * 4 + w], f = kF[i * 4 + w];
            if (s0 + 2 * w > t) { h = (h & 0xffff0000u) | 0x8000u; f &= 0xffff0000u; }
            if (s0 + 2 * w + 1 > t) { h = (h & 0x0000ffffu) | 0x80000000u; f &= 0x0000ffffu; }
            kH[i * 4 + w] = h; kF[i * 4 + w] = f; } }
    unsigned T = 0u;
    for (int bit = 15; bit >= 0; --bit) { const unsigned cand = T | (1u << bit); const int cnt = wave_sum_dpp(cnt_ge(kH, kF, cand, nch));
        if (cnt >= 256) T = cand;
        if (cnt == 256) break; }
    unsigned GE[4], GT[4];
    mask_ge(kH, kF, T, nch, GE);
    if (T < 0xffffu) mask_ge(kH, kF, T + 1u, nch, GT); else { GT[0] = GT[1] = GT[2] = GT[3] = 0u; }
    const int nge = (__builtin_popcount(GE[0]) + __builtin_popcount(GE[1])) + (__builtin_popcount(GE[2]) + __builtin_popcount(GE[3]));
    const int ngt = (__builtin_popcount(GT[0]) + __builtin_popcount(GT[1])) + (__builtin_popcount(GT[2]) + __builtin_popcount(GT[3])); const int neq = nge - ngt;
    int pg = wave_scan_dpp(ngt), pe = wave_scan_dpp(neq);
    const int totgt = __builtin_amdgcn_readlane(pg, 63); pg -= ngt; pe -= neq;
    const int need = 256 - totgt; int mytake = need - pe; mytake = mytake < 0 ? 0 : (mytake > neq ? neq : mytake);
    int off = pg + (pe < need ? pe : need);
#pragma unroll
    for (int w = 0; w < 4; ++w) if (w * 4 < nch) { unsigned m = GT[w];
        while (__ballot(m != 0u) != 0ull) {
            if (m != 0u) { const int b = __builtin_ctz(m), pos = b & 15; const int s = w * 2048 + (pos >> 2) * 512 + l * 8 + (pos & 3) * 2 + (b >> 4);
                if (off < 256) SEL[off] = s << 8;
                ++off; m &= m - 1u; } } }
    int tk = 0;
#pragma unroll
    for (int w = 0; w < 4; ++w) if (w * 4 < nch) { unsigned m = GE[w] ^ GT[w];
        while (__ballot(m != 0u && tk < mytake) != 0ull) {
            if (m != 0u && tk < mytake) { const int b = __builtin_ctz(m), pos = b & 15; const int s = w * 2048 + (pos >> 2) * 512 + l * 8 + (pos & 3) * 2 + (b >> 4);
                if (off < 256) SEL[off] = s << 8;
                ++off; ++tk; m &= m - 1u; } } }
}

constexpr int SP_PP = 264;
constexpr int SP_VP = 136;
constexpr int SP_WAVE_BYTES = 16 * SP_PP * 2 + 32 * SP_VP * 2;
__device__ __forceinline__ s16x4 tr_read4(unsigned lds_addr) { s16x4 r; asm volatile("ds_read_b64_tr_b16 %0, %1\n\ts_waitcnt lgkmcnt(0)" : "=&v"(r) : "v"(lds_addr) : "memory"); return r; }
__device__ __forceinline__ void sparse_attn_query(const Frame& F, int t) {
    const int lane_ = lane_id(), tid_ = F.wave * 64 + lane_; (void)tid_;
    const int l = lane_, fr = l & 15, fq = l >> 4;
    LAS unsigned char* wl = F.lds + F.wave * SP_WAVE_BYTES; LAS bf16_t* sP = (LAS bf16_t*)wl; LAS bf16_t* sV = (LAS bf16_t*)(wl + 16 * SP_PP * 2);
    const bf16_t* Q = (const bf16_t*)(F.ws + WS_DQ) + (size_t)t * DM; bf16_t* OB = (bf16_t*)(F.ws + WS_OB) + (size_t)t * DM; const bf16_t* KB = (const bf16_t*)(F.ws + WS_KBR); const bf16_t* VB = (const bf16_t*)(F.ws + WS_VB);
    const LAS int* SEL = (const LAS int*)(F.lds + SEL_LDS_OFF) + F.wave * 256; const int nvalid = t < 255 ? t + 1 : 256;
    LDS_WAIT();
    bf16x8 aq[4];
#pragma unroll
    for (int ks = 0; ks < 4; ++ks) aq[ks] = *(const bf16x8*)(Q + fr * 128 + ks * 32 + 8 * fq);
#pragma unroll
    for (int ks = 0; ks < 2; ++ks) { const size_t tr = (size_t)t * 64 + ks * 32 + 8 * fq;
        const f32x4 c0 = *(const f32x4*)((const float*)(F.ws + WS_COS128) + tr), c1 = *(const f32x4*)((const float*)(F.ws + WS_COS128) + tr + 4), s0 = *(const f32x4*)((const float*)(F.ws + WS_SIN128) + tr), s1 = *(const f32x4*)((const float*)(F.ws + WS_SIN128) + tr + 4);
        rope8(aq[ks], aq[ks + 2], c0, c1, s0, s1); }
    u32x4 vr[8];
#pragma unroll
    for (int i = 0; i < 8; ++i) { const int p = i * 64 + l, row = p >> 4, ch = p & 15; vr[i] = *(const u32x4*)((const unsigned char*)VB + (unsigned)(SEL[(row & 15) * 16 + (row >> 4)] + ch * 16)); }
    f32x4 sc[16]; u32x4 k0[4], k1[4]; LAS unsigned char* sK = (LAS unsigned char*)sV;
#define SPA_KLOAD(dst, kt) do { _Pragma("unroll") for (int i = 0; i < 4; ++i) dst[i] = *(const u32x4*)((const unsigned char*)KB + (unsigned)(SEL[(kt) * 16 + i * 4 + (l >> 4)] + (l & 15) * 16)); } while (0)
#define SPA_KMUL(src, kt) do { _Pragma("unroll") for (int i = 0; i < 4; ++i) *(LAS u32x4*)(sK + (i * 4 + (l >> 4)) * 272 + (l & 15) * 16) = src[i]; \
        f32x4 acc_ = (f32x4){0.f, 0.f, 0.f, 0.f}; _Pragma("unroll") for (int ks = 0; ks < 4; ++ks) acc_ = __builtin_amdgcn_mfma_f32_16x16x32_bf16(aq[ks], *(const LAS bf16x8*)(sK + fr * 272 + ks * 64 + fq * 16), acc_, 0, 0, 0); MFMA_FENCE1(acc_); \
        if (nvalid < 256) { const bool ok_ = ((kt) * 16 + fr) < nvalid; _Pragma("unroll") for (int r = 0; r < 4; ++r) acc_[r] = ok_ ? acc_[r] : -3.0e38f; }     \
        sc[kt] = acc_; } while (0)
    SPA_KLOAD(k0, 0);
#pragma unroll
    for (int kt = 0; kt < 16; kt += 2) { SPA_KLOAD(k1, kt + 1); SPA_KMUL(k0, kt); if (kt + 2 < 16) SPA_KLOAD(k0, kt + 2); SPA_KMUL(k1, kt + 1); }
#undef SPA_KLOAD
#undef SPA_KMUL
    f32x4 mx = sc[0];
#pragma unroll
    for (int kt = 1; kt < 16; ++kt)
#pragma unroll
        for (int r = 0; r < 4; ++r) mx[r] = fmaxf(mx[r], sc[kt][r]);
#pragma unroll
    for (int r = 0; r < 4; ++r) mx[r] = row16_max(mx[r]);
    f32x4 sm = (f32x4){0.f, 0.f, 0.f, 0.f};
    constexpr float SPA_A = 0.08838834764831845f * 1.4426950408889634f;
#pragma unroll
    for (int r = 0; r < 4; ++r) mx[r] *= -SPA_A;
#pragma unroll
    for (int kt = 0; kt < 16; ++kt)
#pragma unroll
        for (int r = 0; r < 4; ++r) { const float e = __builtin_amdgcn_exp2f(fmaf(sc[kt][r], SPA_A, mx[r])); sc[kt][r] = e; sm[r] += e; }
#pragma unroll
    for (int r = 0; r < 4; ++r) sm[r] = row16_sum(sm[r]);
#pragma unroll
    for (int r = 0; r < 4; ++r) sm[r] = __builtin_amdgcn_rcpf(sm[r]);
#pragma unroll
    for (int r = 0; r < 4; ++r) { u32x4 w0, w1;
        w0.x = pk2(sc[0][r], sc[1][r]); w0.y = pk2(sc[2][r], sc[3][r]); w0.z = pk2(sc[4][r], sc[5][r]); w0.w = pk2(sc[6][r], sc[7][r]);
        w1.x = pk2(sc[8][r], sc[9][r]); w1.y = pk2(sc[10][r], sc[11][r]); w1.z = pk2(sc[12][r], sc[13][r]); w1.w = pk2(sc[14][r], sc[15][r]);
        *(LAS u32x4*)(sP + (4 * fq + r) * SP_PP + fr * 16) = w0; *(LAS u32x4*)(sP + (4 * fq + r) * SP_PP + fr * 16 + 8) = w1; }
    f32x4 o[8];
#pragma unroll
    for (int nt = 0; nt < 8; ++nt) o[nt] = (f32x4){0.f, 0.f, 0.f, 0.f};
    const unsigned tbase = (unsigned)(size_t)sV + (unsigned)(((8 * fq + (fr >> 2)) * SP_VP + 4 * (fr & 3)) * 2);
    for (int kst = 0; kst < 8; ++kst) {
#pragma unroll
        for (int i = 0; i < 8; ++i) { const int p = i * 64 + l, row = p >> 4, ch = p & 15; *(LAS u32x4*)(sV + row * SP_VP + ch * 8) = vr[i]; }
        if (kst < 7) {
#pragma unroll
            for (int i = 0; i < 8; ++i) { const int p = i * 64 + l, row = p >> 4, ch = p & 15; vr[i] = *(const u32x4*)((const unsigned char*)VB + (unsigned)(SEL[(row & 15) * 16 + 2 * (kst + 1) + (row >> 4)] + ch * 16)); } }
        const bf16x8 pa = *(const LAS bf16x8*)(sP + fr * SP_PP + kst * 32 + 8 * fq);
        LDS_WAIT(); __builtin_amdgcn_sched_barrier(0);
        s16x4 lo[8], hi[8];
        asm volatile("ds_read_b64_tr_b16 %0, %16\n\tds_read_b64_tr_b16 %1, %16 offset:32\n\tds_read_b64_tr_b16 %2, %16 offset:64\n\tds_read_b64_tr_b16 %3, %16 offset:96\n\t"
                     "ds_read_b64_tr_b16 %4, %16 offset:128\n\tds_read_b64_tr_b16 %5, %16 offset:160\n\tds_read_b64_tr_b16 %6, %16 offset:192\n\tds_read_b64_tr_b16 %7, %16 offset:224\n\t"
                     "ds_read_b64_tr_b16 %8, %16 offset:1088\n\tds_read_b64_tr_b16 %9, %16 offset:1120\n\tds_read_b64_tr_b16 %10, %16 offset:1152\n\tds_read_b64_tr_b16 %11, %16 offset:1184\n\t"
                     "ds_read_b64_tr_b16 %12, %16 offset:1216\n\tds_read_b64_tr_b16 %13, %16 offset:1248\n\tds_read_b64_tr_b16 %14, %16 offset:1280\n\tds_read_b64_tr_b16 %15, %16 offset:1312\n\ts_waitcnt lgkmcnt(0)"
                     : "=&v"(lo[0]), "=&v"(lo[1]), "=&v"(lo[2]), "=&v"(lo[3]), "=&v"(lo[4]), "=&v"(lo[5]), "=&v"(lo[6]), "=&v"(lo[7]),
                       "=&v"(hi[0]), "=&v"(hi[1]), "=&v"(hi[2]), "=&v"(hi[3]), "=&v"(hi[4]), "=&v"(hi[5]), "=&v"(hi[6]), "=&v"(hi[7]) : "v"(tbase) : "memory");
        __builtin_amdgcn_sched_barrier(0);
#pragma unroll
        for (int nt = 0; nt < 8; ++nt) { bf16x8 bv; bv[0] = lo[nt][0]; bv[1] = lo[nt][1]; bv[2] = lo[nt][2]; bv[3] = lo[nt][3]; bv[4] = hi[nt][0]; bv[5] = hi[nt][1]; bv[6] = hi[nt][2]; bv[7] = hi[nt][3];
            o[nt] = __builtin_amdgcn_mfma_f32_16x16x32_bf16(pa, bv, o[nt], 0, 0, 0); }
        __builtin_amdgcn_sched_barrier(0);
    }
    MFMA_FENCE8(o[0], o[1], o[2], o[3], o[4], o[5], o[6], o[7]);
#pragma unroll
    for (int nt = 0; nt < 8; ++nt)
#pragma unroll
        for (int r = 0; r < 4; ++r) sP[(4 * fq + r) * SP_PP + 16 * nt + fr] = (bf16_t)f2bf(o[nt][r] * sm[r]);
#pragma unroll
    for (int i = 0; i < 4; ++i) { const int p = i * 64 + l, hd = p >> 4, pc = p & 15; *(u32x4*)(OB + hd * 128 + pc * 8) = *(const LAS u32x4*)(sP + hd * SP_PP + pc * 8); }
}

__device__ __forceinline__ void gla_state_item(const Frame& F, int item) {
    const int lane_ = lane_id(), fr = lane_ & 15, fq = lane_ >> 4;
    const int h = item >> 6, eb = (item >> 1) & 31, d0 = (item & 1) * 128 + F.wave * 16;
    const bf16_t* KH = (const bf16_t*)(F.ws + WS_KHT) + ((size_t)h * 16 + (d0 >> 4)) * 128 * 1024 + lane_ * 8;
    const int tid_ = F.wave * 64 + lane_;
    const bf16_t* VT = (const bf16_t*)(F.ws + WS_VT) + ((size_t)h * 32 + eb) * 128 * 1024 + (tid_ >> 7) * 1024 + (tid_ & 127) * 8;
    bf16_t* ST = (bf16_t*)(F.ws + WS_ST) + (((size_t)h * 32 + eb) * 16 + (d0 >> 4)) * 256 + fr * 16 + 4 * fq;
    const float* DV = (const float*)(F.ws + WS_DVEC) + ((size_t)h * 16 + (d0 >> 4)) * 128 * 16 + 4 * fq;
    LAS unsigned char* sA = F.lds + F.wave * 2304; LAS unsigned char* sVs = F.lds + 8 * 2304;
    const int wo = (lane_ >> 3) * 144 + (lane_ & 7) * 16, ro = fr * 144 + fq * 16;
    const int vwo = (tid_ >> 7) * 2304 + ((tid_ & 127) >> 3) * 144 + (tid_ & 7) * 16;
    f32x4 S = (f32x4){0.f, 0.f, 0.f, 0.f};
#define GST_LOAD(a, dv, cbase) do { _Pragma("unroll") for (int i = 0; i < 4; ++i) { const size_t c = (cbase) + i; const bf16_t* kp = KH + c * 1024; \
        a[i][0] = *(const u32x4*)kp; a[i][1] = *(const u32x4*)(kp + 512); dv[i] = *(const f32x4*)(DV + c * 16); } } while (0)
#define GST_STEP(a, dv, cbase, buf) do { _Pragma("unroll") for (int i = 0; i < 4; ++i) { const size_t c = (cbase) + i; \
        *(LAS u32x4*)(sA + wo) = a[i][0]; *(LAS u32x4*)(sA + 8 * 144 + wo) = a[i][1]; \
        const bf16x8 af0 = *(const LAS bf16x8*)(sA + ro), af1 = *(const LAS bf16x8*)(sA + ro + 64), bf0 = *(const LAS bf16x8*)(sVs + (buf) * 9216 + i * 2304 + ro), bf1 = *(const LAS bf16x8*)(sVs + (buf) * 9216 + i * 2304 + ro + 64); \
        f32x4 L = __builtin_amdgcn_mfma_f32_16x16x32_bf16(af0, bf0, (f32x4){0.f, 0.f, 0.f, 0.f}, 0, 0, 0); L = __builtin_amdgcn_mfma_f32_16x16x32_bf16(af1, bf1, L, 0, 0, 0); MFMA_FENCE1(L); \
        u32x2 w; w.x = pk2(S[0], S[1]); w.y = pk2(S[2], S[3]); *(u32x2*)(ST + c * (4 * 512 * 256)) = w; S = dv[i] * S + L; } } while (0)
    u32x4 ak[3][4][2], vpre[2]; f32x4 dvk[3][4];
    vpre[0] = *(const u32x4*)VT; vpre[1] = *(const u32x4*)(VT + (size_t)4 * 1024);
    GST_LOAD(ak[0], dvk[0], 0); GST_LOAD(ak[1], dvk[1], 4);
#pragma unroll
    for (int n = 0; n < 32; ++n) {
        *(LAS u32x4*)(sVs + (n & 1) * 9216 + vwo) = vpre[n & 1]; __syncthreads();
        if (n + 2 < 32) { vpre[n & 1] = *(const u32x4*)(VT + (size_t)(4 * (n + 2)) * 1024); GST_LOAD(ak[(n + 2) % 3], dvk[(n + 2) % 3], 4 * (n + 2)); }
        GST_STEP(ak[n % 3], dvk[n % 3], 4 * n, (n & 1));
    }
#undef GST_LOAD
#undef GST_STEP
}
__device__ __forceinline__ void gla_out_item(const Frame& F, const Args& a, int item) {
    const int lane_ = lane_id(), tid_ = F.wave * 64 + lane_; (void)tid_;
    const int c = item >> 2, h = item & 3, t0 = c * 64, fr = lane_ & 15, fq = lane_ >> 4, w = F.wave;
    LAS unsigned char* sBq = F.lds; LAS unsigned char* sAw = F.lds + 9216 + w * 9216; LAS float* sred = (LAS float*)(F.lds + 9216 * 9);
    f32x4 acc[4][4];
#pragma unroll
    for (int i = 0; i < 4; ++i)
#pragma unroll
        for (int j = 0; j < 4; ++j) acc[i][j] = (f32x4){0.f, 0.f, 0.f, 0.f};
    const bf16_t* STw = (const bf16_t*)(F.ws + WS_ST) + ((size_t)item * 32 + w * 4) * 4096 + (lane_ >> 5) * 256 + (lane_ & 31) * 8; const bf16_t* QTi = (const bf16_t*)(F.ws + WS_QT) + (size_t)t0 * 1024 + h * 256;
    const bf16_t* VTw = (const bf16_t*)(F.ws + WS_VT) + (((size_t)h * 32 + w * 4) * 128 + c) * 1024; const bf16_t* ATi = (const bf16_t*)(F.ws + WS_ATT) + (size_t)item * 4096;
    const int rw = lane_ >> 3, pw = lane_ & 7, rb = tid_ >> 3, pb = tid_ & 7;
    u32x4 av[8], bv;
#define GOUT_LOAD(kb) do { if ((kb) < 4) { _Pragma("unroll") for (int i = 0; i < 8; ++i) av[i] = *(const u32x4*)(STw + (i >> 1) * 4096 + ((kb) * 4 + (i & 1) * 2) * 256);     \
            bv = *(const u32x4*)(QTi + (size_t)rb * 1024 + (kb) * 64 + pb * 8); } \
        else { _Pragma("unroll") for (int i = 0; i < 8; ++i) av[i] = *(const u32x4*)(VTw + (size_t)(i >> 1) * (128 * 1024) + ((i & 1) * 8 + rw) * 64 + pw * 8);     \
            bv = *(const u32x4*)(ATi + rb * 64 + pb * 8); } } while (0)
    GOUT_LOAD(0);
#pragma unroll
    for (int kb = 0; kb < 5; ++kb) {
        __syncthreads();
#pragma unroll
        for (int i = 0; i < 8; ++i) { if (kb < 4) *(LAS u32x4*)(sAw + ((i >> 1) * 16 + ((lane_ & 31) >> 1)) * 144 + ((i & 1) * 2 + (lane_ >> 5)) * 32 + (lane_ & 1) * 16) = av[i];
            else *(LAS u32x4*)(sAw + (i * 8 + rw) * 144 + pw * 16) = av[i]; }
        *(LAS u32x4*)(sBq + rb * 144 + pb * 16) = bv;
        __syncthreads();
        if (kb + 1 < 5) GOUT_LOAD(kb + 1);
#pragma unroll
        for (int ks = 0; ks < 2; ++ks) { bf16x8 af[4], bf[4];
#pragma unroll
            for (int mt = 0; mt < 4; ++mt) af[mt] = *(const LAS bf16x8*)(sAw + (16 * mt + fr) * 144 + ks * 64 + fq * 16);
#pragma unroll
            for (int nt = 0; nt < 4; ++nt) bf[nt] = *(const LAS bf16x8*)(sBq + (16 * nt + fr) * 144 + ks * 64 + fq * 16);
#pragma unroll
            for (int mt = 0; mt < 4; ++mt)
#pragma unroll
                for (int nt = 0; nt < 4; ++nt) acc[mt][nt] = __builtin_amdgcn_mfma_f32_16x16x32_bf16(af[mt], bf[nt], acc[mt][nt], 0, 0, 0); }
    }
#undef GOUT_LOAD
#pragma unroll
    for (int mt = 0; mt < 4; ++mt) MFMA_FENCE4(acc[mt][0], acc[mt][1], acc[mt][2], acc[mt][3]);
    float ss[4];
#pragma unroll
    for (int nt = 0; nt < 4; ++nt) { float s = 0.f;
#pragma unroll
        for (int mt = 0; mt < 4; ++mt) s += (acc[mt][nt][0] * acc[mt][nt][0] + acc[mt][nt][1] * acc[mt][nt][1]) + (acc[mt][nt][2] * acc[mt][nt][2] + acc[mt][nt][3] * acc[mt][nt][3]);
        s = fadd_x16x32(s); ss[nt] = s;
        if (fq == 0) sred[w * 64 + 16 * nt + fr] = s; }
    __syncthreads();
    const bf16_t* GR = (const bf16_t*)(F.ws + WS_GR); bf16_t* OA = (bf16_t*)(F.ws + WS_OA); const float* gain = a.in[7] + h * 512;
    LAS unsigned char* sO = F.lds;
#pragma unroll
    for (int nt = 0; nt < 4; ++nt) { const int tok = 16 * nt + fr; float tot = 0.f;
#pragma unroll
        for (int ww = 0; ww < 8; ++ww) tot += sred[ww * 64 + tok];
        const float rstd = rsqrtf(tot * (1.f / 512.f) + EPS);
#pragma unroll
        for (int mt = 0; mt < 4; ++mt) { const int e = w * 64 + 16 * mt + 4 * fq; const f32x4 gn = *(const f32x4*)(gain + e);
            u32x2 o; o.x = pk2(acc[mt][nt][0] * rstd * gn[0], acc[mt][nt][1] * rstd * gn[1]); o.y = pk2(acc[mt][nt][2] * rstd * gn[2], acc[mt][nt][3] * rstd * gn[3]);
            *(LAS u32x2*)(sO + tok * 1040 + e * 2) = o; } }
    __syncthreads();
    u32x4 gv[8];
#pragma unroll
    for (int i = 0; i < 8; ++i) gv[i] = *(const u32x4*)(GR + (size_t)(t0 + i * 8 + w) * DM + h * 512 + lane_ * 8);
#pragma unroll
    for (int i = 0; i < 8; ++i) { const int tok = i * 8 + w; const u32x4 ov = *(const LAS u32x4*)(sO + tok * 1040 + lane_ * 16); u32x4 o;
#pragma unroll
        for (int j = 0; j < 4; ++j) { const float r0 = bflo(gv[i][j]), r1 = bfhi(gv[i][j]); o[j] = pk2(bflo(ov[j]) * r0 * sigmoidf_(r0), bfhi(ov[j]) * r1 * sigmoidf_(r1)); }
        *(u32x4*)(OA + (size_t)(t0 + tok) * DM + h * 512 + lane_ * 8) = o; }
    __syncthreads();
}

__device__ const unsigned char PEER_CAND[52] = {
    0x00,0x01,0x02,0x03,0x04,0x05,0x06,0x07,0x08,0x09,0x0a,0x0b,0x0c,0x0d,0x0e,0x0f, 0x10,0x11,0x12,0x13,0x14,0x15,0x16,0x17, 0x20,0x21,0x22,0x23,0x24, 0x30,0x31,0x32,0x33,
    0x40,0x41,0x42, 0x50,0x51, 0x60,0x61, 0x70,0x71, 0x80,0x90,0xa0,0xb0,0xc0,0xd0,0xe0,0xf0, 0xff,0xff };
__device__ __forceinline__ unsigned f32ord(float f) { const unsigned u = __builtin_bit_cast(unsigned, f); return (u & 0x80000000u) ? ~u : (u | 0x80000000u); }
__device__ __forceinline__ float ordf32(unsigned k) { const unsigned u = (k & 0x80000000u) ? (k & 0x7fffffffu) : ~k; return __builtin_bit_cast(float, u); }
__device__ __forceinline__ unsigned umax_x32(unsigned v) { const unsigned o = __shfl_xor(v, 32); return v > o ? v : o; }
__device__ __forceinline__ float fmax_x32(float v) { return fmaxf(v, __shfl_xor(v, 32)); }
__device__ __forceinline__ float fadd_x32(float v) { return v + __shfl_xor(v, 32); }
__device__ __forceinline__ unsigned umax3(unsigned a, unsigned b, unsigned c) { const unsigned t = a > b ? a : b; return t > c ? t : c; }
__device__ __forceinline__ void peer_select_core(unsigned char* ws, int t0, int h, LAS unsigned* tv, const LAS unsigned char* qlds, LAS unsigned char* klds, int wid) {
    const int lane_ = lane_id(), tid_ = wid * 64 + lane_;
    const int l = lane_, fr = l & 15, fq = l >> 4;
    const bf16_t* KEYS = (const bf16_t*)(ws + WS_KEYS);
    int* EXPI = (int*)(ws + WS_EXPI); float* GATEW = (float*)(ws + WS_GATEW);
    {
#pragma unroll 1
        for (int p = 0; p < 2; ++p) { const int g = h * 2 + p;
            { u32x4 kv[4];
#pragma unroll
              for (int i = 0; i < 4; ++i) { const int ch = tid_ + 512 * i; kv[i] = *(const u32x4*)(KEYS + ((size_t)g * 128 + (ch >> 4)) * 128 + (ch & 15) * 8); }
              __syncthreads();
#pragma unroll
              for (int i = 0; i < 4; ++i) { const int ch = tid_ + 512 * i; *(LAS u32x4*)(klds + (ch >> 4) * 272 + (ch & 15) * 16) = kv[i]; }
              __syncthreads(); }
            f32x4 acc[8];
#pragma unroll
            for (int mt = 0; mt < 8; ++mt) acc[mt] = (f32x4){0.f, 0.f, 0.f, 0.f};
#pragma unroll
            for (int ks = 0; ks < 4; ++ks) { const bf16x8 bq = *(const LAS bf16x8*)(qlds + fr * 528 + (p * 128 + ks * 32 + 8 * fq) * 2);
#pragma unroll
                for (int mt = 0; mt < 8; ++mt) acc[mt] = __builtin_amdgcn_mfma_f32_16x16x32_bf16(*(const LAS bf16x8*)(klds + (16 * mt + fr) * 272 + ks * 64 + fq * 16), bq, acc[mt], 0, 0, 0); }
            MFMA_FENCE8(acc[0], acc[1], acc[2], acc[3], acc[4], acc[5], acc[6], acc[7]);
            unsigned q0[8], q1[8], q2[8], q3[8];
#pragma unroll
            for (int mt = 0; mt < 8; ++mt) { unsigned a = (f32ord(acc[mt][0]) & ~127u) | (unsigned)(127 - (16 * mt + 4 * fq + 0)), b = (f32ord(acc[mt][1]) & ~127u) | (unsigned)(127 - (16 * mt + 4 * fq + 1)),
                         c = (f32ord(acc[mt][2]) & ~127u) | (unsigned)(127 - (16 * mt + 4 * fq + 2)), d = (f32ord(acc[mt][3]) & ~127u) | (unsigned)(127 - (16 * mt + 4 * fq + 3)), t;
#define CE_(x, y) do { t = x > y ? x : y; y = x > y ? y : x; x = t; } while (0)
                CE_(a, b); CE_(c, d); CE_(a, c); CE_(b, d); CE_(b, c);
#undef CE_
                q0[mt] = a; q1[mt] = b; q2[mt] = c; q3[mt] = d; }
#pragma unroll
            for (int i = 0; i < 16; ++i) { unsigned m = umax3(umax3(q0[0], q0[1], q0[2]), umax3(q0[3], q0[4], q0[5]), q0[6] > q0[7] ? q0[6] : q0[7]);
                m = umax_x16x32(m);
#pragma unroll
                for (int g = 0; g < 8; ++g) { const bool hit = q0[g] == m; q0[g] = hit ? q1[g] : q0[g]; q1[g] = hit ? q2[g] : q1[g]; q2[g] = hit ? q3[g] : q2[g]; q3[g] = hit ? 0u : q3[g]; }
                if (fq == (i & 3)) tv[(fr * 2 + p) * 16 + i] = m; }
        }
        LDS_WAIT();
        unsigned ck[13];
#pragma unroll
        for (int ci = 0; ci < 13; ++ci) { const int cidx = fq + 4 * ci; const unsigned ab = PEER_CAND[cidx];
            if (cidx < 50) { const float v = ordf32(tv[(fr * 2 + 0) * 16 + (ab >> 4)] & ~127u) + ordf32(tv[(fr * 2 + 1) * 16 + (ab & 15)] & ~127u); ck[ci] = (f32ord(v) & ~63u) | (unsigned)(63 - cidx); }
            else ck[ci] = 0u; }
        float scv[4]; int exv[4];
        unsigned c0[4], c1[3], c2[3], c3[3];
#pragma unroll
        for (int g = 0; g < 3; ++g) { unsigned a = ck[4 * g], b = ck[4 * g + 1], c = ck[4 * g + 2], d = ck[4 * g + 3], t;
#define CE_(x, y) do { t = x > y ? x : y; y = x > y ? y : x; x = t; } while (0)
            CE_(a, b); CE_(c, d); CE_(a, c); CE_(b, d); CE_(b, c);
#undef CE_
            c0[g] = a; c1[g] = b; c2[g] = c; c3[g] = d; }
        c0[3] = ck[12];
#pragma unroll
        for (int i = 0; i < 16; ++i) { unsigned m = umax3(c0[0], c0[1], c0[2]); m = m > c0[3] ? m : c0[3];
            m = umax_x16x32(m);
#pragma unroll
            for (int g = 0; g < 3; ++g) { const bool hit = c0[g] == m; c0[g] = hit ? c1[g] : c0[g]; c1[g] = hit ? c2[g] : c1[g]; c2[g] = hit ? c3[g] : c2[g]; c3[g] = hit ? 0u : c3[g]; }
            c0[3] = (c0[3] == m) ? 0u : c0[3];
            if (fq == (i & 3)) { const int cidx = 63 - (int)(m & 63u); const unsigned ab = PEER_CAND[cidx];
                const int n1 = 127 - (int)(tv[(fr * 2 + 0) * 16 + (ab >> 4)] & 127u), n2 = 127 - (int)(tv[(fr * 2 + 1) * 16 + (ab & 15)] & 127u);
                exv[i >> 2] = n1 * 128 + n2; scv[i >> 2] = ordf32(m & ~63u); } }
        float mx = fmaxf(fmaxf(scv[0], scv[1]), fmaxf(scv[2], scv[3])); mx = fmax_x16x32(mx);
        float ev[4], s = 0.f;
#pragma unroll
        for (int j = 0; j < 4; ++j) { ev[j] = __expf(scv[j] - mx); s += ev[j]; }
        s = fadd_x16x32(s); const float inv = __builtin_amdgcn_rcpf(s);
#pragma unroll
        for (int j = 0; j < 4; ++j) { const size_t o = (size_t)(t0 + fr) * 128 + h * 16 + j * 4 + fq; EXPI[o] = exv[j]; GATEW[o] = ev[j] * inv; }
        LDS_WAIT();
    }
}
__device__ __forceinline__ float gelu_tanh(float x) { const float u = 0.7978845608028654f * (x + 0.044715f * x * x * x); const float e = __expf(2.f * u); const float th = 1.f - 2.f * __builtin_amdgcn_rcpf(e + 1.f); return 0.5f * x * (1.f + th); }
template <bool SIGNED> __device__ __forceinline__ void quant_row(const float* src, unsigned char* dst, float* scale_out, int lane, const float* cgain) {
    f32x4 v[8]; float mx = 0.f;
#pragma unroll
    for (int i = 0; i < 2; ++i)
#pragma unroll
        for (int j = 0; j < 4; ++j) { f32x4 x = *(const f32x4*)(src + i * 1024 + lane * 16 + j * 4); if (cgain) x *= *(const f32x4*)(cgain + i * 1024 + lane * 16 + j * 4); v[i * 4 + j] = x; mx = fmaxf(mx, fmaxf(fmaxf(fabsf(x[0]), fabsf(x[1])), fmaxf(fabsf(x[2]), fabsf(x[3])))); }
#pragma unroll
    for (int o = 1; o < 64; o <<= 1) mx = fmaxf(mx, __shfl_xor(mx, o));
    const float inv = mx > 0.f ? 127.f / mx : 0.f;
#pragma unroll
    for (int i = 0; i < 2; ++i) { u32x4 w;
#pragma unroll
        for (int j = 0; j < 4; ++j) { const f32x4 x = v[i * 4 + j];
            const float off = SIGNED ? 0.f : 128.f;
            const unsigned b0 = (unsigned)(int)(rintf(x[0] * inv) + off) & 0xffu, b1 = (unsigned)(int)(rintf(x[1] * inv) + off) & 0xffu, b2 = (unsigned)(int)(rintf(x[2] * inv) + off) & 0xffu, b3 = (unsigned)(int)(rintf(x[3] * inv) + off) & 0xffu;
            w[j] = b0 | (b1 << 8) | (b2 << 16) | (b3 << 24); }
        *(u32x4*)(dst + i * 1024 + lane * 16) = w; }
    if (lane == 0) *scale_out = mx * (1.f / 127.f);
}
__device__ __forceinline__ void quant_rows4(const float* ut, const float* vt, const float* ug, unsigned char* ws, int r, int rs, int rend, int lane) {
    f32x4 v[4][8];
#pragma unroll
    for (int q = 0; q < 4; ++q) { const int rq = r + q * rs; if (rq < rend) { const float* src = (rq < 16384 ? ut : vt) + (size_t)(rq & 16383) * DM;
#pragma unroll
            for (int i = 0; i < 2; ++i)
#pragma unroll
                for (int j = 0; j < 4; ++j) v[q][i * 4 + j] = *(const f32x4*)(src + i * 1024 + lane * 16 + j * 4); } }
#pragma unroll
    for (int q = 0; q < 4; ++q) { const int rq = r + q * rs; if (rq < rend) { const int e = rq & 16383; const bool sg = rq < 16384; float mx = 0.f;
#pragma unroll
            for (int i = 0; i < 2; ++i)
#pragma unroll
                for (int j = 0; j < 4; ++j) { f32x4 x = v[q][i * 4 + j]; if (sg) x *= *(const f32x4*)(ug + i * 1024 + lane * 16 + j * 4); v[q][i * 4 + j] = x; mx = fmaxf(mx, fmaxf(fmaxf(fabsf(x[0]), fabsf(x[1])), fmaxf(fabsf(x[2]), fabsf(x[3])))); }
            mx = wave_max(mx);
            const float inv = mx > 0.f ? 127.f / mx : 0.f, off = sg ? 0.f : 128.f;
            unsigned char* dst = ws + WS_UB + (size_t)e * 4096 + (sg ? 0 : 2048);
#pragma unroll
            for (int i = 0; i < 2; ++i) { u32x4 w;
#pragma unroll
                for (int j = 0; j < 4; ++j) { const f32x4 x = v[q][i * 4 + j];
                    const unsigned b0 = (unsigned)(int)(rintf(x[0] * inv) + off) & 0xffu, b1 = (unsigned)(int)(rintf(x[1] * inv) + off) & 0xffu, b2 = (unsigned)(int)(rintf(x[2] * inv) + off) & 0xffu, b3 = (unsigned)(int)(rintf(x[3] * inv) + off) & 0xffu;
                    w[j] = b0 | (b1 << 8) | (b2 << 16) | (b3 << 24); }
                *(u32x4*)(dst + i * 1024 + lane * 16) = w; }
            if (lane == 0) ((float*)(ws + (sg ? WS_USC : WS_VSC)))[e] = mx * (1.f / 127.f); } }
}
__device__ __forceinline__ float ub(unsigned w, int b) { return (float)((w >> (8 * b)) & 0xffu); }
__device__ __forceinline__ float dot16q(const u32x4 w, const float* x) {
    float s = 0.f;
#pragma unroll
    for (int k = 0; k < 4; ++k) { s = fmaf(ub(w[k], 0), x[4 * k + 0], s); s = fmaf(ub(w[k], 1), x[4 * k + 1], s); s = fmaf(ub(w[k], 2), x[4 * k + 2], s); s = fmaf(ub(w[k], 3), x[4 * k + 3], s); }
    return s;
}
__device__ __forceinline__ void axpy16q(const u32x4 w, float c, float* o) {
#pragma unroll
    for (int k = 0; k < 4; ++k) { o[4 * k + 0] = fmaf(c, ub(w[k], 0), o[4 * k + 0]); o[4 * k + 1] = fmaf(c, ub(w[k], 1), o[4 * k + 1]); o[4 * k + 2] = fmaf(c, ub(w[k], 2), o[4 * k + 2]); o[4 * k + 3] = fmaf(c, ub(w[k], 3), o[4 * k + 3]); }
}
__device__ __forceinline__ void peer_expert_token(const Frame& F, const Args& a, int t) {
    const int lane_ = lane_id(), tid_ = F.wave * 64 + lane_; (void)tid_;
    const int l = lane_;
    const unsigned char* UQ = (const unsigned char*)(F.ws + WS_UB); const unsigned char* VQ = UQ + 2048;
    const float* US = (const float*)(F.ws + WS_USC); const float* VS = (const float*)(F.ws + WS_VSC);
    const int* EXPI = (const int*)(F.ws + WS_EXPI) + (size_t)t * 128; const float* GATEW = (const float*)(F.ws + WS_GATEW) + (size_t)t * 128;
    const float rstd2 = rsqrtf(((const float*)(F.ws + WS_CTL))[CW_RSQ2 + t] * (1.f / DM) + EPS);
    float x[32], o[32]; float csum = 0.f;
#pragma unroll
    for (int i = 0; i < 2; ++i)
#pragma unroll
        for (int hf = 0; hf < 2; ++hf) { const u32x4 w = *(const u32x4*)((const bf16_t*)(F.ws + WS_A2) + (size_t)t * DM + i * 1024 + l * 16 + hf * 8); float* xp = x + i * 16 + hf * 8;
            xp[0] = bflo(w.x); xp[1] = bfhi(w.x); xp[2] = bflo(w.y); xp[3] = bfhi(w.y); xp[4] = bflo(w.z); xp[5] = bfhi(w.z); xp[6] = bflo(w.w); xp[7] = bfhi(w.w); }
    float xmax = 0.f;
#pragma unroll
    for (int i = 0; i < 32; ++i) { o[i] = 0.f; xmax = fmaxf(xmax, fabsf(x[i])); }
    xmax = wave_max(xmax);
    const float xinv = xmax > 0.f ? 127.f / xmax : 0.f, xsc = xmax * (1.f / 127.f);
    int xq[8];
#pragma unroll
    for (int k = 0; k < 8; ++k) { const unsigned b0 = (unsigned)(int)rintf(x[4 * k] * xinv) & 0xffu, b1 = (unsigned)(int)rintf(x[4 * k + 1] * xinv) & 0xffu, b2 = (unsigned)(int)rintf(x[4 * k + 2] * xinv) & 0xffu, b3 = (unsigned)(int)rintf(x[4 * k + 3] * xinv) & 0xffu;
        xq[k] = (int)(b0 | (b1 << 8) | (b2 << 16) | (b3 << 24)); }
    for (int jb = 0; jb < 32; ++jb) {
        int e[4]; float g[4];
#pragma unroll
        for (int q = 0; q < 4; ++q) { e[q] = __builtin_amdgcn_readfirstlane(EXPI[jb * 4 + q]); g[q] = __builtin_bit_cast(float, __builtin_amdgcn_readfirstlane(__builtin_bit_cast(int, GATEW[jb * 4 + q]))); }
        u32x4 uw[4][2], vw[4][2];
#pragma unroll
        for (int q = 0; q < 4; ++q) { uw[q][0] = *(const u32x4*)(UQ + (size_t)e[q] * 4096 + l * 16); uw[q][1] = *(const u32x4*)(UQ + (size_t)e[q] * 4096 + 1024 + l * 16); }
#pragma unroll
        for (int q = 0; q < 4; ++q) { vw[q][0] = *(const u32x4*)(VQ + (size_t)e[q] * 4096 + l * 16); vw[q][1] = *(const u32x4*)(VQ + (size_t)e[q] * 4096 + 1024 + l * 16); }
        int di[4];
#pragma unroll
        for (int q = 0; q < 4; ++q) { int acc = 0;
#pragma unroll
            for (int k = 0; k < 4; ++k) { acc = __builtin_amdgcn_sdot4((int)uw[q][0][k], xq[k], acc, false); acc = __builtin_amdgcn_sdot4((int)uw[q][1][k], xq[4 + k], acc, false); }
            di[q] = acc; }
        float d[4];
#pragma unroll
        for (int q = 0; q < 4; ++q) d[q] = (float)wave_sum_dpp(di[q]) * xsc;
#pragma unroll
        for (int q = 0; q < 4; ++q) { const float c = g[q] * gelu_tanh(d[q] * US[e[q]] * rstd2) * VS[e[q]]; csum += c; axpy16q(vw[q][0], c, o); axpy16q(vw[q][1], c, o + 16); }
    }
    float* H = a.out + (size_t)t * DM; const float* gf = a.in[22]; float ss = 0.f; csum *= 128.f;
#pragma unroll
    for (int i = 0; i < 32; ++i) { const float v = o[i] - csum + x[i]; o[i] = v; ss += v * v; }
    const float rstd = rsqrtf(wave_sum(ss) * (1.f / DM) + EPS);
#pragma unroll
    for (int i = 0; i < 2; ++i)
#pragma unroll
        for (int j = 0; j < 4; ++j) { const f32x4 gv = *(const f32x4*)(gf + i * 1024 + l * 16 + j * 4); f32x4 r;
#pragma unroll
            for (int k = 0; k < 4; ++k) r[k] = o[i * 16 + j * 4 + k] * rstd * gv[k];
            *(f32x4*)(H + i * 1024 + l * 16 + j * 4) = r; }
}

struct EpiPeerQ {
    static constexpr bool AFTER_DRAIN = true, HAS_MID = false;
    unsigned char* ws; const float* rowsq; const float* ut; const float* vt; const float* ug; int gw0, ngw, qfrom;
    __device__ __forceinline__ void prefetch(const Unit&, int, int, unsigned&) const {}
    __device__ __forceinline__ void fused(f32x4 (&acc)[2][2][4][2], const Unit& u, int wr, int wc, int fr, int fq, LAS unsigned char* lds, int wid, int lane) const {
#pragma unroll
        for (int ai = 0; ai < 2; ++ai) {
#pragma unroll
            for (int m = 0; m < 4; ++m) { const int rl = wr * 64 + m * 16 + fr; const float sc = rsqrtf(rowsq[u.pm * 256 + ai * 128 + rl] * (1.f / DM) + EPS);
#pragma unroll
                for (int bj = 0; bj < 2; ++bj) *(LAS u32x4*)(lds + rl * 528 + (wc * 32 + 8 * fq + bj * 128) * 2) = pack8(acc[ai][bj][m][0] * sc, acc[ai][bj][m][1] * sc); }
            __syncthreads();
            peer_select_core(ws, u.pm * 256 + ai * 128 + wid * 16, u.pn, (LAS unsigned*)(lds + 128 * 528 + wid * 2048), lds + wid * 16 * 528, lds + 128 * 528 + 8 * 2048, wid);
            for (int r = qfrom + gw0 + wid + ai * ngw; r < 32768; r += 8 * ngw) quant_rows4(ut, vt, ug, ws, r, 2 * ngw, 32768, lane);
            __syncthreads(); }
    }
};

constexpr int N_PHASES = 17;
constexpr int QSPLIT = 24576;
__global__ void __launch_bounds__(NTHREADS, 2) hybrid_fwd(Args args) {
    extern __shared__ __attribute__((aligned(16))) unsigned char lds_raw[];
    Frame F;
    F.lds = (LAS unsigned char*)lds_raw;
    F.wave = __builtin_amdgcn_readfirstlane((int)threadIdx.x >> 6);
    F.G = gridDim.x; F.bid = blockIdx.x; F.ws = args.ws;
    unsigned* ctl = (unsigned*)(args.ws + WS_CTL);
    volatile LAS unsigned* MISCW = (volatile LAS unsigned*)(F.lds + LDSCTL_OFF);
    if (F.wave == 0) MISCW[lane_id()] = 0u;
    __syncthreads();
    XcdBarrier bar; bar.bar = ctl + CW_BAR; bar.x = 0; bar.st = nullptr;
    if (args.use_bar) bar = xcd_barrier_post(ctl + CW_BAR, MISCW + 8, F.wave == 0 && lane_id() == 0);
    const int lo = args.ph_lo, hi = args.ph_hi;
    LAS unsigned char* ring = F.lds;
    const int gw = F.bid * NWAVES + F.wave, NGW = F.G * NWAVES;
    float* rsq1 = (float*)ctl + CW_RSQ1; float* rsq2 = (float*)ctl + CW_RSQ2;
#define IN(k) (lo <= (k) && (k) < hi)
    unsigned long long tph0_ = 0ull;
#define TBEG(k) do { if (TPH == (k)) { __syncthreads(); tph0_ = __builtin_amdgcn_s_memrealtime(); } } while (0)
#define TEND(k) do { if (TPH == (k)) { __syncthreads(); const unsigned long long t1_ = __builtin_amdgcn_s_memrealtime(), d_ = t1_ - tph0_; while (__builtin_amdgcn_s_memrealtime() - t1_ < d_) __builtin_amdgcn_s_sleep(8); __syncthreads(); } } while (0)
#define SEAM(k) do { if (args.use_bar && IN(k) && IN((k) + 1)) { if (args.use_bar == 2) { cg::this_grid().sync(); } else { xcd_barrier(bar, F.wave); } } } while (0)
#define ROT(r) ((F.bid + F.G - ((r) % F.G)) % F.G)

    TBEG(0);
    if (IN(0)) { p0_prologue(F, args); }
    SEAM(0); TEND(0);
    TBEG(1);
    if (IN(1)) {
        { pg8::Gemm g{(const bf16_t*)(F.ws + WS_A0), (const bf16_t*)(F.ws + WS_WIN), SEQ, NIN, DM, DM, DM}; pg8::StaticOrder S; S.init(SEQ, NIN, F.G, F.bid);
          EpiRoute E{F.ws}; pg8::gemm_phase<EpiRoute, true>(ring, g, S, E, F.wave); }
        { pg8::Gemm g{(const bf16_t*)(F.ws + WS_MEMN), (const bf16_t*)(F.ws + WS_WXK), MEM, DM, DM, DM, DM}; pg8::StaticOrder S; S.init(MEM, DM, F.G, ROT(192));
          EpiBf16 E{(bf16_t*)(F.ws + WS_XK), DM, nullptr}; pg8::gemm_phase<EpiBf16, true>(ring, g, S, E, F.wave); }
        { pg8::Gemm g{(const bf16_t*)(F.ws + WS_MEMN), (const bf16_t*)(F.ws + WS_WXV), MEM, DM, DM, DM, DM}; pg8::StaticOrder S; S.init(MEM, DM, F.G, ROT(200));
          EpiBf16 E{(bf16_t*)(F.ws + WS_XV), DM, nullptr}; pg8::gemm_phase<EpiBf16, true>(ring, g, S, E, F.wave); }
    }
    SEAM(1); TEND(1);
    TBEG(2);
    if (IN(2)) {
#pragma unroll 1
        for (int h = 0; h < 4; ++h) {
            pg8::Gemm g{(const bf16_t*)(F.ws + WS_XK) + h * 512, (const bf16_t*)(F.ws + WS_WXQ) + h * 512, MEM, DM, 512, DM, DM}; pg8::StaticOrder S; S.init(MEM, DM, F.G, ROT(8 * h));
            EpiBf16 E{(bf16_t*)(F.ws + WS_WQK) + (size_t)h * 256 * DM, DM, nullptr}; pg8::gemm_phase<EpiBf16, true>(ring, g, S, E, F.wave); }
#pragma unroll 1
        for (int h = 0; h < 4; ++h) {
            pg8::Gemm g{(const bf16_t*)(F.ws + WS_WXO) + h * 512, (const bf16_t*)(F.ws + WS_XV) + h * 512, DM, MEM, 512, DM, DM}; pg8::StaticOrder S; S.init(DM, MEM, F.G, ROT(32 + 8 * h));
            EpiBf16 E{(bf16_t*)(F.ws + WS_WVO) + h * 256, 1024, nullptr}; pg8::gemm_phase<EpiBf16, true>(ring, g, S, E, F.wave); }
        __syncthreads();
        { const int l_ = lane_id(); const float inv128 = powf(10000.f, -(float)(2 * l_) / 128.f), inv64 = powf(10000.f, -(float)(2 * (l_ & 31)) / 64.f);
          if (NGW * 4 == SEQ) rope_tokens4(F, args, gw, NGW, inv128, inv64); else for (int t = gw; t < SEQ; t += NGW) rope_token(F, args, t, inv128, inv64); }
        for (int it = F.bid; it < 512; it += F.G) gla_prep_item(F, args, it);
    }
    SEAM(2); TEND(2);
    TBEG(3);
    if (IN(3)) { scores_phase(F); }
    SEAM(3); TEND(3);
    TBEG(4);
    if (IN(4)) { for (int t = gw; t < SEQ; t += NGW) {
            unsigned long long tp0_ = 0ull; if (TPH == 41) tp0_ = __builtin_amdgcn_s_memrealtime();
            select_row(F, t);
            if (TPH == 41) { const unsigned long long t1_ = __builtin_amdgcn_s_memrealtime(), d_ = t1_ - tp0_; while (__builtin_amdgcn_s_memrealtime() - t1_ < d_) __builtin_amdgcn_s_sleep(8); }
            if (TPH == 42) tp0_ = __builtin_amdgcn_s_memrealtime();
            sparse_attn_query(F, t);
            if (TPH == 42) { const unsigned long long t1_ = __builtin_amdgcn_s_memrealtime(), d_ = t1_ - tp0_; while (__builtin_amdgcn_s_memrealtime() - t1_ < d_) __builtin_amdgcn_s_sleep(8); } } }
    SEAM(5); TEND(4);
    TBEG(6);
    if (IN(6)) {
        if (F.G == 256) gla_state_item(F, ((F.bid & 7) >> 1) * 64 + (F.bid >> 3) * 2 + (F.bid & 1));
        else for (int it = F.bid; it < 256; it += F.G) gla_state_item(F, it); }
    SEAM(7); TEND(6);
    TBEG(8);
    if (IN(8)) { for (int it = F.bid; it < 512; it += F.G) gla_out_item(F, args, it); }
    SEAM(8); TEND(8);
    TBEG(9);
    if (IN(9)) { pg8::Gemm g{(const bf16_t*)(F.ws + WS_OA), (const bf16_t*)(F.ws + WS_WPA), SEQ, DM, DM, DM, DM}; pg8::StaticOrder S; S.init(SEQ, DM, F.G, F.bid);
        EpiStaged<GatePiece> E{{(bf16_t*)(F.ws + WS_T1), (const bf16_t*)(F.ws + WS_GATES), 0, nullptr}}; pg8::gemm_phase<EpiStaged<GatePiece>, false>(ring, g, S, E, F.wave); }
    TEND(9);
    TBEG(10);
    if (IN(10)) { pg8::Gemm g{(const bf16_t*)(F.ws + WS_OB), (const bf16_t*)(F.ws + WS_WPB), SEQ, DM, DM, DM, DM}; pg8::StaticOrder S; S.init(SEQ, DM, F.G, F.bid);
        EpiStaged<GatePiece> E{{(bf16_t*)(F.ws + WS_MERGED), (const bf16_t*)(F.ws + WS_GATES), 2048, (const bf16_t*)(F.ws + WS_T1)}}; pg8::gemm_phase<EpiStaged<GatePiece>, false>(ring, g, S, E, F.wave); }
    SEAM(10); TEND(10);
    TBEG(11);
    if (IN(11)) { { pg8::Gemm g{(const bf16_t*)(F.ws + WS_MERGED), (const bf16_t*)(F.ws + WS_WOUT), SEQ, DM, DM, DM, DM}; pg8::StaticOrder S; S.init(SEQ, DM, F.G, F.bid);
          EpiStaged<ResNormPiece<true>> E{{args.in[0], (bf16_t*)(F.ws + WS_A1), rsq1}}; pg8::gemm_phase<EpiStaged<ResNormPiece<true>>, false>(ring, g, S, E, F.wave); }
    }
    SEAM(11); TEND(11);
    TBEG(12);
    if (IN(12)) { { pg8::Gemm g{(const bf16_t*)(F.ws + WS_A1), (const bf16_t*)(F.ws + WS_WQK), SEQ, 1024, DM, DM, DM}; pg8::StaticOrder S; S.init(SEQ, 1024, F.G, F.bid);
        EpiSoftmax E{(bf16_t*)(F.ws + WS_XP), 1024, rsq1, 0.044194173824159216f}; pg8::gemm_phase<EpiSoftmax, false>(ring, g, S, E, F.wave); }
        if (F.G > 128 && F.bid >= 128) { const int lane_ = lane_id();
            const int rs = (F.G - 128) * NWAVES;
            for (int r = (F.bid - 128) * NWAVES + F.wave; r < QSPLIT; r += 4 * rs) quant_rows4(args.in[20], args.in[21], args.in[17], F.ws, r, rs, QSPLIT, lane_); }
    }
    SEAM(12); TEND(12);
    TBEG(13);
    if (IN(13)) { pg8::Gemm g{(const bf16_t*)(F.ws + WS_XP), (const bf16_t*)(F.ws + WS_WVO), SEQ, DM, 1024, 1024, 1024}; pg8::StaticOrder S; S.init(SEQ, DM, F.G, F.bid);
        EpiStaged<ResNormPiece<false>> E{{(const bf16_t*)(F.ws + WS_A1), (bf16_t*)(F.ws + WS_A2), rsq2}}; pg8::gemm_phase<EpiStaged<ResNormPiece<false>>, false>(ring, g, S, E, F.wave); }
    SEAM(13); TEND(13);
    TBEG(14);
    if (IN(14)) { pg8::Gemm g{(const bf16_t*)(F.ws + WS_A2), (const bf16_t*)(F.ws + WS_WPQ), SEQ, DM, DM, DM, DM}; pg8::StaticOrder S; S.init(SEQ, DM, F.G, F.bid);
        EpiPeerQ E{F.ws, rsq2, args.in[20], args.in[21], args.in[17], F.bid * NWAVES, NGW, (F.G > 128 ? QSPLIT : 0)}; pg8::gemm_phase<EpiPeerQ, false>(ring, g, S, E, F.wave); }
    SEAM(15); TEND(14);
    TBEG(16);
    if (IN(16)) { for (int t = gw; t < SEQ; t += NGW) peer_expert_token(F, args, t); }
    TEND(16);
#undef IN
#undef SEAM
#undef ROT
}

#ifndef MK_ONE_LAUNCH
#define MK_ONE_LAUNCH 1
#endif
extern "C" void kernel_launch(void* const* d_in, const int* in_sizes, int n_in, void* d_out, int out_size, void* d_ws, size_t ws_size, hipStream_t stream) {
    static int grid = 0;
    if (grid == 0) {
        if (n_in != 23 || out_size != SEQ * DM || ws_size < WS_END) { fprintf(stderr, "kernel_launch: unexpected problem (n_in %d, out %d, ws %zu < %zu)\n", n_in, out_size, ws_size, (size_t)WS_END); grid = -1; return; }
        int dev = 0, cus = 0, per_cu = 0;
        if (hipGetDevice(&dev) != hipSuccess || hipDeviceGetAttribute(&cus, hipDeviceAttributeMultiprocessorCount, dev) != hipSuccess) { grid = -1; return; }
        if (hipFuncSetAttribute((const void*)hybrid_fwd, hipFuncAttributeMaxDynamicSharedMemorySize, LDS_BYTES) != hipSuccess) { fprintf(stderr, "kernel_launch: hipFuncSetAttribute failed\n"); grid = -1; return; }
        if (hipOccupancyMaxActiveBlocksPerMultiprocessor(&per_cu, (const void*)hybrid_fwd, NTHREADS, LDS_BYTES) != hipSuccess || per_cu < 1) { fprintf(stderr, "kernel_launch: occupancy query says %d\n", per_cu); per_cu = 1; }
        (void)hipGetLastError();
        grid = cus;
    }
    if (grid < 0) return;
    (void)hipMemsetAsync((char*)d_ws + WS_CTL, 0, CTL_ZERO_BYTES, stream);
    Args a{};
    for (int i = 0; i < 23; ++i) a.in[i] = (const float*)d_in[i];
    a.out = (float*)d_out; a.ws = (unsigned char*)d_ws;
#if MK_ONE_LAUNCH
    a.ph_lo = 0; a.ph_hi = N_PHASES; a.use_bar = 1;
    void* kargs[] = {&a};
    hipError_t e = hipLaunchCooperativeKernel((const void*)hybrid_fwd, dim3(grid), dim3(NTHREADS), kargs, LDS_BYTES, stream);
    if (e != hipSuccess) fprintf(stderr, "cooperative launch failed: %s (grid %d)\n", hipGetErrorString(e), grid);
#else
    for (int p = 0; p < N_PHASES; ++p) { a.ph_lo = p; a.ph_hi = p + 1; a.use_bar = 0;
        hipLaunchKernelGGL(hybrid_fwd, dim3(grid), dim3(NTHREADS), LDS_BYTES, stream, a); }
#endif
}
```
